# Optimizing an MI355X kernel written in HIP

```python
import math
import jax
import jax.numpy as jnp
from jax import lax
import numpy as np

D_MODEL = 1024
BATCH = 4
SEQ = 4096
DEPTH = 4
DEC_BATCH = 8
DEC_SEQ = 64
PAST_LEN = 1024

CHUNK = 64
N_ATT_HEADS = 8
HEAD_DIM = 64
D_ATT = N_ATT_HEADS * HEAD_DIM
D_SSM = D_MODEL - D_ATT
D_MIX = D_ATT + D_SSM
SSM_GROUP = 16
N_SSM_GROUPS = D_SSM // SSM_GROUP
SSM_STATE = 64
D_FF = ((8 * D_MODEL + 3 * 256 - 1) // (3 * 256)) * 256
D_IN = 3 * D_ATT + N_ATT_HEADS + D_SSM
Q_BLOCK = 128
FORGET_BIAS_INIT = 2.0
EPS = 1e-6

kernel_name = "fox_s5_hybrid_stream_step"


def _rmsnorm(x, g):
    x32 = x.astype(jnp.float32)
    y = x32 * lax.rsqrt(jnp.mean(x32 * x32, axis=-1, keepdims=True) + EPS) * g.astype(jnp.float32)
    return y.astype(x.dtype)


def _heads(t):
    b, n, _ = t.shape
    return t.reshape(b, n, N_ATT_HEADS, HEAD_DIM).transpose(0, 2, 1, 3)


def _fox_attention(q, k, v, f_q, f_k, q_pos, k_pos):
    s = jnp.einsum("bhqd,bhkd->bhqk", q, k).astype(jnp.float32) * (HEAD_DIM ** -0.5)
    s = s + f_q[..., :, None] - f_k[..., None, :]
    s = jnp.where(k_pos[None, :] <= q_pos[:, None], s, -jnp.inf)
    p = jax.nn.softmax(s, axis=-1)
    return jnp.einsum("bhqk,bhkd->bhqd", p.astype(v.dtype), v)


def _fox_prompt(q, k, v, logf):
    b, h, s, d = q.shape
    nb = s // Q_BLOCK
    f_cum = jnp.cumsum(logf, axis=-1)
    pos = jnp.arange(s)
    qb = q.reshape(b, h, nb, Q_BLOCK, d).transpose(2, 0, 1, 3, 4)
    fb = f_cum.reshape(b, h, nb, Q_BLOCK).transpose(2, 0, 1, 3)
    pb = pos.reshape(nb, Q_BLOCK)
    out = lax.map(lambda a: _fox_attention(a[0], k, v, a[1], f_cum, a[2], pos), (qb, fb, pb))
    return out.transpose(1, 2, 0, 3, 4).reshape(b, h, s, d)


def _ssm_combine(left, right):
    a_l, b_l = left
    a_r, b_r = right
    return (a_l * a_r, a_r * b_l + b_r)


def _s5_mix(u, p, h0):
    bsz, t, _ = u.shape
    f32 = jnp.float32
    u32 = u.astype(f32).reshape(bsz, t, N_SSM_GROUPS, SSM_GROUP)
    lam = lax.complex(p["ssm_a_re"].astype(f32), p["ssm_a_im"].astype(f32))
    dt = jnp.exp(p["ssm_log_dt"].astype(f32))[:, None]
    a_bar = jnp.exp(lam * dt)
    b_c = lax.complex(p["ssm_b_re"].astype(f32), p["ssm_b_im"].astype(f32))
    b_bar = ((a_bar - 1.0) / lam)[..., None] * b_c
    bu = jnp.einsum("btgm,gpm->btgp", u32.astype(jnp.complex64), b_bar)
    if h0 is not None:
        bu = bu.at[:, 0].add(a_bar[None] * h0)
    a_seq = jnp.broadcast_to(a_bar, bu.shape)
    _, h = lax.associative_scan(_ssm_combine, (a_seq, bu), axis=1)
    c_c = lax.complex(p["ssm_c_re"].astype(f32), p["ssm_c_im"].astype(f32))
    y = jnp.einsum("btgp,gmp->btgm", h, c_c).real
    y = y + p["ssm_d"].astype(f32).reshape(N_SSM_GROUPS, SSM_GROUP) * u32
    z = jax.nn.gelu(y.reshape(bsz, t, D_SSM))
    out = z * jax.nn.sigmoid(z @ p["w_glu"].astype(f32))
    return out.astype(u.dtype), h[:, -1]


def _layer(x, c, p, past):
    bsz, t, _ = x.shape
    mod = jax.nn.silu(c) @ p["w_ada"] + p["b_ada"]
    sh1, sc1, g1, sh2, sc2, g2 = jnp.split(mod[:, None, :], 6, axis=-1)
    hm = _rmsnorm(x, p["g_pre_mix"]) * (1.0 + sc1) + sh1
    proj = hm @ p["w_in"]
    q = _heads(proj[..., :D_ATT])
    k = _heads(proj[..., D_ATT:2 * D_ATT])
    v = _heads(proj[..., 2 * D_ATT:3 * D_ATT])
    gate_logit = proj[..., 3 * D_ATT:3 * D_ATT + N_ATT_HEADS].astype(jnp.float32)
    logf = jax.nn.log_sigmoid(gate_logit + p["b_forget"].astype(jnp.float32)).transpose(0, 2, 1)
    u = proj[..., 3 * D_ATT + N_ATT_HEADS:]
    if past is None:
        att = _fox_prompt(q, k, v, logf)
        h0 = None
    else:
        k_past, v_past, logf_past, h0_re, h0_im = past
        n_past = k_past.shape[2]
        k_all = jnp.concatenate([k_past.astype(k.dtype), k], axis=2)
        v_all = jnp.concatenate([v_past.astype(v.dtype), v], axis=2)
        f_cum = jnp.cumsum(jnp.concatenate([logf_past.astype(jnp.float32), logf], axis=-1), axis=-1)
        att = _fox_attention(q, k_all, v_all, f_cum[..., n_past:], f_cum,
                             n_past + jnp.arange(t), jnp.arange(n_past + t))
        h0 = lax.complex(h0_re.astype(jnp.float32), h0_im.astype(jnp.float32))
    ssm_out, h_last = _s5_mix(u, p, h0)
    mix = jnp.concatenate([att.transpose(0, 2, 1, 3).reshape(bsz, t, D_ATT), ssm_out], axis=-1)
    x = x + g1 * _rmsnorm(mix @ p["w_out"], p["g_post_mix"])
    hf = _rmsnorm(x, p["g_pre_ffn"]) * (1.0 + sc2) + sh2
    f = (jax.nn.silu(hf @ p["w_gate"]) * (hf @ p["w_up"])) @ p["w_down"]
    x = x + g2 * _rmsnorm(f, p["g_post_ffn"])
    return x, (k, v, logf, h_last.real, h_last.imag)


def setup_inputs(seed: int = 0) -> dict:
    key = jax.random.key(seed)
    ks = jax.random.split(key, 32)
    f32 = jnp.float32

    def nrm(k, shape, scale):
        return jax.random.normal(k, shape, f32) * scale

    n_idx = jnp.arange(SSM_STATE, dtype=f32)
    G, P, M = N_SSM_GROUPS, SSM_STATE, SSM_GROUP
    return {
        "x_prompt": nrm(ks[0], (BATCH, SEQ, D_MODEL), 1.0),
        "x_sample": nrm(ks[1], (DEC_BATCH, DEC_SEQ, D_MODEL), 1.0),
        "c_prompt": nrm(ks[2], (BATCH, D_MODEL), 1.0),
        "c_sample": nrm(ks[3], (DEC_BATCH, D_MODEL), 1.0),
        "cache_k": nrm(ks[4], (DEPTH, DEC_BATCH, N_ATT_HEADS, PAST_LEN, HEAD_DIM), 1.0),
        "cache_v": nrm(ks[5], (DEPTH, DEC_BATCH, N_ATT_HEADS, PAST_LEN, HEAD_DIM), 1.0),
        "cache_logf": jax.nn.log_sigmoid(FORGET_BIAS_INIT + nrm(ks[6], (DEPTH, DEC_BATCH, N_ATT_HEADS, PAST_LEN), 0.5)),
        "state_ssm_re": nrm(ks[7], (DEPTH, DEC_BATCH, G, P), 0.5),
        "state_ssm_im": nrm(ks[8], (DEPTH, DEC_BATCH, G, P), 0.5),
        "w_ada": nrm(ks[9], (DEPTH, D_MODEL, 6 * D_MODEL), D_MODEL ** -0.5),
        "b_ada": nrm(ks[10], (DEPTH, 6 * D_MODEL), 0.02),
        "g_pre_mix": 1.0 + nrm(ks[11], (DEPTH, D_MODEL), 0.02),
        "g_post_mix": 1.0 + nrm(ks[12], (DEPTH, D_MODEL), 0.02),
        "g_pre_ffn": 1.0 + nrm(ks[13], (DEPTH, D_MODEL), 0.02),
        "g_post_ffn": 1.0 + nrm(ks[14], (DEPTH, D_MODEL), 0.02),
        "w_in": nrm(ks[15], (DEPTH, D_MODEL, D_IN), D_MODEL ** -0.5),
        "b_forget": FORGET_BIAS_INIT + nrm(ks[16], (DEPTH, N_ATT_HEADS), 0.1),
        "ssm_a_re": -0.5 + nrm(ks[17], (DEPTH, G, P), 0.01),
        "ssm_a_im": math.pi * n_idx + nrm(ks[18], (DEPTH, G, P), 0.01),
        "ssm_log_dt": jax.random.uniform(ks[19], (DEPTH, G), f32, math.log(1e-3), math.log(1e-1)),
        "ssm_b_re": nrm(ks[20], (DEPTH, G, P, M), (2 * M) ** -0.5),
        "ssm_b_im": nrm(ks[21], (DEPTH, G, P, M), (2 * M) ** -0.5),
        "ssm_c_re": nrm(ks[22], (DEPTH, G, M, P), P ** -0.5),
        "ssm_c_im": nrm(ks[23], (DEPTH, G, M, P), P ** -0.5),
        "ssm_d": nrm(ks[24], (DEPTH, D_SSM), 1.0),
        "w_glu": nrm(ks[25], (DEPTH, D_SSM, D_SSM), D_SSM ** -0.5),
        "w_out": nrm(ks[26], (DEPTH, D_MIX, D_MODEL), D_MIX ** -0.5),
        "w_gate": nrm(ks[27], (DEPTH, D_MODEL, D_FF), D_MODEL ** -0.5),
        "w_up": nrm(ks[28], (DEPTH, D_MODEL, D_FF), D_MODEL ** -0.5),
        "w_down": nrm(ks[29], (DEPTH, D_FF, D_MODEL), D_FF ** -0.5),
    }


def reference(x_prompt, x_sample, c_prompt, c_sample, cache_k, cache_v, cache_logf,
              state_ssm_re, state_ssm_im, w_ada, b_ada, g_pre_mix, g_post_mix, g_pre_ffn,
              g_post_ffn, w_in, b_forget, ssm_a_re, ssm_a_im, ssm_log_dt, ssm_b_re, ssm_b_im,
              ssm_c_re, ssm_c_im, ssm_d, w_glu, w_out, w_gate, w_up, w_down):
    yp, ys = x_prompt, x_sample
    kp, vp, lp, rp, ip = [], [], [], [], []
    ks_, vs_, ls_, rs_, is_ = [], [], [], [], []
    for l in range(DEPTH):
        p = {
            "w_ada": w_ada[l], "b_ada": b_ada[l],
            "g_pre_mix": g_pre_mix[l], "g_post_mix": g_post_mix[l],
            "g_pre_ffn": g_pre_ffn[l], "g_post_ffn": g_post_ffn[l],
            "w_in": w_in[l], "b_forget": b_forget[l],
            "ssm_a_re": ssm_a_re[l], "ssm_a_im": ssm_a_im[l], "ssm_log_dt": ssm_log_dt[l],
            "ssm_b_re": ssm_b_re[l], "ssm_b_im": ssm_b_im[l],
            "ssm_c_re": ssm_c_re[l], "ssm_c_im": ssm_c_im[l], "ssm_d": ssm_d[l],
            "w_glu": w_glu[l], "w_out": w_out[l],
            "w_gate": w_gate[l], "w_up": w_up[l], "w_down": w_down[l],
        }
        yp, (k1, v1, l1, r1, i1) = _layer(yp, c_prompt, p, None)
        ys, (k2, v2, l2, r2, i2) = _layer(ys, c_sample, p, (cache_k[l], cache_v[l], cache_logf[l],
                                                            state_ssm_re[l], state_ssm_im[l]))
        kp.append(k1); vp.append(v1); lp.append(l1); rp.append(r1); ip.append(i1)
        ks_.append(k2); vs_.append(v2); ls_.append(l2); rs_.append(r2); is_.append(i2)
    return (yp, ys,
            jnp.stack(kp), jnp.stack(vp), jnp.stack(lp), jnp.stack(rp), jnp.stack(ip),
            jnp.stack(ks_), jnp.stack(vs_), jnp.stack(ls_), jnp.stack(rs_), jnp.stack(is_))
```

```cpp
#include <hip/hip_runtime.h>
#include <hip/hip_cooperative_groups.h>
#include <cstdio>
#include <cstdint>
namespace cg = cooperative_groups;

#define LAS __attribute__((address_space(3)))
typedef unsigned short bf16_t;
typedef short bf16x8 __attribute__((ext_vector_type(8)));
typedef float f32x4 __attribute__((ext_vector_type(4)));
typedef float f32x16 __attribute__((ext_vector_type(16)));
typedef float f32x8 __attribute__((ext_vector_type(8)));
typedef unsigned u32x4 __attribute__((ext_vector_type(4)));
typedef unsigned u32x2 __attribute__((ext_vector_type(2)));

constexpr int DM = 1024, NPR = 16384, NSM = 512, MT = 16896, NL = 4, NH = 8, HD = 64;
constexpr int SEQ = 4096, PAST = 1024, DSEQ = 64, KVS = 1088, DFF = 2816, DIN = 2056;
constexpr int NG = 32, NP = 64, MG = 16, LC = 16, NCH = MT / LC  , CHP = 1280  , UAK = 384;
constexpr float C2 = 0.125f * 1.4426950408889634f, LOG2E = 1.4426950408889634f, EPS = 1e-6f;
constexpr size_t O_YP = 0, O_KP = 17301504, O_VP = 50855936, O_LP = 84410368, O_RP = 84934656, O_IP = 84967424,
                 O_KS = 85000192, O_VS = 86048768, O_LS = 87097344, O_RS = 87113728, O_IS = 87179264, O_END = 87244800;
constexpr size_t MiB = 1u << 20;
constexpr size_t WS_CTL = 1536 * 1024, CTL_BYTES = 16384;
constexpr int LDS_MISC = 131072 + 64;
constexpr size_t WS_MOD = 0, WS_WG = 2 * MiB, WS_A16 = 2 * MiB + 256 * 1024, WS_BIASP = 3 * MiB, WS_BIASS = 3 * MiB + 512 * 1024, WS_KMAX = 2 * MiB + 384 * 1024;
constexpr size_t WS_WIN = 4 * MiB, WS_WV = 16 * MiB, WS_WGLU = 20 * MiB, WS_WOUT = 22 * MiB, WS_WGU = 30 * MiB, WS_WD = 74 * MiB;
constexpr size_t WS_BT3 = 96 * MiB, WS_BT1 = 120 * MiB, WS_HM = 130 * MiB, WS_X = 164 * MiB, WS_F1 = 230 * MiB, WS_MIX = 264 * MiB;
constexpr size_t WS_Q = 298 * MiB, WS_KP = 315 * MiB, WS_VTP = 331 * MiB, WS_KS = 347 * MiB, WS_VTS = 356 * MiB, WS_UA = 365 * MiB,
                 WS_E = 395 * MiB, WS_Z = 415 * MiB, WS_H = 298 * MiB, WS_FS1 = 435 * MiB, WS_FS2 = 443 * MiB, WS_END = 465 * MiB;
constexpr int LDS_BYTES = 151552;
#ifndef PH_MASK
#define PH_MASK 0xffffffffu
#endif
#define PH(k) if (PH_MASK & (1u << (k)))

__device__ __forceinline__ unsigned cvt_pk_bf16(float lo, float hi) { unsigned r; asm volatile("v_cvt_pk_bf16_f32 %0, %1, %2" : "=v"(r) : "v"(lo), "v"(hi)); return r; }
__device__ __forceinline__ bf16_t f2bf(float f) { return (bf16_t)(cvt_pk_bf16(f, 0.f) & 0xffffu); }
__device__ __forceinline__ float bf2f(unsigned short b) { return __uint_as_float(((unsigned)b) << 16); }
__device__ __forceinline__ int opq(int x) { asm volatile("" : "+v"(x)); return x; }
__device__ __forceinline__ float bperm(float v, int srclane) { return __int_as_float(__builtin_amdgcn_ds_bpermute(srclane << 2, __float_as_int(v))); }
__device__ __forceinline__ float dpp_f(float v, const int ctrl) { return v; }
#define DPPADD(v, ctrl) v += __int_as_float(__builtin_amdgcn_update_dpp(0, __float_as_int(v), ctrl, 0xF, 0xF, true))
__device__ __forceinline__ float wave_sum(float v, int ln) {
    (void)ln;
    DPPADD(v, 0xB1);
    DPPADD(v, 0x4E);
    DPPADD(v, 0x141);
    DPPADD(v, 0x140);
    const float r0 = __int_as_float(__builtin_amdgcn_readlane(__float_as_int(v), 0)), r1 = __int_as_float(__builtin_amdgcn_readlane(__float_as_int(v), 16));
    const float r2 = __int_as_float(__builtin_amdgcn_readlane(__float_as_int(v), 32)), r3 = __int_as_float(__builtin_amdgcn_readlane(__float_as_int(v), 48));
    return (r0 + r1) + (r2 + r3);
}
__device__ __forceinline__ float sigm(float x) { return __builtin_amdgcn_rcpf(1.f + __builtin_amdgcn_exp2f(-1.4426950408889634f * x)); }
__device__ __forceinline__ float silu_f(float x) { return x * sigm(x); }
__device__ __forceinline__ float gelu_f(float x) { const float u = 0.7978845608028654f * (x + 0.044715f * x * x * x); return x * sigm(2.f * u); }
__device__ __forceinline__ float logsig(float x) { return fminf(x, 0.f) - log1pf(__expf(-fabsf(x))); }

namespace pg8 {
constexpr int BM = 256, BK = 64, HALF = 128, HTB = HALF * BK * 2, STAGE_BYTES = 8 * HTB, NXCD = 8, WGM = 8;
__host__ __device__ __forceinline__ int lds_byte(int r, int c) { const int st = (r >> 4) * 2 + (c >> 5), rr = r & 15, cc = c & 31, ob = rr * 64 + cc * 2; return st * 1024 + (ob ^ (((ob >> 9) & 1) << 5)); }
__host__ __device__ __forceinline__ void stage_rc(int b, int& R, int& C) { const int st = b / 1024, sb = b % 1024, swz = sb ^ (((sb >> 9) & 1) << 5); R = (st >> 1) * 16 + swz / 64; C = (st & 1) * 32 + (swz % 64) / 2; }
__host__ __device__ __forceinline__ int perm32(int rho) { const int n = rho >> 4, i = rho & 15; return 8 * (i >> 2) + 4 * n + (i & 3); }
struct Unit { int pm, pn, ks, kind, nt; };
struct Gemm { const bf16_t* A; const bf16_t* Bt; int M, N, K, lda, ldb, gdiv; size_t gstrideB; unsigned kcb; const bf16_t* A1; const bf16_t* Bt1; };
struct StaticOrder {
    int nM, nN, nwg, G, c;
    __device__ __forceinline__ void init(int M, int N, int G_, int c_) { nM = M / BM; nN = N / BM; nwg = nM * nN; G = G_; c = c_; }
    __device__ __forceinline__ bool next(int i, Unit& u) const {
        const long L = (long)i * G + c; if (L >= nwg) return false;
        int wgid = (int)L; { const int q = nwg / NXCD, r = nwg % NXCD, xcd = wgid % NXCD, off = wgid / NXCD; wgid = (xcd < r ? xcd * (q + 1) : r * (q + 1) + (xcd - r) * q) + off; }
        const int nig = WGM * nN, gid = wgid / nig, fm = gid * WGM, gsz = (nM - fm) < WGM ? (nM - fm) : WGM;
        u.pm = fm + ((wgid % nig) % gsz); u.pn = (wgid % nig) / gsz; u.ks = 0; u.kind = 0; u.nt = 0; return true;
    }
};
struct SplitOrder {
    int nsub, G, c, S;
    __device__ __forceinline__ void init(int S_, int G_, int c_) { S = S_; nsub = 8 * S_; G = G_; c = c_; }
    __device__ __forceinline__ bool next(int i, Unit& u) const { const int idx = i * G + c; if (idx >= nsub) return false; u.ks = idx % S; const int t = idx / S; u.pn = t & 3; u.pm = 64 + (t >> 2); u.kind = 0; u.nt = 0; return true; }
};
struct VtOrder {
    int idx;
    __device__ __forceinline__ void init(int G_, int c_) { idx = c_ - (G_ - 116); }
    __device__ __forceinline__ bool next(int i, Unit& u) const { if (i != 0 || idx < 0 || idx >= 116) return false; u.pm = idx / 58; u.pn = idx - u.pm * 58; u.ks = 0; u.kind = 0; u.nt = 0; return true; }
};
struct VtSplitOrder {
    int c;
    __device__ __forceinline__ void init(int c_) { c = c_; }
    __device__ __forceinline__ bool next(int i, Unit& u) const { if (i != 0 || c >= 64) return false; const int tile = c >> 2; u.ks = c & 3; u.pm = tile >> 3; u.pn = 58 + (tile & 7); u.kind = 0; u.nt = 0; return true; }
};
struct PhaseAOrder {
    StaticOrder so; int c;
    __device__ __forceinline__ void init(int G_, int c_) { so.init(MT, 1536, G_, c_); c = c_; }
    __device__ __forceinline__ bool next(int i, Unit& u) const {
        Unit t = {0, 0, 0, 0, 0}; bool ok = false;
        if (i <= 1) ok = so.next(i, t);
        int pm = t.pm, pn = t.pn, ks = 0, kind = 0, nt = 0;
        if (i == 1 && !ok) { const int idx = c - 140; ok = idx >= 0 && idx < 116; pm = idx / 58; pn = idx - pm * 58; kind = 1; nt = 16; }
        if (i == 2) { ok = c < 64; const int tile = c >> 2; ks = c & 3; pm = tile >> 3; pn = 58 + (tile & 7); kind = 1; nt = 4; }
        u.pm = pm; u.pn = pn; u.ks = ks; u.kind = kind; u.nt = nt;
        return ok;
    }
};
struct MainSplitOrder {
    StaticOrder so; int c, S, nts;
    __device__ __forceinline__ void init(int G_, int c_, int S_, int nts_) { so.init(NPR, 1024, G_, c_); c = c_; S = S_; nts = nts_; }
    __device__ __forceinline__ bool next(int i, Unit& u) const {
        Unit t = {0, 0, 0, 0, 0}; bool ok = false;
        if (i == 0) ok = so.next(0, t);
        int pm = t.pm, pn = t.pn, ks = 0, nt = 0;
        if (i == 1) { ok = c < 8 * S; ks = c % S; const int tt = c / S; pn = tt & 3; pm = 64 + (tt >> 2); nt = nts; }
        u.pm = pm; u.pn = pn; u.ks = ks; u.kind = 0; u.nt = nt;
        return ok;
    }
};
template <class Epi, class Sched>
__device__ __forceinline__ void gemm_phase(LAS unsigned char* lds, const Gemm g, const Sched& S, const Epi& E, const int wave_id) {
    const int lane = (int)__builtin_amdgcn_mbcnt_hi(~0u, __builtin_amdgcn_mbcnt_lo(~0u, (unsigned)opq(0))), wid = wave_id, tid = wid * 64 + lane, wr = wid >> 2, wc = wid & 3, fr = lane & 15, fq = lane >> 4;
    unsigned voffA[2], voffB[2];
#pragma unroll
    for (int i = 0; i < 2; ++i) { int R, C; stage_rc(tid * 16 + i * 8192, R, C); const int Rb = (R & ~31) + perm32(R & 31);
        voffA[i] = (unsigned)(R * g.lda + C) * 2u; voffB[i] = (unsigned)(Rb * g.ldb + C) * 2u; }
    const unsigned kstep = (unsigned)(BK * 2);
    const unsigned hstepA = (unsigned)HALF * g.lda * 2, hstepB = (unsigned)HALF * g.ldb * 2, tstepA = 2 * hstepA, tstepB = 2 * hstepB;
    const unsigned ldsw = (unsigned)wid * 1024u;
    const int aoff = lds_byte(wr * 64 + fr, fq * 8), boff = lds_byte(wc * 32 + fr, fq * 8);
#define PG8_SA(b, h) (((b) * 2 + (h)) * HTB)
#define PG8_SB(b, h) ((4 + (b) * 2 + (h)) * HTB)
#define PG8_STAGE(bufoff, gbase, voff) do { _Pragma("unroll") for (int _i = 0; _i < 2; ++_i) \
        __builtin_amdgcn_global_load_lds((const unsigned*)((const char*)(gbase) + (voff)[_i]), (LAS unsigned*)(lds + (bufoff) + ldsw + _i * 8192), 16, 0, 0); } while (0)
#define PG8_LDA(dst, b, h) do { _Pragma("unroll") for (int m = 0; m < 4; ++m) _Pragma("unroll") for (int k = 0; k < 2; ++k) dst[m][k] = *(const LAS bf16x8*)(lds + PG8_SA(b, h) + aoff + m * 2048 + k * 1024); } while (0)
#define PG8_LDB(dst, b, h) do { _Pragma("unroll") for (int n = 0; n < 2; ++n) _Pragma("unroll") for (int k = 0; k < 2; ++k) dst[n][k] = *(const LAS bf16x8*)(lds + PG8_SB(b, h) + boff + n * 2048 + k * 1024); } while (0)
#define PG8_MMA(ai, bj, At, Bt) do { __builtin_amdgcn_s_setprio(1); _Pragma("unroll") for (int m = 0; m < 4; ++m) _Pragma("unroll") for (int n = 0; n < 2; ++n) _Pragma("unroll") for (int k = 0; k < 2; ++k) \
        acc[ai][bj][m][n] = __builtin_amdgcn_mfma_f32_16x16x32_bf16(Bt[n][k], At[m][k], acc[ai][bj][m][n], 0, 0, 0); __builtin_amdgcn_s_setprio(0); } while (0)
#define PG8_WAIT_V(n) asm volatile("s_waitcnt vmcnt(" #n ")" ::: "memory")
#define PG8_WAIT_L(n) asm volatile("s_waitcnt lgkmcnt(" #n ")" ::: "memory")
#define PG8_BAR __builtin_amdgcn_s_barrier()
#define PG8_SCHED __builtin_amdgcn_sched_barrier(0)
    Unit cur = {0, 0, 0, 0, 0}, nxt = {0, 0, 0, 0, 0}; int ui = 0;
    if (!S.next(0, cur)) return;
    f32x4 acc[2][2][4][2];
    const float zf = __int_as_float(opq(0)); const f32x4 zero4 = (f32x4){zf, zf, zf, zf};
#pragma unroll
    for (int a = 0; a < 2; ++a)
#pragma unroll
        for (int b = 0; b < 2; ++b)
#pragma unroll
            for (int m = 0; m < 4; ++m)
#pragma unroll
                for (int n = 0; n < 2; ++n) acc[a][b][m][n] = zero4;
    bf16x8 At[4][2], B0[2][2], B1[2][2];
    const char* cA = (const char*)(cur.kind ? g.A1 : g.A) + (size_t)cur.pm * tstepA + (size_t)cur.ks * g.kcb;
    const char* cB = (const char*)(cur.kind ? g.Bt1 : g.Bt) + (size_t)(cur.pm / g.gdiv) * g.gstrideB * 2 + (size_t)cur.pn * tstepB + (size_t)cur.ks * g.kcb;
    int nt = cur.nt ? cur.nt : g.K / BK;
    PG8_STAGE(PG8_SB(0, 0), cB, voffB); PG8_STAGE(PG8_SB(0, 1), cB + hstepB, voffB); PG8_STAGE(PG8_SA(0, 0), cA, voffA); PG8_STAGE(PG8_SA(0, 1), cA + hstepA, voffA);
    if (wr == 1) PG8_BAR;
    PG8_WAIT_V(2); PG8_BAR;
    PG8_STAGE(PG8_SB(1, 0), cB + kstep, voffB); PG8_STAGE(PG8_SA(1, 0), cA + kstep, voffA); PG8_STAGE(PG8_SB(1, 1), cB + hstepB + kstep, voffB);
    PG8_WAIT_V(6); PG8_BAR;
    for (;;) {
        nxt.pm = 0; nxt.pn = 0; nxt.ks = 0; nxt.kind = 0; nxt.nt = 0;
        const bool has_next = S.next(ui + 1, nxt);
        const char* nA = has_next ? (const char*)(nxt.kind ? g.A1 : g.A) + (size_t)nxt.pm * tstepA + (size_t)nxt.ks * g.kcb : cA;
        const char* nB = has_next ? (const char*)(nxt.kind ? g.Bt1 : g.Bt) + (size_t)(nxt.pm / g.gdiv) * g.gstrideB * 2 + (size_t)nxt.pn * tstepB + (size_t)nxt.ks * g.kcb : cB;
#pragma unroll 1
        for (int t = 0; t < nt; t += 2) {
            const bool last = (t == nt - 2);
            const char* a1 = cA + (unsigned)(t + 1) * kstep;
            const char* a2 = last ? nA : cA + (unsigned)(t + 2) * kstep; const char* b2 = last ? nB : cB + (unsigned)(t + 2) * kstep;
            const char* a3 = a2 + kstep; const char* b3 = b2 + kstep;
            PG8_LDB(B0, 0, 0); PG8_LDB(B1, 0, 1); PG8_SCHED; PG8_LDA(At, 0, 0); PG8_STAGE(PG8_SA(1, 1), a1 + hstepA, voffA);
            PG8_WAIT_V(8); PG8_WAIT_L(0); PG8_BAR; PG8_MMA(0, 0, At, B0); PG8_MMA(0, 1, At, B1); PG8_BAR; PG8_SCHED;
            PG8_LDA(At, 0, 1); PG8_STAGE(PG8_SB(0, 0), b2, voffB); PG8_STAGE(PG8_SB(0, 1), b2 + hstepB, voffB); PG8_STAGE(PG8_SA(0, 0), a2, voffA);
            PG8_WAIT_V(8); PG8_WAIT_L(0); PG8_BAR; PG8_MMA(1, 0, At, B0); PG8_MMA(1, 1, At, B1); PG8_BAR; PG8_SCHED;
            PG8_LDB(B0, 1, 0); PG8_LDB(B1, 1, 1); PG8_SCHED; PG8_LDA(At, 1, 0); PG8_STAGE(PG8_SA(0, 1), a2 + hstepA, voffA);
            PG8_WAIT_V(8); PG8_WAIT_L(0); PG8_BAR; PG8_MMA(0, 0, At, B0); PG8_MMA(0, 1, At, B1); PG8_BAR; PG8_SCHED;
            PG8_LDA(At, 1, 1); PG8_STAGE(PG8_SB(1, 0), b3, voffB); PG8_STAGE(PG8_SB(1, 1), b3 + hstepB, voffB); PG8_STAGE(PG8_SA(1, 0), a3, voffA);
            PG8_WAIT_V(8); PG8_WAIT_L(0); PG8_BAR; PG8_MMA(1, 0, At, B0); PG8_MMA(1, 1, At, B1); PG8_BAR; PG8_SCHED;
        }
        if (wr == 0) PG8_BAR;
        E(acc, cur, wr, wc, fr, fq);
        if (!has_next) break;
#pragma unroll
        for (int a = 0; a < 2; ++a)
#pragma unroll
            for (int b = 0; b < 2; ++b)
#pragma unroll
                for (int m = 0; m < 4; ++m)
#pragma unroll
                    for (int n = 0; n < 2; ++n) acc[a][b][m][n] = zero4;
        cur = nxt; cA = nA; cB = nB; ++ui; nt = cur.nt ? cur.nt : g.K / BK;
        if (wr == 1) PG8_BAR;
    }
    PG8_WAIT_V(0);
    PG8_BAR;
#undef PG8_SA
#undef PG8_SB
#undef PG8_STAGE
#undef PG8_LDA
#undef PG8_LDB
#undef PG8_MMA
#undef PG8_WAIT_V
#undef PG8_WAIT_L
#undef PG8_BAR
#undef PG8_SCHED
}
}
using pg8::Unit;
typedef const f32x4 (&AccRef)[2][2][4][2];
__device__ __forceinline__ u32x4 pack8(f32x4 v0, f32x4 v1) { u32x4 w; w.x = cvt_pk_bf16(v0[0], v0[1]); w.y = cvt_pk_bf16(v0[2], v0[3]); w.z = cvt_pk_bf16(v1[0], v1[1]); w.w = cvt_pk_bf16(v1[2], v1[3]); return w; }

struct EpiPlain {
    bf16_t* O; int ldc;
    __device__ __forceinline__ void operator()(AccRef acc, const Unit& u, int wr, int wc, int fr, int fq) const {
        fr = opq(fr); fq = opq(fq);
#pragma unroll
        for (int ai = 0; ai < 2; ++ai)
#pragma unroll
            for (int m = 0; m < 4; ++m) { const int r = u.pm * 256 + ai * 128 + wr * 64 + m * 16 + fr;
#pragma unroll
                for (int bj = 0; bj < 2; ++bj) { const int c = u.pn * 256 + bj * 128 + wc * 32 + 8 * fq;
                    *(u32x4*)(O + (size_t)r * ldc + c) = pack8(acc[ai][bj][m][0], acc[ai][bj][m][1]); } }
    }
};
struct EpiIn {
    bf16_t *Q, *KP, *KS, *UA; float* out; int l;
    __device__ __forceinline__ void operator()(AccRef acc, const Unit& u, int wr, int wc, int fr, int fq) const {
        fr = opq(fr); fq = opq(fq);
        const bool prompt = u.pm < 64;
#pragma unroll
        for (int ai = 0; ai < 2; ++ai)
#pragma unroll
            for (int m = 0; m < 4; ++m) { const int r = u.pm * 256 + ai * 128 + wr * 64 + m * 16 + fr;
#pragma unroll
                for (int bj = 0; bj < 2; ++bj) { const int c = u.pn * 256 + bj * 128 + wc * 32 + 8 * fq;
                    const f32x4 v0 = acc[ai][bj][m][0], v1 = acc[ai][bj][m][1];
                    if (u.pn < 2) { *(u32x4*)(Q + (size_t)r * 512 + c) = pack8(v0 * C2, v1 * C2); }
                    else if (u.pn < 4) { const int ck = c - 512, h = ck >> 6, d = ck & 63; const u32x4 w = pack8(v0, v1);
                        if (prompt) { const int b = r >> 12, t = r & 4095;
                            *(u32x4*)(KP + ((size_t)(b * 8 + h) * 4096 + t) * 64 + d) = w;
                            float* o = out + O_KP + ((size_t)((l * 4 + b) * 8 + h) * 4096 + t) * 64 + d; *(f32x4*)o = v0; *(f32x4*)(o + 4) = v1; }
                        else { const int rr = r - NPR, b = rr >> 6, t = rr & 63;
                            *(u32x4*)(KS + ((size_t)(b * 8 + h) * KVS + PAST + t) * 64 + d) = w;
                            float* o = out + O_KS + ((size_t)((l * 8 + b) * 8 + h) * 64 + t) * 64 + d; *(f32x4*)o = v0; *(f32x4*)(o + 4) = v1; } }
                    else { const int cu = c - 1024, gq = cu >> 4, m0 = cu & 15, chunk = r >> 4, s = r & 15;
                        *(u32x4*)(UA + ((size_t)gq * CHP + chunk) * UAK + s * 16 + m0) = pack8(v0, v1); }
                    asm volatile("" ::: "memory"); } }
    }
};
struct EpiVT {
    bf16_t *VTP, *VTS; float* out; int l; LAS unsigned char* lds;
    __device__ __forceinline__ void operator()(AccRef acc, const Unit& u, int wr, int wc, int fr, int fq) const {
        fr = opq(fr); fq = opq(fq);
        const bool prompt = u.pn < 64; const int ln = fq * 16 + fr;
        LAS float* stg = (LAS float*)(lds + 131072 + 1024 + (wr * 4 + wc) * 2080);
#pragma unroll
        for (int ai = 0; ai < 2; ++ai)
#pragma unroll
            for (int bj = 0; bj < 2; ++bj) {
                const int h = (u.pm * 256 + ai * 128 + wr * 64) >> 6, tok0 = u.pn * 256 + bj * 128 + wc * 32;
                float* obase; bf16_t* vbase; size_t vpitch;
                if (prompt) { const int b = tok0 >> 12, t0 = tok0 & 4095; obase = out + O_VP + ((size_t)((l * 4 + b) * 8 + h) * 4096 + t0) * 64; vbase = VTP + (size_t)(b * 8 + h) * 64 * 4096 + t0; vpitch = 4096; }
                else { const int tt = tok0 - NPR, b = tt >> 6, t0 = tt & 63; obase = out + O_VS + ((size_t)((l * 8 + b) * 8 + h) * 64 + t0) * 64; vbase = VTS + (size_t)(b * 8 + h) * 64 * KVS + PAST + t0; vpitch = KVS; }
#pragma unroll
                for (int m = 0; m < 4; ++m) *(u32x4*)(vbase + (size_t)(m * 16 + fr) * vpitch + 8 * fq) = pack8(acc[ai][bj][m][0], acc[ai][bj][m][1]);
#pragma unroll
                for (int n = 0; n < 2; ++n)
#pragma unroll
                    for (int j0 = 0; j0 < 4; j0 += 2) {
#pragma unroll
                        for (int m = 0; m < 4; ++m) { stg[(2 * fq) * 65 + 16 * m + fr] = acc[ai][bj][m][n][j0]; stg[(2 * fq + 1) * 65 + 16 * m + fr] = acc[ai][bj][m][n][j0 + 1]; }
                        asm volatile("s_waitcnt lgkmcnt(0)" ::: "memory");
#pragma unroll
                        for (int sl = 0; sl < 8; ++sl) { const float v = stg[sl * 65 + ln]; obase[(size_t)(8 * (sl >> 1) + 4 * n + j0 + (sl & 1)) * 64 + ln] = v; }
                        asm volatile("s_waitcnt lgkmcnt(0)" ::: "memory");
                    }
            }
    }
};
struct EpiVtPart {
    float* PV;
    __device__ __forceinline__ void operator()(AccRef acc, const Unit& u, int wr, int wc, int fr, int fq) const {
        fr = opq(fr); fq = opq(fq);
        float* base = PV + (size_t)((u.pm * 8 + (u.pn - 58)) * 4 + u.ks) * 65536;
#pragma unroll
        for (int ai = 0; ai < 2; ++ai)
#pragma unroll
            for (int m = 0; m < 4; ++m) { const int r = ai * 128 + wr * 64 + m * 16 + fr;
#pragma unroll
                for (int bj = 0; bj < 2; ++bj) { float* o = base + r * 256 + bj * 128 + wc * 32 + 8 * fq; *(f32x4*)o = acc[ai][bj][m][0]; *(f32x4*)(o + 4) = acc[ai][bj][m][1]; } }
    }
};
struct EpiE {
    float* E;
    __device__ __forceinline__ void operator()(AccRef acc, const Unit& u, int wr, int wc, int fr, int fq) const {
        fr = opq(fr); fq = opq(fq);
#pragma unroll
        for (int ai = 0; ai < 2; ++ai)
#pragma unroll
            for (int m = 0; m < 4; ++m) { const int gq = u.pm / 5, chunk = (u.pm - gq * 5) * 256 + ai * 128 + wr * 64 + m * 16 + fr;
                { float* o = E + ((size_t)gq * CHP + chunk) * 128 + wc * 32 + 8 * fq; *(f32x4*)o = acc[ai][0][m][0]; *(f32x4*)(o + 4) = acc[ai][0][m][1]; } }
    }
};
struct EpiZ {
    bf16_t* Z;
    __device__ __forceinline__ void operator()(AccRef acc, const Unit& u, int wr, int wc, int fr, int fq) const {
        fr = opq(fr); fq = opq(fq);
#pragma unroll
        for (int ai = 0; ai < 2; ++ai)
#pragma unroll
            for (int m = 0; m < 4; ++m) { const int gq = u.pm / 5, chunk = (u.pm - gq * 5) * 256 + ai * 128 + wr * 64 + m * 16 + fr;
                {
#pragma unroll
                    for (int bj = 0; bj < 2; ++bj) { const int n = bj * 128 + wc * 32 + 8 * fq, t = n >> 4, m0 = n & 15;
                        f32x4 v0 = acc[ai][bj][m][0], v1 = acc[ai][bj][m][1];
#pragma unroll
                        for (int j = 0; j < 4; ++j) { v0[j] = gelu_f(v0[j]); v1[j] = gelu_f(v1[j]); }
                        *(u32x4*)(Z + (size_t)(chunk * 16 + t) * 512 + gq * 16 + m0) = pack8(v0, v1); __builtin_amdgcn_sched_barrier(0); } } }
    }
};
struct EpiGlu {
    const bf16_t* Z; bf16_t* MIX;
    __device__ __forceinline__ void operator()(AccRef acc, const Unit& u, int wr, int wc, int fr, int fq) const {
        fr = opq(fr); fq = opq(fq);
#pragma unroll
        for (int ai = 0; ai < 2; ++ai)
#pragma unroll
            for (int m = 0; m < 4; ++m) { const int r = u.pm * 256 + ai * 128 + wr * 64 + m * 16 + fr;
#pragma unroll
                for (int bj = 0; bj < 2; ++bj) { const int c = u.pn * 256 + bj * 128 + wc * 32 + 8 * fq;
                    const u32x4 zz = *(const u32x4*)(Z + (size_t)r * 512 + c);
                    f32x4 v0 = acc[ai][bj][m][0], v1 = acc[ai][bj][m][1];
#pragma unroll
                    for (int j = 0; j < 4; ++j) { const unsigned w0 = zz[j >> 1], w1 = zz[2 + (j >> 1)];
                        const float z0 = (j & 1) ? __uint_as_float(w0 & 0xffff0000u) : __uint_as_float(w0 << 16);
                        const float z1 = (j & 1) ? __uint_as_float(w1 & 0xffff0000u) : __uint_as_float(w1 << 16);
                        v0[j] = z0 * sigm(v0[j]); v1[j] = z1 * sigm(v1[j]); }
                    *(u32x4*)(MIX + (size_t)r * 1024 + 512 + c) = pack8(v0, v1); } }
    }
};
struct EpiAtomic {
    float* FS;
    __device__ __forceinline__ void operator()(AccRef acc, const Unit& u, int wr, int wc, int fr, int fq) const {
        fr = opq(fr); fq = opq(fq);
#pragma unroll
        for (int ai = 0; ai < 2; ++ai)
#pragma unroll
            for (int m = 0; m < 4; ++m) { const int r = (u.pm - 64) * 256 + ai * 128 + wr * 64 + m * 16 + fr;
#pragma unroll
                for (int bj = 0; bj < 2; ++bj) { float* o = FS + ((size_t)u.ks * 512 + r) * 1024 + u.pn * 256 + bj * 128 + wc * 32 + 8 * fq;
                    *(f32x4*)o = acc[ai][bj][m][0]; *(f32x4*)(o + 4) = acc[ai][bj][m][1]; } }
    }
};
struct EpiSwi {
    bf16_t* H;
    __device__ __forceinline__ void operator()(AccRef acc, const Unit& u, int wr, int wc, int fr, int fq) const {
        fr = opq(fr); fq = opq(fq);
#pragma unroll
        for (int ai = 0; ai < 2; ++ai)
#pragma unroll
            for (int m = 0; m < 4; ++m) { const int r = u.pm * 256 + ai * 128 + wr * 64 + m * 16 + fr; const int c = u.pn * 128 + wc * 32 + 8 * fq;
                f32x4 v0 = acc[ai][0][m][0], v1 = acc[ai][0][m][1]; const f32x4 u0 = acc[ai][1][m][0], u1 = acc[ai][1][m][1];
#pragma unroll
                for (int j = 0; j < 4; ++j) { v0[j] = silu_f(v0[j]) * u0[j]; v1[j] = silu_f(v1[j]) * u1[j]; }
                *(u32x4*)(H + (size_t)r * DFF + c) = pack8(v0, v1); }
    }
};

struct EpiA {
    EpiIn in; EpiVT vt; EpiVtPart vp;
    __device__ __forceinline__ void operator()(AccRef acc, const Unit& u, int wr, int wc, int fr, int fq) const {
        if (u.kind == 0) in(acc, u, wr, wc, fr, fq); else if (u.nt == 16) vt(acc, u, wr, wc, fr, fq); else vp(acc, u, wr, wc, fr, fq);
    }
};
struct EpiMS {
    EpiPlain p; EpiAtomic q;
    __device__ __forceinline__ void operator()(AccRef acc, const Unit& u, int wr, int wc, int fr, int fq) const {
        if (u.pm < 64) p(acc, u, wr, wc, fr, fq); else q(acc, u, wr, wc, fr, fq);
    }
};
struct Args { const float* in[30]; float* out; unsigned char* ws; };
struct Ctx {
    LAS unsigned char* lds; int tid, lane, wave, G, c;
    const float* const* in; float* out; unsigned char* ws;
};
#define INP(i) (a.in[i])

__device__ __forceinline__ void tr_item(const float* W, size_t ldw, int k0, int sc0, bf16_t* WT, size_t ldo, int dr0, LAS float* scr, int lane) {
    f32x4 tv[8];
#pragma unroll
    for (int i = 0; i < 8; ++i) { const int kk = 8 * i + (lane >> 3); tv[i] = *(const f32x4*)(W + (size_t)(k0 + kk) * ldw + sc0 + 4 * (lane & 7)); }
#pragma unroll
    for (int i = 0; i < 8; ++i) { const int kk = 8 * i + (lane >> 3); LAS float* d = scr + kk * 33 + 4 * (lane & 7); d[0] = tv[i][0]; d[1] = tv[i][1]; d[2] = tv[i][2]; d[3] = tv[i][3]; }
    asm volatile("s_waitcnt lgkmcnt(0)" ::: "memory");
    const int c = lane & 7;
#pragma unroll
    for (int j = 0; j < 4; ++j) { const int n = (lane >> 3) + 8 * j; const LAS float* s = scr + (8 * c) * 33 + n;
        u32x4 o; o.x = cvt_pk_bf16(s[0 * 33], s[1 * 33]); o.y = cvt_pk_bf16(s[2 * 33], s[3 * 33]); o.z = cvt_pk_bf16(s[4 * 33], s[5 * 33]); o.w = cvt_pk_bf16(s[6 * 33], s[7 * 33]);
        *(u32x4*)(WT + (size_t)(dr0 + n) * ldo + k0 + 8 * c) = o; }
    asm volatile("s_waitcnt lgkmcnt(0)" ::: "memory");
}

__device__ __forceinline__ void sincos_d(double x, double& s, double& c) {
    const double k = rint(x * 0.63661977236758134308);
    const double r = (x - k * 1.57079632679489655800) - k * 6.123233995736766036e-17;
    const double r2 = r * r;
    double sp = 1.0 / 6227020800.0; sp = sp * r2 - 1.0 / 39916800.0; sp = sp * r2 + 1.0 / 362880.0; sp = sp * r2 - 1.0 / 5040.0; sp = sp * r2 + 1.0 / 120.0; sp = sp * r2 - 1.0 / 6.0; sp = sp * r2 + 1.0;
    const double sr = r * sp;
    double cp = 1.0 / 87178291200.0; cp = cp * r2 - 1.0 / 479001600.0; cp = cp * r2 + 1.0 / 3628800.0; cp = cp * r2 - 1.0 / 40320.0; cp = cp * r2 + 1.0 / 720.0; cp = cp * r2 - 1.0 / 24.0; cp = cp * r2 + 0.5;
    const double cr = 1.0 - r2 * cp;
    const int q = ((int)k) & 3;
    s = (q == 0) ? sr : (q == 1) ? cr : (q == 2) ? -sr : -cr;
    c = (q == 0) ? cr : (q == 1) ? -sr : (q == 2) ? -cr : sr;
}

__device__ __forceinline__ void p0_weights(const Args& a, LAS unsigned char* lds, int wave, int lane, int gw, int NGW) {
    LAS float* scr = (LAS float*)(lds + wave * 16384);
    constexpr int I_IN = 16 * 16, I_GLU = 8 * 16, I_OUT = 16 * 32, I_G = 16 * 88, I_D = 44 * 32;
    constexpr int PER_L = 4 * I_IN + I_GLU + I_OUT + 2 * I_G + I_D;
    for (int it = gw; it < NL * PER_L; it += NGW) {
        const int l = it / PER_L; int r = it - l * PER_L;
        const float* win = INP(15) + (size_t)l * DM * DIN;
        bf16_t* WIN = (bf16_t*)(a.ws + WS_WIN) + (size_t)l * 1536 * 1024;
        if (r < 4 * I_IN) { const int part = r / I_IN, rr = r % I_IN, kb = rr / 16, nb = rr % 16;
            if (part == 0) tr_item(win, DIN, 64 * kb, 32 * nb, WIN, 1024, 32 * nb, scr, lane);
            else if (part == 1) tr_item(win, DIN, 64 * kb, 512 + 32 * nb, WIN, 1024, 512 + 32 * nb, scr, lane);
            else if (part == 2) tr_item(win, DIN, 64 * kb, 1544 + 32 * nb, WIN, 1024, 1024 + 32 * nb, scr, lane);
            else tr_item(win, DIN, 64 * kb, 1024 + 32 * nb, (bf16_t*)(a.ws + WS_WV) + (size_t)l * 512 * 1024, 1024, 32 * nb, scr, lane);
            continue; }
        r -= 4 * I_IN;
        if (r < I_GLU) { tr_item(INP(25) + (size_t)l * 512 * 512, 512, 64 * (r / 16), 32 * (r % 16), (bf16_t*)(a.ws + WS_WGLU) + (size_t)l * 512 * 512, 512, 32 * (r % 16), scr, lane); continue; }
        r -= I_GLU;
        if (r < I_OUT) { tr_item(INP(26) + (size_t)l * 1024 * 1024, 1024, 64 * (r / 32), 32 * (r % 32), (bf16_t*)(a.ws + WS_WOUT) + (size_t)l * 1024 * 1024, 1024, 32 * (r % 32), scr, lane); continue; }
        r -= I_OUT;
        if (r < 2 * I_G) { const int up = r / I_G, rr = r % I_G, kb = rr / 88, nb = rr % 88, c0 = 32 * nb;
            tr_item(INP(27 + up) + (size_t)l * DM * DFF, DFF, 64 * kb, c0, (bf16_t*)(a.ws + WS_WGU) + (size_t)l * 5632 * 1024, 1024, (c0 >> 7) * 256 + up * 128 + (c0 & 127), scr, lane);
            continue; }
        r -= 2 * I_G;
        tr_item(INP(29) + (size_t)l * DFF * DM, DM, 64 * (r / 32), 32 * (r % 32), (bf16_t*)(a.ws + WS_WD) + (size_t)l * 1024 * DFF, DFF, 32 * (r % 32), scr, lane);
    }
    float* WG = (float*)(a.ws + WS_WG);
    for (int i = gw * 64 + lane; i < NL * 8 * 1024; i += NGW * 64) { const int l = i >> 13, h = (i >> 10) & 7, k = i & 1023; WG[i] = INP(15)[((size_t)l * DM + k) * DIN + 1536 + h]; }
}
__device__ __forceinline__ void p0_adaln(const Args& a, LAS unsigned char* lds, int tid, int wave, int lane, int c, int G) {
    LAS float* sc = (LAS float*)(lds);
    LAS float* red = (LAS float*)(lds + 49152);
    for (int i = tid; i < 12 * 1024; i += 512) { const float v = (i < 4096) ? INP(2)[i] : INP(3)[i - 4096]; sc[i] = silu_f(v); }
    __syncthreads();
    float* MOD = (float*)(a.ws + WS_MOD);
    for (int it = c; it < NL * 96; it += G) {
        const int l = it / 96, n0 = (it % 96) * 64;
        const float* W = INP(9) + (size_t)l * DM * 6144 + n0 + lane;
        float acc[12];
#pragma unroll
        for (int b = 0; b < 12; ++b) acc[b] = 0.f;
        for (int k = wave * 128; k < wave * 128 + 128; k += 16) {
            float w[16];
#pragma unroll
            for (int j = 0; j < 16; ++j) w[j] = W[(size_t)(k + j) * 6144];
#pragma unroll
            for (int j = 0; j < 16; ++j)
#pragma unroll
                for (int b = 0; b < 12; ++b) acc[b] += sc[b * 1024 + k + j] * w[j];
        }
#pragma unroll
        for (int b = 0; b < 12; ++b) red[(wave * 12 + b) * 64 + lane] = acc[b];
        __syncthreads();
        for (int i = tid; i < 768; i += 512) { const int b = i >> 6, cc = i & 63; float s = 0.f;
#pragma unroll
            for (int w = 0; w < 8; ++w) s += red[(w * 12 + b) * 64 + cc];
            MOD[((size_t)l * 12 + b) * 6144 + n0 + cc] = s + INP(10)[(size_t)l * 6144 + n0 + cc]; }
        __syncthreads();
    }
}
__device__ __forceinline__ void p0_ssm(const Args& a, LAS unsigned char* lds, int tid, int c, int G) {
    LAS float* ap_re = (LAS float*)(lds + 65536);
    LAS float* ap_im = ap_re + 17 * 64;
    LAS float* bb_re = ap_im + 17 * 64;
    LAS float* bb_im = bb_re + 1024;
    LAS float* cc_re = bb_im + 1024;
    LAS float* cc_im = cc_re + 1024;
    LAS float* ktab = cc_im + 1024;
    for (int it = c; it < NL * NG; it += G) {
        const int l = it >> 5, gq = it & 31;
        const double dt = exp((double)INP(19)[l * 32 + gq]);
        for (int idx = tid; idx < 17 * 64; idx += 512) { const int d = idx >> 6, p = idx & 63;
            const double ar = (double)INP(17)[(l * 32 + gq) * 64 + p], ai = (double)INP(18)[(l * 32 + gq) * 64 + p];
            double s, co; sincos_d((double)d * ai * dt, s, co); const double er = exp((double)d * ar * dt);
            ap_re[idx] = (float)(er * co); ap_im[idx] = (float)(er * s); }
        for (int idx = tid; idx < 1024; idx += 512) { const int p = idx >> 4, m = idx & 15;
            const double ar = (double)INP(17)[(l * 32 + gq) * 64 + p], ai = (double)INP(18)[(l * 32 + gq) * 64 + p];
            double s, co; sincos_d(ai * dt, s, co); const double er = exp(ar * dt);
            const double xr = er * co - 1.0, xi = er * s, den = 1.0 / (ar * ar + ai * ai);
            const double qr = (xr * ar + xi * ai) * den, qi = (xi * ar - xr * ai) * den;
            const double br = (double)INP(20)[((size_t)(l * 32 + gq) * 64 + p) * 16 + m], bi = (double)INP(21)[((size_t)(l * 32 + gq) * 64 + p) * 16 + m];
            bb_re[idx] = (float)(qr * br - qi * bi); bb_im[idx] = (float)(qr * bi + qi * br);
            cc_re[idx] = INP(22)[(size_t)(l * 32 + gq) * 1024 + idx]; cc_im[idx] = INP(23)[(size_t)(l * 32 + gq) * 1024 + idx]; }
        __syncthreads();
        for (int idx = tid; idx < 4096; idx += 512) { const int d = idx >> 8, m = (idx >> 4) & 15, m2 = idx & 15; float s = 0.f;
            for (int p = 0; p < 64; ++p) { const float cr = cc_re[m * 64 + p], ci = cc_im[m * 64 + p], pr = ap_re[d * 64 + p], pi = ap_im[d * 64 + p];
                const float re = cr * pr - ci * pi, im = cr * pi + ci * pr; s += re * bb_re[p * 16 + m2] - im * bb_im[p * 16 + m2]; }
            if (d == 0 && m == m2) s += INP(24)[l * 512 + gq * 16 + m];
            ktab[idx] = s; }
        __syncthreads();
        bf16_t* BT3 = (bf16_t*)(a.ws + WS_BT3) + (size_t)(l * 32 + gq) * 256 * UAK;
        for (int grp = tid; grp < 256 * 48; grp += 512) { const int n = grp / 48, k0 = (grp % 48) * 8, t = n >> 4, m = n & 15; float v[8];
            if (k0 < 256) { const int s = k0 >> 4, m20 = k0 & 15;
#pragma unroll
                for (int j = 0; j < 8; ++j) v[j] = (s <= t) ? ktab[((t - s) * 16 + m) * 16 + m20 + j] : 0.f; }
            else { const int kk = k0 - 256, ri = kk >> 6, p0 = kk & 63;
#pragma unroll
                for (int j = 0; j < 8; ++j) { const int p = p0 + j; const float cr = cc_re[m * 64 + p], ci = cc_im[m * 64 + p], pr = ap_re[(t + 1) * 64 + p], pi = ap_im[(t + 1) * 64 + p];
                    v[j] = ri ? -(cr * pi + ci * pr) : (cr * pr - ci * pi); } }
            u32x4 w; w.x = cvt_pk_bf16(v[0], v[1]); w.y = cvt_pk_bf16(v[2], v[3]); w.z = cvt_pk_bf16(v[4], v[5]); w.w = cvt_pk_bf16(v[6], v[7]);
            *(u32x4*)(BT3 + (size_t)n * UAK + k0) = w; }
        bf16_t* BT1 = (bf16_t*)(a.ws + WS_BT1) + (size_t)(l * 32 + gq) * 128 * 256;
        for (int grp = tid; grp < 128 * 32; grp += 512) { const int n = grp >> 5, k0 = (grp & 31) * 8, s = k0 >> 4, m0 = k0 & 15, ri = n >> 6, p = n & 63; float v[8];
            const float pr = ap_re[(15 - s) * 64 + p], pi = ap_im[(15 - s) * 64 + p];
#pragma unroll
            for (int j = 0; j < 8; ++j) { const float br = bb_re[p * 16 + m0 + j], bi = bb_im[p * 16 + m0 + j]; v[j] = ri ? (pr * bi + pi * br) : (pr * br - pi * bi); }
            u32x4 w; w.x = cvt_pk_bf16(v[0], v[1]); w.y = cvt_pk_bf16(v[2], v[3]); w.z = cvt_pk_bf16(v[4], v[5]); w.w = cvt_pk_bf16(v[6], v[7]);
            *(u32x4*)(BT1 + (size_t)n * 256 + k0) = w; }
        if (tid < 64) { float* A16 = (float*)(a.ws + WS_A16) + (size_t)(l * 32 + gq) * 128; A16[tid] = ap_re[16 * 64 + tid]; A16[64 + tid] = ap_im[16 * 64 + tid]; }
        __syncthreads();
    }
}

__device__ __forceinline__ void cache_convert(const Args& a, int l, LAS unsigned char* lds, int wave, int lane, int gw, int NGW) {
    bf16_t* KS = (bf16_t*)(a.ws + WS_KS); bf16_t* VTS = (bf16_t*)(a.ws + WS_VTS);
    const float* ck = INP(4) + (size_t)l * 64 * PAST * 64; const float* cv = INP(5) + (size_t)l * 64 * PAST * 64;
    for (int i = gw * 64 + lane; i < 64 * PAST * 8; i += NGW * 64) {
        const int bh = i >> 13, rem = i & 8191;
        const f32x4 v0 = *(const f32x4*)(ck + (size_t)i * 8), v1 = *(const f32x4*)(ck + (size_t)i * 8 + 4);
        *(u32x4*)(KS + (size_t)bh * KVS * 64 + (size_t)rem * 8) = pack8(v0, v1); }
    LAS float* scr = (LAS float*)(lds + wave * 16384);
    for (int it = gw; it < 64 * 32; it += NGW) { const int bh = it >> 5, r = it & 31, kb = r >> 1, nb = r & 1;
        tr_item(cv + (size_t)bh * PAST * 64, 64, 64 * kb, 32 * nb, VTS + (size_t)bh * 64 * KVS, KVS, 32 * nb, scr, lane); }
}

template <int NSPLIT>
__device__ __forceinline__ void rowpass(const float* xsrc_p, const float* xsrc_s, const bf16_t* xsrc_b, const bf16_t* Fb, const float* FS, int nsplit, const float* gate, const float* wpost, float* xdst, bf16_t* xdst_b,
                                        const float* wpre, const float* sc, const float* sh, bf16_t* HMb, const float* WGl, const float* bfor, float* out, int lnext,
                                        int lane, int gw, int NGW) {
    f32x4 wg[8][4];
    if (WGl) {
#pragma unroll
        for (int h = 0; h < 8; ++h)
#pragma unroll
            for (int j = 0; j < 4; ++j) wg[h][j] = *(const f32x4*)(WGl + h * 1024 + 4 * lane + 256 * j);
    }
#define LOADX(dst, rr, xr, j) do { if (xsrc_b) { const u32x2 w_ = *(const u32x2*)(xsrc_b + (size_t)(rr) * DM + 4 * lane + 256 * (j)); \
        dst = (f32x4){__uint_as_float(w_.x << 16), __uint_as_float(w_.x & 0xffff0000u), __uint_as_float(w_.y << 16), __uint_as_float(w_.y & 0xffff0000u)}; } \
        else dst = *(const f32x4*)((xr) + 4 * lane + 256 * (j)); } while (0)
    for (int r = gw; r < MT; r += NGW) {
        const bool prompt = r < NPR; const int bm = prompt ? (r >> 12) : 4 + ((r - NPR) >> 6);
        f32x4 x[4]; u32x2 fw[4];
        { const float* xr = prompt ? xsrc_p + (size_t)r * DM : xsrc_s + (size_t)(r - NPR) * DM;
#pragma unroll
          for (int j = 0; j < 4; ++j) { LOADX(x[j], r, xr, j); fw[j] = (Fb && prompt) ? *(const u32x2*)(Fb + (size_t)r * DM + 4 * lane + 256 * j) : (u32x2){0u, 0u}; } }
        if (Fb) {
            f32x4 f[4]; float ss = 0.f;
#pragma unroll
            for (int j = 0; j < 4; ++j) {
                if (prompt) { const u32x2 w = fw[j];
                    f[j] = (f32x4){__uint_as_float(w.x << 16), __uint_as_float(w.x & 0xffff0000u), __uint_as_float(w.y << 16), __uint_as_float(w.y & 0xffff0000u)}; }
                else { const float* fp = FS + (size_t)(r - NPR) * DM + 4 * lane + 256 * j; f32x4 part[NSPLIT > 0 ? NSPLIT : 1];
#pragma unroll
                    for (int sp = 0; sp < NSPLIT; ++sp) part[sp] = *(const f32x4*)(fp + (size_t)sp * 512 * 1024);
                    f32x4 sacc = part[0];
#pragma unroll
                    for (int sp = 1; sp < NSPLIT; ++sp) sacc = sacc + part[sp];
                    f[j] = sacc; }
                ss += (f[j][0] * f[j][0] + f[j][1] * f[j][1]) + (f[j][2] * f[j][2] + f[j][3] * f[j][3]); }
            const float rstd = rsqrtf(wave_sum(ss, lane) * (1.f / DM) + EPS);
#pragma unroll
            for (int j = 0; j < 4; ++j) { const f32x4 gt = *(const f32x4*)(gate + (size_t)bm * 6144 + 4 * lane + 256 * j), wp = *(const f32x4*)(wpost + 4 * lane + 256 * j);
                x[j] = x[j] + gt * (f[j] * rstd * wp); }
        }
        if (xdst) {
#pragma unroll
            for (int j = 0; j < 4; ++j) *(f32x4*)(xdst + (size_t)r * DM + 4 * lane + 256 * j) = x[j];
        }
        if (xdst_b) {
#pragma unroll
            for (int j = 0; j < 4; ++j) { u32x2 w; w.x = cvt_pk_bf16(x[j][0], x[j][1]); w.y = cvt_pk_bf16(x[j][2], x[j][3]); *(u32x2*)(xdst_b + (size_t)r * DM + 4 * lane + 256 * j) = w;
                x[j] = (f32x4){__uint_as_float(w.x << 16), __uint_as_float(w.x & 0xffff0000u), __uint_as_float(w.y << 16), __uint_as_float(w.y & 0xffff0000u)}; }
        }
        if (wpre) {
            float ss = 0.f;
#pragma unroll
            for (int j = 0; j < 4; ++j) ss += (x[j][0] * x[j][0] + x[j][1] * x[j][1]) + (x[j][2] * x[j][2] + x[j][3] * x[j][3]);
            const float rstd = rsqrtf(wave_sum(ss, lane) * (1.f / DM) + EPS);
            f32x4 hm[4];
#pragma unroll
            for (int j = 0; j < 4; ++j) { const int cidx = 4 * lane + 256 * j;
                const f32x4 wv = *(const f32x4*)(wpre + cidx), s1 = *(const f32x4*)(sc + (size_t)bm * 6144 + cidx), s0 = *(const f32x4*)(sh + (size_t)bm * 6144 + cidx);
                hm[j] = (x[j] * rstd * wv) * (1.f + s1) + s0;
                u32x2 w; w.x = cvt_pk_bf16(hm[j][0], hm[j][1]); w.y = cvt_pk_bf16(hm[j][2], hm[j][3]);
                *(u32x2*)(HMb + (size_t)r * DM + cidx) = w; }
            if (WGl) {
                float mine = 0.f;
#pragma unroll
                for (int h = 0; h < 8; ++h) { float d = 0.f;
#pragma unroll
                    for (int j = 0; j < 4; ++j) { const f32x4 wv = wg[h][j]; d += (hm[j][0] * wv[0] + hm[j][1] * wv[1]) + (hm[j][2] * wv[2] + hm[j][3] * wv[3]); }
                    d = wave_sum(d, lane); if (lane == h) mine = d; }
                if (lane < 8) { const float lf = logsig(mine + bfor[lane]);
                    if (prompt) out[O_LP + ((size_t)((lnext * 4 + (r >> 12)) * 8 + lane)) * 4096 + (r & 4095)] = lf;
                    else { const int rr = r - NPR; out[O_LS + ((size_t)((lnext * 8 + (rr >> 6)) * 8 + lane)) * 64 + (rr & 63)] = lf; } }
            }
        }
    }
}

__device__ __forceinline__ void vt_finalize(const Args& a, int l, int lane, int gwi, int nw) {
    const float* PV = (const float*)(a.ws + WS_F1); bf16_t* VTP = (bf16_t*)(a.ws + WS_VTP); bf16_t* VTS = (bf16_t*)(a.ws + WS_VTS);
    for (int it = gwi; it < 16 * 128; it += nw) {
        const int tile = it >> 7, rem = it & 127, hb = rem >> 5, to = rem & 31, hdl = hb * 64 + lane, pm = tile >> 3, pn = 58 + (tile & 7);
        const int hd = pm * 256 + hdl, h = hd >> 6, d = hd & 63, tok = pn * 256 + to * 8;
        f32x4 v0 = {0.f, 0.f, 0.f, 0.f}, v1 = {0.f, 0.f, 0.f, 0.f};
#pragma unroll
        for (int ks = 0; ks < 4; ++ks) { const float* p = PV + ((size_t)(tile * 4 + ks) * 256 + hdl) * 256 + to * 8; v0 = v0 + *(const f32x4*)p; v1 = v1 + *(const f32x4*)(p + 4); }
        const u32x4 w = pack8(v0, v1);
        if (pn < 64) { const int b = tok >> 12, t = tok & 4095;
            *(u32x4*)(VTP + ((size_t)(b * 8 + h) * 64 + d) * 4096 + t) = w;
            float* o = a.out + O_VP + ((size_t)((l * 4 + b) * 8 + h) * 4096 + t) * 64 + d;
#pragma unroll
            for (int j = 0; j < 4; ++j) { o[(size_t)j * 64] = v0[j]; o[(size_t)(j + 4) * 64] = v1[j]; } }
        else { const int tt = tok - NPR, b = tt >> 6, t = tt & 63;
            *(u32x4*)(VTS + ((size_t)(b * 8 + h) * 64 + d) * KVS + PAST + t) = w;
            float* o = a.out + O_VS + ((size_t)((l * 8 + b) * 8 + h) * 64 + t) * 64 + d;
#pragma unroll
            for (int j = 0; j < 4; ++j) { o[(size_t)j * 64] = v0[j]; o[(size_t)(j + 4) * 64] = v1[j]; } }
    }
}
__device__ __forceinline__ void cumsum_items(const Args& a, int l, LAS unsigned char* lds, int tid, int wave, int lane, int c, int G) {
    LAS float* wt = (LAS float*)(lds);
    for (int it = c - 64; it >= 0 && it < 96; it += G) {
        const bool prompt = it < 32;
        float v[8]; float run = 0.f; int i0, cnt;
        if (prompt) { i0 = tid * 8; cnt = 8;
            const float* src = a.out + O_LP + (size_t)(l * 32 + it) * 4096 + i0;
            const f32x4 p0 = *(const f32x4*)src, p1 = *(const f32x4*)(src + 4);
            v[0] = p0[0]; v[1] = p0[1]; v[2] = p0[2]; v[3] = p0[3]; v[4] = p1[0]; v[5] = p1[1]; v[6] = p1[2]; v[7] = p1[3]; }
        else { const int sq = it - 32; i0 = tid * 4; cnt = tid < 272 ? 4 : 0;
            const float* src = tid < 256 ? INP(6) + (size_t)(l * 64 + sq) * PAST + i0 : a.out + O_LS + (size_t)(l * 64 + sq) * 64 + (tid < 272 ? i0 - PAST : 0);
            const f32x4 p0 = *(const f32x4*)src;
            v[0] = p0[0]; v[1] = p0[1]; v[2] = p0[2]; v[3] = p0[3]; v[4] = 0.f; v[5] = 0.f; v[6] = 0.f; v[7] = 0.f;
            if (tid >= 272) { v[0] = 0.f; v[1] = 0.f; v[2] = 0.f; v[3] = 0.f; } }
#pragma unroll
        for (int j = 0; j < 8; ++j) { run += v[j]; v[j] = run; }
        float incl = run;
#pragma unroll
        for (int o = 1; o < 64; o <<= 1) { const float t = bperm(incl, lane >= o ? lane - o : lane); if (lane >= o) incl += t; }
        if (lane == 63) wt[wave] = incl;
        __syncthreads();
        float off = incl - run;
        for (int w = 0; w < wave; ++w) off += wt[w];
        float* dst = (prompt ? (float*)(a.ws + WS_BIASP) + (size_t)it * 4096 : (float*)(a.ws + WS_BIASS) + (size_t)(it - 32) * KVS) + i0;
        if (cnt == 8) { *(f32x4*)dst = (f32x4){-(off + v[0]) * LOG2E, -(off + v[1]) * LOG2E, -(off + v[2]) * LOG2E, -(off + v[3]) * LOG2E};
                        *(f32x4*)(dst + 4) = (f32x4){-(off + v[4]) * LOG2E, -(off + v[5]) * LOG2E, -(off + v[6]) * LOG2E, -(off + v[7]) * LOG2E}; }
        else if (cnt == 4) *(f32x4*)dst = (f32x4){-(off + v[0]) * LOG2E, -(off + v[1]) * LOG2E, -(off + v[2]) * LOG2E, -(off + v[3]) * LOG2E};
        __syncthreads();
    }
}

__device__ __forceinline__ void ssm_scan(const Args& a, int l, LAS unsigned char* lds, int wave, int lane, int c, int G) {
    const float* E = (const float*)(a.ws + WS_E); bf16_t* UA = (bf16_t*)(a.ws + WS_UA); const float* A16 = (const float*)(a.ws + WS_A16);
    LAS float* endst = (LAS float*)(lds);
    for (int it = c; it < 128; it += G) {
        const int b = it >> 5, gq = it & 31, p = lane;
        const float ar = A16[(l * 32 + gq) * 128 + p], ai = A16[(l * 32 + gq) * 128 + 64 + p];
        float er[32], ei[32];
        const int ch0 = b * 256 + wave * 32;
#pragma unroll
        for (int i = 0; i < 32; ++i) { const float* e = E + ((size_t)gq * CHP + ch0 + i) * 128; er[i] = e[p]; ei[i] = e[64 + p]; }
        float hr = 0.f, hi = 0.f;
#pragma unroll
        for (int i = 0; i < 32; ++i) { const float nr = ar * hr - ai * hi + er[i], ni = ar * hi + ai * hr + ei[i]; hr = nr; hi = ni; }
        endst[(wave * 2) * 64 + p] = hr; endst[(wave * 2 + 1) * 64 + p] = hi;
        float pr = ar, pi = ai;
#pragma unroll
        for (int s = 0; s < 5; ++s) { const float nr = pr * pr - pi * pi, ni = 2.f * pr * pi; pr = nr; pi = ni; }
        __syncthreads();
        hr = 0.f; hi = 0.f;
        for (int w = 0; w < wave; ++w) { const float xr = endst[(w * 2) * 64 + p], xi = endst[(w * 2 + 1) * 64 + p];
            const float nr = pr * hr - pi * hi + xr, ni = pr * hi + pi * hr + xi; hr = nr; hi = ni; }
#pragma unroll
        for (int i = 0; i < 32; ++i) { bf16_t* u = UA + ((size_t)gq * CHP + ch0 + i) * UAK + 256; u[p] = f2bf(hr); u[64 + p] = f2bf(hi);
            const float nr = ar * hr - ai * hi + er[i], ni = ar * hi + ai * hr + ei[i]; hr = nr; hi = ni; }
        if (wave == 7) { a.out[O_RP + (size_t)((l * 4 + b) * 32 + gq) * 64 + p] = hr; a.out[O_IP + (size_t)((l * 4 + b) * 32 + gq) * 64 + p] = hi; }
        __syncthreads();
    }
    for (int it = (G - 1 - c) * 8 + wave; it < 256; it += G * 8) {
        const int b = it >> 5, gq = it & 31, p = lane;
        const float ar = A16[(l * 32 + gq) * 128 + p], ai = A16[(l * 32 + gq) * 128 + 64 + p];
        float hr = INP(7)[(size_t)((l * 8 + b) * 32 + gq) * 64 + p], hi = INP(8)[(size_t)((l * 8 + b) * 32 + gq) * 64 + p];
        const int ch0 = 1024 + b * 4;
#pragma unroll
        for (int i = 0; i < 4; ++i) { const float* e = E + ((size_t)gq * CHP + ch0 + i) * 128; const float xr = e[p], xi = e[64 + p];
            bf16_t* u = UA + ((size_t)gq * CHP + ch0 + i) * UAK + 256; u[p] = f2bf(hr); u[64 + p] = f2bf(hi);
            const float nr = ar * hr - ai * hi + xr, ni = ar * hi + ai * hr + xi; hr = nr; hi = ni; }
        a.out[O_RS + (size_t)((l * 8 + b) * 32 + gq) * 64 + p] = hr; a.out[O_IS + (size_t)((l * 8 + b) * 32 + gq) * 64 + p] = hi;
    }
}

#define DPPMAX(v, ctrl) v = fmaxf(v, __int_as_float(__builtin_amdgcn_update_dpp(0, __float_as_int(v), ctrl, 0xF, 0xF, true)))
__device__ __forceinline__ float wave_max_nonneg(float v) {
    DPPMAX(v, 0xB1); DPPMAX(v, 0x4E); DPPMAX(v, 0x141); DPPMAX(v, 0x140);
    const float r0 = __int_as_float(__builtin_amdgcn_readlane(__float_as_int(v), 0)), r1 = __int_as_float(__builtin_amdgcn_readlane(__float_as_int(v), 16));
    const float r2 = __int_as_float(__builtin_amdgcn_readlane(__float_as_int(v), 32)), r3 = __int_as_float(__builtin_amdgcn_readlane(__float_as_int(v), 48));
    return fmaxf(fmaxf(r0, r1), fmaxf(r2, r3));
}
__device__ __forceinline__ void kmax_items(const Args& a, int lane, int gw, int NGW) {
    float* KM = (float*)(a.ws + WS_KMAX);
    for (int it = NGW - 1 - gw; it < 2048 + 1088; it += NGW) {
        const bf16_t* kp; int oidx;
        if (it < 2048) { const int bh = it >> 6, t = it & 63; kp = (const bf16_t*)(a.ws + WS_KP) + ((size_t)bh * 4096 + t * 64) * 64; oidx = it; }
        else { const int r = it - 2048, sq = r / 17, t = r - sq * 17; kp = (const bf16_t*)(a.ws + WS_KS) + ((size_t)sq * KVS + t * 64) * 64; oidx = (32 + sq) * 64 + t; }
        float ss = 0.f;
#pragma unroll
        for (int i = 0; i < 8; ++i) { const u32x4 w = *(const u32x4*)(kp + (size_t)lane * 64 + i * 8);
#pragma unroll
            for (int j = 0; j < 4; ++j) { const float lo = __uint_as_float(w[j] << 16), hi = __uint_as_float(w[j] & 0xffff0000u); ss += lo * lo + hi * hi; } }
        const float m = wave_max_nonneg(ss);
        if (lane == 0) KM[oidx] = sqrtf(m) * 1.001f;
    }
}
constexpr int AT_ROW = 144, AT_TILE = 64 * AT_ROW  , AT_KB = 0, AT_VB = 4 * AT_TILE, AT_BB = 8 * AT_TILE;
__device__ __forceinline__ void attn_tile(const LAS unsigned char* Kb, const LAS unsigned char* Vb, const LAS float* Bb, const bf16x8 (&qf)[4], f32x16& o0, f32x16& o1, float& lsum,
                                          float bq, int myq, int key0, bool domask, int ka_off, int va_off, int hi) {
    f32x16 s0, s1;
#pragma unroll
    for (int a2 = 0; a2 < 2; ++a2) { const f32x4 b0 = *(const LAS f32x4*)(Bb + a2 * 16 + hi * 8), b1 = *(const LAS f32x4*)(Bb + a2 * 16 + hi * 8 + 4);
        const f32x4 c0 = *(const LAS f32x4*)(Bb + 32 + a2 * 16 + hi * 8), c1 = *(const LAS f32x4*)(Bb + 32 + a2 * 16 + hi * 8 + 4);
#pragma unroll
        for (int j = 0; j < 4; ++j) { s0[a2 * 8 + j] = b0[j]; s0[a2 * 8 + 4 + j] = b1[j]; s1[a2 * 8 + j] = c0[j]; s1[a2 * 8 + 4 + j] = c1[j]; } }
#pragma unroll
    for (int ks = 0; ks < 4; ++ks) {
        const bf16x8 k0 = *(const LAS bf16x8*)(Kb + ka_off + ks * 32), k1 = *(const LAS bf16x8*)(Kb + 32 * AT_ROW + ka_off + ks * 32);
        s0 = __builtin_amdgcn_mfma_f32_32x32x16_bf16(k0, qf[ks], s0, 0, 0, 0);
        s1 = __builtin_amdgcn_mfma_f32_32x32x16_bf16(k1, qf[ks], s1, 0, 0, 0);
    }
    if (domask) {
#pragma unroll
        for (int r = 0; r < 16; ++r) { const int kj = key0 + 16 * (r >> 3) + 8 * hi + (r & 7);
            if (kj > myq) s0[r] = -INFINITY; if (kj + 32 > myq) s1[r] = -INFINITY; }
    }
    s0 = s0 - bq; s1 = s1 - bq;
#pragma unroll
    for (int r = 0; r < 16; ++r) { s0[r] = __builtin_amdgcn_exp2f(s0[r]); s1[r] = __builtin_amdgcn_exp2f(s1[r]); }
    { const f32x16 e = s0 + s1;
      const f32x8 e8 = __builtin_shufflevector(e, e, 0, 1, 2, 3, 4, 5, 6, 7) + __builtin_shufflevector(e, e, 8, 9, 10, 11, 12, 13, 14, 15);
      const f32x4 e4 = __builtin_shufflevector(e8, e8, 0, 1, 2, 3) + __builtin_shufflevector(e8, e8, 4, 5, 6, 7);
      lsum += (e4[0] + e4[1]) + (e4[2] + e4[3]); }
    bf16x8 pa[4];
#pragma unroll
    for (int a2 = 0; a2 < 2; ++a2) {
        u32x4 w0, w1;
        w0.x = cvt_pk_bf16(s0[a2 * 8 + 0], s0[a2 * 8 + 1]); w0.y = cvt_pk_bf16(s0[a2 * 8 + 2], s0[a2 * 8 + 3]); w0.z = cvt_pk_bf16(s0[a2 * 8 + 4], s0[a2 * 8 + 5]); w0.w = cvt_pk_bf16(s0[a2 * 8 + 6], s0[a2 * 8 + 7]);
        w1.x = cvt_pk_bf16(s1[a2 * 8 + 0], s1[a2 * 8 + 1]); w1.y = cvt_pk_bf16(s1[a2 * 8 + 2], s1[a2 * 8 + 3]); w1.z = cvt_pk_bf16(s1[a2 * 8 + 4], s1[a2 * 8 + 5]); w1.w = cvt_pk_bf16(s1[a2 * 8 + 6], s1[a2 * 8 + 7]);
        pa[a2] = __builtin_bit_cast(bf16x8, w0); pa[2 + a2] = __builtin_bit_cast(bf16x8, w1);
    }
#pragma unroll
    for (int kk = 0; kk < 4; ++kk) {
        const bf16x8 v0 = *(const LAS bf16x8*)(Vb + va_off + kk * 32), v1 = *(const LAS bf16x8*)(Vb + 32 * AT_ROW + va_off + kk * 32);
        o0 = __builtin_amdgcn_mfma_f32_32x32x16_bf16(v0, pa[kk], o0, 0, 0, 0);
        o1 = __builtin_amdgcn_mfma_f32_32x32x16_bf16(v1, pa[kk], o1, 0, 0, 0);
    }
}
__device__ __forceinline__ void attn_unit(LAS unsigned char* lds, const bf16_t* Qrow0, int h, int nrows, int qpos0, int NT,
                                          const bf16_t* Kp, const bf16_t* VTp, int vpitch, const float* biasp, const float* kmaxp, bf16_t* Orow0, int tid, int wave, int lane) {
    const int q = lane & 31, hi = lane >> 5;
    const bool active = wave * 32 < nrows;
    bf16x8 qf[4];
#pragma unroll
    for (int ks = 0; ks < 4; ++ks) qf[ks] = active ? *(const bf16x8*)(Qrow0 + (size_t)(wave * 32 + q) * 512 + h * 64 + ks * 16 + hi * 8) : (bf16x8){0, 0, 0, 0, 0, 0, 0, 0};
    f32x16 o0 = {}, o1 = {};
    float lsum = 0.f;
    const int myq = qpos0 + wave * 32 + q;
    const int wq_lo = qpos0 + wave * 32, wq_hi = wq_lo + 31;
    const float bq = active ? biasp[myq] : 0.f;
    const int NS = (NT + 1) >> 1;
    int s_first;
    { float ssq = 0.f;
#pragma unroll
      for (int ks = 0; ks < 4; ++ks)
#pragma unroll
          for (int e = 0; e < 8; ++e) { const float v = __uint_as_float(((unsigned)(unsigned short)qf[ks][e]) << 16); ssq += v * v; }
      ssq += bperm(ssq, lane ^ 32);
      const float wm = wave_max_nonneg(ssq);
      volatile LAS float* qm = (volatile LAS float*)(lds + 131072 + 512);
      volatile LAS int* tst = (volatile LAS int*)(lds + 131072 + 576);
      if (lane == 0) qm[wave] = wm;
      __syncthreads();
      if (wave == 0) {
          float m2 = 0.f;
#pragma unroll
          for (int w = 0; w < 8; ++w) m2 = fmaxf(m2, qm[w]);
          const float QN = sqrtf(m2) * 1.001f;
          bool fail = true;
          if (lane < NT) fail = !(QN * kmaxp[lane] + biasp[64 * lane + 63] - biasp[qpos0] < -160.f);
          const unsigned long long mask = __builtin_amdgcn_ballot_w64(fail);
          const int tfirst = mask ? (int)__builtin_ctzll(mask) : 0;
          if (lane == 0) tst[0] = tfirst >> 1;
      }
      __syncthreads();
      s_first = tst[0]; }
    const int krow = tid >> 3, kch = tid & 7;
    const bf16_t* kg = Kp + (size_t)tid * 8;
    const bf16_t* vg = VTp + (size_t)krow * vpitch + kch * 8;
    const int st_off = krow * AT_ROW + kch * 16;
    const int kap = (q & 19) | ((q & 4) << 1) | ((q & 8) >> 1);
    const int ka_off = kap * AT_ROW + hi * 16, va_off = q * AT_ROW + hi * 16;
    u32x4 kr0, kr1, vr0, vr1; f32x4 br = {0.f, 0.f, 0.f, 0.f};
    { const int tb = 2 * s_first; kr0 = *(const u32x4*)(kg + (size_t)tb * 4096); kr1 = *(const u32x4*)(kg + (size_t)(tb + 1) * 4096); vr0 = *(const u32x4*)(vg + tb * 64); vr1 = *(const u32x4*)(vg + (tb + 1) * 64); if (tid < 32) br = *(const f32x4*)(biasp + tb * 64 + tid * 4); }
    *(LAS u32x4*)(lds + AT_KB + st_off) = kr0; *(LAS u32x4*)(lds + AT_KB + AT_TILE + st_off) = kr1;
    *(LAS u32x4*)(lds + AT_VB + st_off) = vr0; *(LAS u32x4*)(lds + AT_VB + AT_TILE + st_off) = vr1; if (tid < 32) *(LAS f32x4*)(lds + AT_BB + tid * 16) = br;
    __syncthreads();
    for (int sidx = s_first; sidx < NS; ++sidx) {
        const int buf = (sidx - s_first) & 1, t0 = 2 * sidx;
        const bool more = sidx + 1 < NS;
        if (more) { kr0 = *(const u32x4*)(kg + (size_t)(t0 + 2) * 4096); kr1 = *(const u32x4*)(kg + (size_t)(t0 + 3) * 4096); vr0 = *(const u32x4*)(vg + (t0 + 2) * 64); vr1 = *(const u32x4*)(vg + (t0 + 3) * 64);
            if (tid < 32) br = *(const f32x4*)(biasp + (t0 + 2) * 64 + tid * 4); }
        if (active) {
            const LAS unsigned char* Kb = lds + AT_KB + buf * 2 * AT_TILE;
            const LAS unsigned char* Vb = lds + AT_VB + buf * 2 * AT_TILE;
            const LAS float* Bb = (const LAS float*)(lds + AT_BB + buf * 512);
            if (t0 * 64 <= wq_hi) attn_tile(Kb, Vb, Bb, qf, o0, o1, lsum, bq, myq, t0 * 64, t0 * 64 + 63 > wq_lo, ka_off, va_off, hi);
            if ((t0 + 1) * 64 <= wq_hi) attn_tile(Kb + AT_TILE, Vb + AT_TILE, Bb + 64, qf, o0, o1, lsum, bq, myq, (t0 + 1) * 64, (t0 + 1) * 64 + 63 > wq_lo, ka_off, va_off, hi);
        }
        if (more) { const int nb = buf ^ 1;
            *(LAS u32x4*)(lds + AT_KB + nb * 2 * AT_TILE + st_off) = kr0; *(LAS u32x4*)(lds + AT_KB + nb * 2 * AT_TILE + AT_TILE + st_off) = kr1;
            *(LAS u32x4*)(lds + AT_VB + nb * 2 * AT_TILE + st_off) = vr0; *(LAS u32x4*)(lds + AT_VB + nb * 2 * AT_TILE + AT_TILE + st_off) = vr1;
            if (tid < 32) *(LAS f32x4*)(lds + AT_BB + nb * 512 + tid * 16) = br; }
        __syncthreads();
    }
    if (active) {
        lsum += bperm(lsum, lane ^ 32);
        const float inv = 1.f / lsum;
        bf16_t* orow = Orow0 + (size_t)(wave * 32 + q) * 1024 + h * 64;
#pragma unroll
        for (int i = 0; i < 4; ++i) { u32x2 w0, w1;
            w0.x = cvt_pk_bf16(o0[4 * i] * inv, o0[4 * i + 1] * inv); w0.y = cvt_pk_bf16(o0[4 * i + 2] * inv, o0[4 * i + 3] * inv);
            w1.x = cvt_pk_bf16(o1[4 * i] * inv, o1[4 * i + 1] * inv); w1.y = cvt_pk_bf16(o1[4 * i + 2] * inv, o1[4 * i + 3] * inv);
            *(u32x2*)(orow + 8 * i + 4 * hi) = w0; *(u32x2*)(orow + 32 + 8 * i + 4 * hi) = w1; }
    }
}
__device__ __forceinline__ void attn_phase(const Args& a, int l, LAS unsigned char* lds, int tid, int wave, int lane) {
    const bf16_t* Q = (const bf16_t*)(a.ws + WS_Q); bf16_t* MIX = (bf16_t*)(a.ws + WS_MIX);
    unsigned* ctr = (unsigned*)(a.ws + WS_CTL) + 3600 + 64 * l;
    volatile LAS unsigned* slot = (volatile LAS unsigned*)(lds + 131072 + 256);
    for (;;) {
        if (tid == 0) slot[0] = __hip_atomic_fetch_add(ctr, 1u, __ATOMIC_RELAXED, __HIP_MEMORY_SCOPE_AGENT);
        __syncthreads();
        const int idx = (int)slot[0];
        __syncthreads();
        if (idx >= 576) break;
        if (idx < 512) { const int qb = 15 - (idx >> 5), bh = idx & 31, b = bh >> 3, h = bh & 7; const size_t row0 = (size_t)b * 4096 + qb * 256;
            attn_unit(lds, Q + row0 * 512, h, 256, qb * 256, 4 * qb + 4, (const bf16_t*)(a.ws + WS_KP) + (size_t)bh * 4096 * 64, (const bf16_t*)(a.ws + WS_VTP) + (size_t)bh * 64 * 4096, 4096,
                      (const float*)(a.ws + WS_BIASP) + (size_t)bh * 4096, (const float*)(a.ws + WS_KMAX) + bh * 64, MIX + row0 * 1024, tid, wave, lane); }
        else { const int sidx = idx - 512, b = sidx >> 3, h = sidx & 7;
            attn_unit(lds, Q + (size_t)(NPR + b * 64) * 512, h, 64, PAST, 17, (const bf16_t*)(a.ws + WS_KS) + (size_t)sidx * KVS * 64, (const bf16_t*)(a.ws + WS_VTS) + (size_t)sidx * 64 * KVS, KVS,
                      (const float*)(a.ws + WS_BIASS) + (size_t)sidx * KVS, (const float*)(a.ws + WS_KMAX) + (32 + sidx) * 64, MIX + (size_t)(NPR + b * 64) * 1024, tid, wave, lane); }
    }
}

#define XB_TMO      128
#define XB_XCNT(j)  (256  + 64 * (j))
#define XB_XSUB(j)  (1280 + 64 * (j))
#define XB_XGEN(j)  (2304 + 64 * (j))
#define XB_TOP      3328
#define XB_TOPGEN   3392
#define XCD_BAR_WORDS 3456
#define XB_SPIN_CAP (1u << 18)
__device__ __forceinline__ unsigned xb_ld(unsigned* p)              { return __hip_atomic_load(p, __ATOMIC_RELAXED, __HIP_MEMORY_SCOPE_AGENT); }
__device__ __forceinline__ unsigned xb_add(unsigned* p, unsigned v) { return __hip_atomic_fetch_add(p, v, __ATOMIC_RELAXED, __HIP_MEMORY_SCOPE_AGENT); }
__device__ __forceinline__ unsigned xb_xcc_id() { return (unsigned)__builtin_amdgcn_s_getreg((3 << 11) | 20) & 0xFu; }
#define XB_SPIN(cond, bar) do { unsigned _sp = 0; while (cond) { __builtin_amdgcn_s_sleep(1); \
    if ((++_sp & 255u) == 0u) { if (xb_ld(&(bar)[XB_TMO])) break; if (_sp > XB_SPIN_CAP) { atomicAdd(&(bar)[XB_TMO], 1u); break; } } } } while (0)
__device__ __forceinline__ void xcd_barrier_complete(unsigned* bar, unsigned x, unsigned G, unsigned& nloc, unsigned& nx) {
    unsigned sum, cnt, mine, sp = 0u;
    for (;;) {
        sum = 0u; cnt = 0u; mine = 0u;
#pragma unroll
        for (unsigned j = 0; j < 16; ++j) { const unsigned c = xb_ld(&bar[XB_XCNT(j)]); sum += c; cnt += (c > 0u) ? 1u : 0u; mine = (j == x) ? c : mine; }
        if (sum == G) break;
        __builtin_amdgcn_s_sleep(1);
        if ((++sp & 255u) == 0u) { if (xb_ld(&bar[XB_TMO])) break; if (sp > XB_SPIN_CAP) { atomicAdd(&bar[XB_TMO], 1u); break; } }
    }
    nloc = mine > 0u ? mine : 1u; nx = cnt > 0u ? cnt : 1u;
}
__device__ __forceinline__ void xcd_barrier(unsigned* bar, volatile LAS unsigned* st, bool leader, unsigned G) {
    asm volatile("s_waitcnt vmcnt(0)" ::: "memory");
    __syncthreads();
    if (leader) {
        const unsigned x = xb_xcc_id();
        __builtin_amdgcn_s_waitcnt(0);
        unsigned nloc = st[0], nx = st[1];
        if (nloc == 0u) { xcd_barrier_complete(bar, x, G, nloc, nx); st[0] = nloc; st[1] = nx; }
        const unsigned old = xb_add(&bar[XB_XSUB(x)], 1u);
        const unsigned gen = old / nloc;
        if (old + 1u == (gen + 1u) * nloc) {
            __builtin_amdgcn_fence(__ATOMIC_RELEASE, "agent");
            asm volatile("s_waitcnt vmcnt(0)" ::: "memory");
            const unsigned og = xb_add(&bar[XB_TOP], 1u);
            const unsigned tg = og / nx;
            if (og + 1u == (tg + 1u) * nx) xb_add(&bar[XB_TOPGEN], 1u);
            else XB_SPIN(xb_ld(&bar[XB_TOPGEN]) == tg, bar);
            __builtin_amdgcn_fence(__ATOMIC_ACQUIRE, "agent");
            xb_add(&bar[XB_XGEN(x)], 1u);
            asm volatile("s_waitcnt vmcnt(0)" ::: "memory");
        } else {
            XB_SPIN(xb_ld(&bar[XB_XGEN(x)]) == gen, bar);
            __builtin_amdgcn_fence(__ATOMIC_ACQUIRE, "agent");
            asm volatile("s_waitcnt vmcnt(0)" ::: "memory");
        }
    }
    __syncthreads();
}

#undef INP
#define INP(i) (al.in[i])
typedef const __attribute__((address_space(4))) unsigned char* kptr_t;
__device__ __forceinline__ kptr_t opq_k(kptr_t p) { asm volatile("" : "+s"(p)); return p; }
__device__ __forceinline__ Args load_args(kptr_t kp) {
    typedef const __attribute__((address_space(4))) unsigned long long* q_t; q_t q = (q_t)kp; Args r;
#pragma unroll
    for (int i = 0; i < 30; ++i) r.in[i] = (const float*)q[i];
    r.out = (float*)q[30]; r.ws = (unsigned char*)q[31]; return r;
}
#define FRESH() const Args al = load_args(opq_k((kptr_t)__builtin_amdgcn_kernarg_segment_ptr())); unsigned char* ws = al.ws; \
    const int G = __builtin_amdgcn_readfirstlane(opq((int)gridDim.x)); const int NGW = G * 8; (void)NGW; \
    const int wave = __builtin_amdgcn_readfirstlane(opq(wave0)); const int c = __builtin_amdgcn_readfirstlane(opq((int)blockIdx.x)); const int gw = c * 8 + wave; \
    float* MOD = (float*)(ws + WS_MOD); float* X = (float*)(ws + WS_X); bf16_t* HM = (bf16_t*)(ws + WS_HM); bf16_t* F1 = (bf16_t*)(ws + WS_F1); bf16_t* MIX = (bf16_t*)(ws + WS_MIX); \
    (void)MOD; (void)X; (void)HM; (void)F1; (void)MIX; (void)gw;
#define LAYER_BODY(l) { \
        { FRESH(); PH(5) cumsum_items(al, l, lds, tid, wave, lane, c, G); } \
        PH(6) { FRESH(); pg8::Gemm g{HM, (const bf16_t*)(ws + WS_WIN) + (size_t)l * 1536 * 1024, MT, 1536, 1024, 1024, 1024, 1 << 20, 0, 512u, (const bf16_t*)(ws + WS_WV) + (size_t)l * 512 * 1024, HM}; \
          pg8::PhaseAOrder S; S.init(G, c); \
          EpiA E{EpiIn{(bf16_t*)(ws + WS_Q), (bf16_t*)(ws + WS_KP), (bf16_t*)(ws + WS_KS), (bf16_t*)(ws + WS_UA), al.out, l}, EpiVT{(bf16_t*)(ws + WS_VTP), (bf16_t*)(ws + WS_VTS), al.out, l, lds}, EpiVtPart{(float*)(ws + WS_F1)}}; \
          pg8::gemm_phase(lds, g, S, E, wave); } \
        GSYNC(); \
        PH(8) { FRESH(); pg8::Gemm g{(const bf16_t*)(ws + WS_UA), (const bf16_t*)(ws + WS_BT1) + (size_t)l * 32 * 128 * 256, NG * CHP, 256, 256, UAK, 256, 5, (size_t)128 * 256, 0u}; \
          pg8::StaticOrder S; S.init(NG * CHP, 256, G, c); \
          EpiE E{(float*)(ws + WS_E)}; \
          pg8::gemm_phase(lds, g, S, E, wave); } \
        { FRESH(); if (c >= 160) vt_finalize(al, l, lane, (c - 160) * 8 + wave, (G - 160) * 8); } \
        GSYNC(); \
        { FRESH(); PH(9) ssm_scan(al, l, lds, wave, lane, c, G); kmax_items(al, lane, gw, NGW); } \
        GSYNC(); \
        PH(10) { FRESH(); pg8::Gemm g{(const bf16_t*)(ws + WS_UA), (const bf16_t*)(ws + WS_BT3) + (size_t)l * 32 * 256 * UAK, NG * CHP, 256, UAK, UAK, UAK, 5, (size_t)256 * UAK, 0u}; \
          pg8::StaticOrder S; S.init(NG * CHP, 256, G, c); \
          EpiZ E{(bf16_t*)(ws + WS_Z)}; \
          pg8::gemm_phase(lds, g, S, E, wave); } \
        GSYNC(); \
        PH(11) { FRESH(); pg8::Gemm g{(const bf16_t*)(ws + WS_Z), (const bf16_t*)(ws + WS_WGLU) + (size_t)l * 512 * 512, MT, 512, 512, 512, 512, 1 << 20, 0, 0u}; \
          pg8::StaticOrder S; S.init(MT, 512, G, c); \
          EpiGlu E{(const bf16_t*)(ws + WS_Z), MIX}; \
          pg8::gemm_phase(lds, g, S, E, wave); } \
        __syncthreads(); \
        { FRESH(); PH(12) attn_phase(al, l, lds, tid, wave, lane); } \
        GSYNC(); \
        PH(13) { FRESH(); pg8::Gemm g{MIX, (const bf16_t*)(ws + WS_WOUT) + (size_t)l * 1024 * 1024, MT, 1024, 1024, 1024, 1024, 1 << 20, 0, 256u}; \
          pg8::MainSplitOrder S; S.init(G, c, 8, 2); \
          EpiMS E{EpiPlain{F1, 1024}, EpiAtomic{(float*)(ws + WS_Q)}}; \
          pg8::gemm_phase(lds, g, S, E, wave); } \
        GSYNC(); \
        { FRESH(); const float* modl = MOD + (size_t)l * 12 * 6144; \
          PH(14) rowpass<8>(INP(0), INP(1), l == 0 ? (const bf16_t*)nullptr : (const bf16_t*)X, F1, (const float*)(ws + WS_Q), 8, modl + 2 * 1024, INP(12) + l * 1024, nullptr, (bf16_t*)X, \
                INP(13) + l * 1024, modl + 4 * 1024, modl + 3 * 1024, HM, nullptr, nullptr, al.out, 0, lane, gw, NGW); } \
        GSYNC(); \
        PH(15) { FRESH(); pg8::Gemm g{HM, (const bf16_t*)(ws + WS_WGU) + (size_t)l * 5632 * 1024, MT, 5632, 1024, 1024, 1024, 1 << 20, 0, 0u}; \
          pg8::StaticOrder S; S.init(MT, 5632, G, c); \
          EpiSwi E{(bf16_t*)(ws + WS_H)}; \
          pg8::gemm_phase(lds, g, S, E, wave); } \
        GSYNC(); \
        PH(16) { FRESH(); pg8::Gemm g{(const bf16_t*)(ws + WS_H), (const bf16_t*)(ws + WS_WD) + (size_t)l * 1024 * DFF, MT, 1024, DFF, DFF, DFF, 1 << 20, 0, 512u}; \
          pg8::MainSplitOrder S; S.init(G, c, 11, 4); \
          EpiMS E{EpiPlain{F1, 1024}, EpiAtomic{(float*)(ws + WS_FS2)}}; \
          pg8::gemm_phase(lds, g, S, E, wave); } \
        GSYNC(); \
        if (l + 1 < NL) { \
            { FRESH(); const float* modl = MOD + (size_t)l * 12 * 6144; const float* modn = MOD + (size_t)(l + 1) * 12 * 6144; \
              PH(17) rowpass<11>(INP(0), INP(1), (const bf16_t*)X, F1, (const float*)(ws + WS_FS2), 11, modl + 5 * 1024, INP(14) + l * 1024, nullptr, (bf16_t*)X, INP(11) + (l + 1) * 1024, modn + 1024, modn, HM, \
                    (const float*)(ws + WS_WG) + (size_t)(l + 1) * 8 * 1024, INP(16) + (l + 1) * 8, al.out, l + 1, lane, gw, NGW); \
              PH(1) cache_convert(al, l + 1, lds, wave, lane, gw, NGW); } \
            GSYNC(); \
        } else { \
            FRESH(); const float* modl = MOD + (size_t)l * 12 * 6144; \
            PH(18) rowpass<11>(INP(0), INP(1), (const bf16_t*)X, F1, (const float*)(ws + WS_FS2), 11, modl + 5 * 1024, INP(14) + l * 1024, al.out, nullptr, nullptr, nullptr, nullptr, nullptr, nullptr, nullptr, al.out, 0, lane, gw, NGW); \
        } \
    }
__global__ void __launch_bounds__(512, 2) mega(Args a) {
    extern __shared__ __attribute__((aligned(16))) unsigned char lds_raw[];
    LAS unsigned char* lds = (LAS unsigned char*)lds_raw;
    cg::grid_group grid = cg::this_grid();
    const int wave0 = __builtin_amdgcn_readfirstlane((int)threadIdx.x >> 6);
#define GSYNC() do { const Args alb = load_args(opq_k((kptr_t)__builtin_amdgcn_kernarg_segment_ptr())); \
        const int ln_ = (int)__builtin_amdgcn_mbcnt_hi(~0u, __builtin_amdgcn_mbcnt_lo(~0u, (unsigned)opq(0))); \
        xcd_barrier((unsigned*)(alb.ws + WS_CTL), (volatile LAS unsigned*)(lds + LDS_MISC), wave0 == 0 && ln_ == 0, (unsigned)gridDim.x); } while (0)
    if (threadIdx.x < 2) ((volatile LAS unsigned*)(lds + LDS_MISC))[threadIdx.x] = 0u;
    if (threadIdx.x == 0) (void)xb_add((unsigned*)(a.ws + WS_CTL) + XB_XCNT(xb_xcc_id()), 1u);
    __syncthreads();
#define lane ((int)__builtin_amdgcn_mbcnt_hi(~0u, __builtin_amdgcn_mbcnt_lo(~0u, (unsigned)opq(0))))
#define tid (wave * 64 + lane)

    { FRESH();
      PH(0) p0_weights(al, lds, wave, lane, gw, NGW);
      PH(1) cache_convert(al, 0, lds, wave, lane, gw, NGW);
      __syncthreads();
      PH(2) p0_adaln(al, lds, tid, wave, lane, c, G);
      PH(3) p0_ssm(al, lds, tid, (c + 128) % G, G); }
    grid.sync();
    { FRESH();
      PH(4) rowpass<0>(INP(0), INP(1), nullptr, nullptr, nullptr, 0, nullptr, nullptr, nullptr, nullptr, INP(11), MOD + 1024, MOD, HM, (const float*)(ws + WS_WG), INP(16), al.out, 0, lane, gw, NGW); }
    GSYNC();

    LAYER_BODY(0)
    LAYER_BODY(1)
    LAYER_BODY(2)
    LAYER_BODY(3)
}
#undef tid
#undef lane

extern "C" void kernel_launch(void* const* d_in, const int* in_sizes, int n_in, void* d_out, int out_size, void* d_ws, size_t ws_size, hipStream_t stream) {
    static int grid = 0;
    if (grid == 0) {
        if (n_in != 30 || (size_t)out_size != O_END || ws_size < WS_END) { fprintf(stderr, "kernel_launch: unexpected sizes n_in %d out %d ws %zu\n", n_in, out_size, ws_size); grid = -1; return; }
        int dev = 0, cus = 0, per_cu = 0;
        hipGetDevice(&dev); hipDeviceGetAttribute(&cus, hipDeviceAttributeMultiprocessorCount, dev);
        hipFuncSetAttribute((const void*)mega, hipFuncAttributeMaxDynamicSharedMemorySize, LDS_BYTES);
        hipOccupancyMaxActiveBlocksPerMultiprocessor(&per_cu, (const void*)mega, 512, LDS_BYTES);
        if (per_cu < 1) { fprintf(stderr, "kernel_launch: occupancy query reports %d blocks per CU\n", per_cu); grid = -1; return; }
        if (cus != 256) { fprintf(stderr, "kernel_launch: this build's static unit orders need 256 CUs (found %d)\n", cus); grid = -1; return; }
        grid = cus;
    }
    if (grid < 0) return;
    if (hipMemsetAsync((char*)d_ws + WS_CTL, 0, CTL_BYTES, stream) != hipSuccess) { fprintf(stderr, "kernel_launch: memset failed\n"); return; }
    Args a{};
    for (int i = 0; i < 30; ++i) a.in[i] = (const float*)d_in[i];
    a.out = (float*)d_out; a.ws = (unsigned char*)d_ws;
    void* args[] = {&a};
    hipError_t e = hipLaunchCooperativeKernel((const void*)mega, dim3(grid), dim3(512), args, LDS_BYTES, stream);
    if (e != hipSuccess) fprintf(stderr, "cooperative launch failed: %s (grid %d)\n", hipGetErrorString(e), grid);
}
```

```cpp
#include <hip/hip_runtime.h>
#include <hip/hip_cooperative_groups.h>
#include <cstdio>
#include <cstdint>
namespace cg = cooperative_groups;

#define LAS __attribute__((address_space(3)))
typedef unsigned short bf16_t;
typedef short bf16x8 __attribute__((ext_vector_type(8)));
typedef float f32x4 __attribute__((ext_vector_type(4)));
typedef float f32x16 __attribute__((ext_vector_type(16)));
typedef float f32x8 __attribute__((ext_vector_type(8)));
typedef unsigned u32x4 __attribute__((ext_vector_type(4)));
typedef unsigned u32x2 __attribute__((ext_vector_type(2)));

constexpr int DM = 1024, NPR = 16384, NSM = 512, MT = 16896, NL = 4, NH = 8, HD = 64;
constexpr int SEQ = 4096, PAST = 1024, DSEQ = 64, KVS = 1088, DFF = 2816, DIN = 2056;
constexpr int NG = 32, NP = 64, MG = 16, LC = 16, NCH = MT / LC  , CHP = 1280  , UAK = 384;
constexpr float C2 = 0.125f * 1.4426950408889634f, LOG2E = 1.4426950408889634f, EPS = 1e-6f;
constexpr size_t O_YP = 0, O_KP = 17301504, O_VP = 50855936, O_LP = 84410368, O_RP = 84934656, O_IP = 84967424,
                 O_KS = 85000192, O_VS = 86048768, O_LS = 87097344, O_RS = 87113728, O_IS = 87179264, O_END = 87244800;
constexpr size_t MiB = 1u << 20;
constexpr size_t WS_CTL = 1536 * 1024, CTL_BYTES = 32768;
constexpr int LDS_MISC = 131072 + 64;
constexpr size_t WS_MOD = 0, WS_WG = 2 * MiB, WS_A16 = 2 * MiB + 256 * 1024, WS_BIASP = 3 * MiB, WS_BIASS = 3 * MiB + 512 * 1024, WS_KMAX = 2 * MiB + 384 * 1024;
constexpr size_t WS_WIN = 4 * MiB, WS_WV = 16 * MiB, WS_WGLU = 20 * MiB, WS_WOUT = 22 * MiB, WS_WGU = 30 * MiB, WS_WD = 74 * MiB;
constexpr size_t WS_BT3 = 96 * MiB, WS_BT1 = 120 * MiB, WS_HM = 130 * MiB, WS_X = 164 * MiB, WS_F1 = 230 * MiB, WS_MIX = 264 * MiB;
constexpr size_t WS_Q = 298 * MiB, WS_KP = 315 * MiB, WS_VTP = 331 * MiB, WS_KS = 347 * MiB, WS_VTS = 356 * MiB, WS_UA = 365 * MiB,
                 WS_E = 395 * MiB, WS_Z = 415 * MiB, WS_H = 298 * MiB, WS_FS1 = 435 * MiB, WS_FS2 = 443 * MiB, WS_END = 465 * MiB;
constexpr int LDS_BYTES = 151552;
#ifndef PH_MASK
#define PH_MASK 0xffffffffu
#endif
#define PH(k) if (PH_MASK & (1u << (k)))

__device__ __forceinline__ unsigned cvt_pk_bf16(float lo, float hi) { unsigned r; asm volatile("v_cvt_pk_bf16_f32 %0, %1, %2" : "=v"(r) : "v"(lo), "v"(hi)); return r; }
__device__ __forceinline__ bf16_t f2bf(float f) { return (bf16_t)(cvt_pk_bf16(f, 0.f) & 0xffffu); }
__device__ __forceinline__ float bf2f(unsigned short b) { return __uint_as_float(((unsigned)b) << 16); }
__device__ __forceinline__ int opq(int x) { asm volatile("" : "+v"(x)); return x; }
__device__ __forceinline__ float bperm(float v, int srclane) { return __int_as_float(__builtin_amdgcn_ds_bpermute(srclane << 2, __float_as_int(v))); }
__device__ __forceinline__ float dpp_f(float v, const int ctrl) { return v; }
#define DPPADD(v, ctrl) v += __int_as_float(__builtin_amdgcn_update_dpp(0, __float_as_int(v), ctrl, 0xF, 0xF, true))
__device__ __forceinline__ float wave_sum(float v, int ln) {
    (void)ln;
    DPPADD(v, 0xB1);
    DPPADD(v, 0x4E);
    DPPADD(v, 0x141);
    DPPADD(v, 0x140);
    const float r0 = __int_as_float(__builtin_amdgcn_readlane(__float_as_int(v), 0)), r1 = __int_as_float(__builtin_amdgcn_readlane(__float_as_int(v), 16));
    const float r2 = __int_as_float(__builtin_amdgcn_readlane(__float_as_int(v), 32)), r3 = __int_as_float(__builtin_amdgcn_readlane(__float_as_int(v), 48));
    return (r0 + r1) + (r2 + r3);
}
__device__ __forceinline__ float sigm(float x) { return __builtin_amdgcn_rcpf(1.f + __builtin_amdgcn_exp2f(-1.4426950408889634f * x)); }
__device__ __forceinline__ float silu_f(float x) { return x * sigm(x); }
__device__ __forceinline__ float gelu_f(float x) { const float u = 0.7978845608028654f * (x + 0.044715f * x * x * x); return x * sigm(2.f * u); }
__device__ __forceinline__ float logsig(float x) { return fminf(x, 0.f) - log1pf(__expf(-fabsf(x))); }

namespace pg8 {
constexpr int BM = 256, BK = 64, HALF = 128, HTB = HALF * BK * 2, STAGE_BYTES = 8 * HTB, NXCD = 8, WGM = 8;
__host__ __device__ __forceinline__ int lds_byte(int r, int c) { const int st = (r >> 4) * 2 + (c >> 5), rr = r & 15, cc = c & 31, ob = rr * 64 + cc * 2; return st * 1024 + (ob ^ (((ob >> 9) & 1) << 5)); }
__host__ __device__ __forceinline__ void stage_rc(int b, int& R, int& C) { const int st = b / 1024, sb = b % 1024, swz = sb ^ (((sb >> 9) & 1) << 5); R = (st >> 1) * 16 + swz / 64; C = (st & 1) * 32 + (swz % 64) / 2; }
__host__ __device__ __forceinline__ int perm32(int rho) { const int n = rho >> 4, i = rho & 15; return 8 * (i >> 2) + 4 * n + (i & 3); }
struct Unit { int pm, pn, ks, kind, nt; };
struct Gemm { const bf16_t* A; const bf16_t* Bt; int M, N, K, lda, ldb, gdiv; size_t gstrideB; unsigned kcb; const bf16_t* A1; const bf16_t* Bt1; };
struct StaticOrder {
    int nM, nN, nwg, G, c;
    __device__ __forceinline__ void init(int M, int N, int G_, int c_) { nM = M / BM; nN = N / BM; nwg = nM * nN; G = G_; c = c_; }
    __device__ __forceinline__ bool next(int i, Unit& u) const {
        const long L = (long)i * G + c; if (L >= nwg) return false;
        int wgid = (int)L; { const int q = nwg / NXCD, r = nwg % NXCD, xcd = wgid % NXCD, off = wgid / NXCD; wgid = (xcd < r ? xcd * (q + 1) : r * (q + 1) + (xcd - r) * q) + off; }
        const int nig = WGM * nN, gid = wgid / nig, fm = gid * WGM, gsz = (nM - fm) < WGM ? (nM - fm) : WGM;
        u.pm = fm + ((wgid % nig) % gsz); u.pn = (wgid % nig) / gsz; u.ks = 0; u.kind = 0; u.nt = 0; return true;
    }
};
struct SplitOrder {
    int nsub, G, c, S;
    __device__ __forceinline__ void init(int S_, int G_, int c_) { S = S_; nsub = 8 * S_; G = G_; c = c_; }
    __device__ __forceinline__ bool next(int i, Unit& u) const { const int idx = i * G + c; if (idx >= nsub) return false; u.ks = idx % S; const int t = idx / S; u.pn = t & 3; u.pm = 64 + (t >> 2); u.kind = 0; u.nt = 0; return true; }
};
struct VtOrder {
    int idx;
    __device__ __forceinline__ void init(int G_, int c_) { idx = c_ - (G_ - 116); }
    __device__ __forceinline__ bool next(int i, Unit& u) const { if (i != 0 || idx < 0 || idx >= 116) return false; u.pm = idx / 58; u.pn = idx - u.pm * 58; u.ks = 0; u.kind = 0; u.nt = 0; return true; }
};
struct VtSplitOrder {
    int c;
    __device__ __forceinline__ void init(int c_) { c = c_; }
    __device__ __forceinline__ bool next(int i, Unit& u) const { if (i != 0 || c >= 64) return false; const int tile = c >> 2; u.ks = c & 3; u.pm = tile >> 3; u.pn = 58 + (tile & 7); u.kind = 0; u.nt = 0; return true; }
};
struct PhaseAOrder {
    StaticOrder so; int c;
    __device__ __forceinline__ void init(int G_, int c_) { so.init(MT, 1536, G_, c_); c = c_; }
    __device__ __forceinline__ bool next(int i, Unit& u) const {
        Unit t = {0, 0, 0, 0, 0}; bool ok = false;
        if (i <= 1) ok = so.next(i, t);
        int pm = t.pm, pn = t.pn, ks = 0, kind = 0, nt = 0;
        if (i == 1 && !ok) { const int idx = c - 140; ok = idx >= 0 && idx < 116; pm = idx / 58; pn = idx - pm * 58; kind = 1; nt = 16; }
        if (i == 2) { ok = c < 64; const int tile = c >> 2; ks = c & 3; pm = tile >> 3; pn = 58 + (tile & 7); kind = 1; nt = 4; }
        u.pm = pm; u.pn = pn; u.ks = ks; u.kind = kind; u.nt = nt;
        return ok;
    }
};
struct MainSplitOrder {
    StaticOrder so; int c, S, nts;
    __device__ __forceinline__ void init(int G_, int c_, int S_, int nts_) { so.init(NPR, 1024, G_, c_); c = c_; S = S_; nts = nts_; }
    __device__ __forceinline__ bool next(int i, Unit& u) const {
        Unit t = {0, 0, 0, 0, 0}; bool ok = false;
        if (i == 0) ok = so.next(0, t);
        int pm = t.pm, pn = t.pn, ks = 0, nt = 0;
        if (i == 1) { ok = c < 8 * S; ks = c % S; const int tt = c / S; pn = tt & 3; pm = 64 + (tt >> 2); nt = nts; }
        u.pm = pm; u.pn = pn; u.ks = ks; u.kind = 0; u.nt = nt;
        return ok;
    }
};
template <class Epi, class Sched>
__device__ __forceinline__ void gemm_phase(LAS unsigned char* lds, const Gemm g, const Sched& S, const Epi& E, const int wave_id) {
    const int lane = (int)__builtin_amdgcn_mbcnt_hi(~0u, __builtin_amdgcn_mbcnt_lo(~0u, (unsigned)opq(0))), wid = wave_id, tid = wid * 64 + lane, wr = wid >> 2, wc = wid & 3, fr = lane & 15, fq = lane >> 4;
    unsigned voffA[2], voffB[2];
#pragma unroll
    for (int i = 0; i < 2; ++i) { int R, C; stage_rc(tid * 16 + i * 8192, R, C); const int Rb = (R & ~31) + perm32(R & 31);
        voffA[i] = (unsigned)(R * g.lda + C) * 2u; voffB[i] = (unsigned)(Rb * g.ldb + C) * 2u; }
    const unsigned kstep = (unsigned)(BK * 2);
    const unsigned hstepA = (unsigned)HALF * g.lda * 2, hstepB = (unsigned)HALF * g.ldb * 2, tstepA = 2 * hstepA, tstepB = 2 * hstepB;
    const unsigned ldsw = (unsigned)wid * 1024u;
    const int aoff = lds_byte(wr * 64 + fr, fq * 8), boff = lds_byte(wc * 32 + fr, fq * 8);
#define PG8_SA(b, h) (((b) * 2 + (h)) * HTB)
#define PG8_SB(b, h) ((4 + (b) * 2 + (h)) * HTB)
#define PG8_STAGE(bufoff, gbase, voff) do { _Pragma("unroll") for (int _i = 0; _i < 2; ++_i) \
        __builtin_amdgcn_global_load_lds((const unsigned*)((const char*)(gbase) + (voff)[_i]), (LAS unsigned*)(lds + (bufoff) + ldsw + _i * 8192), 16, 0, 0); } while (0)
#define PG8_LDA(dst, b, h) do { _Pragma("unroll") for (int m = 0; m < 4; ++m) _Pragma("unroll") for (int k = 0; k < 2; ++k) dst[m][k] = *(const LAS bf16x8*)(lds + PG8_SA(b, h) + aoff + m * 2048 + k * 1024); } while (0)
#define PG8_LDB(dst, b, h) do { _Pragma("unroll") for (int n = 0; n < 2; ++n) _Pragma("unroll") for (int k = 0; k < 2; ++k) dst[n][k] = *(const LAS bf16x8*)(lds + PG8_SB(b, h) + boff + n * 2048 + k * 1024); } while (0)
#define PG8_MMA(ai, bj, At, Bt) do { __builtin_amdgcn_s_setprio(1); _Pragma("unroll") for (int m = 0; m < 4; ++m) _Pragma("unroll") for (int n = 0; n < 2; ++n) _Pragma("unroll") for (int k = 0; k < 2; ++k) \
        acc[ai][bj][m][n] = __builtin_amdgcn_mfma_f32_16x16x32_bf16(Bt[n][k], At[m][k], acc[ai][bj][m][n], 0, 0, 0); __builtin_amdgcn_s_setprio(0); } while (0)
#define PG8_WAIT_V(n) asm volatile("s_waitcnt vmcnt(" #n ")" ::: "memory")
#define PG8_WAIT_L(n) asm volatile("s_waitcnt lgkmcnt(" #n ")" ::: "memory")
#define PG8_BAR __builtin_amdgcn_s_barrier()
#define PG8_SCHED __builtin_amdgcn_sched_barrier(0)
    Unit cur = {0, 0, 0, 0, 0}, nxt = {0, 0, 0, 0, 0}; int ui = 0;
    if (!S.next(0, cur)) return;
    f32x4 acc[2][2][4][2];
    const float zf = __int_as_float(opq(0)); const f32x4 zero4 = (f32x4){zf, zf, zf, zf};
#pragma unroll
    for (int a = 0; a < 2; ++a)
#pragma unroll
        for (int b = 0; b < 2; ++b)
#pragma unroll
            for (int m = 0; m < 4; ++m)
#pragma unroll
                for (int n = 0; n < 2; ++n) acc[a][b][m][n] = zero4;
    bf16x8 At[4][2], B0[2][2], B1[2][2];
    const char* cA = (const char*)(cur.kind ? g.A1 : g.A) + (size_t)cur.pm * tstepA + (size_t)cur.ks * g.kcb;
    const char* cB = (const char*)(cur.kind ? g.Bt1 : g.Bt) + (size_t)(cur.pm / g.gdiv) * g.gstrideB * 2 + (size_t)cur.pn * tstepB + (size_t)cur.ks * g.kcb;
    int nt = cur.nt ? cur.nt : g.K / BK;
    PG8_STAGE(PG8_SB(0, 0), cB, voffB); PG8_STAGE(PG8_SB(0, 1), cB + hstepB, voffB); PG8_STAGE(PG8_SA(0, 0), cA, voffA); PG8_STAGE(PG8_SA(0, 1), cA + hstepA, voffA);
    if (wr == 1) PG8_BAR;
    PG8_WAIT_V(2); PG8_BAR;
    PG8_STAGE(PG8_SB(1, 0), cB + kstep, voffB); PG8_STAGE(PG8_SA(1, 0), cA + kstep, voffA); PG8_STAGE(PG8_SB(1, 1), cB + hstepB + kstep, voffB);
    PG8_WAIT_V(6); PG8_BAR;
    for (;;) {
        nxt.pm = 0; nxt.pn = 0; nxt.ks = 0; nxt.kind = 0; nxt.nt = 0;
        const bool has_next = S.next(ui + 1, nxt);
        const char* nA = has_next ? (const char*)(nxt.kind ? g.A1 : g.A) + (size_t)nxt.pm * tstepA + (size_t)nxt.ks * g.kcb : cA;
        const char* nB = has_next ? (const char*)(nxt.kind ? g.Bt1 : g.Bt) + (size_t)(nxt.pm / g.gdiv) * g.gstrideB * 2 + (size_t)nxt.pn * tstepB + (size_t)nxt.ks * g.kcb : cB;
#pragma unroll 1
        for (int t = 0; t < nt; t += 2) {
            const bool last = (t == nt - 2);
            const char* a1 = cA + (unsigned)(t + 1) * kstep;
            const char* a2 = last ? nA : cA + (unsigned)(t + 2) * kstep; const char* b2 = last ? nB : cB + (unsigned)(t + 2) * kstep;
            const char* a3 = a2 + kstep; const char* b3 = b2 + kstep;
            PG8_LDB(B0, 0, 0); PG8_LDB(B1, 0, 1); PG8_SCHED; PG8_LDA(At, 0, 0); PG8_STAGE(PG8_SA(1, 1), a1 + hstepA, voffA);
            PG8_WAIT_V(8); PG8_WAIT_L(0); PG8_BAR; PG8_MMA(0, 0, At, B0); PG8_MMA(0, 1, At, B1); PG8_BAR; PG8_SCHED;
            PG8_LDA(At, 0, 1); PG8_STAGE(PG8_SB(0, 0), b2, voffB); PG8_STAGE(PG8_SB(0, 1), b2 + hstepB, voffB); PG8_STAGE(PG8_SA(0, 0), a2, voffA);
            PG8_WAIT_V(8); PG8_WAIT_L(0); PG8_BAR; PG8_MMA(1, 0, At, B0); PG8_MMA(1, 1, At, B1); PG8_BAR; PG8_SCHED;
            PG8_LDB(B0, 1, 0); PG8_LDB(B1, 1, 1); PG8_SCHED; PG8_LDA(At, 1, 0); PG8_STAGE(PG8_SA(0, 1), a2 + hstepA, voffA);
            PG8_WAIT_V(8); PG8_WAIT_L(0); PG8_BAR; PG8_MMA(0, 0, At, B0); PG8_MMA(0, 1, At, B1); PG8_BAR; PG8_SCHED;
            PG8_LDA(At, 1, 1); PG8_STAGE(PG8_SB(1, 0), b3, voffB); PG8_STAGE(PG8_SB(1, 1), b3 + hstepB, voffB); PG8_STAGE(PG8_SA(1, 0), a3, voffA);
            PG8_WAIT_V(8); PG8_WAIT_L(0); PG8_BAR; PG8_MMA(1, 0, At, B0); PG8_MMA(1, 1, At, B1); PG8_BAR; PG8_SCHED;
        }
        if (wr == 0) PG8_BAR;
        E(acc, cur, wr, wc, fr, fq);
        if (!has_next) break;
#pragma unroll
        for (int a = 0; a < 2; ++a)
#pragma unroll
            for (int b = 0; b < 2; ++b)
#pragma unroll
                for (int m = 0; m < 4; ++m)
#pragma unroll
                    for (int n = 0; n < 2; ++n) acc[a][b][m][n] = zero4;
        cur = nxt; cA = nA; cB = nB; ++ui; nt = cur.nt ? cur.nt : g.K / BK;
        if (wr == 1) PG8_BAR;
    }
    PG8_WAIT_V(0);
    PG8_BAR;
#undef PG8_SA
#undef PG8_SB
#undef PG8_STAGE
#undef PG8_LDA
#undef PG8_LDB
#undef PG8_MMA
#undef PG8_WAIT_V
#undef PG8_WAIT_L
#undef PG8_BAR
#undef PG8_SCHED
}
}
using pg8::Unit;
typedef const f32x4 (&AccRef)[2][2][4][2];
__device__ __forceinline__ u32x4 pack8(f32x4 v0, f32x4 v1) { u32x4 w; w.x = cvt_pk_bf16(v0[0], v0[1]); w.y = cvt_pk_bf16(v0[2], v0[3]); w.z = cvt_pk_bf16(v1[0], v1[1]); w.w = cvt_pk_bf16(v1[2], v1[3]); return w; }

struct EpiPlain {
    bf16_t* O; int ldc;
    __device__ __forceinline__ void operator()(AccRef acc, const Unit& u, int wr, int wc, int fr, int fq) const {
        fr = opq(fr); fq = opq(fq);
#pragma unroll
        for (int ai = 0; ai < 2; ++ai)
#pragma unroll
            for (int m = 0; m < 4; ++m) { const int r = u.pm * 256 + ai * 128 + wr * 64 + m * 16 + fr;
#pragma unroll
                for (int bj = 0; bj < 2; ++bj) { const int c = u.pn * 256 + bj * 128 + wc * 32 + 8 * fq;
                    *(u32x4*)(O + (size_t)r * ldc + c) = pack8(acc[ai][bj][m][0], acc[ai][bj][m][1]); } }
    }
};
struct EpiIn {
    bf16_t *Q, *KP, *KS, *UA; float* out; int l;
    __device__ __forceinline__ void operator()(AccRef acc, const Unit& u, int wr, int wc, int fr, int fq) const {
        fr = opq(fr); fq = opq(fq);
        const bool prompt = u.pm < 64;
#pragma unroll
        for (int ai = 0; ai < 2; ++ai)
#pragma unroll
            for (int m = 0; m < 4; ++m) { const int r = u.pm * 256 + ai * 128 + wr * 64 + m * 16 + fr;
#pragma unroll
                for (int bj = 0; bj < 2; ++bj) { const int c = u.pn * 256 + bj * 128 + wc * 32 + 8 * fq;
                    const f32x4 v0 = acc[ai][bj][m][0], v1 = acc[ai][bj][m][1];
                    if (u.pn < 2) { *(u32x4*)(Q + (size_t)r * 512 + c) = pack8(v0 * C2, v1 * C2); }
                    else if (u.pn < 4) { const int ck = c - 512, h = ck >> 6, d = ck & 63; const u32x4 w = pack8(v0, v1);
                        if (prompt) { const int b = r >> 12, t = r & 4095;
                            *(u32x4*)(KP + ((size_t)(b * 8 + h) * 4096 + t) * 64 + d) = w;
                            float* o = out + O_KP + ((size_t)((l * 4 + b) * 8 + h) * 4096 + t) * 64 + d; *(f32x4*)o = v0; *(f32x4*)(o + 4) = v1; }
                        else { const int rr = r - NPR, b = rr >> 6, t = rr & 63;
                            *(u32x4*)(KS + ((size_t)(b * 8 + h) * KVS + PAST + t) * 64 + d) = w;
                            float* o = out + O_KS + ((size_t)((l * 8 + b) * 8 + h) * 64 + t) * 64 + d; *(f32x4*)o = v0; *(f32x4*)(o + 4) = v1; } }
                    else { const int cu = c - 1024, gq = cu >> 4, m0 = cu & 15, chunk = r >> 4, s = r & 15;
                        *(u32x4*)(UA + ((size_t)gq * CHP + chunk) * UAK + s * 16 + m0) = pack8(v0, v1); }
                    asm volatile("" ::: "memory"); } }
    }
};
struct EpiVT {
    bf16_t *VTP, *VTS; float* out; int l; LAS unsigned char* lds;
    __device__ __forceinline__ void operator()(AccRef acc, const Unit& u, int wr, int wc, int fr, int fq) const {
        fr = opq(fr); fq = opq(fq);
        const bool prompt = u.pn < 64; const int ln = fq * 16 + fr;
        LAS float* stg = (LAS float*)(lds + 131072 + 1024 + (wr * 4 + wc) * 2080);
#pragma unroll
        for (int ai = 0; ai < 2; ++ai)
#pragma unroll
            for (int bj = 0; bj < 2; ++bj) {
                const int h = (u.pm * 256 + ai * 128 + wr * 64) >> 6, tok0 = u.pn * 256 + bj * 128 + wc * 32;
                float* obase; bf16_t* vbase; size_t vpitch;
                if (prompt) { const int b = tok0 >> 12, t0 = tok0 & 4095; obase = out + O_VP + ((size_t)((l * 4 + b) * 8 + h) * 4096 + t0) * 64; vbase = VTP + (size_t)(b * 8 + h) * 64 * 4096 + t0; vpitch = 4096; }
                else { const int tt = tok0 - NPR, b = tt >> 6, t0 = tt & 63; obase = out + O_VS + ((size_t)((l * 8 + b) * 8 + h) * 64 + t0) * 64; vbase = VTS + (size_t)(b * 8 + h) * 64 * KVS + PAST + t0; vpitch = KVS; }
#pragma unroll
                for (int m = 0; m < 4; ++m) *(u32x4*)(vbase + (size_t)(m * 16 + fr) * vpitch + 8 * fq) = pack8(acc[ai][bj][m][0], acc[ai][bj][m][1]);
#pragma unroll
                for (int n = 0; n < 2; ++n)
#pragma unroll
                    for (int j0 = 0; j0 < 4; j0 += 2) {
#pragma unroll
                        for (int m = 0; m < 4; ++m) { stg[(2 * fq) * 65 + 16 * m + fr] = acc[ai][bj][m][n][j0]; stg[(2 * fq + 1) * 65 + 16 * m + fr] = acc[ai][bj][m][n][j0 + 1]; }
                        asm volatile("s_waitcnt lgkmcnt(0)" ::: "memory");
#pragma unroll
                        for (int sl = 0; sl < 8; ++sl) { const float v = stg[sl * 65 + ln]; obase[(size_t)(8 * (sl >> 1) + 4 * n + j0 + (sl & 1)) * 64 + ln] = v; }
                        asm volatile("s_waitcnt lgkmcnt(0)" ::: "memory");
                    }
            }
    }
};
struct EpiVtPart {
    float* PV;
    __device__ __forceinline__ void operator()(AccRef acc, const Unit& u, int wr, int wc, int fr, int fq) const {
        fr = opq(fr); fq = opq(fq);
        float* base = PV + (size_t)((u.pm * 8 + (u.pn - 58)) * 4 + u.ks) * 65536;
#pragma unroll
        for (int ai = 0; ai < 2; ++ai)
#pragma unroll
            for (int m = 0; m < 4; ++m) { const int r = ai * 128 + wr * 64 + m * 16 + fr;
#pragma unroll
                for (int bj = 0; bj < 2; ++bj) { float* o = base + r * 256 + bj * 128 + wc * 32 + 8 * fq; *(f32x4*)o = acc[ai][bj][m][0]; *(f32x4*)(o + 4) = acc[ai][bj][m][1]; } }
    }
};
struct EpiE {
    float* E;
    __device__ __forceinline__ void operator()(AccRef acc, const Unit& u, int wr, int wc, int fr, int fq) const {
        fr = opq(fr); fq = opq(fq);
#pragma unroll
        for (int ai = 0; ai < 2; ++ai)
#pragma unroll
            for (int m = 0; m < 4; ++m) { const int gq = u.pm / 5, chunk = (u.pm - gq * 5) * 256 + ai * 128 + wr * 64 + m * 16 + fr;
                { float* o = E + ((size_t)gq * CHP + chunk) * 128 + wc * 32 + 8 * fq; *(f32x4*)o = acc[ai][0][m][0]; *(f32x4*)(o + 4) = acc[ai][0][m][1]; } }
    }
};
struct EpiZ {
    bf16_t* Z;
    __device__ __forceinline__ void operator()(AccRef acc, const Unit& u, int wr, int wc, int fr, int fq) const {
        fr = opq(fr); fq = opq(fq);
#pragma unroll
        for (int ai = 0; ai < 2; ++ai)
#pragma unroll
            for (int m = 0; m < 4; ++m) { const int gq = u.pm / 5, chunk = (u.pm - gq * 5) * 256 + ai * 128 + wr * 64 + m * 16 + fr;
                {
#pragma unroll
                    for (int bj = 0; bj < 2; ++bj) { const int n = bj * 128 + wc * 32 + 8 * fq, t = n >> 4, m0 = n & 15;
                        f32x4 v0 = acc[ai][bj][m][0], v1 = acc[ai][bj][m][1];
#pragma unroll
                        for (int j = 0; j < 4; ++j) { v0[j] = gelu_f(v0[j]); v1[j] = gelu_f(v1[j]); }
                        *(u32x4*)(Z + (size_t)(chunk * 16 + t) * 512 + gq * 16 + m0) = pack8(v0, v1); __builtin_amdgcn_sched_barrier(0); } } }
    }
};
struct EpiGlu {
    const bf16_t* Z; bf16_t* MIX;
    __device__ __forceinline__ void operator()(AccRef acc, const Unit& u, int wr, int wc, int fr, int fq) const {
        fr = opq(fr); fq = opq(fq);
#pragma unroll
        for (int ai = 0; ai < 2; ++ai)
#pragma unroll
            for (int m = 0; m < 4; ++m) { const int r = u.pm * 256 + ai * 128 + wr * 64 + m * 16 + fr;
#pragma unroll
                for (int bj = 0; bj < 2; ++bj) { const int c = u.pn * 256 + bj * 128 + wc * 32 + 8 * fq;
                    const u32x4 zz = *(const u32x4*)(Z + (size_t)r * 512 + c);
                    f32x4 v0 = acc[ai][bj][m][0], v1 = acc[ai][bj][m][1];
#pragma unroll
                    for (int j = 0; j < 4; ++j) { const unsigned w0 = zz[j >> 1], w1 = zz[2 + (j >> 1)];
                        const float z0 = (j & 1) ? __uint_as_float(w0 & 0xffff0000u) : __uint_as_float(w0 << 16);
                        const float z1 = (j & 1) ? __uint_as_float(w1 & 0xffff0000u) : __uint_as_float(w1 << 16);
                        v0[j] = z0 * sigm(v0[j]); v1[j] = z1 * sigm(v1[j]); }
                    *(u32x4*)(MIX + (size_t)r * 1024 + 512 + c) = pack8(v0, v1); } }
    }
};
struct EpiAtomic {
    float* FS;
    __device__ __forceinline__ void operator()(AccRef acc, const Unit& u, int wr, int wc, int fr, int fq) const {
        fr = opq(fr); fq = opq(fq);
#pragma unroll
        for (int ai = 0; ai < 2; ++ai)
#pragma unroll
            for (int m = 0; m < 4; ++m) { const int r = (u.pm - 64) * 256 + ai * 128 + wr * 64 + m * 16 + fr;
#pragma unroll
                for (int bj = 0; bj < 2; ++bj) { float* o = FS + ((size_t)u.ks * 512 + r) * 1024 + u.pn * 256 + bj * 128 + wc * 32 + 8 * fq;
                    *(f32x4*)o = acc[ai][bj][m][0]; *(f32x4*)(o + 4) = acc[ai][bj][m][1]; } }
    }
};
struct EpiSwi {
    bf16_t* H;
    __device__ __forceinline__ void operator()(AccRef acc, const Unit& u, int wr, int wc, int fr, int fq) const {
        fr = opq(fr); fq = opq(fq);
#pragma unroll
        for (int ai = 0; ai < 2; ++ai)
#pragma unroll
            for (int m = 0; m < 4; ++m) { const int r = u.pm * 256 + ai * 128 + wr * 64 + m * 16 + fr; const int c = u.pn * 128 + wc * 32 + 8 * fq;
                f32x4 v0 = acc[ai][0][m][0], v1 = acc[ai][0][m][1]; const f32x4 u0 = acc[ai][1][m][0], u1 = acc[ai][1][m][1];
#pragma unroll
                for (int j = 0; j < 4; ++j) { v0[j] = silu_f(v0[j]) * u0[j]; v1[j] = silu_f(v1[j]) * u1[j]; }
                *(u32x4*)(H + (size_t)r * DFF + c) = pack8(v0, v1); }
    }
};

struct EpiA {
    EpiIn in; EpiVT vt; EpiVtPart vp;
    __device__ __forceinline__ void operator()(AccRef acc, const Unit& u, int wr, int wc, int fr, int fq) const {
        if (u.kind == 0) in(acc, u, wr, wc, fr, fq); else if (u.nt == 16) vt(acc, u, wr, wc, fr, fq); else vp(acc, u, wr, wc, fr, fq);
    }
};
struct EpiMS {
    EpiPlain p; EpiAtomic q;
    __device__ __forceinline__ void operator()(AccRef acc, const Unit& u, int wr, int wc, int fr, int fq) const {
        if (u.pm < 64) p(acc, u, wr, wc, fr, fq); else q(acc, u, wr, wc, fr, fq);
    }
};
struct Args { const float* in[30]; float* out; unsigned char* ws; };
struct Ctx {
    LAS unsigned char* lds; int tid, lane, wave, G, c;
    const float* const* in; float* out; unsigned char* ws;
};
#define INP(i) (a.in[i])

__device__ __forceinline__ void tr_item(const float* W, size_t ldw, int k0, int sc0, bf16_t* WT, size_t ldo, int dr0, LAS float* scr, int lane) {
    f32x4 tv[8];
#pragma unroll
    for (int i = 0; i < 8; ++i) { const int kk = 8 * i + (lane >> 3); tv[i] = *(const f32x4*)(W + (size_t)(k0 + kk) * ldw + sc0 + 4 * (lane & 7)); }
#pragma unroll
    for (int i = 0; i < 8; ++i) { const int kk = 8 * i + (lane >> 3); LAS float* d = scr + kk * 33 + 4 * (lane & 7); d[0] = tv[i][0]; d[1] = tv[i][1]; d[2] = tv[i][2]; d[3] = tv[i][3]; }
    asm volatile("s_waitcnt lgkmcnt(0)" ::: "memory");
    const int c = lane & 7;
#pragma unroll
    for (int j = 0; j < 4; ++j) { const int n = (lane >> 3) + 8 * j; const LAS float* s = scr + (8 * c) * 33 + n;
        u32x4 o; o.x = cvt_pk_bf16(s[0 * 33], s[1 * 33]); o.y = cvt_pk_bf16(s[2 * 33], s[3 * 33]); o.z = cvt_pk_bf16(s[4 * 33], s[5 * 33]); o.w = cvt_pk_bf16(s[6 * 33], s[7 * 33]);
        *(u32x4*)(WT + (size_t)(dr0 + n) * ldo + k0 + 8 * c) = o; }
    asm volatile("s_waitcnt lgkmcnt(0)" ::: "memory");
}

__device__ __forceinline__ void sincos_d(double x, double& s, double& c) {
    const double k = rint(x * 0.63661977236758134308);
    const double r = (x - k * 1.57079632679489655800) - k * 6.123233995736766036e-17;
    const double r2 = r * r;
    double sp = 1.0 / 6227020800.0; sp = sp * r2 - 1.0 / 39916800.0; sp = sp * r2 + 1.0 / 362880.0; sp = sp * r2 - 1.0 / 5040.0; sp = sp * r2 + 1.0 / 120.0; sp = sp * r2 - 1.0 / 6.0; sp = sp * r2 + 1.0;
    const double sr = r * sp;
    double cp = 1.0 / 87178291200.0; cp = cp * r2 - 1.0 / 479001600.0; cp = cp * r2 + 1.0 / 3628800.0; cp = cp * r2 - 1.0 / 40320.0; cp = cp * r2 + 1.0 / 720.0; cp = cp * r2 - 1.0 / 24.0; cp = cp * r2 + 0.5;
    const double cr = 1.0 - r2 * cp;
    const int q = ((int)k) & 3;
    s = (q == 0) ? sr : (q == 1) ? cr : (q == 2) ? -sr : -cr;
    c = (q == 0) ? cr : (q == 1) ? -sr : (q == 2) ? -cr : sr;
}

__device__ __forceinline__ void p0_weights(const Args& a, LAS unsigned char* lds, int wave, int lane, int gw, int NGW) {
    LAS float* scr = (LAS float*)(lds + wave * 16384);
    constexpr int I_IN = 16 * 16, I_GLU = 8 * 16, I_OUT = 16 * 32, I_G = 16 * 88, I_D = 44 * 32;
    constexpr int PER_L = 4 * I_IN + I_GLU + I_OUT + 2 * I_G + I_D;
    for (int it = gw; it < NL * PER_L; it += NGW) {
        const int l = it / PER_L; int r = it - l * PER_L;
        const float* win = INP(15) + (size_t)l * DM * DIN;
        bf16_t* WIN = (bf16_t*)(a.ws + WS_WIN) + (size_t)l * 1536 * 1024;
        if (r < 4 * I_IN) { const int part = r / I_IN, rr = r % I_IN, kb = rr / 16, nb = rr % 16;
            if (part == 0) tr_item(win, DIN, 64 * kb, 32 * nb, WIN, 1024, 32 * nb, scr, lane);
            else if (part == 1) tr_item(win, DIN, 64 * kb, 512 + 32 * nb, WIN, 1024, 512 + 32 * nb, scr, lane);
            else if (part == 2) tr_item(win, DIN, 64 * kb, 1544 + 32 * nb, WIN, 1024, 1024 + 32 * nb, scr, lane);
            else tr_item(win, DIN, 64 * kb, 1024 + 32 * nb, (bf16_t*)(a.ws + WS_WV) + (size_t)l * 512 * 1024, 1024, 32 * nb, scr, lane);
            continue; }
        r -= 4 * I_IN;
        if (r < I_GLU) { tr_item(INP(25) + (size_t)l * 512 * 512, 512, 64 * (r / 16), 32 * (r % 16), (bf16_t*)(a.ws + WS_WGLU) + (size_t)l * 512 * 512, 512, 32 * (r % 16), scr, lane); continue; }
        r -= I_GLU;
        if (r < I_OUT) { tr_item(INP(26) + (size_t)l * 1024 * 1024, 1024, 64 * (r / 32), 32 * (r % 32), (bf16_t*)(a.ws + WS_WOUT) + (size_t)l * 1024 * 1024, 1024, 32 * (r % 32), scr, lane); continue; }
        r -= I_OUT;
        if (r < 2 * I_G) { const int up = r / I_G, rr = r % I_G, kb = rr / 88, nb = rr % 88, c0 = 32 * nb;
            tr_item(INP(27 + up) + (size_t)l * DM * DFF, DFF, 64 * kb, c0, (bf16_t*)(a.ws + WS_WGU) + (size_t)l * 5632 * 1024, 1024, (c0 >> 7) * 256 + up * 128 + (c0 & 127), scr, lane);
            continue; }
        r -= 2 * I_G;
        tr_item(INP(29) + (size_t)l * DFF * DM, DM, 64 * (r / 32), 32 * (r % 32), (bf16_t*)(a.ws + WS_WD) + (size_t)l * 1024 * DFF, DFF, 32 * (r % 32), scr, lane);
    }
    float* WG = (float*)(a.ws + WS_WG);
    for (int i = gw * 64 + lane; i < NL * 8 * 1024; i += NGW * 64) { const int l = i >> 13, h = (i >> 10) & 7, k = i & 1023; WG[i] = INP(15)[((size_t)l * DM + k) * DIN + 1536 + h]; }
}
__device__ __forceinline__ void p0_adaln(const Args& a, LAS unsigned char* lds, int tid, int wave, int lane, int c, int G) {
    LAS float* sc = (LAS float*)(lds);
    LAS float* red = (LAS float*)(lds + 49152);
    for (int i = tid; i < 12 * 1024; i += 512) { const float v = (i < 4096) ? INP(2)[i] : INP(3)[i - 4096]; sc[i] = silu_f(v); }
    __syncthreads();
    float* MOD = (float*)(a.ws + WS_MOD);
    for (int it = c; it < NL * 96; it += G) {
        const int l = it / 96, n0 = (it % 96) * 64;
        const float* W = INP(9) + (size_t)l * DM * 6144 + n0 + lane;
        float acc[12];
#pragma unroll
        for (int b = 0; b < 12; ++b) acc[b] = 0.f;
        for (int k = wave * 128; k < wave * 128 + 128; k += 16) {
            float w[16];
#pragma unroll
            for (int j = 0; j < 16; ++j) w[j] = W[(size_t)(k + j) * 6144];
#pragma unroll
            for (int j = 0; j < 16; ++j)
#pragma unroll
                for (int b = 0; b < 12; ++b) acc[b] += sc[b * 1024 + k + j] * w[j];
        }
#pragma unroll
        for (int b = 0; b < 12; ++b) red[(wave * 12 + b) * 64 + lane] = acc[b];
        __syncthreads();
        for (int i = tid; i < 768; i += 512) { const int b = i >> 6, cc = i & 63; float s = 0.f;
#pragma unroll
            for (int w = 0; w < 8; ++w) s += red[(w * 12 + b) * 64 + cc];
            MOD[((size_t)l * 12 + b) * 6144 + n0 + cc] = s + INP(10)[(size_t)l * 6144 + n0 + cc]; }
        __syncthreads();
    }
}
__device__ __forceinline__ void p0_ssm(const Args& a, LAS unsigned char* lds, int tid, int c, int G) {
    LAS float* ap_re = (LAS float*)(lds + 65536);
    LAS float* ap_im = ap_re + 17 * 64;
    LAS float* bb_re = ap_im + 17 * 64;
    LAS float* bb_im = bb_re + 1024;
    LAS float* cc_re = bb_im + 1024;
    LAS float* cc_im = cc_re + 1024;
    LAS float* ktab = cc_im + 1024;
    for (int it = c; it < NL * NG; it += G) {
        const int l = it >> 5, gq = it & 31;
        const double dt = exp((double)INP(19)[l * 32 + gq]);
        for (int idx = tid; idx < 17 * 64; idx += 512) { const int d = idx >> 6, p = idx & 63;
            const double ar = (double)INP(17)[(l * 32 + gq) * 64 + p], ai = (double)INP(18)[(l * 32 + gq) * 64 + p];
            double s, co; sincos_d((double)d * ai * dt, s, co); const double er = exp((double)d * ar * dt);
            ap_re[idx] = (float)(er * co); ap_im[idx] = (float)(er * s); }
        for (int idx = tid; idx < 1024; idx += 512) { const int p = idx >> 4, m = idx & 15;
            const double ar = (double)INP(17)[(l * 32 + gq) * 64 + p], ai = (double)INP(18)[(l * 32 + gq) * 64 + p];
            double s, co; sincos_d(ai * dt, s, co); const double er = exp(ar * dt);
            const double xr = er * co - 1.0, xi = er * s, den = 1.0 / (ar * ar + ai * ai);
            const double qr = (xr * ar + xi * ai) * den, qi = (xi * ar - xr * ai) * den;
            const double br = (double)INP(20)[((size_t)(l * 32 + gq) * 64 + p) * 16 + m], bi = (double)INP(21)[((size_t)(l * 32 + gq) * 64 + p) * 16 + m];
            bb_re[idx] = (float)(qr * br - qi * bi); bb_im[idx] = (float)(qr * bi + qi * br);
            cc_re[idx] = INP(22)[(size_t)(l * 32 + gq) * 1024 + idx]; cc_im[idx] = INP(23)[(size_t)(l * 32 + gq) * 1024 + idx]; }
        __syncthreads();
        for (int idx = tid; idx < 4096; idx += 512) { const int d = idx >> 8, m = (idx >> 4) & 15, m2 = idx & 15; float s = 0.f;
            for (int p = 0; p < 64; ++p) { const float cr = cc_re[m * 64 + p], ci = cc_im[m * 64 + p], pr = ap_re[d * 64 + p], pi = ap_im[d * 64 + p];
                const float re = cr * pr - ci * pi, im = cr * pi + ci * pr; s += re * bb_re[p * 16 + m2] - im * bb_im[p * 16 + m2]; }
            if (d == 0 && m == m2) s += INP(24)[l * 512 + gq * 16 + m];
            ktab[idx] = s; }
        __syncthreads();
        bf16_t* BT3 = (bf16_t*)(a.ws + WS_BT3) + (size_t)(l * 32 + gq) * 256 * UAK;
        for (int grp = tid; grp < 256 * 48; grp += 512) { const int n = grp / 48, k0 = (grp % 48) * 8, t = n >> 4, m = n & 15; float v[8];
            if (k0 < 256) { const int s = k0 >> 4, m20 = k0 & 15;
#pragma unroll
                for (int j = 0; j < 8; ++j) v[j] = (s <= t) ? ktab[((t - s) * 16 + m) * 16 + m20 + j] : 0.f; }
            else { const int kk = k0 - 256, ri = kk >> 6, p0 = kk & 63;
#pragma unroll
                for (int j = 0; j < 8; ++j) { const int p = p0 + j; const float cr = cc_re[m * 64 + p], ci = cc_im[m * 64 + p], pr = ap_re[(t + 1) * 64 + p], pi = ap_im[(t + 1) * 64 + p];
                    v[j] = ri ? -(cr * pi + ci * pr) : (cr * pr - ci * pi); } }
            u32x4 w; w.x = cvt_pk_bf16(v[0], v[1]); w.y = cvt_pk_bf16(v[2], v[3]); w.z = cvt_pk_bf16(v[4], v[5]); w.w = cvt_pk_bf16(v[6], v[7]);
            *(u32x4*)(BT3 + (size_t)n * UAK + k0) = w; }
        bf16_t* BT1 = (bf16_t*)(a.ws + WS_BT1) + (size_t)(l * 32 + gq) * 128 * 256;
        for (int grp = tid; grp < 128 * 32; grp += 512) { const int n = grp >> 5, k0 = (grp & 31) * 8, s = k0 >> 4, m0 = k0 & 15, ri = n >> 6, p = n & 63; float v[8];
            const float pr = ap_re[(15 - s) * 64 + p], pi = ap_im[(15 - s) * 64 + p];
#pragma unroll
            for (int j = 0; j < 8; ++j) { const float br = bb_re[p * 16 + m0 + j], bi = bb_im[p * 16 + m0 + j]; v[j] = ri ? (pr * bi + pi * br) : (pr * br - pi * bi); }
            u32x4 w; w.x = cvt_pk_bf16(v[0], v[1]); w.y = cvt_pk_bf16(v[2], v[3]); w.z = cvt_pk_bf16(v[4], v[5]); w.w = cvt_pk_bf16(v[6], v[7]);
            *(u32x4*)(BT1 + (size_t)n * 256 + k0) = w; }
        if (tid < 64) { float* A16 = (float*)(a.ws + WS_A16) + (size_t)(l * 32 + gq) * 128; A16[tid] = ap_re[16 * 64 + tid]; A16[64 + tid] = ap_im[16 * 64 + tid]; }
        __syncthreads();
    }
}

__device__ __forceinline__ void cache_convert(const Args& a, int l, LAS unsigned char* lds, int wave, int lane, int gw, int NGW) {
    bf16_t* KS = (bf16_t*)(a.ws + WS_KS); bf16_t* VTS = (bf16_t*)(a.ws + WS_VTS);
    const float* ck = INP(4) + (size_t)l * 64 * PAST * 64; const float* cv = INP(5) + (size_t)l * 64 * PAST * 64;
    for (int i = gw * 64 + lane; i < 64 * PAST * 8; i += NGW * 64) {
        const int bh = i >> 13, rem = i & 8191;
        const f32x4 v0 = *(const f32x4*)(ck + (size_t)i * 8), v1 = *(const f32x4*)(ck + (size_t)i * 8 + 4);
        *(u32x4*)(KS + (size_t)bh * KVS * 64 + (size_t)rem * 8) = pack8(v0, v1); }
    LAS float* scr = (LAS float*)(lds + wave * 16384);
    for (int it = gw; it < 64 * 32; it += NGW) { const int bh = it >> 5, r = it & 31, kb = r >> 1, nb = r & 1;
        tr_item(cv + (size_t)bh * PAST * 64, 64, 64 * kb, 32 * nb, VTS + (size_t)bh * 64 * KVS, KVS, 32 * nb, scr, lane); }
}

template <int NSPLIT>
__device__ __forceinline__ void rowpass(const float* xsrc_p, const float* xsrc_s, const bf16_t* xsrc_b, const bf16_t* Fb, const float* FS, int nsplit, const float* gate, const float* wpost, float* xdst, bf16_t* xdst_b,
                                        const float* wpre, const float* sc, const float* sh, bf16_t* HMb, const float* WGl, const float* bfor, float* out, int lnext,
                                        int lane, int gw, int NGW) {
    f32x4 wg[8][4];
    if (WGl) {
#pragma unroll
        for (int h = 0; h < 8; ++h)
#pragma unroll
            for (int j = 0; j < 4; ++j) wg[h][j] = *(const f32x4*)(WGl + h * 1024 + 4 * lane + 256 * j);
    }
#define LOADX(dst, rr, xr, j) do { if (xsrc_b) { const u32x2 w_ = *(const u32x2*)(xsrc_b + (size_t)(rr) * DM + 4 * lane + 256 * (j)); \
        dst = (f32x4){__uint_as_float(w_.x << 16), __uint_as_float(w_.x & 0xffff0000u), __uint_as_float(w_.y << 16), __uint_as_float(w_.y & 0xffff0000u)}; } \
        else dst = *(const f32x4*)((xr) + 4 * lane + 256 * (j)); } while (0)
    for (int r = gw; r < MT; r += NGW) {
        const bool prompt = r < NPR; const int bm = prompt ? (r >> 12) : 4 + ((r - NPR) >> 6);
        f32x4 x[4]; u32x2 fw[4];
        { const float* xr = prompt ? xsrc_p + (size_t)r * DM : xsrc_s + (size_t)(r - NPR) * DM;
#pragma unroll
          for (int j = 0; j < 4; ++j) { LOADX(x[j], r, xr, j); fw[j] = (Fb && prompt) ? *(const u32x2*)(Fb + (size_t)r * DM + 4 * lane + 256 * j) : (u32x2){0u, 0u}; } }
        if (Fb) {
            f32x4 f[4]; float ss = 0.f;
#pragma unroll
            for (int j = 0; j < 4; ++j) {
                if (prompt) { const u32x2 w = fw[j];
                    f[j] = (f32x4){__uint_as_float(w.x << 16), __uint_as_float(w.x & 0xffff0000u), __uint_as_float(w.y << 16), __uint_as_float(w.y & 0xffff0000u)}; }
                else { const float* fp = FS + (size_t)(r - NPR) * DM + 4 * lane + 256 * j; f32x4 part[NSPLIT > 0 ? NSPLIT : 1];
#pragma unroll
                    for (int sp = 0; sp < NSPLIT; ++sp) part[sp] = *(const f32x4*)(fp + (size_t)sp * 512 * 1024);
                    f32x4 sacc = part[0];
#pragma unroll
                    for (int sp = 1; sp < NSPLIT; ++sp) sacc = sacc + part[sp];
                    f[j] = sacc; }
                ss += (f[j][0] * f[j][0] + f[j][1] * f[j][1]) + (f[j][2] * f[j][2] + f[j][3] * f[j][3]); }
            const float rstd = rsqrtf(wave_sum(ss, lane) * (1.f / DM) + EPS);
#pragma unroll
            for (int j = 0; j < 4; ++j) { const f32x4 gt = *(const f32x4*)(gate + (size_t)bm * 6144 + 4 * lane + 256 * j), wp = *(const f32x4*)(wpost + 4 * lane + 256 * j);
                x[j] = x[j] + gt * (f[j] * rstd * wp); }
        }
        if (xdst) {
#pragma unroll
            for (int j = 0; j < 4; ++j) *(f32x4*)(xdst + (size_t)r * DM + 4 * lane + 256 * j) = x[j];
        }
        if (xdst_b) {
#pragma unroll
            for (int j = 0; j < 4; ++j) { u32x2 w; w.x = cvt_pk_bf16(x[j][0], x[j][1]); w.y = cvt_pk_bf16(x[j][2], x[j][3]); *(u32x2*)(xdst_b + (size_t)r * DM + 4 * lane + 256 * j) = w;
                x[j] = (f32x4){__uint_as_float(w.x << 16), __uint_as_float(w.x & 0xffff0000u), __uint_as_float(w.y << 16), __uint_as_float(w.y & 0xffff0000u)}; }
        }
        if (wpre) {
            float ss = 0.f;
#pragma unroll
            for (int j = 0; j < 4; ++j) ss += (x[j][0] * x[j][0] + x[j][1] * x[j][1]) + (x[j][2] * x[j][2] + x[j][3] * x[j][3]);
            const float rstd = rsqrtf(wave_sum(ss, lane) * (1.f / DM) + EPS);
            f32x4 hm[4];
#pragma unroll
            for (int j = 0; j < 4; ++j) { const int cidx = 4 * lane + 256 * j;
                const f32x4 wv = *(const f32x4*)(wpre + cidx), s1 = *(const f32x4*)(sc + (size_t)bm * 6144 + cidx), s0 = *(const f32x4*)(sh + (size_t)bm * 6144 + cidx);
                hm[j] = (x[j] * rstd * wv) * (1.f + s1) + s0;
                u32x2 w; w.x = cvt_pk_bf16(hm[j][0], hm[j][1]); w.y = cvt_pk_bf16(hm[j][2], hm[j][3]);
                *(u32x2*)(HMb + (size_t)r * DM + cidx) = w; }
            if (WGl) {
                float mine = 0.f;
#pragma unroll
                for (int h = 0; h < 8; ++h) { float d = 0.f;
#pragma unroll
                    for (int j = 0; j < 4; ++j) { const f32x4 wv = wg[h][j]; d += (hm[j][0] * wv[0] + hm[j][1] * wv[1]) + (hm[j][2] * wv[2] + hm[j][3] * wv[3]); }
                    d = wave_sum(d, lane); if (lane == h) mine = d; }
                if (lane < 8) { const float lf = logsig(mine + bfor[lane]);
                    if (prompt) out[O_LP + ((size_t)((lnext * 4 + (r >> 12)) * 8 + lane)) * 4096 + (r & 4095)] = lf;
                    else { const int rr = r - NPR; out[O_LS + ((size_t)((lnext * 8 + (rr >> 6)) * 8 + lane)) * 64 + (rr & 63)] = lf; } }
            }
        }
    }
}

__device__ __forceinline__ void vt_finalize(const Args& a, int l, int lane, int gwi, int nw) {
    const float* PV = (const float*)(a.ws + WS_F1); bf16_t* VTP = (bf16_t*)(a.ws + WS_VTP); bf16_t* VTS = (bf16_t*)(a.ws + WS_VTS);
    for (int it = gwi; it < 16 * 128; it += nw) {
        const int tile = it >> 7, rem = it & 127, hb = rem >> 5, to = rem & 31, hdl = hb * 64 + lane, pm = tile >> 3, pn = 58 + (tile & 7);
        const int hd = pm * 256 + hdl, h = hd >> 6, d = hd & 63, tok = pn * 256 + to * 8;
        f32x4 v0 = {0.f, 0.f, 0.f, 0.f}, v1 = {0.f, 0.f, 0.f, 0.f};
#pragma unroll
        for (int ks = 0; ks < 4; ++ks) { const float* p = PV + ((size_t)(tile * 4 + ks) * 256 + hdl) * 256 + to * 8; v0 = v0 + *(const f32x4*)p; v1 = v1 + *(const f32x4*)(p + 4); }
        const u32x4 w = pack8(v0, v1);
        if (pn < 64) { const int b = tok >> 12, t = tok & 4095;
            *(u32x4*)(VTP + ((size_t)(b * 8 + h) * 64 + d) * 4096 + t) = w;
            float* o = a.out + O_VP + ((size_t)((l * 4 + b) * 8 + h) * 4096 + t) * 64 + d;
#pragma unroll
            for (int j = 0; j < 4; ++j) { o[(size_t)j * 64] = v0[j]; o[(size_t)(j + 4) * 64] = v1[j]; } }
        else { const int tt = tok - NPR, b = tt >> 6, t = tt & 63;
            *(u32x4*)(VTS + ((size_t)(b * 8 + h) * 64 + d) * KVS + PAST + t) = w;
            float* o = a.out + O_VS + ((size_t)((l * 8 + b) * 8 + h) * 64 + t) * 64 + d;
#pragma unroll
            for (int j = 0; j < 4; ++j) { o[(size_t)j * 64] = v0[j]; o[(size_t)(j + 4) * 64] = v1[j]; } }
    }
}
__device__ __forceinline__ void cumsum_items(const Args& a, int l, LAS unsigned char* lds, int tid, int wave, int lane, int c, int G) {
    LAS float* wt = (LAS float*)(lds);
    for (int it = c - 64; it >= 0 && it < 96; it += G) {
        const bool prompt = it < 32;
        float v[8]; float run = 0.f; int i0, cnt;
        if (prompt) { i0 = tid * 8; cnt = 8;
            const float* src = a.out + O_LP + (size_t)(l * 32 + it) * 4096 + i0;
            const f32x4 p0 = *(const f32x4*)src, p1 = *(const f32x4*)(src + 4);
            v[0] = p0[0]; v[1] = p0[1]; v[2] = p0[2]; v[3] = p0[3]; v[4] = p1[0]; v[5] = p1[1]; v[6] = p1[2]; v[7] = p1[3]; }
        else { const int sq = it - 32; i0 = tid * 4; cnt = tid < 272 ? 4 : 0;
            const float* src = tid < 256 ? INP(6) + (size_t)(l * 64 + sq) * PAST + i0 : a.out + O_LS + (size_t)(l * 64 + sq) * 64 + (tid < 272 ? i0 - PAST : 0);
            const f32x4 p0 = *(const f32x4*)src;
            v[0] = p0[0]; v[1] = p0[1]; v[2] = p0[2]; v[3] = p0[3]; v[4] = 0.f; v[5] = 0.f; v[6] = 0.f; v[7] = 0.f;
            if (tid >= 272) { v[0] = 0.f; v[1] = 0.f; v[2] = 0.f; v[3] = 0.f; } }
#pragma unroll
        for (int j = 0; j < 8; ++j) { run += v[j]; v[j] = run; }
        float incl = run;
#pragma unroll
        for (int o = 1; o < 64; o <<= 1) { const float t = bperm(incl, lane >= o ? lane - o : lane); if (lane >= o) incl += t; }
        if (lane == 63) wt[wave] = incl;
        __syncthreads();
        float off = incl - run;
        for (int w = 0; w < wave; ++w) off += wt[w];
        float* dst = (prompt ? (float*)(a.ws + WS_BIASP) + (size_t)it * 4096 : (float*)(a.ws + WS_BIASS) + (size_t)(it - 32) * KVS) + i0;
        if (cnt == 8) { *(f32x4*)dst = (f32x4){-(off + v[0]) * LOG2E, -(off + v[1]) * LOG2E, -(off + v[2]) * LOG2E, -(off + v[3]) * LOG2E};
                        *(f32x4*)(dst + 4) = (f32x4){-(off + v[4]) * LOG2E, -(off + v[5]) * LOG2E, -(off + v[6]) * LOG2E, -(off + v[7]) * LOG2E}; }
        else if (cnt == 4) *(f32x4*)dst = (f32x4){-(off + v[0]) * LOG2E, -(off + v[1]) * LOG2E, -(off + v[2]) * LOG2E, -(off + v[3]) * LOG2E};
        __syncthreads();
    }
}

__device__ __forceinline__ void ssm_scan(const Args& a, int l, LAS unsigned char* lds, int wave, int lane, int c, int G) {
    const float* E = (const float*)(a.ws + WS_E); bf16_t* UA = (bf16_t*)(a.ws + WS_UA); const float* A16 = (const float*)(a.ws + WS_A16);
    LAS float* endst = (LAS float*)(lds);
    for (int it = c; it < 128; it += G) {
        const int b = it >> 5, gq = it & 31, p = lane;
        const float ar = A16[(l * 32 + gq) * 128 + p], ai = A16[(l * 32 + gq) * 128 + 64 + p];
        float er[32], ei[32];
        const int ch0 = b * 256 + wave * 32;
#pragma unroll
        for (int i = 0; i < 32; ++i) { const float* e = E + ((size_t)gq * CHP + ch0 + i) * 128; er[i] = e[p]; ei[i] = e[64 + p]; }
        float hr = 0.f, hi = 0.f;
#pragma unroll
        for (int i = 0; i < 32; ++i) { const float nr = ar * hr - ai * hi + er[i], ni = ar * hi + ai * hr + ei[i]; hr = nr; hi = ni; }
        endst[(wave * 2) * 64 + p] = hr; endst[(wave * 2 + 1) * 64 + p] = hi;
        float pr = ar, pi = ai;
#pragma unroll
        for (int s = 0; s < 5; ++s) { const float nr = pr * pr - pi * pi, ni = 2.f * pr * pi; pr = nr; pi = ni; }
        __syncthreads();
        hr = 0.f; hi = 0.f;
        for (int w = 0; w < wave; ++w) { const float xr = endst[(w * 2) * 64 + p], xi = endst[(w * 2 + 1) * 64 + p];
            const float nr = pr * hr - pi * hi + xr, ni = pr * hi + pi * hr + xi; hr = nr; hi = ni; }
#pragma unroll
        for (int i = 0; i < 32; ++i) { bf16_t* u = UA + ((size_t)gq * CHP + ch0 + i) * UAK + 256; u[p] = f2bf(hr); u[64 + p] = f2bf(hi);
            const float nr = ar * hr - ai * hi + er[i], ni = ar * hi + ai * hr + ei[i]; hr = nr; hi = ni; }
        if (wave == 7) { a.out[O_RP + (size_t)((l * 4 + b) * 32 + gq) * 64 + p] = hr; a.out[O_IP + (size_t)((l * 4 + b) * 32 + gq) * 64 + p] = hi; }
        __syncthreads();
    }
    for (int it = (G - 1 - c) * 8 + wave; it < 256; it += G * 8) {
        const int b = it >> 5, gq = it & 31, p = lane;
        const float ar = A16[(l * 32 + gq) * 128 + p], ai = A16[(l * 32 + gq) * 128 + 64 + p];
        float hr = INP(7)[(size_t)((l * 8 + b) * 32 + gq) * 64 + p], hi = INP(8)[(size_t)((l * 8 + b) * 32 + gq) * 64 + p];
        const int ch0 = 1024 + b * 4;
#pragma unroll
        for (int i = 0; i < 4; ++i) { const float* e = E + ((size_t)gq * CHP + ch0 + i) * 128; const float xr = e[p], xi = e[64 + p];
            bf16_t* u = UA + ((size_t)gq * CHP + ch0 + i) * UAK + 256; u[p] = f2bf(hr); u[64 + p] = f2bf(hi);
            const float nr = ar * hr - ai * hi + xr, ni = ar * hi + ai * hr + xi; hr = nr; hi = ni; }
        a.out[O_RS + (size_t)((l * 8 + b) * 32 + gq) * 64 + p] = hr; a.out[O_IS + (size_t)((l * 8 + b) * 32 + gq) * 64 + p] = hi;
    }
}

#define DPPMAX(v, ctrl) v = fmaxf(v, __int_as_float(__builtin_amdgcn_update_dpp(0, __float_as_int(v), ctrl, 0xF, 0xF, true)))
__device__ __forceinline__ float wave_max_nonneg(float v) {
    DPPMAX(v, 0xB1); DPPMAX(v, 0x4E); DPPMAX(v, 0x141); DPPMAX(v, 0x140);
    const float r0 = __int_as_float(__builtin_amdgcn_readlane(__float_as_int(v), 0)), r1 = __int_as_float(__builtin_amdgcn_readlane(__float_as_int(v), 16));
    const float r2 = __int_as_float(__builtin_amdgcn_readlane(__float_as_int(v), 32)), r3 = __int_as_float(__builtin_amdgcn_readlane(__float_as_int(v), 48));
    return fmaxf(fmaxf(r0, r1), fmaxf(r2, r3));
}
__device__ __forceinline__ void kmax_items(const Args& a, int lane, int gw, int NGW) {
    float* KM = (float*)(a.ws + WS_KMAX);
    for (int it = NGW - 1 - gw; it < 2048 + 1088; it += NGW) {
        const bf16_t* kp; int oidx;
        if (it < 2048) { const int bh = it >> 6, t = it & 63; kp = (const bf16_t*)(a.ws + WS_KP) + ((size_t)bh * 4096 + t * 64) * 64; oidx = it; }
        else { const int r = it - 2048, sq = r / 17, t = r - sq * 17; kp = (const bf16_t*)(a.ws + WS_KS) + ((size_t)sq * KVS + t * 64) * 64; oidx = (32 + sq) * 64 + t; }
        float ss = 0.f;
#pragma unroll
        for (int i = 0; i < 8; ++i) { const u32x4 w = *(const u32x4*)(kp + (size_t)lane * 64 + i * 8);
#pragma unroll
            for (int j = 0; j < 4; ++j) { const float lo = __uint_as_float(w[j] << 16), hi = __uint_as_float(w[j] & 0xffff0000u); ss += lo * lo + hi * hi; } }
        const float m = wave_max_nonneg(ss);
        if (lane == 0) KM[oidx] = sqrtf(m) * 1.001f;
    }
}
constexpr int AT_ROW = 144, AT_TILE = 64 * AT_ROW  , AT_KB = 0, AT_VB = 4 * AT_TILE, AT_BB = 8 * AT_TILE;
__device__ __forceinline__ void attn_tile(const LAS unsigned char* Kb, const LAS unsigned char* Vb, const LAS float* Bb, const bf16x8 (&qf)[4], f32x16& o0, f32x16& o1, float& lsum,
                                          float bq, int myq, int key0, bool domask, int ka_off, int va_off, int hi) {
    f32x16 s0, s1;
#pragma unroll
    for (int a2 = 0; a2 < 2; ++a2) { const f32x4 b0 = *(const LAS f32x4*)(Bb + a2 * 16 + hi * 8), b1 = *(const LAS f32x4*)(Bb + a2 * 16 + hi * 8 + 4);
        const f32x4 c0 = *(const LAS f32x4*)(Bb + 32 + a2 * 16 + hi * 8), c1 = *(const LAS f32x4*)(Bb + 32 + a2 * 16 + hi * 8 + 4);
#pragma unroll
        for (int j = 0; j < 4; ++j) { s0[a2 * 8 + j] = b0[j]; s0[a2 * 8 + 4 + j] = b1[j]; s1[a2 * 8 + j] = c0[j]; s1[a2 * 8 + 4 + j] = c1[j]; } }
#pragma unroll
    for (int ks = 0; ks < 4; ++ks) {
        const bf16x8 k0 = *(const LAS bf16x8*)(Kb + ka_off + ks * 32), k1 = *(const LAS bf16x8*)(Kb + 32 * AT_ROW + ka_off + ks * 32);
        s0 = __builtin_amdgcn_mfma_f32_32x32x16_bf16(k0, qf[ks], s0, 0, 0, 0);
        s1 = __builtin_amdgcn_mfma_f32_32x32x16_bf16(k1, qf[ks], s1, 0, 0, 0);
    }
    if (domask) {
#pragma unroll
        for (int r = 0; r < 16; ++r) { const int kj = key0 + 16 * (r >> 3) + 8 * hi + (r & 7);
            if (kj > myq) s0[r] = -INFINITY; if (kj + 32 > myq) s1[r] = -INFINITY; }
    }
    s0 = s0 - bq; s1 = s1 - bq;
#pragma unroll
    for (int r = 0; r < 16; ++r) { s0[r] = __builtin_amdgcn_exp2f(s0[r]); s1[r] = __builtin_amdgcn_exp2f(s1[r]); }
    { const f32x16 e = s0 + s1;
      const f32x8 e8 = __builtin_shufflevector(e, e, 0, 1, 2, 3, 4, 5, 6, 7) + __builtin_shufflevector(e, e, 8, 9, 10, 11, 12, 13, 14, 15);
      const f32x4 e4 = __builtin_shufflevector(e8, e8, 0, 1, 2, 3) + __builtin_shufflevector(e8, e8, 4, 5, 6, 7);
      lsum += (e4[0] + e4[1]) + (e4[2] + e4[3]); }
    bf16x8 pa[4];
#pragma unroll
    for (int a2 = 0; a2 < 2; ++a2) {
        u32x4 w0, w1;
        w0.x = cvt_pk_bf16(s0[a2 * 8 + 0], s0[a2 * 8 + 1]); w0.y = cvt_pk_bf16(s0[a2 * 8 + 2], s0[a2 * 8 + 3]); w0.z = cvt_pk_bf16(s0[a2 * 8 + 4], s0[a2 * 8 + 5]); w0.w = cvt_pk_bf16(s0[a2 * 8 + 6], s0[a2 * 8 + 7]);
        w1.x = cvt_pk_bf16(s1[a2 * 8 + 0], s1[a2 * 8 + 1]); w1.y = cvt_pk_bf16(s1[a2 * 8 + 2], s1[a2 * 8 + 3]); w1.z = cvt_pk_bf16(s1[a2 * 8 + 4], s1[a2 * 8 + 5]); w1.w = cvt_pk_bf16(s1[a2 * 8 + 6], s1[a2 * 8 + 7]);
        pa[a2] = __builtin_bit_cast(bf16x8, w0); pa[2 + a2] = __builtin_bit_cast(bf16x8, w1);
    }
#pragma unroll
    for (int kk = 0; kk < 4; ++kk) {
        const bf16x8 v0 = *(const LAS bf16x8*)(Vb + va_off + kk * 32), v1 = *(const LAS bf16x8*)(Vb + 32 * AT_ROW + va_off + kk * 32);
        o0 = __builtin_amdgcn_mfma_f32_32x32x16_bf16(v0, pa[kk], o0, 0, 0, 0);
        o1 = __builtin_amdgcn_mfma_f32_32x32x16_bf16(v1, pa[kk], o1, 0, 0, 0);
    }
}
__device__ __forceinline__ void attn_unit(LAS unsigned char* lds, const bf16_t* Qrow0, int h, int nrows, int qpos0, int NT,
                                          const bf16_t* Kp, const bf16_t* VTp, int vpitch, const float* biasp, const float* kmaxp, bf16_t* Orow0, int tid, int wave, int lane) {
    const int q = lane & 31, hi = lane >> 5;
    const bool active = wave * 32 < nrows;
    bf16x8 qf[4];
#pragma unroll
    for (int ks = 0; ks < 4; ++ks) qf[ks] = active ? *(const bf16x8*)(Qrow0 + (size_t)(wave * 32 + q) * 512 + h * 64 + ks * 16 + hi * 8) : (bf16x8){0, 0, 0, 0, 0, 0, 0, 0};
    f32x16 o0 = {}, o1 = {};
    float lsum = 0.f;
    const int myq = qpos0 + wave * 32 + q;
    const int wq_lo = qpos0 + wave * 32, wq_hi = wq_lo + 31;
    const float bq = active ? biasp[myq] : 0.f;
    const int NS = (NT + 1) >> 1;
    int s_first;
    { float ssq = 0.f;
#pragma unroll
      for (int ks = 0; ks < 4; ++ks)
#pragma unroll
          for (int e = 0; e < 8; ++e) { const float v = __uint_as_float(((unsigned)(unsigned short)qf[ks][e]) << 16); ssq += v * v; }
      ssq += bperm(ssq, lane ^ 32);
      const float wm = wave_max_nonneg(ssq);
      volatile LAS float* qm = (volatile LAS float*)(lds + 131072 + 512);
      volatile LAS int* tst = (volatile LAS int*)(lds + 131072 + 576);
      if (lane == 0) qm[wave] = wm;
      __syncthreads();
      if (wave == 0) {
          float m2 = 0.f;
#pragma unroll
          for (int w = 0; w < 8; ++w) m2 = fmaxf(m2, qm[w]);
          const float QN = sqrtf(m2) * 1.001f;
          bool fail = true;
          if (lane < NT) fail = !(QN * kmaxp[lane] + biasp[64 * lane + 63] - biasp[qpos0] < -160.f);
          const unsigned long long mask = __builtin_amdgcn_ballot_w64(fail);
          const int tfirst = mask ? (int)__builtin_ctzll(mask) : 0;
          if (lane == 0) tst[0] = tfirst >> 1;
      }
      __syncthreads();
      s_first = tst[0]; }
    const int krow = tid >> 3, kch = tid & 7;
    const bf16_t* kg = Kp + (size_t)tid * 8;
    const bf16_t* vg = VTp + (size_t)krow * vpitch + kch * 8;
    const int st_off = krow * AT_ROW + kch * 16;
    const int kap = (q & 19) | ((q & 4) << 1) | ((q & 8) >> 1);
    const int ka_off = kap * AT_ROW + hi * 16, va_off = q * AT_ROW + hi * 16;
    u32x4 kr0, kr1, vr0, vr1; f32x4 br = {0.f, 0.f, 0.f, 0.f};
    { const int tb = 2 * s_first; kr0 = *(const u32x4*)(kg + (size_t)tb * 4096); kr1 = *(const u32x4*)(kg + (size_t)(tb + 1) * 4096); vr0 = *(const u32x4*)(vg + tb * 64); vr1 = *(const u32x4*)(vg + (tb + 1) * 64); if (tid < 32) br = *(const f32x4*)(biasp + tb * 64 + tid * 4); }
    *(LAS u32x4*)(lds + AT_KB + st_off) = kr0; *(LAS u32x4*)(lds + AT_KB + AT_TILE + st_off) = kr1;
    *(LAS u32x4*)(lds + AT_VB + st_off) = vr0; *(LAS u32x4*)(lds + AT_VB + AT_TILE + st_off) = vr1; if (tid < 32) *(LAS f32x4*)(lds + AT_BB + tid * 16) = br;
    __syncthreads();
    for (int sidx = s_first; sidx < NS; ++sidx) {
        const int buf = (sidx - s_first) & 1, t0 = 2 * sidx;
        const bool more = sidx + 1 < NS;
        if (more) { kr0 = *(const u32x4*)(kg + (size_t)(t0 + 2) * 4096); kr1 = *(const u32x4*)(kg + (size_t)(t0 + 3) * 4096); vr0 = *(const u32x4*)(vg + (t0 + 2) * 64); vr1 = *(const u32x4*)(vg + (t0 + 3) * 64);
            if (tid < 32) br = *(const f32x4*)(biasp + (t0 + 2) * 64 + tid * 4); }
        if (active) {
            const LAS unsigned char* Kb = lds + AT_KB + buf * 2 * AT_TILE;
            const LAS unsigned char* Vb = lds + AT_VB + buf * 2 * AT_TILE;
            const LAS float* Bb = (const LAS float*)(lds + AT_BB + buf * 512);
            if (t0 * 64 <= wq_hi) attn_tile(Kb, Vb, Bb, qf, o0, o1, lsum, bq, myq, t0 * 64, t0 * 64 + 63 > wq_lo, ka_off, va_off, hi);
            if ((t0 + 1) * 64 <= wq_hi) attn_tile(Kb + AT_TILE, Vb + AT_TILE, Bb + 64, qf, o0, o1, lsum, bq, myq, (t0 + 1) * 64, (t0 + 1) * 64 + 63 > wq_lo, ka_off, va_off, hi);
        }
        if (more) { const int nb = buf ^ 1;
            *(LAS u32x4*)(lds + AT_KB + nb * 2 * AT_TILE + st_off) = kr0; *(LAS u32x4*)(lds + AT_KB + nb * 2 * AT_TILE + AT_TILE + st_off) = kr1;
            *(LAS u32x4*)(lds + AT_VB + nb * 2 * AT_TILE + st_off) = vr0; *(LAS u32x4*)(lds + AT_VB + nb * 2 * AT_TILE + AT_TILE + st_off) = vr1;
            if (tid < 32) *(LAS f32x4*)(lds + AT_BB + nb * 512 + tid * 16) = br; }
        __syncthreads();
    }
    if (active) {
        lsum += bperm(lsum, lane ^ 32);
        const float inv = 1.f / lsum;
        bf16_t* orow = Orow0 + (size_t)(wave * 32 + q) * 1024 + h * 64;
#pragma unroll
        for (int i = 0; i < 4; ++i) { u32x2 w0, w1;
            w0.x = cvt_pk_bf16(o0[4 * i] * inv, o0[4 * i + 1] * inv); w0.y = cvt_pk_bf16(o0[4 * i + 2] * inv, o0[4 * i + 3] * inv);
            w1.x = cvt_pk_bf16(o1[4 * i] * inv, o1[4 * i + 1] * inv); w1.y = cvt_pk_bf16(o1[4 * i + 2] * inv, o1[4 * i + 3] * inv);
            *(u32x2*)(orow + 8 * i + 4 * hi) = w0; *(u32x2*)(orow + 32 + 8 * i + 4 * hi) = w1; }
    }
}
__device__ __forceinline__ void attn_phase(const Args& a, int l, LAS unsigned char* lds, int tid, int wave, int lane) {
    const bf16_t* Q = (const bf16_t*)(a.ws + WS_Q); bf16_t* MIX = (bf16_t*)(a.ws + WS_MIX);
    unsigned* ctr = (unsigned*)(a.ws + WS_CTL) + 3600 + 64 * l;
    volatile LAS unsigned* slot = (volatile LAS unsigned*)(lds + 131072 + 256);
    for (;;) {
        if (tid == 0) slot[0] = __hip_atomic_fetch_add(ctr, 1u, __ATOMIC_RELAXED, __HIP_MEMORY_SCOPE_AGENT);
        __syncthreads();
        const int idx = (int)slot[0];
        __syncthreads();
        if (idx >= 576) break;
        if (idx < 512) { const int qb = 15 - (idx >> 5), bh = idx & 31, b = bh >> 3, h = bh & 7; const size_t row0 = (size_t)b * 4096 + qb * 256;
            attn_unit(lds, Q + row0 * 512, h, 256, qb * 256, 4 * qb + 4, (const bf16_t*)(a.ws + WS_KP) + (size_t)bh * 4096 * 64, (const bf16_t*)(a.ws + WS_VTP) + (size_t)bh * 64 * 4096, 4096,
                      (const float*)(a.ws + WS_BIASP) + (size_t)bh * 4096, (const float*)(a.ws + WS_KMAX) + bh * 64, MIX + row0 * 1024, tid, wave, lane); }
        else { const int sidx = idx - 512, b = sidx >> 3, h = sidx & 7;
            attn_unit(lds, Q + (size_t)(NPR + b * 64) * 512, h, 64, PAST, 17, (const bf16_t*)(a.ws + WS_KS) + (size_t)sidx * KVS * 64, (const bf16_t*)(a.ws + WS_VTS) + (size_t)sidx * 64 * KVS, KVS,
                      (const float*)(a.ws + WS_BIASS) + (size_t)sidx * KVS, (const float*)(a.ws + WS_KMAX) + (32 + sidx) * 64, MIX + (size_t)(NPR + b * 64) * 1024, tid, wave, lane); }
    }
}

#define XB_TMO      128
#define XB_XCNT(j)  (256  + 64 * (j))
#define XB_XSUB(j)  (1280 + 64 * (j))
#define XB_XGEN(j)  (2304 + 64 * (j))
#define XB_TOP      3328
#define XB_TOPGEN   3392
#define XCD_BAR_WORDS 3456
#define XB_SPIN_CAP (1u << 18)
__device__ __forceinline__ unsigned xb_ld(unsigned* p)              { return __hip_atomic_load(p, __ATOMIC_RELAXED, __HIP_MEMORY_SCOPE_AGENT); }
__device__ __forceinline__ unsigned xb_add(unsigned* p, unsigned v) { return __hip_atomic_fetch_add(p, v, __ATOMIC_RELAXED, __HIP_MEMORY_SCOPE_AGENT); }
__device__ __forceinline__ unsigned xb_xcc_id() { return (unsigned)__builtin_amdgcn_s_getreg((3 << 11) | 20) & 0xFu; }
#define XB_SPIN(cond, bar) do { unsigned _sp = 0; while (cond) { __builtin_amdgcn_s_sleep(1); \
    if ((++_sp & 255u) == 0u) { if (xb_ld(&(bar)[XB_TMO])) break; if (_sp > XB_SPIN_CAP) { atomicAdd(&(bar)[XB_TMO], 1u); break; } } } } while (0)
__device__ __forceinline__ void xcd_barrier_complete(unsigned* bar, unsigned x, unsigned G, unsigned& nloc, unsigned& nx) {
    unsigned sum, cnt, mine, sp = 0u;
    for (;;) {
        sum = 0u; cnt = 0u; mine = 0u;
#pragma unroll
        for (unsigned j = 0; j < 16; ++j) { const unsigned c = xb_ld(&bar[XB_XCNT(j)]); sum += c; cnt += (c > 0u) ? 1u : 0u; mine = (j == x) ? c : mine; }
        if (sum == G) break;
        __builtin_amdgcn_s_sleep(1);
        if ((++sp & 255u) == 0u) { if (xb_ld(&bar[XB_TMO])) break; if (sp > XB_SPIN_CAP) { atomicAdd(&bar[XB_TMO], 1u); break; } }
    }
    nloc = mine > 0u ? mine : 1u; nx = cnt > 0u ? cnt : 1u;
}
__device__ __forceinline__ void xcd_barrier(unsigned* bar, volatile LAS unsigned* st, bool leader, unsigned G) {
    asm volatile("s_waitcnt vmcnt(0)" ::: "memory");
    __syncthreads();
    if (leader) {
        const unsigned x = xb_xcc_id();
        __builtin_amdgcn_s_waitcnt(0);
        unsigned nloc = st[0], nx = st[1];
        if (nloc == 0u) { xcd_barrier_complete(bar, x, G, nloc, nx); st[0] = nloc; st[1] = nx; }
        const unsigned old = xb_add(&bar[XB_XSUB(x)], 1u);
        const unsigned gen = old / nloc;
        if (old + 1u == (gen + 1u) * nloc) {
            __builtin_amdgcn_fence(__ATOMIC_RELEASE, "agent");
            asm volatile("s_waitcnt vmcnt(0)" ::: "memory");
            const unsigned og = xb_add(&bar[XB_TOP], 1u);
            const unsigned tg = og / nx;
            if (og + 1u == (tg + 1u) * nx) xb_add(&bar[XB_TOPGEN], 1u);
            else XB_SPIN(xb_ld(&bar[XB_TOPGEN]) == tg, bar);
            __builtin_amdgcn_fence(__ATOMIC_ACQUIRE, "agent");
            xb_add(&bar[XB_XGEN(x)], 1u);
            asm volatile("s_waitcnt vmcnt(0)" ::: "memory");
        } else {
            XB_SPIN(xb_ld(&bar[XB_XGEN(x)]) == gen, bar);
            __builtin_amdgcn_fence(__ATOMIC_ACQUIRE, "agent");
            asm volatile("s_waitcnt vmcnt(0)" ::: "memory");
        }
    }
    __syncthreads();
}

constexpr int NS5 = 80, CW_SUB = 3520;
__device__ __forceinline__ void sub_barrier(unsigned* ctr, unsigned target, bool leader) {
    asm volatile("s_waitcnt vmcnt(0)" ::: "memory");
    __syncthreads();
    if (leader) {
        __builtin_amdgcn_fence(__ATOMIC_RELEASE, "agent");
        asm volatile("s_waitcnt vmcnt(0)" ::: "memory");
        (void)xb_add(ctr, 1u);
        unsigned sp = 0u;
        while (xb_ld(ctr) < target) { __builtin_amdgcn_s_sleep(1); if (++sp > (1u << 22)) break; }
        __builtin_amdgcn_fence(__ATOMIC_ACQUIRE, "agent");
        asm volatile("s_waitcnt vmcnt(0)" ::: "memory");
    }
    __syncthreads();
}
#undef INP
#define INP(i) (al.in[i])
typedef const __attribute__((address_space(4))) unsigned char* kptr_t;
__device__ __forceinline__ kptr_t opq_k(kptr_t p) { asm volatile("" : "+s"(p)); return p; }
__device__ __forceinline__ Args load_args(kptr_t kp) {
    typedef const __attribute__((address_space(4))) unsigned long long* q_t; q_t q = (q_t)kp; Args r;
#pragma unroll
    for (int i = 0; i < 30; ++i) r.in[i] = (const float*)q[i];
    r.out = (float*)q[30]; r.ws = (unsigned char*)q[31]; return r;
}
#define FRESH() const Args al = load_args(opq_k((kptr_t)__builtin_amdgcn_kernarg_segment_ptr())); unsigned char* ws = al.ws; \
    const int G = __builtin_amdgcn_readfirstlane(opq((int)gridDim.x)); const int NGW = G * 8; (void)NGW; \
    const int wave = __builtin_amdgcn_readfirstlane(opq(wave0)); const int c = __builtin_amdgcn_readfirstlane(opq((int)blockIdx.x)); const int gw = c * 8 + wave; \
    float* MOD = (float*)(ws + WS_MOD); float* X = (float*)(ws + WS_X); bf16_t* HM = (bf16_t*)(ws + WS_HM); bf16_t* F1 = (bf16_t*)(ws + WS_F1); bf16_t* MIX = (bf16_t*)(ws + WS_MIX); \
    (void)MOD; (void)X; (void)HM; (void)F1; (void)MIX; (void)gw;
#define LAYER_BODY(l) { \
        { FRESH(); PH(5) cumsum_items(al, l, lds, tid, wave, lane, c, G); } \
        PH(6) { FRESH(); pg8::Gemm g{HM, (const bf16_t*)(ws + WS_WIN) + (size_t)l * 1536 * 1024, MT, 1536, 1024, 1024, 1024, 1 << 20, 0, 512u, (const bf16_t*)(ws + WS_WV) + (size_t)l * 512 * 1024, HM}; \
          pg8::PhaseAOrder S; S.init(G, c); \
          EpiA E{EpiIn{(bf16_t*)(ws + WS_Q), (bf16_t*)(ws + WS_KP), (bf16_t*)(ws + WS_KS), (bf16_t*)(ws + WS_UA), al.out, l}, EpiVT{(bf16_t*)(ws + WS_VTP), (bf16_t*)(ws + WS_VTS), al.out, l, lds}, EpiVtPart{(float*)(ws + WS_F1)}}; \
          pg8::gemm_phase(lds, g, S, E, wave); } \
        GSYNC(); \
        { FRESH(); kmax_items(al, lane, gw, NGW); vt_finalize(al, l, lane, gw, NGW); } \
        GSYNC(); \
        if (INS5) { \
        PH(8) { FRESH(); pg8::Gemm g{(const bf16_t*)(ws + WS_UA), (const bf16_t*)(ws + WS_BT1) + (size_t)l * 32 * 128 * 256, NG * CHP, 256, 256, UAK, 256, 5, (size_t)128 * 256, 0u}; \
          pg8::StaticOrder S; S.init(NG * CHP, 256, NS5, c); \
          EpiE E{(float*)(ws + WS_E)}; \
          pg8::gemm_phase(lds, g, S, E, wave); } \
        SUBBAR((l) * 3 + 1); \
        { FRESH(); PH(9) ssm_scan(al, l, lds, wave, lane, c, NS5); } \
        SUBBAR((l) * 3 + 2); \
        PH(10) { FRESH(); pg8::Gemm g{(const bf16_t*)(ws + WS_UA), (const bf16_t*)(ws + WS_BT3) + (size_t)l * 32 * 256 * UAK, NG * CHP, 256, UAK, UAK, UAK, 5, (size_t)256 * UAK, 0u}; \
          pg8::StaticOrder S; S.init(NG * CHP, 256, NS5, c); \
          EpiZ E{(bf16_t*)(ws + WS_Z)}; \
          pg8::gemm_phase(lds, g, S, E, wave); } \
        SUBBAR((l) * 3 + 3); \
        PH(11) { FRESH(); pg8::Gemm g{(const bf16_t*)(ws + WS_Z), (const bf16_t*)(ws + WS_WGLU) + (size_t)l * 512 * 512, MT, 512, 512, 512, 512, 1 << 20, 0, 0u}; \
          pg8::StaticOrder S; S.init(MT, 512, NS5, c); \
          EpiGlu E{(const bf16_t*)(ws + WS_Z), MIX}; \
          pg8::gemm_phase(lds, g, S, E, wave); } \
        __syncthreads(); \
        } \
        { FRESH(); PH(12) attn_phase(al, l, lds, tid, wave, lane); } \
        GSYNC(); \
        PH(13) { FRESH(); pg8::Gemm g{MIX, (const bf16_t*)(ws + WS_WOUT) + (size_t)l * 1024 * 1024, MT, 1024, 1024, 1024, 1024, 1 << 20, 0, 256u}; \
          pg8::MainSplitOrder S; S.init(G, c, 8, 2); \
          EpiMS E{EpiPlain{F1, 1024}, EpiAtomic{(float*)(ws + WS_Q)}}; \
          pg8::gemm_phase(lds, g, S, E, wave); } \
        GSYNC(); \
        { FRESH(); const float* modl = MOD + (size_t)l * 12 * 6144; \
          PH(14) rowpass<8>(INP(0), INP(1), l == 0 ? (const bf16_t*)nullptr : (const bf16_t*)X, F1, (const float*)(ws + WS_Q), 8, modl + 2 * 1024, INP(12) + l * 1024, nullptr, (bf16_t*)X, \
                INP(13) + l * 1024, modl + 4 * 1024, modl + 3 * 1024, HM, nullptr, nullptr, al.out, 0, lane, gw, NGW); } \
        GSYNC(); \
        PH(15) { FRESH(); pg8::Gemm g{HM, (const bf16_t*)(ws + WS_WGU) + (size_t)l * 5632 * 1024, MT, 5632, 1024, 1024, 1024, 1 << 20, 0, 0u}; \
          pg8::StaticOrder S; S.init(MT, 5632, G, c); \
          EpiSwi E{(bf16_t*)(ws + WS_H)}; \
          pg8::gemm_phase(lds, g, S, E, wave); } \
        GSYNC(); \
        PH(16) { FRESH(); pg8::Gemm g{(const bf16_t*)(ws + WS_H), (const bf16_t*)(ws + WS_WD) + (size_t)l * 1024 * DFF, MT, 1024, DFF, DFF, DFF, 1 << 20, 0, 512u}; \
          pg8::MainSplitOrder S; S.init(G, c, 11, 4); \
          EpiMS E{EpiPlain{F1, 1024}, EpiAtomic{(float*)(ws + WS_FS2)}}; \
          pg8::gemm_phase(lds, g, S, E, wave); } \
        GSYNC(); \
        if (l + 1 < NL) { \
            { FRESH(); const float* modl = MOD + (size_t)l * 12 * 6144; const float* modn = MOD + (size_t)(l + 1) * 12 * 6144; \
              PH(17) rowpass<11>(INP(0), INP(1), (const bf16_t*)X, F1, (const float*)(ws + WS_FS2), 11, modl + 5 * 1024, INP(14) + l * 1024, nullptr, (bf16_t*)X, INP(11) + (l + 1) * 1024, modn + 1024, modn, HM, \
                    (const float*)(ws + WS_WG) + (size_t)(l + 1) * 8 * 1024, INP(16) + (l + 1) * 8, al.out, l + 1, lane, gw, NGW); \
              PH(1) cache_convert(al, l + 1, lds, wave, lane, gw, NGW); } \
            GSYNC(); \
        } else { \
            FRESH(); const float* modl = MOD + (size_t)l * 12 * 6144; \
            PH(18) rowpass<11>(INP(0), INP(1), (const bf16_t*)X, F1, (const float*)(ws + WS_FS2), 11, modl + 5 * 1024, INP(14) + l * 1024, al.out, nullptr, nullptr, nullptr, nullptr, nullptr, nullptr, nullptr, al.out, 0, lane, gw, NGW); \
        } \
    }
__global__ void __launch_bounds__(512, 2) mega(Args a) {
    extern __shared__ __attribute__((aligned(16))) unsigned char lds_raw[];
    LAS unsigned char* lds = (LAS unsigned char*)lds_raw;
    cg::grid_group grid = cg::this_grid();
    const int wave0 = __builtin_amdgcn_readfirstlane((int)threadIdx.x >> 6);
#define GSYNC() do { const Args alb = load_args(opq_k((kptr_t)__builtin_amdgcn_kernarg_segment_ptr())); \
        const int ln_ = (int)__builtin_amdgcn_mbcnt_hi(~0u, __builtin_amdgcn_mbcnt_lo(~0u, (unsigned)opq(0))); \
        xcd_barrier((unsigned*)(alb.ws + WS_CTL), (volatile LAS unsigned*)(lds + LDS_MISC), wave0 == 0 && ln_ == 0, (unsigned)gridDim.x); } while (0)
#define SUBBAR(seq) do { const Args alb = load_args(opq_k((kptr_t)__builtin_amdgcn_kernarg_segment_ptr())); \
        const int ln_ = (int)__builtin_amdgcn_mbcnt_hi(~0u, __builtin_amdgcn_mbcnt_lo(~0u, (unsigned)opq(0))); \
        xcd_barrier((unsigned*)(alb.ws + WS_CTL) + 4096, (volatile LAS unsigned*)(lds + LDS_MISC + 16), wave0 == 0 && ln_ == 0, (unsigned)NS5); } while (0)
#define INS5 (__builtin_amdgcn_readfirstlane(opq((int)blockIdx.x)) < NS5)
    if (threadIdx.x < 8) ((volatile LAS unsigned*)(lds + LDS_MISC))[threadIdx.x] = 0u;
    if (threadIdx.x == 0) (void)xb_add((unsigned*)(a.ws + WS_CTL) + XB_XCNT(xb_xcc_id()), 1u);
    if (threadIdx.x == 0 && blockIdx.x < NS5) (void)xb_add((unsigned*)(a.ws + WS_CTL) + 4096 + XB_XCNT(xb_xcc_id()), 1u);
    __syncthreads();
#define lane ((int)__builtin_amdgcn_mbcnt_hi(~0u, __builtin_amdgcn_mbcnt_lo(~0u, (unsigned)opq(0))))
#define tid (wave * 64 + lane)

    { FRESH();
      PH(0) p0_weights(al, lds, wave, lane, gw, NGW);
      PH(1) cache_convert(al, 0, lds, wave, lane, gw, NGW);
      __syncthreads();
      PH(2) p0_adaln(al, lds, tid, wave, lane, c, G);
      PH(3) p0_ssm(al, lds, tid, (c + 128) % G, G); }
    grid.sync();
    { FRESH();
      PH(4) rowpass<0>(INP(0), INP(1), nullptr, nullptr, nullptr, 0, nullptr, nullptr, nullptr, nullptr, INP(11), MOD + 1024, MOD, HM, (const float*)(ws + WS_WG), INP(16), al.out, 0, lane, gw, NGW); }
    GSYNC();

    LAYER_BODY(0)
    LAYER_BODY(1)
    LAYER_BODY(2)
    LAYER_BODY(3)
}
#undef tid
#undef lane

extern "C" void kernel_launch(void* const* d_in, const int* in_sizes, int n_in, void* d_out, int out_size, void* d_ws, size_t ws_size, hipStream_t stream) {
    static int grid = 0;
    if (grid == 0) {
        if (n_in != 30 || (size_t)out_size != O_END || ws_size < WS_END) { fprintf(stderr, "kernel_launch: unexpected sizes n_in %d out %d ws %zu\n", n_in, out_size, ws_size); grid = -1; return; }
        int dev = 0, cus = 0, per_cu = 0;
        hipGetDevice(&dev); hipDeviceGetAttribute(&cus, hipDeviceAttributeMultiprocessorCount, dev);
        hipFuncSetAttribute((const void*)mega, hipFuncAttributeMaxDynamicSharedMemorySize, LDS_BYTES);
        hipOccupancyMaxActiveBlocksPerMultiprocessor(&per_cu, (const void*)mega, 512, LDS_BYTES);
        if (per_cu < 1) { fprintf(stderr, "kernel_launch: occupancy query reports %d blocks per CU\n", per_cu); grid = -1; return; }
        if (cus != 256) { fprintf(stderr, "kernel_launch: this build's static unit orders need 256 CUs (found %d)\n", cus); grid = -1; return; }
        grid = cus;
    }
    if (grid < 0) return;
    if (hipMemsetAsync((char*)d_ws + WS_CTL, 0, CTL_BYTES, stream) != hipSuccess) { fprintf(stderr, "kernel_launch: memset failed\n"); return; }
    Args a{};
    for (int i = 0; i < 30; ++i) a.in[i] = (const float*)d_in[i];
    a.out = (float*)d_out; a.ws = (unsigned char*)d_ws;
    void* args[] = {&a};
    hipError_t e = hipLaunchCooperativeKernel((const void*)mega, dim3(grid), dim3(512), args, LDS_BYTES, stream);
    if (e != hipSuccess) fprintf(stderr, "cooperative launch failed: %s (grid %d)\n", hipGetErrorString(e), grid);
}
```

```cpp
#include <hip/hip_runtime.h>
#include <hip/hip_cooperative_groups.h>
#include <cstdio>
#include <cstdint>
namespace cg = cooperative_groups;

#define LAS __attribute__((address_space(3)))
typedef unsigned short bf16_t;
typedef short bf16x8 __attribute__((ext_vector_type(8)));
typedef float f32x4 __attribute__((ext_vector_type(4)));
typedef float f32x16 __attribute__((ext_vector_type(16)));
typedef float f32x8 __attribute__((ext_vector_type(8)));
typedef unsigned u32x4 __attribute__((ext_vector_type(4)));
typedef unsigned u32x2 __attribute__((ext_vector_type(2)));

constexpr int DM = 1024, NPR = 16384, NSM = 512, MT = 16896, NL = 4, NH = 8, HD = 64;
constexpr int SEQ = 4096, PAST = 1024, DSEQ = 64, KVS = 1088, DFF = 2816, DIN = 2056;
constexpr int NG = 32, NP = 64, MG = 16, LC = 16, NCH = MT / LC  , CHP = 1280  , UAK = 384;
constexpr float C2 = 0.125f * 1.4426950408889634f, LOG2E = 1.4426950408889634f, EPS = 1e-6f;
constexpr size_t O_YP = 0, O_KP = 17301504, O_VP = 50855936, O_LP = 84410368, O_RP = 84934656, O_IP = 84967424,
                 O_KS = 85000192, O_VS = 86048768, O_LS = 87097344, O_RS = 87113728, O_IS = 87179264, O_END = 87244800;
constexpr size_t MiB = 1u << 20;
constexpr size_t WS_CTL = 1536 * 1024, CTL_BYTES = 32768;
constexpr int LDS_MISC = 131072 + 64;
constexpr size_t WS_MOD = 0, WS_WG = 2 * MiB, WS_A16 = 2 * MiB + 256 * 1024, WS_BIASP = 3 * MiB, WS_BIASS = 3 * MiB + 512 * 1024, WS_KMAX = 2 * MiB + 384 * 1024;
constexpr size_t WS_WIN = 4 * MiB, WS_WV = 16 * MiB, WS_WGLU = 20 * MiB, WS_WOUT = 22 * MiB, WS_WGU = 30 * MiB, WS_WD = 74 * MiB;
constexpr size_t WS_BT3 = 96 * MiB, WS_BT1 = 120 * MiB, WS_HM = 130 * MiB, WS_X = 164 * MiB, WS_F1 = 230 * MiB, WS_MIX = 264 * MiB;
constexpr size_t WS_Q = 298 * MiB, WS_KP = 315 * MiB, WS_VTP = 331 * MiB, WS_KS = 347 * MiB, WS_VTS = 356 * MiB, WS_UA = 365 * MiB,
                 WS_E = 395 * MiB, WS_Z = 415 * MiB, WS_H = 298 * MiB, WS_FS1 = 435 * MiB, WS_FS2 = 443 * MiB, WS_END = 465 * MiB;
constexpr int LDS_BYTES = 151552;
#ifndef PH_MASK
#define PH_MASK 0xffffffffu
#endif
#define PH(k) if (PH_MASK & (1u << (k)))

__device__ __forceinline__ unsigned cvt_pk_bf16(float lo, float hi) { unsigned r; asm volatile("v_cvt_pk_bf16_f32 %0, %1, %2" : "=v"(r) : "v"(lo), "v"(hi)); return r; }
__device__ __forceinline__ bf16_t f2bf(float f) { return (bf16_t)(cvt_pk_bf16(f, 0.f) & 0xffffu); }
__device__ __forceinline__ float bf2f(unsigned short b) { return __uint_as_float(((unsigned)b) << 16); }
__device__ __forceinline__ int opq(int x) { asm volatile("" : "+v"(x)); return x; }
__device__ __forceinline__ float bperm(float v, int srclane) { return __int_as_float(__builtin_amdgcn_ds_bpermute(srclane << 2, __float_as_int(v))); }
__device__ __forceinline__ float dpp_f(float v, const int ctrl) { return v; }
#define DPPADD(v, ctrl) v += __int_as_float(__builtin_amdgcn_update_dpp(0, __float_as_int(v), ctrl, 0xF, 0xF, true))
__device__ __forceinline__ float wave_sum(float v, int ln) {
    (void)ln;
    DPPADD(v, 0xB1);
    DPPADD(v, 0x4E);
    DPPADD(v, 0x141);
    DPPADD(v, 0x140);
    const float r0 = __int_as_float(__builtin_amdgcn_readlane(__float_as_int(v), 0)), r1 = __int_as_float(__builtin_amdgcn_readlane(__float_as_int(v), 16));
    const float r2 = __int_as_float(__builtin_amdgcn_readlane(__float_as_int(v), 32)), r3 = __int_as_float(__builtin_amdgcn_readlane(__float_as_int(v), 48));
    return (r0 + r1) + (r2 + r3);
}
__device__ __forceinline__ float sigm(float x) { return __builtin_amdgcn_rcpf(1.f + __builtin_amdgcn_exp2f(-1.4426950408889634f * x)); }
__device__ __forceinline__ float silu_f(float x) { return x * sigm(x); }
__device__ __forceinline__ float gelu_f(float x) { const float u = 0.7978845608028654f * (x + 0.044715f * x * x * x); return x * sigm(2.f * u); }
__device__ __forceinline__ float logsig(float x) { return fminf(x, 0.f) - log1pf(__expf(-fabsf(x))); }

namespace pg8 {
constexpr int BM = 256, BK = 64, HALF = 128, HTB = HALF * BK * 2, STAGE_BYTES = 8 * HTB, NXCD = 8, WGM = 8;
__host__ __device__ __forceinline__ int lds_byte(int r, int c) { const int st = (r >> 4) * 2 + (c >> 5), rr = r & 15, cc = c & 31, ob = rr * 64 + cc * 2; return st * 1024 + (ob ^ (((ob >> 9) & 1) << 5)); }
__host__ __device__ __forceinline__ void stage_rc(int b, int& R, int& C) { const int st = b / 1024, sb = b % 1024, swz = sb ^ (((sb >> 9) & 1) << 5); R = (st >> 1) * 16 + swz / 64; C = (st & 1) * 32 + (swz % 64) / 2; }
__host__ __device__ __forceinline__ int perm32(int rho) { const int n = rho >> 4, i = rho & 15; return 8 * (i >> 2) + 4 * n + (i & 3); }
struct Unit { int pm, pn, ks, kind, nt; };
struct Gemm { const bf16_t* A; const bf16_t* Bt; int M, N, K, lda, ldb, gdiv; size_t gstrideB; unsigned kcb; const bf16_t* A1; const bf16_t* Bt1; };
struct StaticOrder {
    int nM, nN, nwg, G, c;
    __device__ __forceinline__ void init(int M, int N, int G_, int c_) { nM = M / BM; nN = N / BM; nwg = nM * nN; G = G_; c = c_; }
    __device__ __forceinline__ bool next(int i, Unit& u) const {
        const long L = (long)i * G + c; if (L >= nwg) return false;
        int wgid = (int)L; { const int q = nwg / NXCD, r = nwg % NXCD, xcd = wgid % NXCD, off = wgid / NXCD; wgid = (xcd < r ? xcd * (q + 1) : r * (q + 1) + (xcd - r) * q) + off; }
        const int nig = WGM * nN, gid = wgid / nig, fm = gid * WGM, gsz = (nM - fm) < WGM ? (nM - fm) : WGM;
        u.pm = fm + ((wgid % nig) % gsz); u.pn = (wgid % nig) / gsz; u.ks = 0; u.kind = 0; u.nt = 0; return true;
    }
};
struct SplitOrder {
    int nsub, G, c, S;
    __device__ __forceinline__ void init(int S_, int G_, int c_) { S = S_; nsub = 8 * S_; G = G_; c = c_; }
    __device__ __forceinline__ bool next(int i, Unit& u) const { const int idx = i * G + c; if (idx >= nsub) return false; u.ks = idx % S; const int t = idx / S; u.pn = t & 3; u.pm = 64 + (t >> 2); u.kind = 0; u.nt = 0; return true; }
};
struct VtOrder {
    int idx;
    __device__ __forceinline__ void init(int G_, int c_) { idx = c_ - (G_ - 116); }
    __device__ __forceinline__ bool next(int i, Unit& u) const { if (i != 0 || idx < 0 || idx >= 116) return false; u.pm = idx / 58; u.pn = idx - u.pm * 58; u.ks = 0; u.kind = 0; u.nt = 0; return true; }
};
struct VtSplitOrder {
    int c;
    __device__ __forceinline__ void init(int c_) { c = c_; }
    __device__ __forceinline__ bool next(int i, Unit& u) const { if (i != 0 || c >= 64) return false; const int tile = c >> 2; u.ks = c & 3; u.pm = tile >> 3; u.pn = 58 + (tile & 7); u.kind = 0; u.nt = 0; return true; }
};
struct PhaseAOrder {
    StaticOrder so; int c;
    __device__ __forceinline__ void init(int G_, int c_) { so.init(MT, 1536, G_, c_); c = c_; }
    __device__ __forceinline__ bool next(int i, Unit& u) const {
        Unit t = {0, 0, 0, 0, 0}; bool ok = false;
        if (i <= 1) ok = so.next(i, t);
        int pm = t.pm, pn = t.pn, ks = 0, kind = 0, nt = 0;
        if (i == 1 && !ok) { const int idx = c - 140; ok = idx >= 0 && idx < 116; pm = idx / 58; pn = idx - pm * 58; kind = 1; nt = 16; }
        if (i == 2) { ok = c < 64; const int tile = c >> 2; ks = c & 3; pm = tile >> 3; pn = 58 + (tile & 7); kind = 1; nt = 4; }
        u.pm = pm; u.pn = pn; u.ks = ks; u.kind = kind; u.nt = nt;
        return ok;
    }
};
struct MainSplitOrder {
    StaticOrder so; int c, S, nts;
    __device__ __forceinline__ void init(int G_, int c_, int S_, int nts_) { so.init(NPR, 1024, G_, c_); c = c_; S = S_; nts = nts_; }
    __device__ __forceinline__ bool next(int i, Unit& u) const {
        Unit t = {0, 0, 0, 0, 0}; bool ok = false;
        if (i == 0) ok = so.next(0, t);
        int pm = t.pm, pn = t.pn, ks = 0, nt = 0;
        if (i == 1) { ok = c < 8 * S; ks = c % S; const int tt = c / S; pn = tt & 3; pm = 64 + (tt >> 2); nt = nts; }
        u.pm = pm; u.pn = pn; u.ks = ks; u.kind = 0; u.nt = nt;
        return ok;
    }
};
template <class Epi, class Sched>
__device__ __forceinline__ void gemm_phase(LAS unsigned char* lds, const Gemm g, const Sched& S, const Epi& E, const int wave_id) {
    const int lane = (int)__builtin_amdgcn_mbcnt_hi(~0u, __builtin_amdgcn_mbcnt_lo(~0u, (unsigned)opq(0))), wid = wave_id, tid = wid * 64 + lane, wr = wid >> 2, wc = wid & 3, fr = lane & 15, fq = lane >> 4;
    unsigned voffA[2], voffB[2];
#pragma unroll
    for (int i = 0; i < 2; ++i) { int R, C; stage_rc(tid * 16 + i * 8192, R, C); const int Rb = (R & ~31) + perm32(R & 31);
        voffA[i] = (unsigned)(R * g.lda + C) * 2u; voffB[i] = (unsigned)(Rb * g.ldb + C) * 2u; }
    const unsigned kstep = (unsigned)(BK * 2);
    const unsigned hstepA = (unsigned)HALF * g.lda * 2, hstepB = (unsigned)HALF * g.ldb * 2, tstepA = 2 * hstepA, tstepB = 2 * hstepB;
    const unsigned ldsw = (unsigned)wid * 1024u;
    const int aoff = lds_byte(wr * 64 + fr, fq * 8), boff = lds_byte(wc * 32 + fr, fq * 8);
#define PG8_SA(b, h) (((b) * 2 + (h)) * HTB)
#define PG8_SB(b, h) ((4 + (b) * 2 + (h)) * HTB)
#define PG8_STAGE(bufoff, gbase, voff) do { _Pragma("unroll") for (int _i = 0; _i < 2; ++_i) \
        __builtin_amdgcn_global_load_lds((const unsigned*)((const char*)(gbase) + (voff)[_i]), (LAS unsigned*)(lds + (bufoff) + ldsw + _i * 8192), 16, 0, 0); } while (0)
#define PG8_LDA(dst, b, h) do { _Pragma("unroll") for (int m = 0; m < 4; ++m) _Pragma("unroll") for (int k = 0; k < 2; ++k) dst[m][k] = *(const LAS bf16x8*)(lds + PG8_SA(b, h) + aoff + m * 2048 + k * 1024); } while (0)
#define PG8_LDB(dst, b, h) do { _Pragma("unroll") for (int n = 0; n < 2; ++n) _Pragma("unroll") for (int k = 0; k < 2; ++k) dst[n][k] = *(const LAS bf16x8*)(lds + PG8_SB(b, h) + boff + n * 2048 + k * 1024); } while (0)
#define PG8_MMA(ai, bj, At, Bt) do { __builtin_amdgcn_s_setprio(1); _Pragma("unroll") for (int m = 0; m < 4; ++m) _Pragma("unroll") for (int n = 0; n < 2; ++n) _Pragma("unroll") for (int k = 0; k < 2; ++k) \
        acc[ai][bj][m][n] = __builtin_amdgcn_mfma_f32_16x16x32_bf16(Bt[n][k], At[m][k], acc[ai][bj][m][n], 0, 0, 0); __builtin_amdgcn_s_setprio(0); } while (0)
#define PG8_WAIT_V(n) asm volatile("s_waitcnt vmcnt(" #n ")" ::: "memory")
#define PG8_WAIT_L(n) asm volatile("s_waitcnt lgkmcnt(" #n ")" ::: "memory")
#define PG8_BAR __builtin_amdgcn_s_barrier()
#define PG8_SCHED __builtin_amdgcn_sched_barrier(0)
    Unit cur = {0, 0, 0, 0, 0}, nxt = {0, 0, 0, 0, 0}; int ui = 0;
    if (!S.next(0, cur)) return;
    f32x4 acc[2][2][4][2];
    const float zf = __int_as_float(opq(0)); const f32x4 zero4 = (f32x4){zf, zf, zf, zf};
#pragma unroll
    for (int a = 0; a < 2; ++a)
#pragma unroll
        for (int b = 0; b < 2; ++b)
#pragma unroll
            for (int m = 0; m < 4; ++m)
#pragma unroll
                for (int n = 0; n < 2; ++n) acc[a][b][m][n] = zero4;
    bf16x8 At[4][2], B0[2][2], B1[2][2];
    const char* cA = (const char*)(cur.kind ? g.A1 : g.A) + (size_t)cur.pm * tstepA + (size_t)cur.ks * g.kcb;
    const char* cB = (const char*)(cur.kind ? g.Bt1 : g.Bt) + (size_t)(cur.pm / g.gdiv) * g.gstrideB * 2 + (size_t)cur.pn * tstepB + (size_t)cur.ks * g.kcb;
    int nt = cur.nt ? cur.nt : g.K / BK;
    PG8_STAGE(PG8_SB(0, 0), cB, voffB); PG8_STAGE(PG8_SB(0, 1), cB + hstepB, voffB); PG8_STAGE(PG8_SA(0, 0), cA, voffA); PG8_STAGE(PG8_SA(0, 1), cA + hstepA, voffA);
    if (wr == 1) PG8_BAR;
    PG8_WAIT_V(2); PG8_BAR;
    PG8_STAGE(PG8_SB(1, 0), cB + kstep, voffB); PG8_STAGE(PG8_SA(1, 0), cA + kstep, voffA); PG8_STAGE(PG8_SB(1, 1), cB + hstepB + kstep, voffB);
    PG8_WAIT_V(6); PG8_BAR;
    for (;;) {
        nxt.pm = 0; nxt.pn = 0; nxt.ks = 0; nxt.kind = 0; nxt.nt = 0;
        const bool has_next = S.next(ui + 1, nxt);
        const char* nA = has_next ? (const char*)(nxt.kind ? g.A1 : g.A) + (size_t)nxt.pm * tstepA + (size_t)nxt.ks * g.kcb : cA;
        const char* nB = has_next ? (const char*)(nxt.kind ? g.Bt1 : g.Bt) + (size_t)(nxt.pm / g.gdiv) * g.gstrideB * 2 + (size_t)nxt.pn * tstepB + (size_t)nxt.ks * g.kcb : cB;
#pragma unroll 1
        for (int t = 0; t < nt; t += 2) {
            const bool last = (t == nt - 2);
            const char* a1 = cA + (unsigned)(t + 1) * kstep;
            const char* a2 = last ? nA : cA + (unsigned)(t + 2) * kstep; const char* b2 = last ? nB : cB + (unsigned)(t + 2) * kstep;
            const char* a3 = a2 + kstep; const char* b3 = b2 + kstep;
            PG8_LDB(B0, 0, 0); PG8_LDB(B1, 0, 1); PG8_SCHED; PG8_LDA(At, 0, 0); PG8_STAGE(PG8_SA(1, 1), a1 + hstepA, voffA);
            PG8_WAIT_V(8); PG8_WAIT_L(0); PG8_BAR; PG8_MMA(0, 0, At, B0); PG8_MMA(0, 1, At, B1); PG8_BAR; PG8_SCHED;
            PG8_LDA(At, 0, 1); PG8_STAGE(PG8_SB(0, 0), b2, voffB); PG8_STAGE(PG8_SB(0, 1), b2 + hstepB, voffB); PG8_STAGE(PG8_SA(0, 0), a2, voffA);
            PG8_WAIT_V(8); PG8_WAIT_L(0); PG8_BAR; PG8_MMA(1, 0, At, B0); PG8_MMA(1, 1, At, B1); PG8_BAR; PG8_SCHED;
            PG8_LDB(B0, 1, 0); PG8_LDB(B1, 1, 1); PG8_SCHED; PG8_LDA(At, 1, 0); PG8_STAGE(PG8_SA(0, 1), a2 + hstepA, voffA);
            PG8_WAIT_V(8); PG8_WAIT_L(0); PG8_BAR; PG8_MMA(0, 0, At, B0); PG8_MMA(0, 1, At, B1); PG8_BAR; PG8_SCHED;
            PG8_LDA(At, 1, 1); PG8_STAGE(PG8_SB(1, 0), b3, voffB); PG8_STAGE(PG8_SB(1, 1), b3 + hstepB, voffB); PG8_STAGE(PG8_SA(1, 0), a3, voffA);
            PG8_WAIT_V(8); PG8_WAIT_L(0); PG8_BAR; PG8_MMA(1, 0, At, B0); PG8_MMA(1, 1, At, B1); PG8_BAR; PG8_SCHED;
        }
        if (wr == 0) PG8_BAR;
        E(acc, cur, wr, wc, fr, fq);
        if (!has_next) break;
#pragma unroll
        for (int a = 0; a < 2; ++a)
#pragma unroll
            for (int b = 0; b < 2; ++b)
#pragma unroll
                for (int m = 0; m < 4; ++m)
#pragma unroll
                    for (int n = 0; n < 2; ++n) acc[a][b][m][n] = zero4;
        cur = nxt; cA = nA; cB = nB; ++ui; nt = cur.nt ? cur.nt : g.K / BK;
        if (wr == 1) PG8_BAR;
    }
    PG8_WAIT_V(0);
    PG8_BAR;
#undef PG8_SA
#undef PG8_SB
#undef PG8_STAGE
#undef PG8_LDA
#undef PG8_LDB
#undef PG8_MMA
#undef PG8_WAIT_V
#undef PG8_WAIT_L
#undef PG8_BAR
#undef PG8_SCHED
}
}
using pg8::Unit;
typedef const f32x4 (&AccRef)[2][2][4][2];
__device__ __forceinline__ u32x4 pack8(f32x4 v0, f32x4 v1) { u32x4 w; w.x = cvt_pk_bf16(v0[0], v0[1]); w.y = cvt_pk_bf16(v0[2], v0[3]); w.z = cvt_pk_bf16(v1[0], v1[1]); w.w = cvt_pk_bf16(v1[2], v1[3]); return w; }

struct EpiPlain {
    bf16_t* O; int ldc;
    __device__ __forceinline__ void operator()(AccRef acc, const Unit& u, int wr, int wc, int fr, int fq) const {
        fr = opq(fr); fq = opq(fq);
#pragma unroll
        for (int ai = 0; ai < 2; ++ai)
#pragma unroll
            for (int m = 0; m < 4; ++m) { const int r = u.pm * 256 + ai * 128 + wr * 64 + m * 16 + fr;
#pragma unroll
                for (int bj = 0; bj < 2; ++bj) { const int c = u.pn * 256 + bj * 128 + wc * 32 + 8 * fq;
                    *(u32x4*)(O + (size_t)r * ldc + c) = pack8(acc[ai][bj][m][0], acc[ai][bj][m][1]); } }
    }
};
struct EpiIn {
    bf16_t *Q, *KP, *KS, *UA; float* out; int l;
    __device__ __forceinline__ void operator()(AccRef acc, const Unit& u, int wr, int wc, int fr, int fq) const {
        fr = opq(fr); fq = opq(fq);
        const bool prompt = u.pm < 64;
#pragma unroll
        for (int ai = 0; ai < 2; ++ai)
#pragma unroll
            for (int m = 0; m < 4; ++m) { const int r = u.pm * 256 + ai * 128 + wr * 64 + m * 16 + fr;
#pragma unroll
                for (int bj = 0; bj < 2; ++bj) { const int c = u.pn * 256 + bj * 128 + wc * 32 + 8 * fq;
                    const f32x4 v0 = acc[ai][bj][m][0], v1 = acc[ai][bj][m][1];
                    if (u.pn < 2) { *(u32x4*)(Q + (size_t)r * 512 + c) = pack8(v0 * C2, v1 * C2); }
                    else if (u.pn < 4) { const int ck = c - 512, h = ck >> 6, d = ck & 63; const u32x4 w = pack8(v0, v1);
                        if (prompt) { const int b = r >> 12, t = r & 4095;
                            *(u32x4*)(KP + ((size_t)(b * 8 + h) * 4096 + t) * 64 + d) = w;
                            float* o = out + O_KP + ((size_t)((l * 4 + b) * 8 + h) * 4096 + t) * 64 + d; *(f32x4*)o = v0; *(f32x4*)(o + 4) = v1; }
                        else { const int rr = r - NPR, b = rr >> 6, t = rr & 63;
                            *(u32x4*)(KS + ((size_t)(b * 8 + h) * KVS + PAST + t) * 64 + d) = w;
                            float* o = out + O_KS + ((size_t)((l * 8 + b) * 8 + h) * 64 + t) * 64 + d; *(f32x4*)o = v0; *(f32x4*)(o + 4) = v1; } }
                    else { const int cu = c - 1024, gq = cu >> 4, m0 = cu & 15, chunk = r >> 4, s = r & 15;
                        *(u32x4*)(UA + ((size_t)gq * CHP + chunk) * UAK + s * 16 + m0) = pack8(v0, v1); }
                    asm volatile("" ::: "memory"); } }
    }
};
struct EpiVT {
    bf16_t *VTP, *VTS; float* out; int l; LAS unsigned char* lds;
    __device__ __forceinline__ void operator()(AccRef acc, const Unit& u, int wr, int wc, int fr, int fq) const {
        fr = opq(fr); fq = opq(fq);
        const bool prompt = u.pn < 64; const int ln = fq * 16 + fr;
        LAS float* stg = (LAS float*)(lds + 131072 + 1024 + (wr * 4 + wc) * 2080);
#pragma unroll
        for (int ai = 0; ai < 2; ++ai)
#pragma unroll
            for (int bj = 0; bj < 2; ++bj) {
                const int h = (u.pm * 256 + ai * 128 + wr * 64) >> 6, tok0 = u.pn * 256 + bj * 128 + wc * 32;
                float* obase; bf16_t* vbase; size_t vpitch;
                if (prompt) { const int b = tok0 >> 12, t0 = tok0 & 4095; obase = out + O_VP + ((size_t)((l * 4 + b) * 8 + h) * 4096 + t0) * 64; vbase = VTP + (size_t)(b * 8 + h) * 64 * 4096 + t0; vpitch = 4096; }
                else { const int tt = tok0 - NPR, b = tt >> 6, t0 = tt & 63; obase = out + O_VS + ((size_t)((l * 8 + b) * 8 + h) * 64 + t0) * 64; vbase = VTS + (size_t)(b * 8 + h) * 64 * KVS + PAST + t0; vpitch = KVS; }
#pragma unroll
                for (int m = 0; m < 4; ++m) *(u32x4*)(vbase + (size_t)(m * 16 + fr) * vpitch + 8 * fq) = pack8(acc[ai][bj][m][0], acc[ai][bj][m][1]);
#pragma unroll
                for (int n = 0; n < 2; ++n)
#pragma unroll
                    for (int j0 = 0; j0 < 4; j0 += 2) {
#pragma unroll
                        for (int m = 0; m < 4; ++m) { stg[(2 * fq) * 65 + 16 * m + fr] = acc[ai][bj][m][n][j0]; stg[(2 * fq + 1) * 65 + 16 * m + fr] = acc[ai][bj][m][n][j0 + 1]; }
                        asm volatile("s_waitcnt lgkmcnt(0)" ::: "memory");
#pragma unroll
                        for (int sl = 0; sl < 8; ++sl) { const float v = stg[sl * 65 + ln]; obase[(size_t)(8 * (sl >> 1) + 4 * n + j0 + (sl & 1)) * 64 + ln] = v; }
                        asm volatile("s_waitcnt lgkmcnt(0)" ::: "memory");
                    }
            }
    }
};
struct EpiVtPart {
    float* PV;
    __device__ __forceinline__ void operator()(AccRef acc, const Unit& u, int wr, int wc, int fr, int fq) const {
        fr = opq(fr); fq = opq(fq);
        float* base = PV + (size_t)((u.pm * 8 + (u.pn - 58)) * 4 + u.ks) * 65536;
#pragma unroll
        for (int ai = 0; ai < 2; ++ai)
#pragma unroll
            for (int m = 0; m < 4; ++m) { const int r = ai * 128 + wr * 64 + m * 16 + fr;
#pragma unroll
                for (int bj = 0; bj < 2; ++bj) { float* o = base + r * 256 + bj * 128 + wc * 32 + 8 * fq; *(f32x4*)o = acc[ai][bj][m][0]; *(f32x4*)(o + 4) = acc[ai][bj][m][1]; } }
    }
};
struct EpiE {
    float* E;
    __device__ __forceinline__ void operator()(AccRef acc, const Unit& u, int wr, int wc, int fr, int fq) const {
        fr = opq(fr); fq = opq(fq);
#pragma unroll
        for (int ai = 0; ai < 2; ++ai)
#pragma unroll
            for (int m = 0; m < 4; ++m) { const int gq = u.pm / 5, chunk = (u.pm - gq * 5) * 256 + ai * 128 + wr * 64 + m * 16 + fr;
                { float* o = E + ((size_t)gq * CHP + chunk) * 128 + wc * 32 + 8 * fq; *(f32x4*)o = acc[ai][0][m][0]; *(f32x4*)(o + 4) = acc[ai][0][m][1]; } }
    }
};
struct EpiZ {
    bf16_t* Z;
    __device__ __forceinline__ void operator()(AccRef acc, const Unit& u, int wr, int wc, int fr, int fq) const {
        fr = opq(fr); fq = opq(fq);
#pragma unroll
        for (int ai = 0; ai < 2; ++ai)
#pragma unroll
            for (int m = 0; m < 4; ++m) { const int gq = u.pm / 5, chunk = (u.pm - gq * 5) * 256 + ai * 128 + wr * 64 + m * 16 + fr;
                {
#pragma unroll
                    for (int bj = 0; bj < 2; ++bj) { const int n = bj * 128 + wc * 32 + 8 * fq, t = n >> 4, m0 = n & 15;
                        f32x4 v0 = acc[ai][bj][m][0], v1 = acc[ai][bj][m][1];
#pragma unroll
                        for (int j = 0; j < 4; ++j) { v0[j] = gelu_f(v0[j]); v1[j] = gelu_f(v1[j]); }
                        *(u32x4*)(Z + (size_t)(chunk * 16 + t) * 512 + gq * 16 + m0) = pack8(v0, v1); __builtin_amdgcn_sched_barrier(0); } } }
    }
};
struct EpiGlu {
    const bf16_t* Z; bf16_t* MIX;
    __device__ __forceinline__ void operator()(AccRef acc, const Unit& u, int wr, int wc, int fr, int fq) const {
        fr = opq(fr); fq = opq(fq);
#pragma unroll
        for (int ai = 0; ai < 2; ++ai)
#pragma unroll
            for (int m = 0; m < 4; ++m) { const int r = u.pm * 256 + ai * 128 + wr * 64 + m * 16 + fr;
#pragma unroll
                for (int bj = 0; bj < 2; ++bj) { const int c = u.pn * 256 + bj * 128 + wc * 32 + 8 * fq;
                    const u32x4 zz = *(const u32x4*)(Z + (size_t)r * 512 + c);
                    f32x4 v0 = acc[ai][bj][m][0], v1 = acc[ai][bj][m][1];
#pragma unroll
                    for (int j = 0; j < 4; ++j) { const unsigned w0 = zz[j >> 1], w1 = zz[2 + (j >> 1)];
                        const float z0 = (j & 1) ? __uint_as_float(w0 & 0xffff0000u) : __uint_as_float(w0 << 16);
                        const float z1 = (j & 1) ? __uint_as_float(w1 & 0xffff0000u) : __uint_as_float(w1 << 16);
                        v0[j] = z0 * sigm(v0[j]); v1[j] = z1 * sigm(v1[j]); }
                    *(u32x4*)(MIX + (size_t)r * 1024 + 512 + c) = pack8(v0, v1); } }
    }
};
struct EpiAtomic {
    float* FS;
    __device__ __forceinline__ void operator()(AccRef acc, const Unit& u, int wr, int wc, int fr, int fq) const {
        fr = opq(fr); fq = opq(fq);
#pragma unroll
        for (int ai = 0; ai < 2; ++ai)
#pragma unroll
            for (int m = 0; m < 4; ++m) { const int r = (u.pm - 64) * 256 + ai * 128 + wr * 64 + m * 16 + fr;
#pragma unroll
                for (int bj = 0; bj < 2; ++bj) { float* o = FS + ((size_t)u.ks * 512 + r) * 1024 + u.pn * 256 + bj * 128 + wc * 32 + 8 * fq;
                    *(f32x4*)o = acc[ai][bj][m][0]; *(f32x4*)(o + 4) = acc[ai][bj][m][1]; } }
    }
};
struct EpiSwi {
    bf16_t* H;
    __device__ __forceinline__ void operator()(AccRef acc, const Unit& u, int wr, int wc, int fr, int fq) const {
        fr = opq(fr); fq = opq(fq);
#pragma unroll
        for (int ai = 0; ai < 2; ++ai)
#pragma unroll
            for (int m = 0; m < 4; ++m) { const int r = u.pm * 256 + ai * 128 + wr * 64 + m * 16 + fr; const int c = u.pn * 128 + wc * 32 + 8 * fq;
                f32x4 v0 = acc[ai][0][m][0], v1 = acc[ai][0][m][1]; const f32x4 u0 = acc[ai][1][m][0], u1 = acc[ai][1][m][1];
#pragma unroll
                for (int j = 0; j < 4; ++j) { v0[j] = silu_f(v0[j]) * u0[j]; v1[j] = silu_f(v1[j]) * u1[j]; }
                *(u32x4*)(H + (size_t)r * DFF + c) = pack8(v0, v1); }
    }
};

struct EpiA {
    EpiIn in; EpiVT vt; EpiVtPart vp;
    __device__ __forceinline__ void operator()(AccRef acc, const Unit& u, int wr, int wc, int fr, int fq) const {
        if (u.kind == 0) in(acc, u, wr, wc, fr, fq); else if (u.nt == 16) vt(acc, u, wr, wc, fr, fq); else vp(acc, u, wr, wc, fr, fq);
    }
};
struct EpiMS {
    EpiPlain p; EpiAtomic q;
    __device__ __forceinline__ void operator()(AccRef acc, const Unit& u, int wr, int wc, int fr, int fq) const {
        if (u.pm < 64) p(acc, u, wr, wc, fr, fq); else q(acc, u, wr, wc, fr, fq);
    }
};
struct Args { const float* in[30]; float* out; unsigned char* ws; };
struct Ctx {
    LAS unsigned char* lds; int tid, lane, wave, G, c;
    const float* const* in; float* out; unsigned char* ws;
};
#define INP(i) (a.in[i])

__device__ __forceinline__ void tr_item(const float* W, size_t ldw, int k0, int sc0, bf16_t* WT, size_t ldo, int dr0, LAS float* scr, int lane) {
    f32x4 tv[8];
#pragma unroll
    for (int i = 0; i < 8; ++i) { const int kk = 8 * i + (lane >> 3); tv[i] = *(const f32x4*)(W + (size_t)(k0 + kk) * ldw + sc0 + 4 * (lane & 7)); }
#pragma unroll
    for (int i = 0; i < 8; ++i) { const int kk = 8 * i + (lane >> 3); LAS float* d = scr + kk * 33 + 4 * (lane & 7); d[0] = tv[i][0]; d[1] = tv[i][1]; d[2] = tv[i][2]; d[3] = tv[i][3]; }
    asm volatile("s_waitcnt lgkmcnt(0)" ::: "memory");
    const int c = lane & 7;
#pragma unroll
    for (int j = 0; j < 4; ++j) { const int n = (lane >> 3) + 8 * j; const LAS float* s = scr + (8 * c) * 33 + n;
        u32x4 o; o.x = cvt_pk_bf16(s[0 * 33], s[1 * 33]); o.y = cvt_pk_bf16(s[2 * 33], s[3 * 33]); o.z = cvt_pk_bf16(s[4 * 33], s[5 * 33]); o.w = cvt_pk_bf16(s[6 * 33], s[7 * 33]);
        *(u32x4*)(WT + (size_t)(dr0 + n) * ldo + k0 + 8 * c) = o; }
    asm volatile("s_waitcnt lgkmcnt(0)" ::: "memory");
}

__device__ __forceinline__ void sincos_d(double x, double& s, double& c) {
    const double k = rint(x * 0.63661977236758134308);
    const double r = (x - k * 1.57079632679489655800) - k * 6.123233995736766036e-17;
    const double r2 = r * r;
    double sp = 1.0 / 6227020800.0; sp = sp * r2 - 1.0 / 39916800.0; sp = sp * r2 + 1.0 / 362880.0; sp = sp * r2 - 1.0 / 5040.0; sp = sp * r2 + 1.0 / 120.0; sp = sp * r2 - 1.0 / 6.0; sp = sp * r2 + 1.0;
    const double sr = r * sp;
    double cp = 1.0 / 87178291200.0; cp = cp * r2 - 1.0 / 479001600.0; cp = cp * r2 + 1.0 / 3628800.0; cp = cp * r2 - 1.0 / 40320.0; cp = cp * r2 + 1.0 / 720.0; cp = cp * r2 - 1.0 / 24.0; cp = cp * r2 + 0.5;
    const double cr = 1.0 - r2 * cp;
    const int q = ((int)k) & 3;
    s = (q == 0) ? sr : (q == 1) ? cr : (q == 2) ? -sr : -cr;
    c = (q == 0) ? cr : (q == 1) ? -sr : (q == 2) ? -cr : sr;
}

__device__ __forceinline__ void p0_weights(const Args& a, LAS unsigned char* lds, int wave, int lane, int gw, int NGW) {
    LAS float* scr = (LAS float*)(lds + wave * 16384);
    constexpr int I_IN = 16 * 16, I_GLU = 8 * 16, I_OUT = 16 * 32, I_G = 16 * 88, I_D = 44 * 32;
    constexpr int PER_L = 4 * I_IN + I_GLU + I_OUT + 2 * I_G + I_D;
    for (int it = gw; it < NL * PER_L; it += NGW) {
        const int l = it / PER_L; int r = it - l * PER_L;
        const float* win = INP(15) + (size_t)l * DM * DIN;
        bf16_t* WIN = (bf16_t*)(a.ws + WS_WIN) + (size_t)l * 1536 * 1024;
        if (r < 4 * I_IN) { const int part = r / I_IN, rr = r % I_IN, kb = rr / 16, nb = rr % 16;
            if (part == 0) tr_item(win, DIN, 64 * kb, 32 * nb, WIN, 1024, 32 * nb, scr, lane);
            else if (part == 1) tr_item(win, DIN, 64 * kb, 512 + 32 * nb, WIN, 1024, 512 + 32 * nb, scr, lane);
            else if (part == 2) tr_item(win, DIN, 64 * kb, 1544 + 32 * nb, WIN, 1024, 1024 + 32 * nb, scr, lane);
            else tr_item(win, DIN, 64 * kb, 1024 + 32 * nb, (bf16_t*)(a.ws + WS_WV) + (size_t)l * 512 * 1024, 1024, 32 * nb, scr, lane);
            continue; }
        r -= 4 * I_IN;
        if (r < I_GLU) { tr_item(INP(25) + (size_t)l * 512 * 512, 512, 64 * (r / 16), 32 * (r % 16), (bf16_t*)(a.ws + WS_WGLU) + (size_t)l * 512 * 512, 512, 32 * (r % 16), scr, lane); continue; }
        r -= I_GLU;
        if (r < I_OUT) { tr_item(INP(26) + (size_t)l * 1024 * 1024, 1024, 64 * (r / 32), 32 * (r % 32), (bf16_t*)(a.ws + WS_WOUT) + (size_t)l * 1024 * 1024, 1024, 32 * (r % 32), scr, lane); continue; }
        r -= I_OUT;
        if (r < 2 * I_G) { const int up = r / I_G, rr = r % I_G, kb = rr / 88, nb = rr % 88, c0 = 32 * nb;
            tr_item(INP(27 + up) + (size_t)l * DM * DFF, DFF, 64 * kb, c0, (bf16_t*)(a.ws + WS_WGU) + (size_t)l * 5632 * 1024, 1024, (c0 >> 7) * 256 + up * 128 + (c0 & 127), scr, lane);
            continue; }
        r -= 2 * I_G;
        tr_item(INP(29) + (size_t)l * DFF * DM, DM, 64 * (r / 32), 32 * (r % 32), (bf16_t*)(a.ws + WS_WD) + (size_t)l * 1024 * DFF, DFF, 32 * (r % 32), scr, lane);
    }
    float* WG = (float*)(a.ws + WS_WG);
    for (int i = gw * 64 + lane; i < NL * 8 * 1024; i += NGW * 64) { const int l = i >> 13, h = (i >> 10) & 7, k = i & 1023; WG[i] = INP(15)[((size_t)l * DM + k) * DIN + 1536 + h]; }
}
__device__ __forceinline__ void p0_adaln(const Args& a, LAS unsigned char* lds, int tid, int wave, int lane, int c, int G) {
    LAS float* sc = (LAS float*)(lds);
    LAS float* red = (LAS float*)(lds + 49152);
    for (int i = tid; i < 12 * 1024; i += 512) { const float v = (i < 4096) ? INP(2)[i] : INP(3)[i - 4096]; sc[i] = silu_f(v); }
    __syncthreads();
    float* MOD = (float*)(a.ws + WS_MOD);
    for (int it = c; it < NL * 96; it += G) {
        const int l = it / 96, n0 = (it % 96) * 64;
        const float* W = INP(9) + (size_t)l * DM * 6144 + n0 + lane;
        float acc[12];
#pragma unroll
        for (int b = 0; b < 12; ++b) acc[b] = 0.f;
        for (int k = wave * 128; k < wave * 128 + 128; k += 16) {
            float w[16];
#pragma unroll
            for (int j = 0; j < 16; ++j) w[j] = W[(size_t)(k + j) * 6144];
#pragma unroll
            for (int j = 0; j < 16; ++j)
#pragma unroll
                for (int b = 0; b < 12; ++b) acc[b] += sc[b * 1024 + k + j] * w[j];
        }
#pragma unroll
        for (int b = 0; b < 12; ++b) red[(wave * 12 + b) * 64 + lane] = acc[b];
        __syncthreads();
        for (int i = tid; i < 768; i += 512) { const int b = i >> 6, cc = i & 63; float s = 0.f;
#pragma unroll
            for (int w = 0; w < 8; ++w) s += red[(w * 12 + b) * 64 + cc];
            MOD[((size_t)l * 12 + b) * 6144 + n0 + cc] = s + INP(10)[(size_t)l * 6144 + n0 + cc]; }
        __syncthreads();
    }
}
__device__ __forceinline__ void p0_ssm(const Args& a, LAS unsigned char* lds, int tid, int c, int G) {
    LAS float* ap_re = (LAS float*)(lds + 65536);
    LAS float* ap_im = ap_re + 17 * 64;
    LAS float* bb_re = ap_im + 17 * 64;
    LAS float* bb_im = bb_re + 1024;
    LAS float* cc_re = bb_im + 1024;
    LAS float* cc_im = cc_re + 1024;
    LAS float* ktab = cc_im + 1024;
    for (int it = c; it < NL * NG; it += G) {
        const int l = it >> 5, gq = it & 31;
        const double dt = exp((double)INP(19)[l * 32 + gq]);
        for (int idx = tid; idx < 17 * 64; idx += 512) { const int d = idx >> 6, p = idx & 63;
            const double ar = (double)INP(17)[(l * 32 + gq) * 64 + p], ai = (double)INP(18)[(l * 32 + gq) * 64 + p];
            double s, co; sincos_d((double)d * ai * dt, s, co); const double er = exp((double)d * ar * dt);
            ap_re[idx] = (float)(er * co); ap_im[idx] = (float)(er * s); }
        for (int idx = tid; idx < 1024; idx += 512) { const int p = idx >> 4, m = idx & 15;
            const double ar = (double)INP(17)[(l * 32 + gq) * 64 + p], ai = (double)INP(18)[(l * 32 + gq) * 64 + p];
            double s, co; sincos_d(ai * dt, s, co); const double er = exp(ar * dt);
            const double xr = er * co - 1.0, xi = er * s, den = 1.0 / (ar * ar + ai * ai);
            const double qr = (xr * ar + xi * ai) * den, qi = (xi * ar - xr * ai) * den;
            const double br = (double)INP(20)[((size_t)(l * 32 + gq) * 64 + p) * 16 + m], bi = (double)INP(21)[((size_t)(l * 32 + gq) * 64 + p) * 16 + m];
            bb_re[idx] = (float)(qr * br - qi * bi); bb_im[idx] = (float)(qr * bi + qi * br);
            cc_re[idx] = INP(22)[(size_t)(l * 32 + gq) * 1024 + idx]; cc_im[idx] = INP(23)[(size_t)(l * 32 + gq) * 1024 + idx]; }
        __syncthreads();
        for (int idx = tid; idx < 4096; idx += 512) { const int d = idx >> 8, m = (idx >> 4) & 15, m2 = idx & 15; float s = 0.f;
            for (int p = 0; p < 64; ++p) { const float cr = cc_re[m * 64 + p], ci = cc_im[m * 64 + p], pr = ap_re[d * 64 + p], pi = ap_im[d * 64 + p];
                const float re = cr * pr - ci * pi, im = cr * pi + ci * pr; s += re * bb_re[p * 16 + m2] - im * bb_im[p * 16 + m2]; }
            if (d == 0 && m == m2) s += INP(24)[l * 512 + gq * 16 + m];
            ktab[idx] = s; }
        __syncthreads();
        bf16_t* BT3 = (bf16_t*)(a.ws + WS_BT3) + (size_t)(l * 32 + gq) * 256 * UAK;
        for (int grp = tid; grp < 256 * 48; grp += 512) { const int n = grp / 48, k0 = (grp % 48) * 8, t = n >> 4, m = n & 15; float v[8];
            if (k0 < 256) { const int s = k0 >> 4, m20 = k0 & 15;
#pragma unroll
                for (int j = 0; j < 8; ++j) v[j] = (s <= t) ? ktab[((t - s) * 16 + m) * 16 + m20 + j] : 0.f; }
            else { const int kk = k0 - 256, ri = kk >> 6, p0 = kk & 63;
#pragma unroll
                for (int j = 0; j < 8; ++j) { const int p = p0 + j; const float cr = cc_re[m * 64 + p], ci = cc_im[m * 64 + p], pr = ap_re[(t + 1) * 64 + p], pi = ap_im[(t + 1) * 64 + p];
                    v[j] = ri ? -(cr * pi + ci * pr) : (cr * pr - ci * pi); } }
            u32x4 w; w.x = cvt_pk_bf16(v[0], v[1]); w.y = cvt_pk_bf16(v[2], v[3]); w.z = cvt_pk_bf16(v[4], v[5]); w.w = cvt_pk_bf16(v[6], v[7]);
            *(u32x4*)(BT3 + (size_t)n * UAK + k0) = w; }
        bf16_t* BT1 = (bf16_t*)(a.ws + WS_BT1) + (size_t)(l * 32 + gq) * 128 * 256;
        for (int grp = tid; grp < 128 * 32; grp += 512) { const int n = grp >> 5, k0 = (grp & 31) * 8, s = k0 >> 4, m0 = k0 & 15, ri = n >> 6, p = n & 63; float v[8];
            const float pr = ap_re[(15 - s) * 64 + p], pi = ap_im[(15 - s) * 64 + p];
#pragma unroll
            for (int j = 0; j < 8; ++j) { const float br = bb_re[p * 16 + m0 + j], bi = bb_im[p * 16 + m0 + j]; v[j] = ri ? (pr * bi + pi * br) : (pr * br - pi * bi); }
            u32x4 w; w.x = cvt_pk_bf16(v[0], v[1]); w.y = cvt_pk_bf16(v[2], v[3]); w.z = cvt_pk_bf16(v[4], v[5]); w.w = cvt_pk_bf16(v[6], v[7]);
            *(u32x4*)(BT1 + (size_t)n * 256 + k0) = w; }
        if (tid < 64) { float* A16 = (float*)(a.ws + WS_A16) + (size_t)(l * 32 + gq) * 128; A16[tid] = ap_re[16 * 64 + tid]; A16[64 + tid] = ap_im[16 * 64 + tid]; }
        __syncthreads();
    }
}

__device__ __forceinline__ void cache_convert(const Args& a, int l, LAS unsigned char* lds, int wave, int lane, int gw, int NGW) {
    bf16_t* KS = (bf16_t*)(a.ws + WS_KS); bf16_t* VTS = (bf16_t*)(a.ws + WS_VTS);
    const float* ck = INP(4) + (size_t)l * 64 * PAST * 64; const float* cv = INP(5) + (size_t)l * 64 * PAST * 64;
    for (int i = gw * 64 + lane; i < 64 * PAST * 8; i += NGW * 64) {
        const int bh = i >> 13, rem = i & 8191;
        const f32x4 v0 = *(const f32x4*)(ck + (size_t)i * 8), v1 = *(const f32x4*)(ck + (size_t)i * 8 + 4);
        *(u32x4*)(KS + (size_t)bh * KVS * 64 + (size_t)rem * 8) = pack8(v0, v1); }
    LAS float* scr = (LAS float*)(lds + wave * 16384);
    for (int it = gw; it < 64 * 32; it += NGW) { const int bh = it >> 5, r = it & 31, kb = r >> 1, nb = r & 1;
        tr_item(cv + (size_t)bh * PAST * 64, 64, 64 * kb, 32 * nb, VTS + (size_t)bh * 64 * KVS, KVS, 32 * nb, scr, lane); }
}

template <int NSPLIT>
__device__ __forceinline__ void rowpass(const float* xsrc_p, const float* xsrc_s, const bf16_t* xsrc_b, const bf16_t* Fb, const float* FS, int nsplit, const float* gate, const float* wpost, float* xdst, bf16_t* xdst_b,
                                        const float* wpre, const float* sc, const float* sh, bf16_t* HMb, const float* WGl, const float* bfor, float* out, int lnext,
                                        int lane, int gw, int NGW) {
    f32x4 wg[8][4];
    if (WGl) {
#pragma unroll
        for (int h = 0; h < 8; ++h)
#pragma unroll
            for (int j = 0; j < 4; ++j) wg[h][j] = *(const f32x4*)(WGl + h * 1024 + 4 * lane + 256 * j);
    }
#define LOADX(dst, rr, xr, j) do { if (xsrc_b) { const u32x2 w_ = *(const u32x2*)(xsrc_b + (size_t)(rr) * DM + 4 * lane + 256 * (j)); \
        dst = (f32x4){__uint_as_float(w_.x << 16), __uint_as_float(w_.x & 0xffff0000u), __uint_as_float(w_.y << 16), __uint_as_float(w_.y & 0xffff0000u)}; } \
        else dst = *(const f32x4*)((xr) + 4 * lane + 256 * (j)); } while (0)
    for (int r = gw; r < MT; r += NGW) {
        const bool prompt = r < NPR; const int bm = prompt ? (r >> 12) : 4 + ((r - NPR) >> 6);
        f32x4 x[4]; u32x2 fw[4];
        { const float* xr = prompt ? xsrc_p + (size_t)r * DM : xsrc_s + (size_t)(r - NPR) * DM;
#pragma unroll
          for (int j = 0; j < 4; ++j) { LOADX(x[j], r, xr, j); fw[j] = (Fb && prompt) ? *(const u32x2*)(Fb + (size_t)r * DM + 4 * lane + 256 * j) : (u32x2){0u, 0u}; } }
        if (Fb) {
            f32x4 f[4]; float ss = 0.f;
#pragma unroll
            for (int j = 0; j < 4; ++j) {
                if (prompt) { const u32x2 w = fw[j];
                    f[j] = (f32x4){__uint_as_float(w.x << 16), __uint_as_float(w.x & 0xffff0000u), __uint_as_float(w.y << 16), __uint_as_float(w.y & 0xffff0000u)}; }
                else { const float* fp = FS + (size_t)(r - NPR) * DM + 4 * lane + 256 * j; f32x4 part[NSPLIT > 0 ? NSPLIT : 1];
#pragma unroll
                    for (int sp = 0; sp < NSPLIT; ++sp) part[sp] = *(const f32x4*)(fp + (size_t)sp * 512 * 1024);
                    f32x4 sacc = part[0];
#pragma unroll
                    for (int sp = 1; sp < NSPLIT; ++sp) sacc = sacc + part[sp];
                    f[j] = sacc; }
                ss += (f[j][0] * f[j][0] + f[j][1] * f[j][1]) + (f[j][2] * f[j][2] + f[j][3] * f[j][3]); }
            const float rstd = rsqrtf(wave_sum(ss, lane) * (1.f / DM) + EPS);
#pragma unroll
            for (int j = 0; j < 4; ++j) { const f32x4 gt = *(const f32x4*)(gate + (size_t)bm * 6144 + 4 * lane + 256 * j), wp = *(const f32x4*)(wpost + 4 * lane + 256 * j);
                x[j] = x[j] + gt * (f[j] * rstd * wp); }
        }
        if (xdst) {
#pragma unroll
            for (int j = 0; j < 4; ++j) *(f32x4*)(xdst + (size_t)r * DM + 4 * lane + 256 * j) = x[j];
        }
        if (xdst_b) {
#pragma unroll
            for (int j = 0; j < 4; ++j) { u32x2 w; w.x = cvt_pk_bf16(x[j][0], x[j][1]); w.y = cvt_pk_bf16(x[j][2], x[j][3]); *(u32x2*)(xdst_b + (size_t)r * DM + 4 * lane + 256 * j) = w;
                x[j] = (f32x4){__uint_as_float(w.x << 16), __uint_as_float(w.x & 0xffff0000u), __uint_as_float(w.y << 16), __uint_as_float(w.y & 0xffff0000u)}; }
        }
        if (wpre) {
            float ss = 0.f;
#pragma unroll
            for (int j = 0; j < 4; ++j) ss += (x[j][0] * x[j][0] + x[j][1] * x[j][1]) + (x[j][2] * x[j][2] + x[j][3] * x[j][3]);
            const float rstd = rsqrtf(wave_sum(ss, lane) * (1.f / DM) + EPS);
            f32x4 hm[4];
#pragma unroll
            for (int j = 0; j < 4; ++j) { const int cidx = 4 * lane + 256 * j;
                const f32x4 wv = *(const f32x4*)(wpre + cidx), s1 = *(const f32x4*)(sc + (size_t)bm * 6144 + cidx), s0 = *(const f32x4*)(sh + (size_t)bm * 6144 + cidx);
                hm[j] = (x[j] * rstd * wv) * (1.f + s1) + s0;
                u32x2 w; w.x = cvt_pk_bf16(hm[j][0], hm[j][1]); w.y = cvt_pk_bf16(hm[j][2], hm[j][3]);
                *(u32x2*)(HMb + (size_t)r * DM + cidx) = w; }
            if (WGl) {
                float mine = 0.f;
#pragma unroll
                for (int h = 0; h < 8; ++h) { float d = 0.f;
#pragma unroll
                    for (int j = 0; j < 4; ++j) { const f32x4 wv = wg[h][j]; d += (hm[j][0] * wv[0] + hm[j][1] * wv[1]) + (hm[j][2] * wv[2] + hm[j][3] * wv[3]); }
                    d = wave_sum(d, lane); if (lane == h) mine = d; }
                if (lane < 8) { const float lf = logsig(mine + bfor[lane]);
                    if (prompt) out[O_LP + ((size_t)((lnext * 4 + (r >> 12)) * 8 + lane)) * 4096 + (r & 4095)] = lf;
                    else { const int rr = r - NPR; out[O_LS + ((size_t)((lnext * 8 + (rr >> 6)) * 8 + lane)) * 64 + (rr & 63)] = lf; } }
            }
        }
    }
}

__device__ __forceinline__ void vt_finalize(const Args& a, int l, int lane, int gwi, int nw) {
    const float* PV = (const float*)(a.ws + WS_F1); bf16_t* VTP = (bf16_t*)(a.ws + WS_VTP); bf16_t* VTS = (bf16_t*)(a.ws + WS_VTS);
    for (int it = gwi; it < 16 * 128; it += nw) {
        const int tile = it >> 7, rem = it & 127, hb = rem >> 5, to = rem & 31, hdl = hb * 64 + lane, pm = tile >> 3, pn = 58 + (tile & 7);
        const int hd = pm * 256 + hdl, h = hd >> 6, d = hd & 63, tok = pn * 256 + to * 8;
        f32x4 v0 = {0.f, 0.f, 0.f, 0.f}, v1 = {0.f, 0.f, 0.f, 0.f};
#pragma unroll
        for (int ks = 0; ks < 4; ++ks) { const float* p = PV + ((size_t)(tile * 4 + ks) * 256 + hdl) * 256 + to * 8; v0 = v0 + *(const f32x4*)p; v1 = v1 + *(const f32x4*)(p + 4); }
        const u32x4 w = pack8(v0, v1);
        if (pn < 64) { const int b = tok >> 12, t = tok & 4095;
            *(u32x4*)(VTP + ((size_t)(b * 8 + h) * 64 + d) * 4096 + t) = w;
            float* o = a.out + O_VP + ((size_t)((l * 4 + b) * 8 + h) * 4096 + t) * 64 + d;
#pragma unroll
            for (int j = 0; j < 4; ++j) { o[(size_t)j * 64] = v0[j]; o[(size_t)(j + 4) * 64] = v1[j]; } }
        else { const int tt = tok - NPR, b = tt >> 6, t = tt & 63;
            *(u32x4*)(VTS + ((size_t)(b * 8 + h) * 64 + d) * KVS + PAST + t) = w;
            float* o = a.out + O_VS + ((size_t)((l * 8 + b) * 8 + h) * 64 + t) * 64 + d;
#pragma unroll
            for (int j = 0; j < 4; ++j) { o[(size_t)j * 64] = v0[j]; o[(size_t)(j + 4) * 64] = v1[j]; } }
    }
}
__device__ __forceinline__ void cumsum_items(const Args& a, int l, LAS unsigned char* lds, int tid, int wave, int lane, int c, int G) {
    LAS float* wt = (LAS float*)(lds);
    for (int it = c - 64; it >= 0 && it < 96; it += G) {
        const bool prompt = it < 32;
        float v[8]; float run = 0.f; int i0, cnt;
        if (prompt) { i0 = tid * 8; cnt = 8;
            const float* src = a.out + O_LP + (size_t)(l * 32 + it) * 4096 + i0;
            const f32x4 p0 = *(const f32x4*)src, p1 = *(const f32x4*)(src + 4);
            v[0] = p0[0]; v[1] = p0[1]; v[2] = p0[2]; v[3] = p0[3]; v[4] = p1[0]; v[5] = p1[1]; v[6] = p1[2]; v[7] = p1[3]; }
        else { const int sq = it - 32; i0 = tid * 4; cnt = tid < 272 ? 4 : 0;
            const float* src = tid < 256 ? INP(6) + (size_t)(l * 64 + sq) * PAST + i0 : a.out + O_LS + (size_t)(l * 64 + sq) * 64 + (tid < 272 ? i0 - PAST : 0);
            const f32x4 p0 = *(const f32x4*)src;
            v[0] = p0[0]; v[1] = p0[1]; v[2] = p0[2]; v[3] = p0[3]; v[4] = 0.f; v[5] = 0.f; v[6] = 0.f; v[7] = 0.f;
            if (tid >= 272) { v[0] = 0.f; v[1] = 0.f; v[2] = 0.f; v[3] = 0.f; } }
#pragma unroll
        for (int j = 0; j < 8; ++j) { run += v[j]; v[j] = run; }
        float incl = run;
#pragma unroll
        for (int o = 1; o < 64; o <<= 1) { const float t = bperm(incl, lane >= o ? lane - o : lane); if (lane >= o) incl += t; }
        if (lane == 63) wt[wave] = incl;
        __syncthreads();
        float off = incl - run;
        for (int w = 0; w < wave; ++w) off += wt[w];
        float* dst = (prompt ? (float*)(a.ws + WS_BIASP) + (size_t)it * 4096 : (float*)(a.ws + WS_BIASS) + (size_t)(it - 32) * KVS) + i0;
        if (cnt == 8) { *(f32x4*)dst = (f32x4){-(off + v[0]) * LOG2E, -(off + v[1]) * LOG2E, -(off + v[2]) * LOG2E, -(off + v[3]) * LOG2E};
                        *(f32x4*)(dst + 4) = (f32x4){-(off + v[4]) * LOG2E, -(off + v[5]) * LOG2E, -(off + v[6]) * LOG2E, -(off + v[7]) * LOG2E}; }
        else if (cnt == 4) *(f32x4*)dst = (f32x4){-(off + v[0]) * LOG2E, -(off + v[1]) * LOG2E, -(off + v[2]) * LOG2E, -(off + v[3]) * LOG2E};
        __syncthreads();
    }
}

__device__ __forceinline__ void ssm_scan(const Args& a, int l, LAS unsigned char* lds, int wave, int lane, int c, int G) {
    const float* E = (const float*)(a.ws + WS_E); bf16_t* UA = (bf16_t*)(a.ws + WS_UA); const float* A16 = (const float*)(a.ws + WS_A16);
    LAS float* endst = (LAS float*)(lds);
    for (int it = c; it < 128; it += G) {
        const int b = it >> 5, gq = it & 31, p = lane;
        const float ar = A16[(l * 32 + gq) * 128 + p], ai = A16[(l * 32 + gq) * 128 + 64 + p];
        float er[32], ei[32];
        const int ch0 = b * 256 + wave * 32;
#pragma unroll
        for (int i = 0; i < 32; ++i) { const float* e = E + ((size_t)gq * CHP + ch0 + i) * 128; er[i] = e[p]; ei[i] = e[64 + p]; }
        float hr = 0.f, hi = 0.f;
#pragma unroll
        for (int i = 0; i < 32; ++i) { const float nr = ar * hr - ai * hi + er[i], ni = ar * hi + ai * hr + ei[i]; hr = nr; hi = ni; }
        endst[(wave * 2) * 64 + p] = hr; endst[(wave * 2 + 1) * 64 + p] = hi;
        float pr = ar, pi = ai;
#pragma unroll
        for (int s = 0; s < 5; ++s) { const float nr = pr * pr - pi * pi, ni = 2.f * pr * pi; pr = nr; pi = ni; }
        __syncthreads();
        hr = 0.f; hi = 0.f;
        for (int w = 0; w < wave; ++w) { const float xr = endst[(w * 2) * 64 + p], xi = endst[(w * 2 + 1) * 64 + p];
            const float nr = pr * hr - pi * hi + xr, ni = pr * hi + pi * hr + xi; hr = nr; hi = ni; }
#pragma unroll
        for (int i = 0; i < 32; ++i) { bf16_t* u = UA + ((size_t)gq * CHP + ch0 + i) * UAK + 256; u[p] = f2bf(hr); u[64 + p] = f2bf(hi);
            const float nr = ar * hr - ai * hi + er[i], ni = ar * hi + ai * hr + ei[i]; hr = nr; hi = ni; }
        if (wave == 7) { a.out[O_RP + (size_t)((l * 4 + b) * 32 + gq) * 64 + p] = hr; a.out[O_IP + (size_t)((l * 4 + b) * 32 + gq) * 64 + p] = hi; }
        __syncthreads();
    }
    for (int it = (G - 1 - c) * 8 + wave; it < 256; it += G * 8) {
        const int b = it >> 5, gq = it & 31, p = lane;
        const float ar = A16[(l * 32 + gq) * 128 + p], ai = A16[(l * 32 + gq) * 128 + 64 + p];
        float hr = INP(7)[(size_t)((l * 8 + b) * 32 + gq) * 64 + p], hi = INP(8)[(size_t)((l * 8 + b) * 32 + gq) * 64 + p];
        const int ch0 = 1024 + b * 4;
#pragma unroll
        for (int i = 0; i < 4; ++i) { const float* e = E + ((size_t)gq * CHP + ch0 + i) * 128; const float xr = e[p], xi = e[64 + p];
            bf16_t* u = UA + ((size_t)gq * CHP + ch0 + i) * UAK + 256; u[p] = f2bf(hr); u[64 + p] = f2bf(hi);
            const float nr = ar * hr - ai * hi + xr, ni = ar * hi + ai * hr + xi; hr = nr; hi = ni; }
        a.out[O_RS + (size_t)((l * 8 + b) * 32 + gq) * 64 + p] = hr; a.out[O_IS + (size_t)((l * 8 + b) * 32 + gq) * 64 + p] = hi;
    }
}

#define DPPMAX(v, ctrl) v = fmaxf(v, __int_as_float(__builtin_amdgcn_update_dpp(0, __float_as_int(v), ctrl, 0xF, 0xF, true)))
__device__ __forceinline__ float wave_max_nonneg(float v) {
    DPPMAX(v, 0xB1); DPPMAX(v, 0x4E); DPPMAX(v, 0x141); DPPMAX(v, 0x140);
    const float r0 = __int_as_float(__builtin_amdgcn_readlane(__float_as_int(v), 0)), r1 = __int_as_float(__builtin_amdgcn_readlane(__float_as_int(v), 16));
    const float r2 = __int_as_float(__builtin_amdgcn_readlane(__float_as_int(v), 32)), r3 = __int_as_float(__builtin_amdgcn_readlane(__float_as_int(v), 48));
    return fmaxf(fmaxf(r0, r1), fmaxf(r2, r3));
}
__device__ __forceinline__ void kmax_items(const Args& a, int lane, int gw, int NGW) {
    float* KM = (float*)(a.ws + WS_KMAX);
    for (int it = NGW - 1 - gw; it < 2048 + 1088; it += NGW) {
        const bf16_t* kp; int oidx;
        if (it < 2048) { const int bh = it >> 6, t = it & 63; kp = (const bf16_t*)(a.ws + WS_KP) + ((size_t)bh * 4096 + t * 64) * 64; oidx = it; }
        else { const int r = it - 2048, sq = r / 17, t = r - sq * 17; kp = (const bf16_t*)(a.ws + WS_KS) + ((size_t)sq * KVS + t * 64) * 64; oidx = (32 + sq) * 64 + t; }
        float ss = 0.f;
#pragma unroll
        for (int i = 0; i < 8; ++i) { const u32x4 w = *(const u32x4*)(kp + (size_t)lane * 64 + i * 8);
#pragma unroll
            for (int j = 0; j < 4; ++j) { const float lo = __uint_as_float(w[j] << 16), hi = __uint_as_float(w[j] & 0xffff0000u); ss += lo * lo + hi * hi; } }
        const float m = wave_max_nonneg(ss);
        if (lane == 0) KM[oidx] = sqrtf(m) * 1.001f;
    }
}
constexpr int AT_ROW = 144, AT_TILE = 64 * AT_ROW  , AT_KB = 0, AT_VB = 4 * AT_TILE, AT_BB = 8 * AT_TILE;
__device__ __forceinline__ void attn_tile(const LAS unsigned char* Kb, const LAS unsigned char* Vb, const LAS float* Bb, const bf16x8 (&qf)[4], f32x16& o0, f32x16& o1, float& lsum,
                                          float bq, int myq, int key0, bool domask, int ka_off, int va_off, int hi) {
    f32x16 s0, s1;
#pragma unroll
    for (int a2 = 0; a2 < 2; ++a2) { const f32x4 b0 = *(const LAS f32x4*)(Bb + a2 * 16 + hi * 8), b1 = *(const LAS f32x4*)(Bb + a2 * 16 + hi * 8 + 4);
        const f32x4 c0 = *(const LAS f32x4*)(Bb + 32 + a2 * 16 + hi * 8), c1 = *(const LAS f32x4*)(Bb + 32 + a2 * 16 + hi * 8 + 4);
#pragma unroll
        for (int j = 0; j < 4; ++j) { s0[a2 * 8 + j] = b0[j]; s0[a2 * 8 + 4 + j] = b1[j]; s1[a2 * 8 + j] = c0[j]; s1[a2 * 8 + 4 + j] = c1[j]; } }
#pragma unroll
    for (int ks = 0; ks < 4; ++ks) {
        const bf16x8 k0 = *(const LAS bf16x8*)(Kb + ka_off + ks * 32), k1 = *(const LAS bf16x8*)(Kb + 32 * AT_ROW + ka_off + ks * 32);
        s0 = __builtin_amdgcn_mfma_f32_32x32x16_bf16(k0, qf[ks], s0, 0, 0, 0);
        s1 = __builtin_amdgcn_mfma_f32_32x32x16_bf16(k1, qf[ks], s1, 0, 0, 0);
    }
    if (domask) {
#pragma unroll
        for (int r = 0; r < 16; ++r) { const int kj = key0 + 16 * (r >> 3) + 8 * hi + (r & 7);
            if (kj > myq) s0[r] = -INFINITY; if (kj + 32 > myq) s1[r] = -INFINITY; }
    }
    s0 = s0 - bq; s1 = s1 - bq;
#pragma unroll
    for (int r = 0; r < 16; ++r) { s0[r] = __builtin_amdgcn_exp2f(s0[r]); s1[r] = __builtin_amdgcn_exp2f(s1[r]); }
    { const f32x16 e = s0 + s1;
      const f32x8 e8 = __builtin_shufflevector(e, e, 0, 1, 2, 3, 4, 5, 6, 7) + __builtin_shufflevector(e, e, 8, 9, 10, 11, 12, 13, 14, 15);
      const f32x4 e4 = __builtin_shufflevector(e8, e8, 0, 1, 2, 3) + __builtin_shufflevector(e8, e8, 4, 5, 6, 7);
      lsum += (e4[0] + e4[1]) + (e4[2] + e4[3]); }
    bf16x8 pa[4];
#pragma unroll
    for (int a2 = 0; a2 < 2; ++a2) {
        u32x4 w0, w1;
        w0.x = cvt_pk_bf16(s0[a2 * 8 + 0], s0[a2 * 8 + 1]); w0.y = cvt_pk_bf16(s0[a2 * 8 + 2], s0[a2 * 8 + 3]); w0.z = cvt_pk_bf16(s0[a2 * 8 + 4], s0[a2 * 8 + 5]); w0.w = cvt_pk_bf16(s0[a2 * 8 + 6], s0[a2 * 8 + 7]);
        w1.x = cvt_pk_bf16(s1[a2 * 8 + 0], s1[a2 * 8 + 1]); w1.y = cvt_pk_bf16(s1[a2 * 8 + 2], s1[a2 * 8 + 3]); w1.z = cvt_pk_bf16(s1[a2 * 8 + 4], s1[a2 * 8 + 5]); w1.w = cvt_pk_bf16(s1[a2 * 8 + 6], s1[a2 * 8 + 7]);
        pa[a2] = __builtin_bit_cast(bf16x8, w0); pa[2 + a2] = __builtin_bit_cast(bf16x8, w1);
    }
#pragma unroll
    for (int kk = 0; kk < 4; ++kk) {
        const bf16x8 v0 = *(const LAS bf16x8*)(Vb + va_off + kk * 32), v1 = *(const LAS bf16x8*)(Vb + 32 * AT_ROW + va_off + kk * 32);
        o0 = __builtin_amdgcn_mfma_f32_32x32x16_bf16(v0, pa[kk], o0, 0, 0, 0);
        o1 = __builtin_amdgcn_mfma_f32_32x32x16_bf16(v1, pa[kk], o1, 0, 0, 0);
    }
}
__device__ __forceinline__ void attn_unit(LAS unsigned char* lds, const bf16_t* Qrow0, int h, int nrows, int qpos0, int NT,
                                          const bf16_t* Kp, const bf16_t* VTp, int vpitch, const float* biasp, const float* kmaxp, bf16_t* Orow0, int tid, int wave, int lane) {
    const int q = lane & 31, hi = lane >> 5;
    const bool active = wave * 32 < nrows;
    bf16x8 qf[4];
#pragma unroll
    for (int ks = 0; ks < 4; ++ks) qf[ks] = active ? *(const bf16x8*)(Qrow0 + (size_t)(wave * 32 + q) * 512 + h * 64 + ks * 16 + hi * 8) : (bf16x8){0, 0, 0, 0, 0, 0, 0, 0};
    f32x16 o0 = {}, o1 = {};
    float lsum = 0.f;
    const int myq = qpos0 + wave * 32 + q;
    const int wq_lo = qpos0 + wave * 32, wq_hi = wq_lo + 31;
    const float bq = active ? biasp[myq] : 0.f;
    const int NS = (NT + 1) >> 1;
    int s_first;
    { float ssq = 0.f;
#pragma unroll
      for (int ks = 0; ks < 4; ++ks)
#pragma unroll
          for (int e = 0; e < 8; ++e) { const float v = __uint_as_float(((unsigned)(unsigned short)qf[ks][e]) << 16); ssq += v * v; }
      ssq += bperm(ssq, lane ^ 32);
      const float wm = wave_max_nonneg(ssq);
      volatile LAS float* qm = (volatile LAS float*)(lds + 131072 + 512);
      volatile LAS int* tst = (volatile LAS int*)(lds + 131072 + 576);
      if (lane == 0) qm[wave] = wm;
      __syncthreads();
      if (wave == 0) {
          float m2 = 0.f;
#pragma unroll
          for (int w = 0; w < 8; ++w) m2 = fmaxf(m2, qm[w]);
          const float QN = sqrtf(m2) * 1.001f;
          bool fail = true;
          if (lane < NT) fail = !(QN * kmaxp[lane] + biasp[64 * lane + 63] - biasp[qpos0] < -160.f);
          const unsigned long long mask = __builtin_amdgcn_ballot_w64(fail);
          const int tfirst = mask ? (int)__builtin_ctzll(mask) : 0;
          if (lane == 0) tst[0] = tfirst >> 1;
      }
      __syncthreads();
      s_first = tst[0]; }
    const int krow = tid >> 3, kch = tid & 7;
    const bf16_t* kg = Kp + (size_t)tid * 8;
    const bf16_t* vg = VTp + (size_t)krow * vpitch + kch * 8;
    const int st_off = krow * AT_ROW + kch * 16;
    const int kap = (q & 19) | ((q & 4) << 1) | ((q & 8) >> 1);
    const int ka_off = kap * AT_ROW + hi * 16, va_off = q * AT_ROW + hi * 16;
    u32x4 kr0, kr1, vr0, vr1; f32x4 br = {0.f, 0.f, 0.f, 0.f};
    { const int tb = 2 * s_first; kr0 = *(const u32x4*)(kg + (size_t)tb * 4096); kr1 = *(const u32x4*)(kg + (size_t)(tb + 1) * 4096); vr0 = *(const u32x4*)(vg + tb * 64); vr1 = *(const u32x4*)(vg + (tb + 1) * 64); if (tid < 32) br = *(const f32x4*)(biasp + tb * 64 + tid * 4); }
    *(LAS u32x4*)(lds + AT_KB + st_off) = kr0; *(LAS u32x4*)(lds + AT_KB + AT_TILE + st_off) = kr1;
    *(LAS u32x4*)(lds + AT_VB + st_off) = vr0; *(LAS u32x4*)(lds + AT_VB + AT_TILE + st_off) = vr1; if (tid < 32) *(LAS f32x4*)(lds + AT_BB + tid * 16) = br;
    __syncthreads();
    for (int sidx = s_first; sidx < NS; ++sidx) {
        const int buf = (sidx - s_first) & 1, t0 = 2 * sidx;
        const bool more = sidx + 1 < NS;
        if (more) { kr0 = *(const u32x4*)(kg + (size_t)(t0 + 2) * 4096); kr1 = *(const u32x4*)(kg + (size_t)(t0 + 3) * 4096); vr0 = *(const u32x4*)(vg + (t0 + 2) * 64); vr1 = *(const u32x4*)(vg + (t0 + 3) * 64);
            if (tid < 32) br = *(const f32x4*)(biasp + (t0 + 2) * 64 + tid * 4); }
        if (active) {
            const LAS unsigned char* Kb = lds + AT_KB + buf * 2 * AT_TILE;
            const LAS unsigned char* Vb = lds + AT_VB + buf * 2 * AT_TILE;
            const LAS float* Bb = (const LAS float*)(lds + AT_BB + buf * 512);
            if (t0 * 64 <= wq_hi) attn_tile(Kb, Vb, Bb, qf, o0, o1, lsum, bq, myq, t0 * 64, t0 * 64 + 63 > wq_lo, ka_off, va_off, hi);
            if ((t0 + 1) * 64 <= wq_hi) attn_tile(Kb + AT_TILE, Vb + AT_TILE, Bb + 64, qf, o0, o1, lsum, bq, myq, (t0 + 1) * 64, (t0 + 1) * 64 + 63 > wq_lo, ka_off, va_off, hi);
        }
        if (more) { const int nb = buf ^ 1;
            *(LAS u32x4*)(lds + AT_KB + nb * 2 * AT_TILE + st_off) = kr0; *(LAS u32x4*)(lds + AT_KB + nb * 2 * AT_TILE + AT_TILE + st_off) = kr1;
            *(LAS u32x4*)(lds + AT_VB + nb * 2 * AT_TILE + st_off) = vr0; *(LAS u32x4*)(lds + AT_VB + nb * 2 * AT_TILE + AT_TILE + st_off) = vr1;
            if (tid < 32) *(LAS f32x4*)(lds + AT_BB + nb * 512 + tid * 16) = br; }
        __syncthreads();
    }
    if (active) {
        lsum += bperm(lsum, lane ^ 32);
        const float inv = 1.f / lsum;
        bf16_t* orow = Orow0 + (size_t)(wave * 32 + q) * 1024 + h * 64;
#pragma unroll
        for (int i = 0; i < 4; ++i) { u32x2 w0, w1;
            w0.x = cvt_pk_bf16(o0[4 * i] * inv, o0[4 * i + 1] * inv); w0.y = cvt_pk_bf16(o0[4 * i + 2] * inv, o0[4 * i + 3] * inv);
            w1.x = cvt_pk_bf16(o1[4 * i] * inv, o1[4 * i + 1] * inv); w1.y = cvt_pk_bf16(o1[4 * i + 2] * inv, o1[4 * i + 3] * inv);
            *(u32x2*)(orow + 8 * i + 4 * hi) = w0; *(u32x2*)(orow + 32 + 8 * i + 4 * hi) = w1; }
    }
}
__device__ __forceinline__ void attn_phase(const Args& a, int l, LAS unsigned char* lds, int tid, int wave, int lane) {
    const bf16_t* Q = (const bf16_t*)(a.ws + WS_Q); bf16_t* MIX = (bf16_t*)(a.ws + WS_MIX);
    unsigned* ctr = (unsigned*)(a.ws + WS_CTL) + 3600 + 64 * l;
    volatile LAS unsigned* slot = (volatile LAS unsigned*)(lds + 131072 + 256);
    for (;;) {
        if (tid == 0) slot[0] = __hip_atomic_fetch_add(ctr, 1u, __ATOMIC_RELAXED, __HIP_MEMORY_SCOPE_AGENT);
        __syncthreads();
        const int idx = (int)slot[0];
        __syncthreads();
        if (idx >= 576) break;
        if (idx < 512) { const int qb = 15 - (idx >> 5), bh = idx & 31, b = bh >> 3, h = bh & 7; const size_t row0 = (size_t)b * 4096 + qb * 256;
            attn_unit(lds, Q + row0 * 512, h, 256, qb * 256, 4 * qb + 4, (const bf16_t*)(a.ws + WS_KP) + (size_t)bh * 4096 * 64, (const bf16_t*)(a.ws + WS_VTP) + (size_t)bh * 64 * 4096, 4096,
                      (const float*)(a.ws + WS_BIASP) + (size_t)bh * 4096, (const float*)(a.ws + WS_KMAX) + bh * 64, MIX + row0 * 1024, tid, wave, lane); }
        else { const int sidx = idx - 512, b = sidx >> 3, h = sidx & 7;
            attn_unit(lds, Q + (size_t)(NPR + b * 64) * 512, h, 64, PAST, 17, (const bf16_t*)(a.ws + WS_KS) + (size_t)sidx * KVS * 64, (const bf16_t*)(a.ws + WS_VTS) + (size_t)sidx * 64 * KVS, KVS,
                      (const float*)(a.ws + WS_BIASS) + (size_t)sidx * KVS, (const float*)(a.ws + WS_KMAX) + (32 + sidx) * 64, MIX + (size_t)(NPR + b * 64) * 1024, tid, wave, lane); }
    }
}

#define XB_TMO      128
#define XB_XCNT(j)  (256  + 64 * (j))
#define XB_XSUB(j)  (1280 + 64 * (j))
#define XB_XGEN(j)  (2304 + 64 * (j))
#define XB_TOP      3328
#define XB_TOPGEN   3392
#define XCD_BAR_WORDS 3456
#define XB_SPIN_CAP (1u << 18)
__device__ __forceinline__ unsigned xb_ld(unsigned* p)              { return __hip_atomic_load(p, __ATOMIC_RELAXED, __HIP_MEMORY_SCOPE_AGENT); }
__device__ __forceinline__ unsigned xb_add(unsigned* p, unsigned v) { return __hip_atomic_fetch_add(p, v, __ATOMIC_RELAXED, __HIP_MEMORY_SCOPE_AGENT); }
__device__ __forceinline__ unsigned xb_xcc_id() { return (unsigned)__builtin_amdgcn_s_getreg((3 << 11) | 20) & 0xFu; }
#define XB_SPIN(cond, bar) do { unsigned _sp = 0; while (cond) { __builtin_amdgcn_s_sleep(1); \
    if ((++_sp & 255u) == 0u) { if (xb_ld(&(bar)[XB_TMO])) break; if (_sp > XB_SPIN_CAP) { atomicAdd(&(bar)[XB_TMO], 1u); break; } } } } while (0)
__device__ __forceinline__ void xcd_barrier_complete(unsigned* bar, unsigned x, unsigned G, unsigned& nloc, unsigned& nx) {
    unsigned sum, cnt, mine, sp = 0u;
    for (;;) {
        sum = 0u; cnt = 0u; mine = 0u;
#pragma unroll
        for (unsigned j = 0; j < 16; ++j) { const unsigned c = xb_ld(&bar[XB_XCNT(j)]); sum += c; cnt += (c > 0u) ? 1u : 0u; mine = (j == x) ? c : mine; }
        if (sum == G) break;
        __builtin_amdgcn_s_sleep(1);
        if ((++sp & 255u) == 0u) { if (xb_ld(&bar[XB_TMO])) break; if (sp > XB_SPIN_CAP) { atomicAdd(&bar[XB_TMO], 1u); break; } }
    }
    nloc = mine > 0u ? mine : 1u; nx = cnt > 0u ? cnt : 1u;
}
__device__ __forceinline__ void xcd_barrier(unsigned* bar, volatile LAS unsigned* st, bool leader, unsigned G) {
    asm volatile("s_waitcnt vmcnt(0)" ::: "memory");
    __syncthreads();
    if (leader) {
        const unsigned x = xb_xcc_id();
        __builtin_amdgcn_s_waitcnt(0);
        unsigned nloc = st[0], nx = st[1];
        if (nloc == 0u) { xcd_barrier_complete(bar, x, G, nloc, nx); st[0] = nloc; st[1] = nx; }
        const unsigned old = xb_add(&bar[XB_XSUB(x)], 1u);
        const unsigned gen = old / nloc;
        if (old + 1u == (gen + 1u) * nloc) {
            __builtin_amdgcn_fence(__ATOMIC_RELEASE, "agent");
            asm volatile("s_waitcnt vmcnt(0)" ::: "memory");
            const unsigned og = xb_add(&bar[XB_TOP], 1u);
            const unsigned tg = og / nx;
            if (og + 1u == (tg + 1u) * nx) xb_add(&bar[XB_TOPGEN], 1u);
            else XB_SPIN(xb_ld(&bar[XB_TOPGEN]) == tg, bar);
            __builtin_amdgcn_fence(__ATOMIC_ACQUIRE, "agent");
            xb_add(&bar[XB_XGEN(x)], 1u);
            asm volatile("s_waitcnt vmcnt(0)" ::: "memory");
        } else {
            XB_SPIN(xb_ld(&bar[XB_XGEN(x)]) == gen, bar);
            __builtin_amdgcn_fence(__ATOMIC_ACQUIRE, "agent");
            asm volatile("s_waitcnt vmcnt(0)" ::: "memory");
        }
    }
    __syncthreads();
}

constexpr int NS5 = 160, CW_SUB = 3520;
__device__ __forceinline__ void sub_barrier(unsigned* ctr, unsigned target, bool leader) {
    asm volatile("s_waitcnt vmcnt(0)" ::: "memory");
    __syncthreads();
    if (leader) {
        __builtin_amdgcn_fence(__ATOMIC_RELEASE, "agent");
        asm volatile("s_waitcnt vmcnt(0)" ::: "memory");
        (void)xb_add(ctr, 1u);
        unsigned sp = 0u;
        while (xb_ld(ctr) < target) { __builtin_amdgcn_s_sleep(1); if (++sp > (1u << 22)) break; }
        __builtin_amdgcn_fence(__ATOMIC_ACQUIRE, "agent");
        asm volatile("s_waitcnt vmcnt(0)" ::: "memory");
    }
    __syncthreads();
}
#undef INP
#define INP(i) (al.in[i])
typedef const __attribute__((address_space(4))) unsigned char* kptr_t;
__device__ __forceinline__ kptr_t opq_k(kptr_t p) { asm volatile("" : "+s"(p)); return p; }
__device__ __forceinline__ Args load_args(kptr_t kp) {
    typedef const __attribute__((address_space(4))) unsigned long long* q_t; q_t q = (q_t)kp; Args r;
#pragma unroll
    for (int i = 0; i < 30; ++i) r.in[i] = (const float*)q[i];
    r.out = (float*)q[30]; r.ws = (unsigned char*)q[31]; return r;
}
#define FRESH() const Args al = load_args(opq_k((kptr_t)__builtin_amdgcn_kernarg_segment_ptr())); unsigned char* ws = al.ws; \
    const int G = __builtin_amdgcn_readfirstlane(opq((int)gridDim.x)); const int NGW = G * 8; (void)NGW; \
    const int wave = __builtin_amdgcn_readfirstlane(opq(wave0)); const int c = __builtin_amdgcn_readfirstlane(opq((int)blockIdx.x)); const int gw = c * 8 + wave; \
    float* MOD = (float*)(ws + WS_MOD); float* X = (float*)(ws + WS_X); bf16_t* HM = (bf16_t*)(ws + WS_HM); bf16_t* F1 = (bf16_t*)(ws + WS_F1); bf16_t* MIX = (bf16_t*)(ws + WS_MIX); \
    (void)MOD; (void)X; (void)HM; (void)F1; (void)MIX; (void)gw;
#define LAYER_BODY(l) { \
        { FRESH(); PH(5) cumsum_items(al, l, lds, tid, wave, lane, c, G); } \
        PH(6) { FRESH(); pg8::Gemm g{HM, (const bf16_t*)(ws + WS_WIN) + (size_t)l * 1536 * 1024, MT, 1536, 1024, 1024, 1024, 1 << 20, 0, 512u, (const bf16_t*)(ws + WS_WV) + (size_t)l * 512 * 1024, HM}; \
          pg8::PhaseAOrder S; S.init(G, c); \
          EpiA E{EpiIn{(bf16_t*)(ws + WS_Q), (bf16_t*)(ws + WS_KP), (bf16_t*)(ws + WS_KS), (bf16_t*)(ws + WS_UA), al.out, l}, EpiVT{(bf16_t*)(ws + WS_VTP), (bf16_t*)(ws + WS_VTS), al.out, l, lds}, EpiVtPart{(float*)(ws + WS_F1)}}; \
          pg8::gemm_phase(lds, g, S, E, wave); } \
        GSYNC(); \
        { FRESH(); kmax_items(al, lane, gw, NGW); vt_finalize(al, l, lane, gw, NGW); } \
        GSYNC(); \
        if (INS5) { \
        PH(8) { FRESH(); pg8::Gemm g{(const bf16_t*)(ws + WS_UA), (const bf16_t*)(ws + WS_BT1) + (size_t)l * 32 * 128 * 256, NG * CHP, 256, 256, UAK, 256, 5, (size_t)128 * 256, 0u}; \
          pg8::StaticOrder S; S.init(NG * CHP, 256, NS5, c); \
          EpiE E{(float*)(ws + WS_E)}; \
          pg8::gemm_phase(lds, g, S, E, wave); } \
        SUBBAR((l) * 3 + 1); \
        { FRESH(); PH(9) ssm_scan(al, l, lds, wave, lane, c, NS5); } \
        SUBBAR((l) * 3 + 2); \
        PH(10) { FRESH(); pg8::Gemm g{(const bf16_t*)(ws + WS_UA), (const bf16_t*)(ws + WS_BT3) + (size_t)l * 32 * 256 * UAK, NG * CHP, 256, UAK, UAK, UAK, 5, (size_t)256 * UAK, 0u}; \
          pg8::StaticOrder S; S.init(NG * CHP, 256, NS5, c); \
          EpiZ E{(bf16_t*)(ws + WS_Z)}; \
          pg8::gemm_phase(lds, g, S, E, wave); } \
        SUBBAR((l) * 3 + 3); \
        PH(11) { FRESH(); pg8::Gemm g{(const bf16_t*)(ws + WS_Z), (const bf16_t*)(ws + WS_WGLU) + (size_t)l * 512 * 512, MT, 512, 512, 512, 512, 1 << 20, 0, 0u}; \
          pg8::StaticOrder S; S.init(MT, 512, NS5, c); \
          EpiGlu E{(const bf16_t*)(ws + WS_Z), MIX}; \
          pg8::gemm_phase(lds, g, S, E, wave); } \
        __syncthreads(); \
        } \
        { FRESH(); PH(12) attn_phase(al, l, lds, tid, wave, lane); } \
        GSYNC(); \
        PH(13) { FRESH(); pg8::Gemm g{MIX, (const bf16_t*)(ws + WS_WOUT) + (size_t)l * 1024 * 1024, MT, 1024, 1024, 1024, 1024, 1 << 20, 0, 256u}; \
          pg8::MainSplitOrder S; S.init(G, c, 8, 2); \
          EpiMS E{EpiPlain{F1, 1024}, EpiAtomic{(float*)(ws + WS_Q)}}; \
          pg8::gemm_phase(lds, g, S, E, wave); } \
        GSYNC(); \
        { FRESH(); const float* modl = MOD + (size_t)l * 12 * 6144; \
          PH(14) rowpass<8>(INP(0), INP(1), l == 0 ? (const bf16_t*)nullptr : (const bf16_t*)X, F1, (const float*)(ws + WS_Q), 8, modl + 2 * 1024, INP(12) + l * 1024, nullptr, (bf16_t*)X, \
                INP(13) + l * 1024, modl + 4 * 1024, modl + 3 * 1024, HM, nullptr, nullptr, al.out, 0, lane, gw, NGW); } \
        GSYNC(); \
        PH(15) { FRESH(); pg8::Gemm g{HM, (const bf16_t*)(ws + WS_WGU) + (size_t)l * 5632 * 1024, MT, 5632, 1024, 1024, 1024, 1 << 20, 0, 0u}; \
          pg8::StaticOrder S; S.init(MT, 5632, G, c); \
          EpiSwi E{(bf16_t*)(ws + WS_H)}; \
          pg8::gemm_phase(lds, g, S, E, wave); } \
        GSYNC(); \
        PH(16) { FRESH(); pg8::Gemm g{(const bf16_t*)(ws + WS_H), (const bf16_t*)(ws + WS_WD) + (size_t)l * 1024 * DFF, MT, 1024, DFF, DFF, DFF, 1 << 20, 0, 512u}; \
          pg8::MainSplitOrder S; S.init(G, c, 11, 4); \
          EpiMS E{EpiPlain{F1, 1024}, EpiAtomic{(float*)(ws + WS_FS2)}}; \
          pg8::gemm_phase(lds, g, S, E, wave); } \
        GSYNC(); \
        if (l + 1 < NL) { \
            { FRESH(); const float* modl = MOD + (size_t)l * 12 * 6144; const float* modn = MOD + (size_t)(l + 1) * 12 * 6144; \
              PH(17) rowpass<11>(INP(0), INP(1), (const bf16_t*)X, F1, (const float*)(ws + WS_FS2), 11, modl + 5 * 1024, INP(14) + l * 1024, nullptr, (bf16_t*)X, INP(11) + (l + 1) * 1024, modn + 1024, modn, HM, \
                    (const float*)(ws + WS_WG) + (size_t)(l + 1) * 8 * 1024, INP(16) + (l + 1) * 8, al.out, l + 1, lane, gw, NGW); \
              PH(1) cache_convert(al, l + 1, lds, wave, lane, gw, NGW); } \
            GSYNC(); \
        } else { \
            FRESH(); const float* modl = MOD + (size_t)l * 12 * 6144; \
            PH(18) rowpass<11>(INP(0), INP(1), (const bf16_t*)X, F1, (const float*)(ws + WS_FS2), 11, modl + 5 * 1024, INP(14) + l * 1024, al.out, nullptr, nullptr, nullptr, nullptr, nullptr, nullptr, nullptr, al.out, 0, lane, gw, NGW); \
        } \
    }
__global__ void __launch_bounds__(512, 2) mega(Args a) {
    extern __shared__ __attribute__((aligned(16))) unsigned char lds_raw[];
    LAS unsigned char* lds = (LAS unsigned char*)lds_raw;
    cg::grid_group grid = cg::this_grid();
    const int wave0 = __builtin_amdgcn_readfirstlane((int)threadIdx.x >> 6);
#define GSYNC() do { const Args alb = load_args(opq_k((kptr_t)__builtin_amdgcn_kernarg_segment_ptr())); \
        const int ln_ = (int)__builtin_amdgcn_mbcnt_hi(~0u, __builtin_amdgcn_mbcnt_lo(~0u, (unsigned)opq(0))); \
        xcd_barrier((unsigned*)(alb.ws + WS_CTL), (volatile LAS unsigned*)(lds + LDS_MISC), wave0 == 0 && ln_ == 0, (unsigned)gridDim.x); } while (0)
#define SUBBAR(seq) do { const Args alb = load_args(opq_k((kptr_t)__builtin_amdgcn_kernarg_segment_ptr())); \
        const int ln_ = (int)__builtin_amdgcn_mbcnt_hi(~0u, __builtin_amdgcn_mbcnt_lo(~0u, (unsigned)opq(0))); \
        xcd_barrier((unsigned*)(alb.ws + WS_CTL) + 4096, (volatile LAS unsigned*)(lds + LDS_MISC + 16), wave0 == 0 && ln_ == 0, (unsigned)NS5); } while (0)
#define INS5 (__builtin_amdgcn_readfirstlane(opq((int)blockIdx.x)) < NS5)
    if (threadIdx.x < 8) ((volatile LAS unsigned*)(lds + LDS_MISC))[threadIdx.x] = 0u;
    if (threadIdx.x == 0) (void)xb_add((unsigned*)(a.ws + WS_CTL) + XB_XCNT(xb_xcc_id()), 1u);
    if (threadIdx.x == 0 && blockIdx.x < NS5) (void)xb_add((unsigned*)(a.ws + WS_CTL) + 4096 + XB_XCNT(xb_xcc_id()), 1u);
    __syncthreads();
#define lane ((int)__builtin_amdgcn_mbcnt_hi(~0u, __builtin_amdgcn_mbcnt_lo(~0u, (unsigned)opq(0))))
#define tid (wave * 64 + lane)

    { FRESH();
      PH(0) p0_weights(al, lds, wave, lane, gw, NGW);
      PH(1) cache_convert(al, 0, lds, wave, lane, gw, NGW);
      __syncthreads();
      PH(2) p0_adaln(al, lds, tid, wave, lane, c, G);
      PH(3) p0_ssm(al, lds, tid, (c + 128) % G, G); }
    grid.sync();
    { FRESH();
      PH(4) rowpass<0>(INP(0), INP(1), nullptr, nullptr, nullptr, 0, nullptr, nullptr, nullptr, nullptr, INP(11), MOD + 1024, MOD, HM, (const float*)(ws + WS_WG), INP(16), al.out, 0, lane, gw, NGW); }
    GSYNC();

    LAYER_BODY(0)
    LAYER_BODY(1)
    LAYER_BODY(2)
    LAYER_BODY(3)
}
#undef tid
#undef lane

extern "C" void kernel_launch(void* const* d_in, const int* in_sizes, int n_in, void* d_out, int out_size, void* d_ws, size_t ws_size, hipStream_t stream) {
    static int grid = 0;
    if (grid == 0) {
        if (n_in != 30 || (size_t)out_size != O_END || ws_size < WS_END) { fprintf(stderr, "kernel_launch: unexpected sizes n_in %d out %d ws %zu\n", n_in, out_size, ws_size); grid = -1; return; }
        int dev = 0, cus = 0, per_cu = 0;
        hipGetDevice(&dev); hipDeviceGetAttribute(&cus, hipDeviceAttributeMultiprocessorCount, dev);
        hipFuncSetAttribute((const void*)mega, hipFuncAttributeMaxDynamicSharedMemorySize, LDS_BYTES);
        hipOccupancyMaxActiveBlocksPerMultiprocessor(&per_cu, (const void*)mega, 512, LDS_BYTES);
        if (per_cu < 1) { fprintf(stderr, "kernel_launch: occupancy query reports %d blocks per CU\n", per_cu); grid = -1; return; }
        if (cus != 256) { fprintf(stderr, "kernel_launch: this build's static unit orders need 256 CUs (found %d)\n", cus); grid = -1; return; }
        grid = cus;
    }
    if (grid < 0) return;
    if (hipMemsetAsync((char*)d_ws + WS_CTL, 0, CTL_BYTES, stream) != hipSuccess) { fprintf(stderr, "kernel_launch: memset failed\n"); return; }
    Args a{};
    for (int i = 0; i < 30; ++i) a.in[i] = (const float*)d_in[i];
    a.out = (float*)d_out; a.ws = (unsigned char*)d_ws;
    void* args[] = {&a};
    hipError_t e = hipLaunchCooperativeKernel((const void*)mega, dim3(grid), dim3(512), args, LDS_BYTES, stream);
    if (e != hipSuccess) fprintf(stderr, "cooperative launch failed: %s (grid %d)\n", hipGetErrorString(e), grid);
}
```

```cpp
#include <hip/hip_runtime.h>
#include <hip/hip_cooperative_groups.h>
#include <cstdio>
#include <cstdint>
namespace cg = cooperative_groups;

#define LAS __attribute__((address_space(3)))
typedef unsigned short bf16_t;
typedef short bf16x8 __attribute__((ext_vector_type(8)));
typedef float f32x4 __attribute__((ext_vector_type(4)));
typedef float f32x16 __attribute__((ext_vector_type(16)));
typedef float f32x8 __attribute__((ext_vector_type(8)));
typedef unsigned u32x4 __attribute__((ext_vector_type(4)));
typedef unsigned u32x2 __attribute__((ext_vector_type(2)));

constexpr int DM = 1024, NPR = 16384, NSM = 512, MT = 16896, NL = 4, NH = 8, HD = 64;
constexpr int SEQ = 4096, PAST = 1024, DSEQ = 64, KVS = 1088, DFF = 2816, DIN = 2056;
constexpr int NG = 32, NP = 64, MG = 16, LC = 16, NCH = MT / LC  , CHP = 1280  , UAK = 384;
constexpr float C2 = 0.125f * 1.4426950408889634f, LOG2E = 1.4426950408889634f, EPS = 1e-6f;
constexpr size_t O_YP = 0, O_KP = 17301504, O_VP = 50855936, O_LP = 84410368, O_RP = 84934656, O_IP = 84967424,
                 O_KS = 85000192, O_VS = 86048768, O_LS = 87097344, O_RS = 87113728, O_IS = 87179264, O_END = 87244800;
constexpr size_t MiB = 1u << 20;
constexpr size_t WS_CTL = 1536 * 1024, CTL_BYTES = 32768;
constexpr int LDS_MISC = 131072 + 64;
constexpr size_t WS_MOD = 0, WS_WG = 2 * MiB, WS_A16 = 2 * MiB + 256 * 1024, WS_BIASP = 3 * MiB, WS_BIASS = 3 * MiB + 512 * 1024, WS_KMAX = 2 * MiB + 384 * 1024;
constexpr size_t WS_WIN = 4 * MiB, WS_WV = 16 * MiB, WS_WGLU = 20 * MiB, WS_WOUT = 22 * MiB, WS_WGU = 30 * MiB, WS_WD = 74 * MiB;
constexpr size_t WS_BT3 = 96 * MiB, WS_BT1 = 120 * MiB, WS_HM = 130 * MiB, WS_X = 164 * MiB, WS_F1 = 230 * MiB, WS_MIX = 264 * MiB;
constexpr size_t WS_Q = 298 * MiB, WS_KP = 315 * MiB, WS_VTP = 331 * MiB, WS_KS = 347 * MiB, WS_VTS = 356 * MiB, WS_UA = 365 * MiB,
                 WS_E = 395 * MiB, WS_Z = 415 * MiB, WS_H = 298 * MiB, WS_FS1 = 435 * MiB, WS_FS2 = 443 * MiB, WS_END = 465 * MiB;
constexpr int LDS_BYTES = 151552;
#ifndef PH_MASK
#define PH_MASK 0xffffffffu
#endif
#define PH(k) if (PH_MASK & (1u << (k)))

__device__ __forceinline__ unsigned cvt_pk_bf16(float lo, float hi) { unsigned r; asm volatile("v_cvt_pk_bf16_f32 %0, %1, %2" : "=v"(r) : "v"(lo), "v"(hi)); return r; }
__device__ __forceinline__ bf16_t f2bf(float f) { return (bf16_t)(cvt_pk_bf16(f, 0.f) & 0xffffu); }
__device__ __forceinline__ float bf2f(unsigned short b) { return __uint_as_float(((unsigned)b) << 16); }
__device__ __forceinline__ int opq(int x) { asm volatile("" : "+v"(x)); return x; }
__device__ __forceinline__ float bperm(float v, int srclane) { return __int_as_float(__builtin_amdgcn_ds_bpermute(srclane << 2, __float_as_int(v))); }
__device__ __forceinline__ float dpp_f(float v, const int ctrl) { return v; }
#define DPPADD(v, ctrl) v += __int_as_float(__builtin_amdgcn_update_dpp(0, __float_as_int(v), ctrl, 0xF, 0xF, true))
__device__ __forceinline__ float wave_sum(float v, int ln) {
    (void)ln;
    DPPADD(v, 0xB1);
    DPPADD(v, 0x4E);
    DPPADD(v, 0x141);
    DPPADD(v, 0x140);
    const float r0 = __int_as_float(__builtin_amdgcn_readlane(__float_as_int(v), 0)), r1 = __int_as_float(__builtin_amdgcn_readlane(__float_as_int(v), 16));
    const float r2 = __int_as_float(__builtin_amdgcn_readlane(__float_as_int(v), 32)), r3 = __int_as_float(__builtin_amdgcn_readlane(__float_as_int(v), 48));
    return (r0 + r1) + (r2 + r3);
}
__device__ __forceinline__ float sigm(float x) { return __builtin_amdgcn_rcpf(1.f + __builtin_amdgcn_exp2f(-1.4426950408889634f * x)); }
__device__ __forceinline__ float silu_f(float x) { return x * sigm(x); }
__device__ __forceinline__ float gelu_f(float x) { const float u = 0.7978845608028654f * (x + 0.044715f * x * x * x); return x * sigm(2.f * u); }
__device__ __forceinline__ float logsig(float x) { return fminf(x, 0.f) - log1pf(__expf(-fabsf(x))); }

namespace pg8 {
constexpr int BM = 256, BK = 64, HALF = 128, HTB = HALF * BK * 2, STAGE_BYTES = 8 * HTB, NXCD = 8, WGM = 8;
__host__ __device__ __forceinline__ int lds_byte(int r, int c) { const int st = (r >> 4) * 2 + (c >> 5), rr = r & 15, cc = c & 31, ob = rr * 64 + cc * 2; return st * 1024 + (ob ^ (((ob >> 9) & 1) << 5)); }
__host__ __device__ __forceinline__ void stage_rc(int b, int& R, int& C) { const int st = b / 1024, sb = b % 1024, swz = sb ^ (((sb >> 9) & 1) << 5); R = (st >> 1) * 16 + swz / 64; C = (st & 1) * 32 + (swz % 64) / 2; }
__host__ __device__ __forceinline__ int perm32(int rho) { const int n = rho >> 4, i = rho & 15; return 8 * (i >> 2) + 4 * n + (i & 3); }
struct Unit { int pm, pn, ks, kind, nt; };
struct Gemm { const bf16_t* A; const bf16_t* Bt; int M, N, K, lda, ldb, gdiv; size_t gstrideB; unsigned kcb; const bf16_t* A1; const bf16_t* Bt1; };
struct StaticOrder {
    int nM, nN, nwg, G, c;
    __device__ __forceinline__ void init(int M, int N, int G_, int c_) { nM = M / BM; nN = N / BM; nwg = nM * nN; G = G_; c = c_; }
    __device__ __forceinline__ bool next(int i, Unit& u) const {
        const long L = (long)i * G + c; if (L >= nwg) return false;
        int wgid = (int)L; { const int q = nwg / NXCD, r = nwg % NXCD, xcd = wgid % NXCD, off = wgid / NXCD; wgid = (xcd < r ? xcd * (q + 1) : r * (q + 1) + (xcd - r) * q) + off; }
        const int nig = WGM * nN, gid = wgid / nig, fm = gid * WGM, gsz = (nM - fm) < WGM ? (nM - fm) : WGM;
        u.pm = fm + ((wgid % nig) % gsz); u.pn = (wgid % nig) / gsz; u.ks = 0; u.kind = 0; u.nt = 0; return true;
    }
};
struct SplitOrder {
    int nsub, G, c, S;
    __device__ __forceinline__ void init(int S_, int G_, int c_) { S = S_; nsub = 8 * S_; G = G_; c = c_; }
    __device__ __forceinline__ bool next(int i, Unit& u) const { const int idx = i * G + c; if (idx >= nsub) return false; u.ks = idx % S; const int t = idx / S; u.pn = t & 3; u.pm = 64 + (t >> 2); u.kind = 0; u.nt = 0; return true; }
};
struct VtOrder {
    int idx;
    __device__ __forceinline__ void init(int G_, int c_) { idx = c_ - (G_ - 116); }
    __device__ __forceinline__ bool next(int i, Unit& u) const { if (i != 0 || idx < 0 || idx >= 116) return false; u.pm = idx / 58; u.pn = idx - u.pm * 58; u.ks = 0; u.kind = 0; u.nt = 0; return true; }
};
struct VtSplitOrder {
    int c;
    __device__ __forceinline__ void init(int c_) { c = c_; }
    __device__ __forceinline__ bool next(int i, Unit& u) const { if (i != 0 || c >= 64) return false; const int tile = c >> 2; u.ks = c & 3; u.pm = tile >> 3; u.pn = 58 + (tile & 7); u.kind = 0; u.nt = 0; return true; }
};
struct PhaseAOrder {
    StaticOrder so; int c;
    __device__ __forceinline__ void init(int G_, int c_) { so.init(MT, 1536, G_, c_); c = c_; }
    __device__ __forceinline__ bool next(int i, Unit& u) const {
        Unit t = {0, 0, 0, 0, 0}; bool ok = false;
        if (i <= 1) ok = so.next(i, t);
        int pm = t.pm, pn = t.pn, ks = 0, kind = 0, nt = 0;
        if (i == 1 && !ok) { const int idx = c - 140; ok = idx >= 0 && idx < 116; pm = idx / 58; pn = idx - pm * 58; kind = 1; nt = 16; }
        if (i == 2) { ok = c < 64; const int tile = c >> 2; ks = c & 3; pm = tile >> 3; pn = 58 + (tile & 7); kind = 1; nt = 4; }
        u.pm = pm; u.pn = pn; u.ks = ks; u.kind = kind; u.nt = nt;
        return ok;
    }
};
struct MainSplitOrder {
    StaticOrder so; int c, S, nts;
    __device__ __forceinline__ void init(int G_, int c_, int S_, int nts_) { so.init(NPR, 1024, G_, c_); c = c_; S = S_; nts = nts_; }
    __device__ __forceinline__ bool next(int i, Unit& u) const {
        Unit t = {0, 0, 0, 0, 0}; bool ok = false;
        if (i == 0) ok = so.next(0, t);
        int pm = t.pm, pn = t.pn, ks = 0, nt = 0;
        if (i == 1) { ok = c < 8 * S; ks = c % S; const int tt = c / S; pn = tt & 3; pm = 64 + (tt >> 2); nt = nts; }
        u.pm = pm; u.pn = pn; u.ks = ks; u.kind = 0; u.nt = nt;
        return ok;
    }
};
template <class Epi, class Sched>
__device__ __forceinline__ void gemm_phase(LAS unsigned char* lds, const Gemm g, const Sched& S, const Epi& E, const int wave_id) {
    const int lane = (int)__builtin_amdgcn_mbcnt_hi(~0u, __builtin_amdgcn_mbcnt_lo(~0u, (unsigned)opq(0))), wid = wave_id, tid = wid * 64 + lane, wr = wid >> 2, wc = wid & 3, fr = lane & 15, fq = lane >> 4;
    unsigned voffA[2], voffB[2];
#pragma unroll
    for (int i = 0; i < 2; ++i) { int R, C; stage_rc(tid * 16 + i * 8192, R, C); const int Rb = (R & ~31) + perm32(R & 31);
        voffA[i] = (unsigned)(R * g.lda + C) * 2u; voffB[i] = (unsigned)(Rb * g.ldb + C) * 2u; }
    const unsigned kstep = (unsigned)(BK * 2);
    const unsigned hstepA = (unsigned)HALF * g.lda * 2, hstepB = (unsigned)HALF * g.ldb * 2, tstepA = 2 * hstepA, tstepB = 2 * hstepB;
    const unsigned ldsw = (unsigned)wid * 1024u;
    const int aoff = lds_byte(wr * 64 + fr, fq * 8), boff = lds_byte(wc * 32 + fr, fq * 8);
#define PG8_SA(b, h) (((b) * 2 + (h)) * HTB)
#define PG8_SB(b, h) ((4 + (b) * 2 + (h)) * HTB)
#define PG8_STAGE(bufoff, gbase, voff) do { _Pragma("unroll") for (int _i = 0; _i < 2; ++_i) \
        __builtin_amdgcn_global_load_lds((const unsigned*)((const char*)(gbase) + (voff)[_i]), (LAS unsigned*)(lds + (bufoff) + ldsw + _i * 8192), 16, 0, 0); } while (0)
#define PG8_LDA(dst, b, h) do { _Pragma("unroll") for (int m = 0; m < 4; ++m) _Pragma("unroll") for (int k = 0; k < 2; ++k) dst[m][k] = *(const LAS bf16x8*)(lds + PG8_SA(b, h) + aoff + m * 2048 + k * 1024); } while (0)
#define PG8_LDB(dst, b, h) do { _Pragma("unroll") for (int n = 0; n < 2; ++n) _Pragma("unroll") for (int k = 0; k < 2; ++k) dst[n][k] = *(const LAS bf16x8*)(lds + PG8_SB(b, h) + boff + n * 2048 + k * 1024); } while (0)
#define PG8_MMA(ai, bj, At, Bt) do { __builtin_amdgcn_s_setprio(1); _Pragma("unroll") for (int m = 0; m < 4; ++m) _Pragma("unroll") for (int n = 0; n < 2; ++n) _Pragma("unroll") for (int k = 0; k < 2; ++k) \
        acc[ai][bj][m][n] = __builtin_amdgcn_mfma_f32_16x16x32_bf16(Bt[n][k], At[m][k], acc[ai][bj][m][n], 0, 0, 0); __builtin_amdgcn_s_setprio(0); } while (0)
#define PG8_WAIT_V(n) asm volatile("s_waitcnt vmcnt(" #n ")" ::: "memory")
#define PG8_WAIT_L(n) asm volatile("s_waitcnt lgkmcnt(" #n ")" ::: "memory")
#define PG8_BAR __builtin_amdgcn_s_barrier()
#define PG8_SCHED __builtin_amdgcn_sched_barrier(0)
    Unit cur = {0, 0, 0, 0, 0}, nxt = {0, 0, 0, 0, 0}; int ui = 0;
    if (!S.next(0, cur)) return;
    f32x4 acc[2][2][4][2];
    const float zf = __int_as_float(opq(0)); const f32x4 zero4 = (f32x4){zf, zf, zf, zf};
#pragma unroll
    for (int a = 0; a < 2; ++a)
#pragma unroll
        for (int b = 0; b < 2; ++b)
#pragma unroll
            for (int m = 0; m < 4; ++m)
#pragma unroll
                for (int n = 0; n < 2; ++n) acc[a][b][m][n] = zero4;
    bf16x8 At[4][2], B0[2][2], B1[2][2];
    const char* cA = (const char*)(cur.kind ? g.A1 : g.A) + (size_t)cur.pm * tstepA + (size_t)cur.ks * g.kcb;
    const char* cB = (const char*)(cur.kind ? g.Bt1 : g.Bt) + (size_t)(cur.pm / g.gdiv) * g.gstrideB * 2 + (size_t)cur.pn * tstepB + (size_t)cur.ks * g.kcb;
    int nt = cur.nt ? cur.nt : g.K / BK;
    PG8_STAGE(PG8_SB(0, 0), cB, voffB); PG8_STAGE(PG8_SB(0, 1), cB + hstepB, voffB); PG8_STAGE(PG8_SA(0, 0), cA, voffA); PG8_STAGE(PG8_SA(0, 1), cA + hstepA, voffA);
    if (wr == 1) PG8_BAR;
    PG8_WAIT_V(2); PG8_BAR;
    PG8_STAGE(PG8_SB(1, 0), cB + kstep, voffB); PG8_STAGE(PG8_SA(1, 0), cA + kstep, voffA); PG8_STAGE(PG8_SB(1, 1), cB + hstepB + kstep, voffB);
    PG8_WAIT_V(6); PG8_BAR;
    for (;;) {
        nxt.pm = 0; nxt.pn = 0; nxt.ks = 0; nxt.kind = 0; nxt.nt = 0;
        const bool has_next = S.next(ui + 1, nxt);
        const char* nA = has_next ? (const char*)(nxt.kind ? g.A1 : g.A) + (size_t)nxt.pm * tstepA + (size_t)nxt.ks * g.kcb : cA;
        const char* nB = has_next ? (const char*)(nxt.kind ? g.Bt1 : g.Bt) + (size_t)(nxt.pm / g.gdiv) * g.gstrideB * 2 + (size_t)nxt.pn * tstepB + (size_t)nxt.ks * g.kcb : cB;
#pragma unroll 1
        for (int t = 0; t < nt; t += 2) {
            const bool last = (t == nt - 2);
            const char* a1 = cA + (unsigned)(t + 1) * kstep;
            const char* a2 = last ? nA : cA + (unsigned)(t + 2) * kstep; const char* b2 = last ? nB : cB + (unsigned)(t + 2) * kstep;
            const char* a3 = a2 + kstep; const char* b3 = b2 + kstep;
            PG8_LDB(B0, 0, 0); PG8_LDB(B1, 0, 1); PG8_SCHED; PG8_LDA(At, 0, 0); PG8_STAGE(PG8_SA(1, 1), a1 + hstepA, voffA);
            PG8_WAIT_V(8); PG8_WAIT_L(0); PG8_BAR; PG8_MMA(0, 0, At, B0); PG8_MMA(0, 1, At, B1); PG8_BAR; PG8_SCHED;
            PG8_LDA(At, 0, 1); PG8_STAGE(PG8_SB(0, 0), b2, voffB); PG8_STAGE(PG8_SB(0, 1), b2 + hstepB, voffB); PG8_STAGE(PG8_SA(0, 0), a2, voffA);
            PG8_WAIT_V(8); PG8_WAIT_L(0); PG8_BAR; PG8_MMA(1, 0, At, B0); PG8_MMA(1, 1, At, B1); PG8_BAR; PG8_SCHED;
            PG8_LDB(B0, 1, 0); PG8_LDB(B1, 1, 1); PG8_SCHED; PG8_LDA(At, 1, 0); PG8_STAGE(PG8_SA(0, 1), a2 + hstepA, voffA);
            PG8_WAIT_V(8); PG8_WAIT_L(0); PG8_BAR; PG8_MMA(0, 0, At, B0); PG8_MMA(0, 1, At, B1); PG8_BAR; PG8_SCHED;
            PG8_LDA(At, 1, 1); PG8_STAGE(PG8_SB(1, 0), b3, voffB); PG8_STAGE(PG8_SB(1, 1), b3 + hstepB, voffB); PG8_STAGE(PG8_SA(1, 0), a3, voffA);
            PG8_WAIT_V(8); PG8_WAIT_L(0); PG8_BAR; PG8_MMA(1, 0, At, B0); PG8_MMA(1, 1, At, B1); PG8_BAR; PG8_SCHED;
        }
        if (wr == 0) PG8_BAR;
        E(acc, cur, wr, wc, fr, fq);
        if (!has_next) break;
#pragma unroll
        for (int a = 0; a < 2; ++a)
#pragma unroll
            for (int b = 0; b < 2; ++b)
#pragma unroll
                for (int m = 0; m < 4; ++m)
#pragma unroll
                    for (int n = 0; n < 2; ++n) acc[a][b][m][n] = zero4;
        cur = nxt; cA = nA; cB = nB; ++ui; nt = cur.nt ? cur.nt : g.K / BK;
        if (wr == 1) PG8_BAR;
    }
    PG8_WAIT_V(0);
    PG8_BAR;
#undef PG8_SA
#undef PG8_SB
#undef PG8_STAGE
#undef PG8_LDA
#undef PG8_LDB
#undef PG8_MMA
#undef PG8_WAIT_V
#undef PG8_WAIT_L
#undef PG8_BAR
#undef PG8_SCHED
}
}
using pg8::Unit;
typedef const f32x4 (&AccRef)[2][2][4][2];
__device__ __forceinline__ u32x4 pack8(f32x4 v0, f32x4 v1) { u32x4 w; w.x = cvt_pk_bf16(v0[0], v0[1]); w.y = cvt_pk_bf16(v0[2], v0[3]); w.z = cvt_pk_bf16(v1[0], v1[1]); w.w = cvt_pk_bf16(v1[2], v1[3]); return w; }

struct EpiPlain {
    bf16_t* O; int ldc;
    __device__ __forceinline__ void operator()(AccRef acc, const Unit& u, int wr, int wc, int fr, int fq) const {
        fr = opq(fr); fq = opq(fq);
#pragma unroll
        for (int ai = 0; ai < 2; ++ai)
#pragma unroll
            for (int m = 0; m < 4; ++m) { const int r = u.pm * 256 + ai * 128 + wr * 64 + m * 16 + fr;
#pragma unroll
                for (int bj = 0; bj < 2; ++bj) { const int c = u.pn * 256 + bj * 128 + wc * 32 + 8 * fq;
                    *(u32x4*)(O + (size_t)r * ldc + c) = pack8(acc[ai][bj][m][0], acc[ai][bj][m][1]); } }
    }
};
struct EpiIn {
    bf16_t *Q, *KP, *KS, *UA; float* out; int l;
    __device__ __forceinline__ void operator()(AccRef acc, const Unit& u, int wr, int wc, int fr, int fq) const {
        fr = opq(fr); fq = opq(fq);
        const bool prompt = u.pm < 64;
#pragma unroll
        for (int ai = 0; ai < 2; ++ai)
#pragma unroll
            for (int m = 0; m < 4; ++m) { const int r = u.pm * 256 + ai * 128 + wr * 64 + m * 16 + fr;
#pragma unroll
                for (int bj = 0; bj < 2; ++bj) { const int c = u.pn * 256 + bj * 128 + wc * 32 + 8 * fq;
                    const f32x4 v0 = acc[ai][bj][m][0], v1 = acc[ai][bj][m][1];
                    if (u.pn < 2) { *(u32x4*)(Q + (size_t)r * 512 + c) = pack8(v0 * C2, v1 * C2); }
                    else if (u.pn < 4) { const int ck = c - 512, h = ck >> 6, d = ck & 63; const u32x4 w = pack8(v0, v1);
                        if (prompt) { const int b = r >> 12, t = r & 4095;
                            *(u32x4*)(KP + ((size_t)(b * 8 + h) * 4096 + t) * 64 + d) = w;
                            float* o = out + O_KP + ((size_t)((l * 4 + b) * 8 + h) * 4096 + t) * 64 + d; *(f32x4*)o = v0; *(f32x4*)(o + 4) = v1; }
                        else { const int rr = r - NPR, b = rr >> 6, t = rr & 63;
                            *(u32x4*)(KS + ((size_t)(b * 8 + h) * KVS + PAST + t) * 64 + d) = w;
                            float* o = out + O_KS + ((size_t)((l * 8 + b) * 8 + h) * 64 + t) * 64 + d; *(f32x4*)o = v0; *(f32x4*)(o + 4) = v1; } }
                    else { const int cu = c - 1024, gq = cu >> 4, m0 = cu & 15, chunk = r >> 4, s = r & 15;
                        *(u32x4*)(UA + ((size_t)gq * CHP + chunk) * UAK + s * 16 + m0) = pack8(v0, v1); }
                    asm volatile("" ::: "memory"); } }
    }
};
struct EpiVT {
    bf16_t *VTP, *VTS; float* out; int l; LAS unsigned char* lds;
    __device__ __forceinline__ void operator()(AccRef acc, const Unit& u, int wr, int wc, int fr, int fq) const {
        fr = opq(fr); fq = opq(fq);
        const bool prompt = u.pn < 64; const int ln = fq * 16 + fr;
        LAS float* stg = (LAS float*)(lds + 131072 + 1024 + (wr * 4 + wc) * 2080);
#pragma unroll
        for (int ai = 0; ai < 2; ++ai)
#pragma unroll
            for (int bj = 0; bj < 2; ++bj) {
                const int h = (u.pm * 256 + ai * 128 + wr * 64) >> 6, tok0 = u.pn * 256 + bj * 128 + wc * 32;
                float* obase; bf16_t* vbase; size_t vpitch;
                if (prompt) { const int b = tok0 >> 12, t0 = tok0 & 4095; obase = out + O_VP + ((size_t)((l * 4 + b) * 8 + h) * 4096 + t0) * 64; vbase = VTP + (size_t)(b * 8 + h) * 64 * 4096 + t0; vpitch = 4096; }
                else { const int tt = tok0 - NPR, b = tt >> 6, t0 = tt & 63; obase = out + O_VS + ((size_t)((l * 8 + b) * 8 + h) * 64 + t0) * 64; vbase = VTS + (size_t)(b * 8 + h) * 64 * KVS + PAST + t0; vpitch = KVS; }
#pragma unroll
                for (int m = 0; m < 4; ++m) *(u32x4*)(vbase + (size_t)(m * 16 + fr) * vpitch + 8 * fq) = pack8(acc[ai][bj][m][0], acc[ai][bj][m][1]);
#pragma unroll
                for (int n = 0; n < 2; ++n)
#pragma unroll
                    for (int j0 = 0; j0 < 4; j0 += 2) {
#pragma unroll
                        for (int m = 0; m < 4; ++m) { stg[(2 * fq) * 65 + 16 * m + fr] = acc[ai][bj][m][n][j0]; stg[(2 * fq + 1) * 65 + 16 * m + fr] = acc[ai][bj][m][n][j0 + 1]; }
                        asm volatile("s_waitcnt lgkmcnt(0)" ::: "memory");
#pragma unroll
                        for (int sl = 0; sl < 8; ++sl) { const float v = stg[sl * 65 + ln]; obase[(size_t)(8 * (sl >> 1) + 4 * n + j0 + (sl & 1)) * 64 + ln] = v; }
                        asm volatile("s_waitcnt lgkmcnt(0)" ::: "memory");
                    }
            }
    }
};
struct EpiVtPart {
    float* PV;
    __device__ __forceinline__ void operator()(AccRef acc, const Unit& u, int wr, int wc, int fr, int fq) const {
        fr = opq(fr); fq = opq(fq);
        float* base = PV + (size_t)((u.pm * 8 + (u.pn - 58)) * 4 + u.ks) * 65536;
#pragma unroll
        for (int ai = 0; ai < 2; ++ai)
#pragma unroll
            for (int m = 0; m < 4; ++m) { const int r = ai * 128 + wr * 64 + m * 16 + fr;
#pragma unroll
                for (int bj = 0; bj < 2; ++bj) { float* o = base + r * 256 + bj * 128 + wc * 32 + 8 * fq; *(f32x4*)o = acc[ai][bj][m][0]; *(f32x4*)(o + 4) = acc[ai][bj][m][1]; } }
    }
};
struct EpiE {
    float* E;
    __device__ __forceinline__ void operator()(AccRef acc, const Unit& u, int wr, int wc, int fr, int fq) const {
        fr = opq(fr); fq = opq(fq);
#pragma unroll
        for (int ai = 0; ai < 2; ++ai)
#pragma unroll
            for (int m = 0; m < 4; ++m) { const int gq = u.pm / 5, chunk = (u.pm - gq * 5) * 256 + ai * 128 + wr * 64 + m * 16 + fr;
                { float* o = E + ((size_t)gq * CHP + chunk) * 128 + wc * 32 + 8 * fq; *(f32x4*)o = acc[ai][0][m][0]; *(f32x4*)(o + 4) = acc[ai][0][m][1]; } }
    }
};
struct EpiZ {
    bf16_t* Z;
    __device__ __forceinline__ void operator()(AccRef acc, const Unit& u, int wr, int wc, int fr, int fq) const {
        fr = opq(fr); fq = opq(fq);
#pragma unroll
        for (int ai = 0; ai < 2; ++ai)
#pragma unroll
            for (int m = 0; m < 4; ++m) { const int gq = u.pm / 5, chunk = (u.pm - gq * 5) * 256 + ai * 128 + wr * 64 + m * 16 + fr;
                {
#pragma unroll
                    for (int bj = 0; bj < 2; ++bj) { const int n = bj * 128 + wc * 32 + 8 * fq, t = n >> 4, m0 = n & 15;
                        f32x4 v0 = acc[ai][bj][m][0], v1 = acc[ai][bj][m][1];
#pragma unroll
                        for (int j = 0; j < 4; ++j) { v0[j] = gelu_f(v0[j]); v1[j] = gelu_f(v1[j]); }
                        *(u32x4*)(Z + (size_t)(chunk * 16 + t) * 512 + gq * 16 + m0) = pack8(v0, v1); __builtin_amdgcn_sched_barrier(0); } } }
    }
};
struct EpiGlu {
    const bf16_t* Z; bf16_t* MIX;
    __device__ __forceinline__ void operator()(AccRef acc, const Unit& u, int wr, int wc, int fr, int fq) const {
        fr = opq(fr); fq = opq(fq);
#pragma unroll
        for (int ai = 0; ai < 2; ++ai)
#pragma unroll
            for (int m = 0; m < 4; ++m) { const int r = u.pm * 256 + ai * 128 + wr * 64 + m * 16 + fr;
#pragma unroll
                for (int bj = 0; bj < 2; ++bj) { const int c = u.pn * 256 + bj * 128 + wc * 32 + 8 * fq;
                    const u32x4 zz = *(const u32x4*)(Z + (size_t)r * 512 + c);
                    f32x4 v0 = acc[ai][bj][m][0], v1 = acc[ai][bj][m][1];
#pragma unroll
                    for (int j = 0; j < 4; ++j) { const unsigned w0 = zz[j >> 1], w1 = zz[2 + (j >> 1)];
                        const float z0 = (j & 1) ? __uint_as_float(w0 & 0xffff0000u) : __uint_as_float(w0 << 16);
                        const float z1 = (j & 1) ? __uint_as_float(w1 & 0xffff0000u) : __uint_as_float(w1 << 16);
                        v0[j] = z0 * sigm(v0[j]); v1[j] = z1 * sigm(v1[j]); }
                    *(u32x4*)(MIX + (size_t)r * 1024 + 512 + c) = pack8(v0, v1); } }
    }
};
struct EpiAtomic {
    float* FS;
    __device__ __forceinline__ void operator()(AccRef acc, const Unit& u, int wr, int wc, int fr, int fq) const {
        fr = opq(fr); fq = opq(fq);
#pragma unroll
        for (int ai = 0; ai < 2; ++ai)
#pragma unroll
            for (int m = 0; m < 4; ++m) { const int r = (u.pm - 64) * 256 + ai * 128 + wr * 64 + m * 16 + fr;
#pragma unroll
                for (int bj = 0; bj < 2; ++bj) { float* o = FS + ((size_t)u.ks * 512 + r) * 1024 + u.pn * 256 + bj * 128 + wc * 32 + 8 * fq;
                    *(f32x4*)o = acc[ai][bj][m][0]; *(f32x4*)(o + 4) = acc[ai][bj][m][1]; } }
    }
};
struct EpiSwi {
    bf16_t* H;
    __device__ __forceinline__ void operator()(AccRef acc, const Unit& u, int wr, int wc, int fr, int fq) const {
        fr = opq(fr); fq = opq(fq);
#pragma unroll
        for (int ai = 0; ai < 2; ++ai)
#pragma unroll
            for (int m = 0; m < 4; ++m) { const int r = u.pm * 256 + ai * 128 + wr * 64 + m * 16 + fr; const int c = u.pn * 128 + wc * 32 + 8 * fq;
                f32x4 v0 = acc[ai][0][m][0], v1 = acc[ai][0][m][1]; const f32x4 u0 = acc[ai][1][m][0], u1 = acc[ai][1][m][1];
#pragma unroll
                for (int j = 0; j < 4; ++j) { v0[j] = silu_f(v0[j]) * u0[j]; v1[j] = silu_f(v1[j]) * u1[j]; }
                *(u32x4*)(H + (size_t)r * DFF + c) = pack8(v0, v1); }
    }
};

struct EpiA {
    EpiIn in; EpiVT vt; EpiVtPart vp;
    __device__ __forceinline__ void operator()(AccRef acc, const Unit& u, int wr, int wc, int fr, int fq) const {
        if (u.kind == 0) in(acc, u, wr, wc, fr, fq); else if (u.nt == 16) vt(acc, u, wr, wc, fr, fq); else vp(acc, u, wr, wc, fr, fq);
    }
};
struct EpiMS {
    EpiPlain p; EpiAtomic q;
    __device__ __forceinline__ void operator()(AccRef acc, const Unit& u, int wr, int wc, int fr, int fq) const {
        if (u.pm < 64) p(acc, u, wr, wc, fr, fq); else q(acc, u, wr, wc, fr, fq);
    }
};
struct Args { const float* in[30]; float* out; unsigned char* ws; };
struct Ctx {
    LAS unsigned char* lds; int tid, lane, wave, G, c;
    const float* const* in; float* out; unsigned char* ws;
};
#define INP(i) (a.in[i])

__device__ __forceinline__ void tr_item(const float* W, size_t ldw, int k0, int sc0, bf16_t* WT, size_t ldo, int dr0, LAS float* scr, int lane) {
    f32x4 tv[8];
#pragma unroll
    for (int i = 0; i < 8; ++i) { const int kk = 8 * i + (lane >> 3); tv[i] = *(const f32x4*)(W + (size_t)(k0 + kk) * ldw + sc0 + 4 * (lane & 7)); }
#pragma unroll
    for (int i = 0; i < 8; ++i) { const int kk = 8 * i + (lane >> 3); LAS float* d = scr + kk * 33 + 4 * (lane & 7); d[0] = tv[i][0]; d[1] = tv[i][1]; d[2] = tv[i][2]; d[3] = tv[i][3]; }
    asm volatile("s_waitcnt lgkmcnt(0)" ::: "memory");
    const int c = lane & 7;
#pragma unroll
    for (int j = 0; j < 4; ++j) { const int n = (lane >> 3) + 8 * j; const LAS float* s = scr + (8 * c) * 33 + n;
        u32x4 o; o.x = cvt_pk_bf16(s[0 * 33], s[1 * 33]); o.y = cvt_pk_bf16(s[2 * 33], s[3 * 33]); o.z = cvt_pk_bf16(s[4 * 33], s[5 * 33]); o.w = cvt_pk_bf16(s[6 * 33], s[7 * 33]);
        *(u32x4*)(WT + (size_t)(dr0 + n) * ldo + k0 + 8 * c) = o; }
    asm volatile("s_waitcnt lgkmcnt(0)" ::: "memory");
}

__device__ __forceinline__ void sincos_d(double x, double& s, double& c) {
    const double k = rint(x * 0.63661977236758134308);
    const double r = (x - k * 1.57079632679489655800) - k * 6.123233995736766036e-17;
    const double r2 = r * r;
    double sp = 1.0 / 6227020800.0; sp = sp * r2 - 1.0 / 39916800.0; sp = sp * r2 + 1.0 / 362880.0; sp = sp * r2 - 1.0 / 5040.0; sp = sp * r2 + 1.0 / 120.0; sp = sp * r2 - 1.0 / 6.0; sp = sp * r2 + 1.0;
    const double sr = r * sp;
    double cp = 1.0 / 87178291200.0; cp = cp * r2 - 1.0 / 479001600.0; cp = cp * r2 + 1.0 / 3628800.0; cp = cp * r2 - 1.0 / 40320.0; cp = cp * r2 + 1.0 / 720.0; cp = cp * r2 - 1.0 / 24.0; cp = cp * r2 + 0.5;
    const double cr = 1.0 - r2 * cp;
    const int q = ((int)k) & 3;
    s = (q == 0) ? sr : (q == 1) ? cr : (q == 2) ? -sr : -cr;
    c = (q == 0) ? cr : (q == 1) ? -sr : (q == 2) ? -cr : sr;
}

__device__ __forceinline__ void p0_weights(const Args& a, int lw, bool do_wg, LAS unsigned char* lds, int wave, int lane, int gw, int NGW) {
    LAS float* scr = (LAS float*)(lds + wave * 16384);
    constexpr int I_IN = 16 * 16, I_GLU = 8 * 16, I_OUT = 16 * 32, I_G = 16 * 88, I_D = 44 * 32;
    constexpr int PER_L = 4 * I_IN + I_GLU + I_OUT + 2 * I_G + I_D;
    for (int it = gw; it < PER_L; it += NGW) {
        const int l = lw; int r = it;
        const float* win = INP(15) + (size_t)l * DM * DIN;
        bf16_t* WIN = (bf16_t*)(a.ws + WS_WIN) + (size_t)l * 1536 * 1024;
        if (r < 4 * I_IN) { const int part = r / I_IN, rr = r % I_IN, kb = rr / 16, nb = rr % 16;
            if (part == 0) tr_item(win, DIN, 64 * kb, 32 * nb, WIN, 1024, 32 * nb, scr, lane);
            else if (part == 1) tr_item(win, DIN, 64 * kb, 512 + 32 * nb, WIN, 1024, 512 + 32 * nb, scr, lane);
            else if (part == 2) tr_item(win, DIN, 64 * kb, 1544 + 32 * nb, WIN, 1024, 1024 + 32 * nb, scr, lane);
            else tr_item(win, DIN, 64 * kb, 1024 + 32 * nb, (bf16_t*)(a.ws + WS_WV) + (size_t)l * 512 * 1024, 1024, 32 * nb, scr, lane);
            continue; }
        r -= 4 * I_IN;
        if (r < I_GLU) { tr_item(INP(25) + (size_t)l * 512 * 512, 512, 64 * (r / 16), 32 * (r % 16), (bf16_t*)(a.ws + WS_WGLU) + (size_t)l * 512 * 512, 512, 32 * (r % 16), scr, lane); continue; }
        r -= I_GLU;
        if (r < I_OUT) { tr_item(INP(26) + (size_t)l * 1024 * 1024, 1024, 64 * (r / 32), 32 * (r % 32), (bf16_t*)(a.ws + WS_WOUT) + (size_t)l * 1024 * 1024, 1024, 32 * (r % 32), scr, lane); continue; }
        r -= I_OUT;
        if (r < 2 * I_G) { const int up = r / I_G, rr = r % I_G, kb = rr / 88, nb = rr % 88, c0 = 32 * nb;
            tr_item(INP(27 + up) + (size_t)l * DM * DFF, DFF, 64 * kb, c0, (bf16_t*)(a.ws + WS_WGU) + (size_t)l * 5632 * 1024, 1024, (c0 >> 7) * 256 + up * 128 + (c0 & 127), scr, lane);
            continue; }
        r -= 2 * I_G;
        tr_item(INP(29) + (size_t)l * DFF * DM, DM, 64 * (r / 32), 32 * (r % 32), (bf16_t*)(a.ws + WS_WD) + (size_t)l * 1024 * DFF, DFF, 32 * (r % 32), scr, lane);
    }
    float* WG = (float*)(a.ws + WS_WG);
    if (do_wg) for (int i = gw * 64 + lane; i < NL * 8 * 1024; i += NGW * 64) { const int l = i >> 13, h = (i >> 10) & 7, k = i & 1023; WG[i] = INP(15)[((size_t)l * DM + k) * DIN + 1536 + h]; }
}
__device__ __forceinline__ void p0_adaln(const Args& a, LAS unsigned char* lds, int tid, int wave, int lane, int c, int G) {
    LAS float* sc = (LAS float*)(lds);
    LAS float* red = (LAS float*)(lds + 49152);
    for (int i = tid; i < 12 * 1024; i += 512) { const float v = (i < 4096) ? INP(2)[i] : INP(3)[i - 4096]; sc[i] = silu_f(v); }
    __syncthreads();
    float* MOD = (float*)(a.ws + WS_MOD);
    for (int it = c; it < NL * 96; it += G) {
        const int l = it / 96, n0 = (it % 96) * 64;
        const float* W = INP(9) + (size_t)l * DM * 6144 + n0 + lane;
        float acc[12];
#pragma unroll
        for (int b = 0; b < 12; ++b) acc[b] = 0.f;
        for (int k = wave * 128; k < wave * 128 + 128; k += 16) {
            float w[16];
#pragma unroll
            for (int j = 0; j < 16; ++j) w[j] = W[(size_t)(k + j) * 6144];
#pragma unroll
            for (int j = 0; j < 16; ++j)
#pragma unroll
                for (int b = 0; b < 12; ++b) acc[b] += sc[b * 1024 + k + j] * w[j];
        }
#pragma unroll
        for (int b = 0; b < 12; ++b) red[(wave * 12 + b) * 64 + lane] = acc[b];
        __syncthreads();
        for (int i = tid; i < 768; i += 512) { const int b = i >> 6, cc = i & 63; float s = 0.f;
#pragma unroll
            for (int w = 0; w < 8; ++w) s += red[(w * 12 + b) * 64 + cc];
            MOD[((size_t)l * 12 + b) * 6144 + n0 + cc] = s + INP(10)[(size_t)l * 6144 + n0 + cc]; }
        __syncthreads();
    }
}
__device__ __forceinline__ void p0_ssm(const Args& a, LAS unsigned char* lds, int tid, int c, int G) {
    LAS float* ap_re = (LAS float*)(lds + 65536);
    LAS float* ap_im = ap_re + 17 * 64;
    LAS float* bb_re = ap_im + 17 * 64;
    LAS float* bb_im = bb_re + 1024;
    LAS float* cc_re = bb_im + 1024;
    LAS float* cc_im = cc_re + 1024;
    LAS float* ktab = cc_im + 1024;
    for (int it = c; it < NL * NG; it += G) {
        const int l = it >> 5, gq = it & 31;
        const double dt = exp((double)INP(19)[l * 32 + gq]);
        for (int idx = tid; idx < 17 * 64; idx += 512) { const int d = idx >> 6, p = idx & 63;
            const double ar = (double)INP(17)[(l * 32 + gq) * 64 + p], ai = (double)INP(18)[(l * 32 + gq) * 64 + p];
            double s, co; sincos_d((double)d * ai * dt, s, co); const double er = exp((double)d * ar * dt);
            ap_re[idx] = (float)(er * co); ap_im[idx] = (float)(er * s); }
        for (int idx = tid; idx < 1024; idx += 512) { const int p = idx >> 4, m = idx & 15;
            const double ar = (double)INP(17)[(l * 32 + gq) * 64 + p], ai = (double)INP(18)[(l * 32 + gq) * 64 + p];
            double s, co; sincos_d(ai * dt, s, co); const double er = exp(ar * dt);
            const double xr = er * co - 1.0, xi = er * s, den = 1.0 / (ar * ar + ai * ai);
            const double qr = (xr * ar + xi * ai) * den, qi = (xi * ar - xr * ai) * den;
            const double br = (double)INP(20)[((size_t)(l * 32 + gq) * 64 + p) * 16 + m], bi = (double)INP(21)[((size_t)(l * 32 + gq) * 64 + p) * 16 + m];
            bb_re[idx] = (float)(qr * br - qi * bi); bb_im[idx] = (float)(qr * bi + qi * br);
            cc_re[idx] = INP(22)[(size_t)(l * 32 + gq) * 1024 + idx]; cc_im[idx] = INP(23)[(size_t)(l * 32 + gq) * 1024 + idx]; }
        __syncthreads();
        for (int idx = tid; idx < 4096; idx += 512) { const int d = idx >> 8, m = (idx >> 4) & 15, m2 = idx & 15; float s = 0.f;
            for (int p = 0; p < 64; ++p) { const float cr = cc_re[m * 64 + p], ci = cc_im[m * 64 + p], pr = ap_re[d * 64 + p], pi = ap_im[d * 64 + p];
                const float re = cr * pr - ci * pi, im = cr * pi + ci * pr; s += re * bb_re[p * 16 + m2] - im * bb_im[p * 16 + m2]; }
            if (d == 0 && m == m2) s += INP(24)[l * 512 + gq * 16 + m];
            ktab[idx] = s; }
        __syncthreads();
        bf16_t* BT3 = (bf16_t*)(a.ws + WS_BT3) + (size_t)(l * 32 + gq) * 256 * UAK;
        for (int grp = tid; grp < 256 * 48; grp += 512) { const int n = grp / 48, k0 = (grp % 48) * 8, t = n >> 4, m = n & 15; float v[8];
            if (k0 < 256) { const int s = k0 >> 4, m20 = k0 & 15;
#pragma unroll
                for (int j = 0; j < 8; ++j) v[j] = (s <= t) ? ktab[((t - s) * 16 + m) * 16 + m20 + j] : 0.f; }
            else { const int kk = k0 - 256, ri = kk >> 6, p0 = kk & 63;
#pragma unroll
                for (int j = 0; j < 8; ++j) { const int p = p0 + j; const float cr = cc_re[m * 64 + p], ci = cc_im[m * 64 + p], pr = ap_re[(t + 1) * 64 + p], pi = ap_im[(t + 1) * 64 + p];
                    v[j] = ri ? -(cr * pi + ci * pr) : (cr * pr - ci * pi); } }
            u32x4 w; w.x = cvt_pk_bf16(v[0], v[1]); w.y = cvt_pk_bf16(v[2], v[3]); w.z = cvt_pk_bf16(v[4], v[5]); w.w = cvt_pk_bf16(v[6], v[7]);
            *(u32x4*)(BT3 + (size_t)n * UAK + k0) = w; }
        bf16_t* BT1 = (bf16_t*)(a.ws + WS_BT1) + (size_t)(l * 32 + gq) * 128 * 256;
        for (int grp = tid; grp < 128 * 32; grp += 512) { const int n = grp >> 5, k0 = (grp & 31) * 8, s = k0 >> 4, m0 = k0 & 15, ri = n >> 6, p = n & 63; float v[8];
            const float pr = ap_re[(15 - s) * 64 + p], pi = ap_im[(15 - s) * 64 + p];
#pragma unroll
            for (int j = 0; j < 8; ++j) { const float br = bb_re[p * 16 + m0 + j], bi = bb_im[p * 16 + m0 + j]; v[j] = ri ? (pr * bi + pi * br) : (pr * br - pi * bi); }
            u32x4 w; w.x = cvt_pk_bf16(v[0], v[1]); w.y = cvt_pk_bf16(v[2], v[3]); w.z = cvt_pk_bf16(v[4], v[5]); w.w = cvt_pk_bf16(v[6], v[7]);
            *(u32x4*)(BT1 + (size_t)n * 256 + k0) = w; }
        if (tid < 64) { float* A16 = (float*)(a.ws + WS_A16) + (size_t)(l * 32 + gq) * 128; A16[tid] = ap_re[16 * 64 + tid]; A16[64 + tid] = ap_im[16 * 64 + tid]; }
        __syncthreads();
    }
}

__device__ __forceinline__ void cache_convert(const Args& a, int l, LAS unsigned char* lds, int wave, int lane, int gw, int NGW) {
    bf16_t* KS = (bf16_t*)(a.ws + WS_KS); bf16_t* VTS = (bf16_t*)(a.ws + WS_VTS);
    const float* ck = INP(4) + (size_t)l * 64 * PAST * 64; const float* cv = INP(5) + (size_t)l * 64 * PAST * 64;
    for (int i = gw * 64 + lane; i < 64 * PAST * 8; i += NGW * 64) {
        const int bh = i >> 13, rem = i & 8191;
        const f32x4 v0 = *(const f32x4*)(ck + (size_t)i * 8), v1 = *(const f32x4*)(ck + (size_t)i * 8 + 4);
        *(u32x4*)(KS + (size_t)bh * KVS * 64 + (size_t)rem * 8) = pack8(v0, v1); }
    LAS float* scr = (LAS float*)(lds + wave * 16384);
    for (int it = gw; it < 64 * 32; it += NGW) { const int bh = it >> 5, r = it & 31, kb = r >> 1, nb = r & 1;
        tr_item(cv + (size_t)bh * PAST * 64, 64, 64 * kb, 32 * nb, VTS + (size_t)bh * 64 * KVS, KVS, 32 * nb, scr, lane); }
}

template <int NSPLIT>
__device__ __forceinline__ void rowpass(const float* xsrc_p, const float* xsrc_s, const bf16_t* xsrc_b, const bf16_t* Fb, const float* FS, int nsplit, const float* gate, const float* wpost, float* xdst, bf16_t* xdst_b,
                                        const float* wpre, const float* sc, const float* sh, bf16_t* HMb, const float* WGl, const float* bfor, float* out, int lnext,
                                        int lane, int gw, int NGW) {
    f32x4 wg[8][4];
    if (WGl) {
#pragma unroll
        for (int h = 0; h < 8; ++h)
#pragma unroll
            for (int j = 0; j < 4; ++j) wg[h][j] = *(const f32x4*)(WGl + h * 1024 + 4 * lane + 256 * j);
    }
#define LOADX(dst, rr, xr, j) do { if (xsrc_b) { const u32x2 w_ = *(const u32x2*)(xsrc_b + (size_t)(rr) * DM + 4 * lane + 256 * (j)); \
        dst = (f32x4){__uint_as_float(w_.x << 16), __uint_as_float(w_.x & 0xffff0000u), __uint_as_float(w_.y << 16), __uint_as_float(w_.y & 0xffff0000u)}; } \
        else dst = *(const f32x4*)((xr) + 4 * lane + 256 * (j)); } while (0)
    for (int r = gw; r < MT; r += NGW) {
        const bool prompt = r < NPR; const int bm = prompt ? (r >> 12) : 4 + ((r - NPR) >> 6);
        f32x4 x[4]; u32x2 fw[4];
        { const float* xr = prompt ? xsrc_p + (size_t)r * DM : xsrc_s + (size_t)(r - NPR) * DM;
#pragma unroll
          for (int j = 0; j < 4; ++j) { LOADX(x[j], r, xr, j); fw[j] = (Fb && prompt) ? *(const u32x2*)(Fb + (size_t)r * DM + 4 * lane + 256 * j) : (u32x2){0u, 0u}; } }
        if (Fb) {
            f32x4 f[4]; float ss = 0.f;
#pragma unroll
            for (int j = 0; j < 4; ++j) {
                if (prompt) { const u32x2 w = fw[j];
                    f[j] = (f32x4){__uint_as_float(w.x << 16), __uint_as_float(w.x & 0xffff0000u), __uint_as_float(w.y << 16), __uint_as_float(w.y & 0xffff0000u)}; }
                else { const float* fp = FS + (size_t)(r - NPR) * DM + 4 * lane + 256 * j; f32x4 part[NSPLIT > 0 ? NSPLIT : 1];
#pragma unroll
                    for (int sp = 0; sp < NSPLIT; ++sp) part[sp] = *(const f32x4*)(fp + (size_t)sp * 512 * 1024);
                    f32x4 sacc = part[0];
#pragma unroll
                    for (int sp = 1; sp < NSPLIT; ++sp) sacc = sacc + part[sp];
                    f[j] = sacc; }
                ss += (f[j][0] * f[j][0] + f[j][1] * f[j][1]) + (f[j][2] * f[j][2] + f[j][3] * f[j][3]); }
            const float rstd = rsqrtf(wave_sum(ss, lane) * (1.f / DM) + EPS);
#pragma unroll
            for (int j = 0; j < 4; ++j) { const f32x4 gt = *(const f32x4*)(gate + (size_t)bm * 6144 + 4 * lane + 256 * j), wp = *(const f32x4*)(wpost + 4 * lane + 256 * j);
                x[j] = x[j] + gt * (f[j] * rstd * wp); }
        }
        if (xdst) {
#pragma unroll
            for (int j = 0; j < 4; ++j) *(f32x4*)(xdst + (size_t)r * DM + 4 * lane + 256 * j) = x[j];
        }
        if (xdst_b) {
#pragma unroll
            for (int j = 0; j < 4; ++j) { u32x2 w; w.x = cvt_pk_bf16(x[j][0], x[j][1]); w.y = cvt_pk_bf16(x[j][2], x[j][3]); *(u32x2*)(xdst_b + (size_t)r * DM + 4 * lane + 256 * j) = w;
                x[j] = (f32x4){__uint_as_float(w.x << 16), __uint_as_float(w.x & 0xffff0000u), __uint_as_float(w.y << 16), __uint_as_float(w.y & 0xffff0000u)}; }
        }
        if (wpre) {
            float ss = 0.f;
#pragma unroll
            for (int j = 0; j < 4; ++j) ss += (x[j][0] * x[j][0] + x[j][1] * x[j][1]) + (x[j][2] * x[j][2] + x[j][3] * x[j][3]);
            const float rstd = rsqrtf(wave_sum(ss, lane) * (1.f / DM) + EPS);
            f32x4 hm[4];
#pragma unroll
            for (int j = 0; j < 4; ++j) { const int cidx = 4 * lane + 256 * j;
                const f32x4 wv = *(const f32x4*)(wpre + cidx), s1 = *(const f32x4*)(sc + (size_t)bm * 6144 + cidx), s0 = *(const f32x4*)(sh + (size_t)bm * 6144 + cidx);
                hm[j] = (x[j] * rstd * wv) * (1.f + s1) + s0;
                u32x2 w; w.x = cvt_pk_bf16(hm[j][0], hm[j][1]); w.y = cvt_pk_bf16(hm[j][2], hm[j][3]);
                *(u32x2*)(HMb + (size_t)r * DM + cidx) = w; }
            if (WGl) {
                float mine = 0.f;
#pragma unroll
                for (int h = 0; h < 8; ++h) { float d = 0.f;
#pragma unroll
                    for (int j = 0; j < 4; ++j) { const f32x4 wv = wg[h][j]; d += (hm[j][0] * wv[0] + hm[j][1] * wv[1]) + (hm[j][2] * wv[2] + hm[j][3] * wv[3]); }
                    d = wave_sum(d, lane); if (lane == h) mine = d; }
                if (lane < 8) { const float lf = logsig(mine + bfor[lane]);
                    if (prompt) out[O_LP + ((size_t)((lnext * 4 + (r >> 12)) * 8 + lane)) * 4096 + (r & 4095)] = lf;
                    else { const int rr = r - NPR; out[O_LS + ((size_t)((lnext * 8 + (rr >> 6)) * 8 + lane)) * 64 + (rr & 63)] = lf; } }
            }
        }
    }
}

__device__ __forceinline__ void vt_finalize(const Args& a, int l, int lane, int gwi, int nw) {
    const float* PV = (const float*)(a.ws + WS_F1); bf16_t* VTP = (bf16_t*)(a.ws + WS_VTP); bf16_t* VTS = (bf16_t*)(a.ws + WS_VTS);
    for (int it = gwi; it < 16 * 128; it += nw) {
        const int tile = it >> 7, rem = it & 127, hb = rem >> 5, to = rem & 31, hdl = hb * 64 + lane, pm = tile >> 3, pn = 58 + (tile & 7);
        const int hd = pm * 256 + hdl, h = hd >> 6, d = hd & 63, tok = pn * 256 + to * 8;
        f32x4 v0 = {0.f, 0.f, 0.f, 0.f}, v1 = {0.f, 0.f, 0.f, 0.f};
#pragma unroll
        for (int ks = 0; ks < 4; ++ks) { const float* p = PV + ((size_t)(tile * 4 + ks) * 256 + hdl) * 256 + to * 8; v0 = v0 + *(const f32x4*)p; v1 = v1 + *(const f32x4*)(p + 4); }
        const u32x4 w = pack8(v0, v1);
        if (pn < 64) { const int b = tok >> 12, t = tok & 4095;
            *(u32x4*)(VTP + ((size_t)(b * 8 + h) * 64 + d) * 4096 + t) = w;
            float* o = a.out + O_VP + ((size_t)((l * 4 + b) * 8 + h) * 4096 + t) * 64 + d;
#pragma unroll
            for (int j = 0; j < 4; ++j) { o[(size_t)j * 64] = v0[j]; o[(size_t)(j + 4) * 64] = v1[j]; } }
        else { const int tt = tok - NPR, b = tt >> 6, t = tt & 63;
            *(u32x4*)(VTS + ((size_t)(b * 8 + h) * 64 + d) * KVS + PAST + t) = w;
            float* o = a.out + O_VS + ((size_t)((l * 8 + b) * 8 + h) * 64 + t) * 64 + d;
#pragma unroll
            for (int j = 0; j < 4; ++j) { o[(size_t)j * 64] = v0[j]; o[(size_t)(j + 4) * 64] = v1[j]; } }
    }
}
__device__ __forceinline__ void cumsum_items(const Args& a, int l, LAS unsigned char* lds, int tid, int wave, int lane, int c, int G) {
    LAS float* wt = (LAS float*)(lds);
    for (int it = c - 64; it >= 0 && it < 96; it += G) {
        const bool prompt = it < 32;
        float v[8]; float run = 0.f; int i0, cnt;
        if (prompt) { i0 = tid * 8; cnt = 8;
            const float* src = a.out + O_LP + (size_t)(l * 32 + it) * 4096 + i0;
            const f32x4 p0 = *(const f32x4*)src, p1 = *(const f32x4*)(src + 4);
            v[0] = p0[0]; v[1] = p0[1]; v[2] = p0[2]; v[3] = p0[3]; v[4] = p1[0]; v[5] = p1[1]; v[6] = p1[2]; v[7] = p1[3]; }
        else { const int sq = it - 32; i0 = tid * 4; cnt = tid < 272 ? 4 : 0;
            const float* src = tid < 256 ? INP(6) + (size_t)(l * 64 + sq) * PAST + i0 : a.out + O_LS + (size_t)(l * 64 + sq) * 64 + (tid < 272 ? i0 - PAST : 0);
            const f32x4 p0 = *(const f32x4*)src;
            v[0] = p0[0]; v[1] = p0[1]; v[2] = p0[2]; v[3] = p0[3]; v[4] = 0.f; v[5] = 0.f; v[6] = 0.f; v[7] = 0.f;
            if (tid >= 272) { v[0] = 0.f; v[1] = 0.f; v[2] = 0.f; v[3] = 0.f; } }
#pragma unroll
        for (int j = 0; j < 8; ++j) { run += v[j]; v[j] = run; }
        float incl = run;
#pragma unroll
        for (int o = 1; o < 64; o <<= 1) { const float t = bperm(incl, lane >= o ? lane - o : lane); if (lane >= o) incl += t; }
        if (lane == 63) wt[wave] = incl;
        __syncthreads();
        float off = incl - run;
        for (int w = 0; w < wave; ++w) off += wt[w];
        float* dst = (prompt ? (float*)(a.ws + WS_BIASP) + (size_t)it * 4096 : (float*)(a.ws + WS_BIASS) + (size_t)(it - 32) * KVS) + i0;
        if (cnt == 8) { *(f32x4*)dst = (f32x4){-(off + v[0]) * LOG2E, -(off + v[1]) * LOG2E, -(off + v[2]) * LOG2E, -(off + v[3]) * LOG2E};
                        *(f32x4*)(dst + 4) = (f32x4){-(off + v[4]) * LOG2E, -(off + v[5]) * LOG2E, -(off + v[6]) * LOG2E, -(off + v[7]) * LOG2E}; }
        else if (cnt == 4) *(f32x4*)dst = (f32x4){-(off + v[0]) * LOG2E, -(off + v[1]) * LOG2E, -(off + v[2]) * LOG2E, -(off + v[3]) * LOG2E};
        __syncthreads();
    }
}

__device__ __forceinline__ void ssm_scan(const Args& a, int l, LAS unsigned char* lds, int wave, int lane, int c, int G) {
    const float* E = (const float*)(a.ws + WS_E); bf16_t* UA = (bf16_t*)(a.ws + WS_UA); const float* A16 = (const float*)(a.ws + WS_A16);
    LAS float* endst = (LAS float*)(lds);
    for (int it = c; it < 128; it += G) {
        const int b = it >> 5, gq = it & 31, p = lane;
        const float ar = A16[(l * 32 + gq) * 128 + p], ai = A16[(l * 32 + gq) * 128 + 64 + p];
        float er[32], ei[32];
        const int ch0 = b * 256 + wave * 32;
#pragma unroll
        for (int i = 0; i < 32; ++i) { const float* e = E + ((size_t)gq * CHP + ch0 + i) * 128; er[i] = e[p]; ei[i] = e[64 + p]; }
        float hr = 0.f, hi = 0.f;
#pragma unroll
        for (int i = 0; i < 32; ++i) { const float nr = ar * hr - ai * hi + er[i], ni = ar * hi + ai * hr + ei[i]; hr = nr; hi = ni; }
        endst[(wave * 2) * 64 + p] = hr; endst[(wave * 2 + 1) * 64 + p] = hi;
        float pr = ar, pi = ai;
#pragma unroll
        for (int s = 0; s < 5; ++s) { const float nr = pr * pr - pi * pi, ni = 2.f * pr * pi; pr = nr; pi = ni; }
        __syncthreads();
        hr = 0.f; hi = 0.f;
        for (int w = 0; w < wave; ++w) { const float xr = endst[(w * 2) * 64 + p], xi = endst[(w * 2 + 1) * 64 + p];
            const float nr = pr * hr - pi * hi + xr, ni = pr * hi + pi * hr + xi; hr = nr; hi = ni; }
#pragma unroll
        for (int i = 0; i < 32; ++i) { bf16_t* u = UA + ((size_t)gq * CHP + ch0 + i) * UAK + 256; u[p] = f2bf(hr); u[64 + p] = f2bf(hi);
            const float nr = ar * hr - ai * hi + er[i], ni = ar * hi + ai * hr + ei[i]; hr = nr; hi = ni; }
        if (wave == 7) { a.out[O_RP + (size_t)((l * 4 + b) * 32 + gq) * 64 + p] = hr; a.out[O_IP + (size_t)((l * 4 + b) * 32 + gq) * 64 + p] = hi; }
        __syncthreads();
    }
    for (int it = (G - 1 - c) * 8 + wave; it < 256; it += G * 8) {
        const int b = it >> 5, gq = it & 31, p = lane;
        const float ar = A16[(l * 32 + gq) * 128 + p], ai = A16[(l * 32 + gq) * 128 + 64 + p];
        float hr = INP(7)[(size_t)((l * 8 + b) * 32 + gq) * 64 + p], hi = INP(8)[(size_t)((l * 8 + b) * 32 + gq) * 64 + p];
        const int ch0 = 1024 + b * 4;
#pragma unroll
        for (int i = 0; i < 4; ++i) { const float* e = E + ((size_t)gq * CHP + ch0 + i) * 128; const float xr = e[p], xi = e[64 + p];
            bf16_t* u = UA + ((size_t)gq * CHP + ch0 + i) * UAK + 256; u[p] = f2bf(hr); u[64 + p] = f2bf(hi);
            const float nr = ar * hr - ai * hi + xr, ni = ar * hi + ai * hr + xi; hr = nr; hi = ni; }
        a.out[O_RS + (size_t)((l * 8 + b) * 32 + gq) * 64 + p] = hr; a.out[O_IS + (size_t)((l * 8 + b) * 32 + gq) * 64 + p] = hi;
    }
}

#define DPPMAX(v, ctrl) v = fmaxf(v, __int_as_float(__builtin_amdgcn_update_dpp(0, __float_as_int(v), ctrl, 0xF, 0xF, true)))
__device__ __forceinline__ float wave_max_nonneg(float v) {
    DPPMAX(v, 0xB1); DPPMAX(v, 0x4E); DPPMAX(v, 0x141); DPPMAX(v, 0x140);
    const float r0 = __int_as_float(__builtin_amdgcn_readlane(__float_as_int(v), 0)), r1 = __int_as_float(__builtin_amdgcn_readlane(__float_as_int(v), 16));
    const float r2 = __int_as_float(__builtin_amdgcn_readlane(__float_as_int(v), 32)), r3 = __int_as_float(__builtin_amdgcn_readlane(__float_as_int(v), 48));
    return fmaxf(fmaxf(r0, r1), fmaxf(r2, r3));
}
__device__ __forceinline__ void kmax_items(const Args& a, int lane, int gw, int NGW) {
    float* KM = (float*)(a.ws + WS_KMAX);
    for (int it = NGW - 1 - gw; it < 2048 + 1088; it += NGW) {
        const bf16_t* kp; int oidx;
        if (it < 2048) { const int bh = it >> 6, t = it & 63; kp = (const bf16_t*)(a.ws + WS_KP) + ((size_t)bh * 4096 + t * 64) * 64; oidx = it; }
        else { const int r = it - 2048, sq = r / 17, t = r - sq * 17; kp = (const bf16_t*)(a.ws + WS_KS) + ((size_t)sq * KVS + t * 64) * 64; oidx = (32 + sq) * 64 + t; }
        float ss = 0.f;
#pragma unroll
        for (int i = 0; i < 8; ++i) { const u32x4 w = *(const u32x4*)(kp + (size_t)lane * 64 + i * 8);
#pragma unroll
            for (int j = 0; j < 4; ++j) { const float lo = __uint_as_float(w[j] << 16), hi = __uint_as_float(w[j] & 0xffff0000u); ss += lo * lo + hi * hi; } }
        const float m = wave_max_nonneg(ss);
        if (lane == 0) KM[oidx] = sqrtf(m) * 1.001f;
    }
}
constexpr int AT_ROW = 144, AT_TILE = 64 * AT_ROW  , AT_KB = 0, AT_VB = 4 * AT_TILE, AT_BB = 8 * AT_TILE;
__device__ __forceinline__ void attn_tile(const LAS unsigned char* Kb, const LAS unsigned char* Vb, const LAS float* Bb, const bf16x8 (&qf)[4], f32x16& o0, f32x16& o1, float& lsum,
                                          float bq, int myq, int key0, bool domask, int ka_off, int va_off, int hi) {
    f32x16 s0, s1;
#pragma unroll
    for (int a2 = 0; a2 < 2; ++a2) { const f32x4 b0 = *(const LAS f32x4*)(Bb + a2 * 16 + hi * 8), b1 = *(const LAS f32x4*)(Bb + a2 * 16 + hi * 8 + 4);
        const f32x4 c0 = *(const LAS f32x4*)(Bb + 32 + a2 * 16 + hi * 8), c1 = *(const LAS f32x4*)(Bb + 32 + a2 * 16 + hi * 8 + 4);
#pragma unroll
        for (int j = 0; j < 4; ++j) { s0[a2 * 8 + j] = b0[j]; s0[a2 * 8 + 4 + j] = b1[j]; s1[a2 * 8 + j] = c0[j]; s1[a2 * 8 + 4 + j] = c1[j]; } }
#pragma unroll
    for (int ks = 0; ks < 4; ++ks) {
        const bf16x8 k0 = *(const LAS bf16x8*)(Kb + ka_off + ks * 32), k1 = *(const LAS bf16x8*)(Kb + 32 * AT_ROW + ka_off + ks * 32);
        s0 = __builtin_amdgcn_mfma_f32_32x32x16_bf16(k0, qf[ks], s0, 0, 0, 0);
        s1 = __builtin_amdgcn_mfma_f32_32x32x16_bf16(k1, qf[ks], s1, 0, 0, 0);
    }
    if (domask) {
#pragma unroll
        for (int r = 0; r < 16; ++r) { const int kj = key0 + 16 * (r >> 3) + 8 * hi + (r & 7);
            if (kj > myq) s0[r] = -INFINITY; if (kj + 32 > myq) s1[r] = -INFINITY; }
    }
    s0 = s0 - bq; s1 = s1 - bq;
#pragma unroll
    for (int r = 0; r < 16; ++r) { s0[r] = __builtin_amdgcn_exp2f(s0[r]); s1[r] = __builtin_amdgcn_exp2f(s1[r]); }
    { const f32x16 e = s0 + s1;
      const f32x8 e8 = __builtin_shufflevector(e, e, 0, 1, 2, 3, 4, 5, 6, 7) + __builtin_shufflevector(e, e, 8, 9, 10, 11, 12, 13, 14, 15);
      const f32x4 e4 = __builtin_shufflevector(e8, e8, 0, 1, 2, 3) + __builtin_shufflevector(e8, e8, 4, 5, 6, 7);
      lsum += (e4[0] + e4[1]) + (e4[2] + e4[3]); }
    bf16x8 pa[4];
#pragma unroll
    for (int a2 = 0; a2 < 2; ++a2) {
        u32x4 w0, w1;
        w0.x = cvt_pk_bf16(s0[a2 * 8 + 0], s0[a2 * 8 + 1]); w0.y = cvt_pk_bf16(s0[a2 * 8 + 2], s0[a2 * 8 + 3]); w0.z = cvt_pk_bf16(s0[a2 * 8 + 4], s0[a2 * 8 + 5]); w0.w = cvt_pk_bf16(s0[a2 * 8 + 6], s0[a2 * 8 + 7]);
        w1.x = cvt_pk_bf16(s1[a2 * 8 + 0], s1[a2 * 8 + 1]); w1.y = cvt_pk_bf16(s1[a2 * 8 + 2], s1[a2 * 8 + 3]); w1.z = cvt_pk_bf16(s1[a2 * 8 + 4], s1[a2 * 8 + 5]); w1.w = cvt_pk_bf16(s1[a2 * 8 + 6], s1[a2 * 8 + 7]);
        pa[a2] = __builtin_bit_cast(bf16x8, w0); pa[2 + a2] = __builtin_bit_cast(bf16x8, w1);
    }
#pragma unroll
    for (int kk = 0; kk < 4; ++kk) {
        const bf16x8 v0 = *(const LAS bf16x8*)(Vb + va_off + kk * 32), v1 = *(const LAS bf16x8*)(Vb + 32 * AT_ROW + va_off + kk * 32);
        o0 = __builtin_amdgcn_mfma_f32_32x32x16_bf16(v0, pa[kk], o0, 0, 0, 0);
        o1 = __builtin_amdgcn_mfma_f32_32x32x16_bf16(v1, pa[kk], o1, 0, 0, 0);
    }
}
__device__ __forceinline__ void attn_unit(LAS unsigned char* lds, const bf16_t* Qrow0, int h, int nrows, int qpos0, int NT,
                                          const bf16_t* Kp, const bf16_t* VTp, int vpitch, const float* biasp, const float* kmaxp, bf16_t* Orow0, int tid, int wave, int lane) {
    const int q = lane & 31, hi = lane >> 5;
    const bool active = wave * 32 < nrows;
    bf16x8 qf[4];
#pragma unroll
    for (int ks = 0; ks < 4; ++ks) qf[ks] = active ? *(const bf16x8*)(Qrow0 + (size_t)(wave * 32 + q) * 512 + h * 64 + ks * 16 + hi * 8) : (bf16x8){0, 0, 0, 0, 0, 0, 0, 0};
    f32x16 o0 = {}, o1 = {};
    float lsum = 0.f;
    const int myq = qpos0 + wave * 32 + q;
    const int wq_lo = qpos0 + wave * 32, wq_hi = wq_lo + 31;
    const float bq = active ? biasp[myq] : 0.f;
    const int NS = (NT + 1) >> 1;
    int s_first;
    { float ssq = 0.f;
#pragma unroll
      for (int ks = 0; ks < 4; ++ks)
#pragma unroll
          for (int e = 0; e < 8; ++e) { const float v = __uint_as_float(((unsigned)(unsigned short)qf[ks][e]) << 16); ssq += v * v; }
      ssq += bperm(ssq, lane ^ 32);
      const float wm = wave_max_nonneg(ssq);
      volatile LAS float* qm = (volatile LAS float*)(lds + 131072 + 512);
      volatile LAS int* tst = (volatile LAS int*)(lds + 131072 + 576);
      if (lane == 0) qm[wave] = wm;
      __syncthreads();
      if (wave == 0) {
          float m2 = 0.f;
#pragma unroll
          for (int w = 0; w < 8; ++w) m2 = fmaxf(m2, qm[w]);
          const float QN = sqrtf(m2) * 1.001f;
          bool fail = true;
          if (lane < NT) fail = !(QN * kmaxp[lane] + biasp[64 * lane + 63] - biasp[qpos0] < -160.f);
          const unsigned long long mask = __builtin_amdgcn_ballot_w64(fail);
          const int tfirst = mask ? (int)__builtin_ctzll(mask) : 0;
          if (lane == 0) tst[0] = tfirst >> 1;
      }
      __syncthreads();
      s_first = tst[0]; }
    const int krow = tid >> 3, kch = tid & 7;
    const bf16_t* kg = Kp + (size_t)tid * 8;
    const bf16_t* vg = VTp + (size_t)krow * vpitch + kch * 8;
    const int st_off = krow * AT_ROW + kch * 16;
    const int kap = (q & 19) | ((q & 4) << 1) | ((q & 8) >> 1);
    const int ka_off = kap * AT_ROW + hi * 16, va_off = q * AT_ROW + hi * 16;
    u32x4 kr0, kr1, vr0, vr1; f32x4 br = {0.f, 0.f, 0.f, 0.f};
    { const int tb = 2 * s_first; kr0 = *(const u32x4*)(kg + (size_t)tb * 4096); kr1 = *(const u32x4*)(kg + (size_t)(tb + 1) * 4096); vr0 = *(const u32x4*)(vg + tb * 64); vr1 = *(const u32x4*)(vg + (tb + 1) * 64); if (tid < 32) br = *(const f32x4*)(biasp + tb * 64 + tid * 4); }
    *(LAS u32x4*)(lds + AT_KB + st_off) = kr0; *(LAS u32x4*)(lds + AT_KB + AT_TILE + st_off) = kr1;
    *(LAS u32x4*)(lds + AT_VB + st_off) = vr0; *(LAS u32x4*)(lds + AT_VB + AT_TILE + st_off) = vr1; if (tid < 32) *(LAS f32x4*)(lds + AT_BB + tid * 16) = br;
    __syncthreads();
    for (int sidx = s_first; sidx < NS; ++sidx) {
        const int buf = (sidx - s_first) & 1, t0 = 2 * sidx;
        const bool more = sidx + 1 < NS;
        if (more) { kr0 = *(const u32x4*)(kg + (size_t)(t0 + 2) * 4096); kr1 = *(const u32x4*)(kg + (size_t)(t0 + 3) * 4096); vr0 = *(const u32x4*)(vg + (t0 + 2) * 64); vr1 = *(const u32x4*)(vg + (t0 + 3) * 64);
            if (tid < 32) br = *(const f32x4*)(biasp + (t0 + 2) * 64 + tid * 4); }
        if (active) {
            const LAS unsigned char* Kb = lds + AT_KB + buf * 2 * AT_TILE;
            const LAS unsigned char* Vb = lds + AT_VB + buf * 2 * AT_TILE;
            const LAS float* Bb = (const LAS float*)(lds + AT_BB + buf * 512);
            if (t0 * 64 <= wq_hi) attn_tile(Kb, Vb, Bb, qf, o0, o1, lsum, bq, myq, t0 * 64, t0 * 64 + 63 > wq_lo, ka_off, va_off, hi);
            if ((t0 + 1) * 64 <= wq_hi) attn_tile(Kb + AT_TILE, Vb + AT_TILE, Bb + 64, qf, o0, o1, lsum, bq, myq, (t0 + 1) * 64, (t0 + 1) * 64 + 63 > wq_lo, ka_off, va_off, hi);
        }
        if (more) { const int nb = buf ^ 1;
            *(LAS u32x4*)(lds + AT_KB + nb * 2 * AT_TILE + st_off) = kr0; *(LAS u32x4*)(lds + AT_KB + nb * 2 * AT_TILE + AT_TILE + st_off) = kr1;
            *(LAS u32x4*)(lds + AT_VB + nb * 2 * AT_TILE + st_off) = vr0; *(LAS u32x4*)(lds + AT_VB + nb * 2 * AT_TILE + AT_TILE + st_off) = vr1;
            if (tid < 32) *(LAS f32x4*)(lds + AT_BB + nb * 512 + tid * 16) = br; }
        __syncthreads();
    }
    if (active) {
        lsum += bperm(lsum, lane ^ 32);
        const float inv = 1.f / lsum;
        bf16_t* orow = Orow0 + (size_t)(wave * 32 + q) * 1024 + h * 64;
#pragma unroll
        for (int i = 0; i < 4; ++i) { u32x2 w0, w1;
            w0.x = cvt_pk_bf16(o0[4 * i] * inv, o0[4 * i + 1] * inv); w0.y = cvt_pk_bf16(o0[4 * i + 2] * inv, o0[4 * i + 3] * inv);
            w1.x = cvt_pk_bf16(o1[4 * i] * inv, o1[4 * i + 1] * inv); w1.y = cvt_pk_bf16(o1[4 * i + 2] * inv, o1[4 * i + 3] * inv);
            *(u32x2*)(orow + 8 * i + 4 * hi) = w0; *(u32x2*)(orow + 32 + 8 * i + 4 * hi) = w1; }
    }
}
__device__ __forceinline__ void attn_phase(const Args& a, int l, LAS unsigned char* lds, int tid, int wave, int lane) {
    const bf16_t* Q = (const bf16_t*)(a.ws + WS_Q); bf16_t* MIX = (bf16_t*)(a.ws + WS_MIX);
    unsigned* ctr = (unsigned*)(a.ws + WS_CTL) + 3600 + 64 * l;
    volatile LAS unsigned* slot = (volatile LAS unsigned*)(lds + 131072 + 256);
    for (;;) {
        if (tid == 0) slot[0] = __hip_atomic_fetch_add(ctr, 1u, __ATOMIC_RELAXED, __HIP_MEMORY_SCOPE_AGENT);
        __syncthreads();
        const int idx = (int)slot[0];
        __syncthreads();
        if (idx >= 576) break;
        if (idx < 512) { const int qb = 15 - (idx >> 5), bh = idx & 31, b = bh >> 3, h = bh & 7; const size_t row0 = (size_t)b * 4096 + qb * 256;
            attn_unit(lds, Q + row0 * 512, h, 256, qb * 256, 4 * qb + 4, (const bf16_t*)(a.ws + WS_KP) + (size_t)bh * 4096 * 64, (const bf16_t*)(a.ws + WS_VTP) + (size_t)bh * 64 * 4096, 4096,
                      (const float*)(a.ws + WS_BIASP) + (size_t)bh * 4096, (const float*)(a.ws + WS_KMAX) + bh * 64, MIX + row0 * 1024, tid, wave, lane); }
        else { const int sidx = idx - 512, b = sidx >> 3, h = sidx & 7;
            attn_unit(lds, Q + (size_t)(NPR + b * 64) * 512, h, 64, PAST, 17, (const bf16_t*)(a.ws + WS_KS) + (size_t)sidx * KVS * 64, (const bf16_t*)(a.ws + WS_VTS) + (size_t)sidx * 64 * KVS, KVS,
                      (const float*)(a.ws + WS_BIASS) + (size_t)sidx * KVS, (const float*)(a.ws + WS_KMAX) + (32 + sidx) * 64, MIX + (size_t)(NPR + b * 64) * 1024, tid, wave, lane); }
    }
}

#define XB_TMO      128
#define XB_XCNT(j)  (256  + 64 * (j))
#define XB_XSUB(j)  (1280 + 64 * (j))
#define XB_XGEN(j)  (2304 + 64 * (j))
#define XB_TOP      3328
#define XB_TOPGEN   3392
#define XCD_BAR_WORDS 3456
#define XB_SPIN_CAP (1u << 18)
__device__ __forceinline__ unsigned xb_ld(unsigned* p)              { return __hip_atomic_load(p, __ATOMIC_RELAXED, __HIP_MEMORY_SCOPE_AGENT); }
__device__ __forceinline__ unsigned xb_add(unsigned* p, unsigned v) { return __hip_atomic_fetch_add(p, v, __ATOMIC_RELAXED, __HIP_MEMORY_SCOPE_AGENT); }
__device__ __forceinline__ unsigned xb_xcc_id() { return (unsigned)__builtin_amdgcn_s_getreg((3 << 11) | 20) & 0xFu; }
#define XB_SPIN(cond, bar) do { unsigned _sp = 0; while (cond) { __builtin_amdgcn_s_sleep(1); \
    if ((++_sp & 255u) == 0u) { if (xb_ld(&(bar)[XB_TMO])) break; if (_sp > XB_SPIN_CAP) { atomicAdd(&(bar)[XB_TMO], 1u); break; } } } } while (0)
__device__ __forceinline__ void xcd_barrier_complete(unsigned* bar, unsigned x, unsigned G, unsigned& nloc, unsigned& nx) {
    unsigned sum, cnt, mine, sp = 0u;
    for (;;) {
        sum = 0u; cnt = 0u; mine = 0u;
#pragma unroll
        for (unsigned j = 0; j < 16; ++j) { const unsigned c = xb_ld(&bar[XB_XCNT(j)]); sum += c; cnt += (c > 0u) ? 1u : 0u; mine = (j == x) ? c : mine; }
        if (sum == G) break;
        __builtin_amdgcn_s_sleep(1);
        if ((++sp & 255u) == 0u) { if (xb_ld(&bar[XB_TMO])) break; if (sp > XB_SPIN_CAP) { atomicAdd(&bar[XB_TMO], 1u); break; } }
    }
    nloc = mine > 0u ? mine : 1u; nx = cnt > 0u ? cnt : 1u;
}
__device__ __forceinline__ void xcd_barrier(unsigned* bar, volatile LAS unsigned* st, bool leader, unsigned G) {
    asm volatile("s_waitcnt vmcnt(0)" ::: "memory");
    __syncthreads();
    if (leader) {
        const unsigned x = xb_xcc_id();
        __builtin_amdgcn_s_waitcnt(0);
        unsigned nloc = st[0], nx = st[1];
        if (nloc == 0u) { xcd_barrier_complete(bar, x, G, nloc, nx); st[0] = nloc; st[1] = nx; }
        const unsigned old = xb_add(&bar[XB_XSUB(x)], 1u);
        const unsigned gen = old / nloc;
        if (old + 1u == (gen + 1u) * nloc) {
            __builtin_amdgcn_fence(__ATOMIC_RELEASE, "agent");
            asm volatile("s_waitcnt vmcnt(0)" ::: "memory");
            const unsigned og = xb_add(&bar[XB_TOP], 1u);
            const unsigned tg = og / nx;
            if (og + 1u == (tg + 1u) * nx) xb_add(&bar[XB_TOPGEN], 1u);
            else XB_SPIN(xb_ld(&bar[XB_TOPGEN]) == tg, bar);
            __builtin_amdgcn_fence(__ATOMIC_ACQUIRE, "agent");
            xb_add(&bar[XB_XGEN(x)], 1u);
            asm volatile("s_waitcnt vmcnt(0)" ::: "memory");
        } else {
            XB_SPIN(xb_ld(&bar[XB_XGEN(x)]) == gen, bar);
            __builtin_amdgcn_fence(__ATOMIC_ACQUIRE, "agent");
            asm volatile("s_waitcnt vmcnt(0)" ::: "memory");
        }
    }
    __syncthreads();
}

constexpr int NS5 = 160, CW_SUB = 3520;
__device__ __forceinline__ void sub_barrier(unsigned* ctr, unsigned target, bool leader) {
    asm volatile("s_waitcnt vmcnt(0)" ::: "memory");
    __syncthreads();
    if (leader) {
        __builtin_amdgcn_fence(__ATOMIC_RELEASE, "agent");
        asm volatile("s_waitcnt vmcnt(0)" ::: "memory");
        (void)xb_add(ctr, 1u);
        unsigned sp = 0u;
        while (xb_ld(ctr) < target) { __builtin_amdgcn_s_sleep(1); if (++sp > (1u << 22)) break; }
        __builtin_amdgcn_fence(__ATOMIC_ACQUIRE, "agent");
        asm volatile("s_waitcnt vmcnt(0)" ::: "memory");
    }
    __syncthreads();
}
#undef INP
#define INP(i) (al.in[i])
typedef const __attribute__((address_space(4))) unsigned char* kptr_t;
__device__ __forceinline__ kptr_t opq_k(kptr_t p) { asm volatile("" : "+s"(p)); return p; }
__device__ __forceinline__ Args load_args(kptr_t kp) {
    typedef const __attribute__((address_space(4))) unsigned long long* q_t; q_t q = (q_t)kp; Args r;
#pragma unroll
    for (int i = 0; i < 30; ++i) r.in[i] = (const float*)q[i];
    r.out = (float*)q[30]; r.ws = (unsigned char*)q[31]; return r;
}
#define FRESH() const Args al = load_args(opq_k((kptr_t)__builtin_amdgcn_kernarg_segment_ptr())); unsigned char* ws = al.ws; \
    const int G = __builtin_amdgcn_readfirstlane(opq((int)gridDim.x)); const int NGW = G * 8; (void)NGW; \
    const int wave = __builtin_amdgcn_readfirstlane(opq(wave0)); const int c = __builtin_amdgcn_readfirstlane(opq((int)blockIdx.x)); const int gw = c * 8 + wave; \
    float* MOD = (float*)(ws + WS_MOD); float* X = (float*)(ws + WS_X); bf16_t* HM = (bf16_t*)(ws + WS_HM); bf16_t* F1 = (bf16_t*)(ws + WS_F1); bf16_t* MIX = (bf16_t*)(ws + WS_MIX); \
    (void)MOD; (void)X; (void)HM; (void)F1; (void)MIX; (void)gw;
#define LAYER_BODY(l) { \
        { FRESH(); PH(5) cumsum_items(al, l, lds, tid, wave, lane, c, G); } \
        PH(6) { FRESH(); pg8::Gemm g{HM, (const bf16_t*)(ws + WS_WIN) + (size_t)l * 1536 * 1024, MT, 1536, 1024, 1024, 1024, 1 << 20, 0, 512u, (const bf16_t*)(ws + WS_WV) + (size_t)l * 512 * 1024, HM}; \
          pg8::PhaseAOrder S; S.init(G, c); \
          EpiA E{EpiIn{(bf16_t*)(ws + WS_Q), (bf16_t*)(ws + WS_KP), (bf16_t*)(ws + WS_KS), (bf16_t*)(ws + WS_UA), al.out, l}, EpiVT{(bf16_t*)(ws + WS_VTP), (bf16_t*)(ws + WS_VTS), al.out, l, lds}, EpiVtPart{(float*)(ws + WS_F1)}}; \
          pg8::gemm_phase(lds, g, S, E, wave); } \
        GSYNC(); \
        { FRESH(); kmax_items(al, lane, gw, NGW); vt_finalize(al, l, lane, gw, NGW); } \
        GSYNC(); \
        if (INS5) { \
        PH(8) { FRESH(); pg8::Gemm g{(const bf16_t*)(ws + WS_UA), (const bf16_t*)(ws + WS_BT1) + (size_t)l * 32 * 128 * 256, NG * CHP, 256, 256, UAK, 256, 5, (size_t)128 * 256, 0u}; \
          pg8::StaticOrder S; S.init(NG * CHP, 256, NS5, c); \
          EpiE E{(float*)(ws + WS_E)}; \
          pg8::gemm_phase(lds, g, S, E, wave); } \
        SUBBAR((l) * 3 + 1); \
        { FRESH(); PH(9) ssm_scan(al, l, lds, wave, lane, c, NS5); } \
        SUBBAR((l) * 3 + 2); \
        PH(10) { FRESH(); pg8::Gemm g{(const bf16_t*)(ws + WS_UA), (const bf16_t*)(ws + WS_BT3) + (size_t)l * 32 * 256 * UAK, NG * CHP, 256, UAK, UAK, UAK, 5, (size_t)256 * UAK, 0u}; \
          pg8::StaticOrder S; S.init(NG * CHP, 256, NS5, c); \
          EpiZ E{(bf16_t*)(ws + WS_Z)}; \
          pg8::gemm_phase(lds, g, S, E, wave); } \
        SUBBAR((l) * 3 + 3); \
        PH(11) { FRESH(); pg8::Gemm g{(const bf16_t*)(ws + WS_Z), (const bf16_t*)(ws + WS_WGLU) + (size_t)l * 512 * 512, MT, 512, 512, 512, 512, 1 << 20, 0, 0u}; \
          pg8::StaticOrder S; S.init(MT, 512, NS5, c); \
          EpiGlu E{(const bf16_t*)(ws + WS_Z), MIX}; \
          pg8::gemm_phase(lds, g, S, E, wave); } \
        __syncthreads(); \
        } \
        { FRESH(); PH(12) attn_phase(al, l, lds, tid, wave, lane); } \
        GSYNC(); \
        PH(13) { FRESH(); pg8::Gemm g{MIX, (const bf16_t*)(ws + WS_WOUT) + (size_t)l * 1024 * 1024, MT, 1024, 1024, 1024, 1024, 1 << 20, 0, 256u}; \
          pg8::MainSplitOrder S; S.init(G, c, 8, 2); \
          EpiMS E{EpiPlain{F1, 1024}, EpiAtomic{(float*)(ws + WS_Q)}}; \
          pg8::gemm_phase(lds, g, S, E, wave); } \
        GSYNC(); \
        { FRESH(); const float* modl = MOD + (size_t)l * 12 * 6144; \
          PH(14) rowpass<8>(INP(0), INP(1), l == 0 ? (const bf16_t*)nullptr : (const bf16_t*)X, F1, (const float*)(ws + WS_Q), 8, modl + 2 * 1024, INP(12) + l * 1024, nullptr, (bf16_t*)X, \
                INP(13) + l * 1024, modl + 4 * 1024, modl + 3 * 1024, HM, nullptr, nullptr, al.out, 0, lane, gw, NGW); } \
        GSYNC(); \
        PH(15) { FRESH(); pg8::Gemm g{HM, (const bf16_t*)(ws + WS_WGU) + (size_t)l * 5632 * 1024, MT, 5632, 1024, 1024, 1024, 1 << 20, 0, 0u}; \
          pg8::StaticOrder S; S.init(MT, 5632, G, c); \
          EpiSwi E{(bf16_t*)(ws + WS_H)}; \
          pg8::gemm_phase(lds, g, S, E, wave); } \
        { FRESH(); if ((l) + 1 < NL && c >= 172) { __syncthreads(); p0_weights(al, (l) + 1, false, lds, wave, lane, (c - 172) * 8 + wave, (G - 172) * 8); } } \
        GSYNC(); \
        PH(16) { FRESH(); pg8::Gemm g{(const bf16_t*)(ws + WS_H), (const bf16_t*)(ws + WS_WD) + (size_t)l * 1024 * DFF, MT, 1024, DFF, DFF, DFF, 1 << 20, 0, 512u}; \
          pg8::MainSplitOrder S; S.init(G, c, 11, 4); \
          EpiMS E{EpiPlain{F1, 1024}, EpiAtomic{(float*)(ws + WS_FS2)}}; \
          pg8::gemm_phase(lds, g, S, E, wave); } \
        GSYNC(); \
        if (l + 1 < NL) { \
            { FRESH(); const float* modl = MOD + (size_t)l * 12 * 6144; const float* modn = MOD + (size_t)(l + 1) * 12 * 6144; \
              PH(17) rowpass<11>(INP(0), INP(1), (const bf16_t*)X, F1, (const float*)(ws + WS_FS2), 11, modl + 5 * 1024, INP(14) + l * 1024, nullptr, (bf16_t*)X, INP(11) + (l + 1) * 1024, modn + 1024, modn, HM, \
                    (const float*)(ws + WS_WG) + (size_t)(l + 1) * 8 * 1024, INP(16) + (l + 1) * 8, al.out, l + 1, lane, gw, NGW); \
              PH(1) cache_convert(al, l + 1, lds, wave, lane, gw, NGW); } \
            GSYNC(); \
        } else { \
            FRESH(); const float* modl = MOD + (size_t)l * 12 * 6144; \
            PH(18) rowpass<11>(INP(0), INP(1), (const bf16_t*)X, F1, (const float*)(ws + WS_FS2), 11, modl + 5 * 1024, INP(14) + l * 1024, al.out, nullptr, nullptr, nullptr, nullptr, nullptr, nullptr, nullptr, al.out, 0, lane, gw, NGW); \
        } \
    }
__global__ void __launch_bounds__(512, 2) mega(Args a) {
    extern __shared__ __attribute__((aligned(16))) unsigned char lds_raw[];
    LAS unsigned char* lds = (LAS unsigned char*)lds_raw;
    cg::grid_group grid = cg::this_grid();
    const int wave0 = __builtin_amdgcn_readfirstlane((int)threadIdx.x >> 6);
#define GSYNC() do { const Args alb = load_args(opq_k((kptr_t)__builtin_amdgcn_kernarg_segment_ptr())); \
        const int ln_ = (int)__builtin_amdgcn_mbcnt_hi(~0u, __builtin_amdgcn_mbcnt_lo(~0u, (unsigned)opq(0))); \
        xcd_barrier((unsigned*)(alb.ws + WS_CTL), (volatile LAS unsigned*)(lds + LDS_MISC), wave0 == 0 && ln_ == 0, (unsigned)gridDim.x); } while (0)
#define SUBBAR(seq) do { const Args alb = load_args(opq_k((kptr_t)__builtin_amdgcn_kernarg_segment_ptr())); \
        const int ln_ = (int)__builtin_amdgcn_mbcnt_hi(~0u, __builtin_amdgcn_mbcnt_lo(~0u, (unsigned)opq(0))); \
        xcd_barrier((unsigned*)(alb.ws + WS_CTL) + 4096, (volatile LAS unsigned*)(lds + LDS_MISC + 16), wave0 == 0 && ln_ == 0, (unsigned)NS5); } while (0)
#define INS5 (__builtin_amdgcn_readfirstlane(opq((int)blockIdx.x)) < NS5)
    if (threadIdx.x < 8) ((volatile LAS unsigned*)(lds + LDS_MISC))[threadIdx.x] = 0u;
    if (threadIdx.x == 0) (void)xb_add((unsigned*)(a.ws + WS_CTL) + XB_XCNT(xb_xcc_id()), 1u);
    if (threadIdx.x == 0 && blockIdx.x < NS5) (void)xb_add((unsigned*)(a.ws + WS_CTL) + 4096 + XB_XCNT(xb_xcc_id()), 1u);
    __syncthreads();
#define lane ((int)__builtin_amdgcn_mbcnt_hi(~0u, __builtin_amdgcn_mbcnt_lo(~0u, (unsigned)opq(0))))
#define tid (wave * 64 + lane)

    { FRESH();
      PH(0) p0_weights(al, 0, true, lds, wave, lane, gw, NGW);
      PH(1) cache_convert(al, 0, lds, wave, lane, gw, NGW);
      __syncthreads();
      PH(2) p0_adaln(al, lds, tid, wave, lane, c, G);
      PH(3) p0_ssm(al, lds, tid, (c + 128) % G, G); }
    grid.sync();
    { FRESH();
      PH(4) rowpass<0>(INP(0), INP(1), nullptr, nullptr, nullptr, 0, nullptr, nullptr, nullptr, nullptr, INP(11), MOD + 1024, MOD, HM, (const float*)(ws + WS_WG), INP(16), al.out, 0, lane, gw, NGW); }
    GSYNC();

    LAYER_BODY(0)
    LAYER_BODY(1)
    LAYER_BODY(2)
    LAYER_BODY(3)
}
#undef tid
#undef lane

extern "C" void kernel_launch(void* const* d_in, const int* in_sizes, int n_in, void* d_out, int out_size, void* d_ws, size_t ws_size, hipStream_t stream) {
    static int grid = 0;
    if (grid == 0) {
        if (n_in != 30 || (size_t)out_size != O_END || ws_size < WS_END) { fprintf(stderr, "kernel_launch: unexpected sizes n_in %d out %d ws %zu\n", n_in, out_size, ws_size); grid = -1; return; }
        int dev = 0, cus = 0, per_cu = 0;
        hipGetDevice(&dev); hipDeviceGetAttribute(&cus, hipDeviceAttributeMultiprocessorCount, dev);
        hipFuncSetAttribute((const void*)mega, hipFuncAttributeMaxDynamicSharedMemorySize, LDS_BYTES);
        hipOccupancyMaxActiveBlocksPerMultiprocessor(&per_cu, (const void*)mega, 512, LDS_BYTES);
        if (per_cu < 1) { fprintf(stderr, "kernel_launch: occupancy query reports %d blocks per CU\n", per_cu); grid = -1; return; }
        if (cus != 256) { fprintf(stderr, "kernel_launch: this build's static unit orders need 256 CUs (found %d)\n", cus); grid = -1; return; }
        grid = cus;
    }
    if (grid < 0) return;
    if (hipMemsetAsync((char*)d_ws + WS_CTL, 0, CTL_BYTES, stream) != hipSuccess) { fprintf(stderr, "kernel_launch: memset failed\n"); return; }
    Args a{};
    for (int i = 0; i < 30; ++i) a.in[i] = (const float*)d_in[i];
    a.out = (float*)d_out; a.ws = (unsigned char*)d_ws;
    void* args[] = {&a};
    hipError_t e = hipLaunchCooperativeKernel((const void*)mega, dim3(grid), dim3(512), args, LDS_BYTES, stream);
    if (e != hipSuccess) fprintf(stderr, "cooperative launch failed: %s (grid %d)\n", hipGetErrorString(e), grid);
}
```

```cpp
#include <hip/hip_runtime.h>
#include <hip/hip_cooperative_groups.h>
#include <cstdio>
#include <cstdint>
namespace cg = cooperative_groups;

#define LAS __attribute__((address_space(3)))
typedef unsigned short bf16_t;
typedef short bf16x8 __attribute__((ext_vector_type(8)));
typedef float f32x4 __attribute__((ext_vector_type(4)));
typedef float f32x16 __attribute__((ext_vector_type(16)));
typedef float f32x8 __attribute__((ext_vector_type(8)));
typedef unsigned u32x4 __attribute__((ext_vector_type(4)));
typedef unsigned u32x2 __attribute__((ext_vector_type(2)));

constexpr int DM = 1024, NPR = 16384, NSM = 512, MT = 16896, NL = 4, NH = 8, HD = 64;
constexpr int SEQ = 4096, PAST = 1024, DSEQ = 64, KVS = 1088, DFF = 2816, DIN = 2056;
constexpr int NG = 32, NP = 64, MG = 16, LC = 16, NCH = MT / LC  , CHP = 1280  , UAK = 384;
constexpr float C2 = 0.125f * 1.4426950408889634f, LOG2E = 1.4426950408889634f, EPS = 1e-6f;
constexpr size_t O_YP = 0, O_KP = 17301504, O_VP = 50855936, O_LP = 84410368, O_RP = 84934656, O_IP = 84967424,
                 O_KS = 85000192, O_VS = 86048768, O_LS = 87097344, O_RS = 87113728, O_IS = 87179264, O_END = 87244800;
constexpr size_t MiB = 1u << 20;
constexpr size_t WS_CTL = 1536 * 1024, CTL_BYTES = 32768;
constexpr int LDS_MISC = 131072 + 64;
constexpr size_t WS_MOD = 0, WS_WG = 2 * MiB, WS_A16 = 2 * MiB + 256 * 1024, WS_BIASP = 3 * MiB, WS_BIASS = 3 * MiB + 512 * 1024, WS_KMAX = 2 * MiB + 384 * 1024;
constexpr size_t WS_WIN = 4 * MiB, WS_WV = 16 * MiB, WS_WGLU = 20 * MiB, WS_WOUT = 22 * MiB, WS_WGU = 30 * MiB, WS_WD = 74 * MiB;
constexpr size_t WS_BT3 = 96 * MiB, WS_BT1 = 120 * MiB, WS_HM = 130 * MiB, WS_X = 164 * MiB, WS_F1 = 230 * MiB, WS_MIX = 264 * MiB;
constexpr size_t WS_Q = 298 * MiB, WS_KP = 315 * MiB, WS_VTP = 331 * MiB, WS_KS = 347 * MiB, WS_VTS = 356 * MiB, WS_UA = 365 * MiB,
                 WS_E = 395 * MiB, WS_Z = 415 * MiB, WS_H = 298 * MiB, WS_FS1 = 435 * MiB, WS_FS2 = 443 * MiB, WS_END = 465 * MiB;
constexpr int LDS_BYTES = 151552;
#ifndef PH_MASK
#define PH_MASK 0xffffffffu
#endif
#define PH(k) if (PH_MASK & (1u << (k)))

__device__ __forceinline__ unsigned cvt_pk_bf16(float lo, float hi) { unsigned r; asm volatile("v_cvt_pk_bf16_f32 %0, %1, %2" : "=v"(r) : "v"(lo), "v"(hi)); return r; }
__device__ __forceinline__ bf16_t f2bf(float f) { return (bf16_t)(cvt_pk_bf16(f, 0.f) & 0xffffu); }
__device__ __forceinline__ float bf2f(unsigned short b) { return __uint_as_float(((unsigned)b) << 16); }
__device__ __forceinline__ int opq(int x) { asm volatile("" : "+v"(x)); return x; }
__device__ __forceinline__ float bperm(float v, int srclane) { return __int_as_float(__builtin_amdgcn_ds_bpermute(srclane << 2, __float_as_int(v))); }
__device__ __forceinline__ float dpp_f(float v, const int ctrl) { return v; }
#define DPPADD(v, ctrl) v += __int_as_float(__builtin_amdgcn_update_dpp(0, __float_as_int(v), ctrl, 0xF, 0xF, true))
__device__ __forceinline__ float wave_sum(float v, int ln) {
    (void)ln;
    DPPADD(v, 0xB1);
    DPPADD(v, 0x4E);
    DPPADD(v, 0x141);
    DPPADD(v, 0x140);
    const float r0 = __int_as_float(__builtin_amdgcn_readlane(__float_as_int(v), 0)), r1 = __int_as_float(__builtin_amdgcn_readlane(__float_as_int(v), 16));
    const float r2 = __int_as_float(__builtin_amdgcn_readlane(__float_as_int(v), 32)), r3 = __int_as_float(__builtin_amdgcn_readlane(__float_as_int(v), 48));
    return (r0 + r1) + (r2 + r3);
}
__device__ __forceinline__ float sigm(float x) { return __builtin_amdgcn_rcpf(1.f + __builtin_amdgcn_exp2f(-1.4426950408889634f * x)); }
__device__ __forceinline__ float silu_f(float x) { return x * sigm(x); }
__device__ __forceinline__ float gelu_f(float x) { const float u = 0.7978845608028654f * (x + 0.044715f * x * x * x); return x * sigm(2.f * u); }
__device__ __forceinline__ float logsig(float x) { return fminf(x, 0.f) - log1pf(__expf(-fabsf(x))); }

namespace pg8 {
constexpr int BM = 256, BK = 64, HALF = 128, HTB = HALF * BK * 2, STAGE_BYTES = 8 * HTB, NXCD = 8, WGM = 8;
__host__ __device__ __forceinline__ int lds_byte(int r, int c) { const int st = (r >> 4) * 2 + (c >> 5), rr = r & 15, cc = c & 31, ob = rr * 64 + cc * 2; return st * 1024 + (ob ^ (((ob >> 9) & 1) << 5)); }
__host__ __device__ __forceinline__ void stage_rc(int b, int& R, int& C) { const int st = b / 1024, sb = b % 1024, swz = sb ^ (((sb >> 9) & 1) << 5); R = (st >> 1) * 16 + swz / 64; C = (st & 1) * 32 + (swz % 64) / 2; }
__host__ __device__ __forceinline__ int perm32(int rho) { const int n = rho >> 4, i = rho & 15; return 8 * (i >> 2) + 4 * n + (i & 3); }
struct Unit { int pm, pn, ks, kind, nt; };
struct Gemm { const bf16_t* A; const bf16_t* Bt; int M, N, K, lda, ldb, gdiv; size_t gstrideB; unsigned kcb; const bf16_t* A1; const bf16_t* Bt1; };
struct StaticOrder {
    int nM, nN, nwg, G, c;
    __device__ __forceinline__ void init(int M, int N, int G_, int c_) { nM = M / BM; nN = N / BM; nwg = nM * nN; G = G_; c = c_; }
    __device__ __forceinline__ bool next(int i, Unit& u) const {
        const long L = (long)i * G + c; if (L >= nwg) return false;
        int wgid = (int)L; { const int q = nwg / NXCD, r = nwg % NXCD, xcd = wgid % NXCD, off = wgid / NXCD; wgid = (xcd < r ? xcd * (q + 1) : r * (q + 1) + (xcd - r) * q) + off; }
        const int nig = WGM * nN, gid = wgid / nig, fm = gid * WGM, gsz = (nM - fm) < WGM ? (nM - fm) : WGM;
        u.pm = fm + ((wgid % nig) % gsz); u.pn = (wgid % nig) / gsz; u.ks = 0; u.kind = 0; u.nt = 0; return true;
    }
};
struct SplitOrder {
    int nsub, G, c, S;
    __device__ __forceinline__ void init(int S_, int G_, int c_) { S = S_; nsub = 8 * S_; G = G_; c = c_; }
    __device__ __forceinline__ bool next(int i, Unit& u) const { const int idx = i * G + c; if (idx >= nsub) return false; u.ks = idx % S; const int t = idx / S; u.pn = t & 3; u.pm = 64 + (t >> 2); u.kind = 0; u.nt = 0; return true; }
};
struct VtOrder {
    int idx;
    __device__ __forceinline__ void init(int G_, int c_) { idx = c_ - (G_ - 116); }
    __device__ __forceinline__ bool next(int i, Unit& u) const { if (i != 0 || idx < 0 || idx >= 116) return false; u.pm = idx / 58; u.pn = idx - u.pm * 58; u.ks = 0; u.kind = 0; u.nt = 0; return true; }
};
struct VtSplitOrder {
    int c;
    __device__ __forceinline__ void init(int c_) { c = c_; }
    __device__ __forceinline__ bool next(int i, Unit& u) const { if (i != 0 || c >= 64) return false; const int tile = c >> 2; u.ks = c & 3; u.pm = tile >> 3; u.pn = 58 + (tile & 7); u.kind = 0; u.nt = 0; return true; }
};
struct PhaseAOrder {
    StaticOrder so; int c;
    __device__ __forceinline__ void init(int G_, int c_) { so.init(MT, 1536, G_, c_); c = c_; }
    __device__ __forceinline__ bool next(int i, Unit& u) const {
        Unit t = {0, 0, 0, 0, 0}; bool ok = false;
        if (i <= 1) ok = so.next(i, t);
        int pm = t.pm, pn = t.pn, ks = 0, kind = 0, nt = 0;
        if (i == 1 && !ok) { const int idx = c - 140; ok = idx >= 0 && idx < 116; pm = idx / 58; pn = idx - pm * 58; kind = 1; nt = 16; }
        if (i == 2) { ok = c < 64; const int tile = c >> 2; ks = c & 3; pm = tile >> 3; pn = 58 + (tile & 7); kind = 1; nt = 4; }
        u.pm = pm; u.pn = pn; u.ks = ks; u.kind = kind; u.nt = nt;
        return ok;
    }
};
struct MainSplitOrder {
    StaticOrder so; int c, S, nts;
    __device__ __forceinline__ void init(int G_, int c_, int S_, int nts_) { so.init(NPR, 1024, G_, c_); c = c_; S = S_; nts = nts_; }
    __device__ __forceinline__ bool next(int i, Unit& u) const {
        Unit t = {0, 0, 0, 0, 0}; bool ok = false;
        if (i == 0) ok = so.next(0, t);
        int pm = t.pm, pn = t.pn, ks = 0, nt = 0;
        if (i == 1) { ok = c < 8 * S; ks = c % S; const int tt = c / S; pn = tt & 3; pm = 64 + (tt >> 2); nt = nts; }
        u.pm = pm; u.pn = pn; u.ks = ks; u.kind = 0; u.nt = nt;
        return ok;
    }
};
template <class Epi, class Sched>
__device__ __forceinline__ void gemm_phase(LAS unsigned char* lds, const Gemm g, const Sched& S, const Epi& E, const int wave_id) {
    const int lane = (int)__builtin_amdgcn_mbcnt_hi(~0u, __builtin_amdgcn_mbcnt_lo(~0u, (unsigned)opq(0))), wid = wave_id, tid = wid * 64 + lane, wr = wid >> 2, wc = wid & 3, fr = lane & 15, fq = lane >> 4;
    unsigned voffA[2], voffB[2];
#pragma unroll
    for (int i = 0; i < 2; ++i) { int R, C; stage_rc(tid * 16 + i * 8192, R, C); const int Rb = (R & ~31) + perm32(R & 31);
        voffA[i] = (unsigned)(R * g.lda + C) * 2u; voffB[i] = (unsigned)(Rb * g.ldb + C) * 2u; }
    const unsigned kstep = (unsigned)(BK * 2);
    const unsigned hstepA = (unsigned)HALF * g.lda * 2, hstepB = (unsigned)HALF * g.ldb * 2, tstepA = 2 * hstepA, tstepB = 2 * hstepB;
    const unsigned ldsw = (unsigned)wid * 1024u;
    const int aoff = lds_byte(wr * 64 + fr, fq * 8), boff = lds_byte(wc * 32 + fr, fq * 8);
#define PG8_SA(b, h) (((b) * 2 + (h)) * HTB)
#define PG8_SB(b, h) ((4 + (b) * 2 + (h)) * HTB)
#define PG8_STAGE(bufoff, gbase, voff) do { _Pragma("unroll") for (int _i = 0; _i < 2; ++_i) \
        __builtin_amdgcn_global_load_lds((const unsigned*)((const char*)(gbase) + (voff)[_i]), (LAS unsigned*)(lds + (bufoff) + ldsw + _i * 8192), 16, 0, 0); } while (0)
#define PG8_LDA(dst, b, h) do { _Pragma("unroll") for (int m = 0; m < 4; ++m) _Pragma("unroll") for (int k = 0; k < 2; ++k) dst[m][k] = *(const LAS bf16x8*)(lds + PG8_SA(b, h) + aoff + m * 2048 + k * 1024); } while (0)
#define PG8_LDB(dst, b, h) do { _Pragma("unroll") for (int n = 0; n < 2; ++n) _Pragma("unroll") for (int k = 0; k < 2; ++k) dst[n][k] = *(const LAS bf16x8*)(lds + PG8_SB(b, h) + boff + n * 2048 + k * 1024); } while (0)
#define PG8_MMA(ai, bj, At, Bt) do { __builtin_amdgcn_s_setprio(1); _Pragma("unroll") for (int m = 0; m < 4; ++m) _Pragma("unroll") for (int n = 0; n < 2; ++n) _Pragma("unroll") for (int k = 0; k < 2; ++k) \
        acc[ai][bj][m][n] = __builtin_amdgcn_mfma_f32_16x16x32_bf16(Bt[n][k], At[m][k], acc[ai][bj][m][n], 0, 0, 0); __builtin_amdgcn_s_setprio(0); } while (0)
#define PG8_WAIT_V(n) asm volatile("s_waitcnt vmcnt(" #n ")" ::: "memory")
#define PG8_WAIT_L(n) asm volatile("s_waitcnt lgkmcnt(" #n ")" ::: "memory")
#define PG8_BAR __builtin_amdgcn_s_barrier()
#define PG8_SCHED __builtin_amdgcn_sched_barrier(0)
    Unit cur = {0, 0, 0, 0, 0}, nxt = {0, 0, 0, 0, 0}; int ui = 0;
    if (!S.next(0, cur)) return;
    f32x4 acc[2][2][4][2];
    const float zf = __int_as_float(opq(0)); const f32x4 zero4 = (f32x4){zf, zf, zf, zf};
#pragma unroll
    for (int a = 0; a < 2; ++a)
#pragma unroll
        for (int b = 0; b < 2; ++b)
#pragma unroll
            for (int m = 0; m < 4; ++m)
#pragma unroll
                for (int n = 0; n < 2; ++n) acc[a][b][m][n] = zero4;
    bf16x8 At[4][2], B0[2][2], B1[2][2];
    const char* cA = (const char*)(cur.kind ? g.A1 : g.A) + (size_t)cur.pm * tstepA + (size_t)cur.ks * g.kcb;
    const char* cB = (const char*)(cur.kind ? g.Bt1 : g.Bt) + (size_t)(cur.pm / g.gdiv) * g.gstrideB * 2 + (size_t)cur.pn * tstepB + (size_t)cur.ks * g.kcb;
    int nt = cur.nt ? cur.nt : g.K / BK;
    PG8_STAGE(PG8_SB(0, 0), cB, voffB); PG8_STAGE(PG8_SB(0, 1), cB + hstepB, voffB); PG8_STAGE(PG8_SA(0, 0), cA, voffA); PG8_STAGE(PG8_SA(0, 1), cA + hstepA, voffA);
    if (wr == 1) PG8_BAR;
    PG8_WAIT_V(2); PG8_BAR;
    PG8_STAGE(PG8_SB(1, 0), cB + kstep, voffB); PG8_STAGE(PG8_SA(1, 0), cA + kstep, voffA); PG8_STAGE(PG8_SB(1, 1), cB + hstepB + kstep, voffB);
    PG8_WAIT_V(6); PG8_BAR;
    for (;;) {
        nxt.pm = 0; nxt.pn = 0; nxt.ks = 0; nxt.kind = 0; nxt.nt = 0;
        const bool has_next = S.next(ui + 1, nxt);
        const char* nA = has_next ? (const char*)(nxt.kind ? g.A1 : g.A) + (size_t)nxt.pm * tstepA + (size_t)nxt.ks * g.kcb : cA;
        const char* nB = has_next ? (const char*)(nxt.kind ? g.Bt1 : g.Bt) + (size_t)(nxt.pm / g.gdiv) * g.gstrideB * 2 + (size_t)nxt.pn * tstepB + (size_t)nxt.ks * g.kcb : cB;
#pragma unroll 1
        for (int t = 0; t < nt; t += 2) {
            const bool last = (t == nt - 2);
            const char* a1 = cA + (unsigned)(t + 1) * kstep;
            const char* a2 = last ? nA : cA + (unsigned)(t + 2) * kstep; const char* b2 = last ? nB : cB + (unsigned)(t + 2) * kstep;
            const char* a3 = a2 + kstep; const char* b3 = b2 + kstep;
            PG8_LDB(B0, 0, 0); PG8_LDB(B1, 0, 1); PG8_SCHED; PG8_LDA(At, 0, 0); PG8_STAGE(PG8_SA(1, 1), a1 + hstepA, voffA);
            PG8_WAIT_V(8); PG8_WAIT_L(0); PG8_BAR; PG8_MMA(0, 0, At, B0); PG8_MMA(0, 1, At, B1); PG8_BAR; PG8_SCHED;
            PG8_LDA(At, 0, 1); PG8_STAGE(PG8_SB(0, 0), b2, voffB); PG8_STAGE(PG8_SB(0, 1), b2 + hstepB, voffB); PG8_STAGE(PG8_SA(0, 0), a2, voffA);
            PG8_WAIT_V(8); PG8_WAIT_L(0); PG8_BAR; PG8_MMA(1, 0, At, B0); PG8_MMA(1, 1, At, B1); PG8_BAR; PG8_SCHED;
            PG8_LDB(B0, 1, 0); PG8_LDB(B1, 1, 1); PG8_SCHED; PG8_LDA(At, 1, 0); PG8_STAGE(PG8_SA(0, 1), a2 + hstepA, voffA);
            PG8_WAIT_V(8); PG8_WAIT_L(0); PG8_BAR; PG8_MMA(0, 0, At, B0); PG8_MMA(0, 1, At, B1); PG8_BAR; PG8_SCHED;
            PG8_LDA(At, 1, 1); PG8_STAGE(PG8_SB(1, 0), b3, voffB); PG8_STAGE(PG8_SB(1, 1), b3 + hstepB, voffB); PG8_STAGE(PG8_SA(1, 0), a3, voffA);
            PG8_WAIT_V(8); PG8_WAIT_L(0); PG8_BAR; PG8_MMA(1, 0, At, B0); PG8_MMA(1, 1, At, B1); PG8_BAR; PG8_SCHED;
        }
        if (wr == 0) PG8_BAR;
        E(acc, cur, wr, wc, fr, fq);
        if (!has_next) break;
#pragma unroll
        for (int a = 0; a < 2; ++a)
#pragma unroll
            for (int b = 0; b < 2; ++b)
#pragma unroll
                for (int m = 0; m < 4; ++m)
#pragma unroll
                    for (int n = 0; n < 2; ++n) acc[a][b][m][n] = zero4;
        cur = nxt; cA = nA; cB = nB; ++ui; nt = cur.nt ? cur.nt : g.K / BK;
        if (wr == 1) PG8_BAR;
    }
    PG8_WAIT_V(0);
    PG8_BAR;
#undef PG8_SA
#undef PG8_SB
#undef PG8_STAGE
#undef PG8_LDA
#undef PG8_LDB
#undef PG8_MMA
#undef PG8_WAIT_V
#undef PG8_WAIT_L
#undef PG8_BAR
#undef PG8_SCHED
}
}
using pg8::Unit;
typedef const f32x4 (&AccRef)[2][2][4][2];
__device__ __forceinline__ u32x4 pack8(f32x4 v0, f32x4 v1) { u32x4 w; w.x = cvt_pk_bf16(v0[0], v0[1]); w.y = cvt_pk_bf16(v0[2], v0[3]); w.z = cvt_pk_bf16(v1[0], v1[1]); w.w = cvt_pk_bf16(v1[2], v1[3]); return w; }

struct EpiPlain {
    bf16_t* O; int ldc;
    __device__ __forceinline__ void operator()(AccRef acc, const Unit& u, int wr, int wc, int fr, int fq) const {
        fr = opq(fr); fq = opq(fq);
#pragma unroll
        for (int ai = 0; ai < 2; ++ai)
#pragma unroll
            for (int m = 0; m < 4; ++m) { const int r = u.pm * 256 + ai * 128 + wr * 64 + m * 16 + fr;
#pragma unroll
                for (int bj = 0; bj < 2; ++bj) { const int c = u.pn * 256 + bj * 128 + wc * 32 + 8 * fq;
                    *(u32x4*)(O + (size_t)r * ldc + c) = pack8(acc[ai][bj][m][0], acc[ai][bj][m][1]); } }
    }
};
struct EpiIn {
    bf16_t *Q, *KP, *KS, *UA; float* out; int l;
    __device__ __forceinline__ void operator()(AccRef acc, const Unit& u, int wr, int wc, int fr, int fq) const {
        fr = opq(fr); fq = opq(fq);
        const bool prompt = u.pm < 64;
#pragma unroll
        for (int ai = 0; ai < 2; ++ai)
#pragma unroll
            for (int m = 0; m < 4; ++m) { const int r = u.pm * 256 + ai * 128 + wr * 64 + m * 16 + fr;
#pragma unroll
                for (int bj = 0; bj < 2; ++bj) { const int c = u.pn * 256 + bj * 128 + wc * 32 + 8 * fq;
                    const f32x4 v0 = acc[ai][bj][m][0], v1 = acc[ai][bj][m][1];
                    if (u.pn < 2) { *(u32x4*)(Q + (size_t)r * 512 + c) = pack8(v0 * C2, v1 * C2); }
                    else if (u.pn < 4) { const int ck = c - 512, h = ck >> 6, d = ck & 63; const u32x4 w = pack8(v0, v1);
                        if (prompt) { const int b = r >> 12, t = r & 4095;
                            *(u32x4*)(KP + ((size_t)(b * 8 + h) * 4096 + t) * 64 + d) = w;
                            float* o = out + O_KP + ((size_t)((l * 4 + b) * 8 + h) * 4096 + t) * 64 + d; *(f32x4*)o = v0; *(f32x4*)(o + 4) = v1; }
                        else { const int rr = r - NPR, b = rr >> 6, t = rr & 63;
                            *(u32x4*)(KS + ((size_t)(b * 8 + h) * KVS + PAST + t) * 64 + d) = w;
                            float* o = out + O_KS + ((size_t)((l * 8 + b) * 8 + h) * 64 + t) * 64 + d; *(f32x4*)o = v0; *(f32x4*)(o + 4) = v1; } }
                    else { const int cu = c - 1024, gq = cu >> 4, m0 = cu & 15, chunk = r >> 4, s = r & 15;
                        *(u32x4*)(UA + ((size_t)gq * CHP + chunk) * UAK + s * 16 + m0) = pack8(v0, v1); }
                    asm volatile("" ::: "memory"); } }
    }
};
struct EpiVT {
    bf16_t *VTP, *VTS; float* out; int l; LAS unsigned char* lds;
    __device__ __forceinline__ void operator()(AccRef acc, const Unit& u, int wr, int wc, int fr, int fq) const {
        fr = opq(fr); fq = opq(fq);
        const bool prompt = u.pn < 64; const int ln = fq * 16 + fr;
        LAS float* stg = (LAS float*)(lds + 131072 + 1024 + (wr * 4 + wc) * 2080);
#pragma unroll
        for (int ai = 0; ai < 2; ++ai)
#pragma unroll
            for (int bj = 0; bj < 2; ++bj) {
                const int h = (u.pm * 256 + ai * 128 + wr * 64) >> 6, tok0 = u.pn * 256 + bj * 128 + wc * 32;
                float* obase; bf16_t* vbase; size_t vpitch;
                if (prompt) { const int b = tok0 >> 12, t0 = tok0 & 4095; obase = out + O_VP + ((size_t)((l * 4 + b) * 8 + h) * 4096 + t0) * 64; vbase = VTP + (size_t)(b * 8 + h) * 64 * 4096 + t0; vpitch = 4096; }
                else { const int tt = tok0 - NPR, b = tt >> 6, t0 = tt & 63; obase = out + O_VS + ((size_t)((l * 8 + b) * 8 + h) * 64 + t0) * 64; vbase = VTS + (size_t)(b * 8 + h) * 64 * KVS + PAST + t0; vpitch = KVS; }
#pragma unroll
                for (int m = 0; m < 4; ++m) *(u32x4*)(vbase + (size_t)(m * 16 + fr) * vpitch + 8 * fq) = pack8(acc[ai][bj][m][0], acc[ai][bj][m][1]);
#pragma unroll
                for (int n = 0; n < 2; ++n)
#pragma unroll
                    for (int j0 = 0; j0 < 4; j0 += 2) {
#pragma unroll
                        for (int m = 0; m < 4; ++m) { stg[(2 * fq) * 65 + 16 * m + fr] = acc[ai][bj][m][n][j0]; stg[(2 * fq + 1) * 65 + 16 * m + fr] = acc[ai][bj][m][n][j0 + 1]; }
                        asm volatile("s_waitcnt lgkmcnt(0)" ::: "memory");
#pragma unroll
                        for (int sl = 0; sl < 8; ++sl) { const float v = stg[sl * 65 + ln]; obase[(size_t)(8 * (sl >> 1) + 4 * n + j0 + (sl & 1)) * 64 + ln] = v; }
                        asm volatile("s_waitcnt lgkmcnt(0)" ::: "memory");
                    }
            }
    }
};
struct EpiVtPart {
    float* PV;
    __device__ __forceinline__ void operator()(AccRef acc, const Unit& u, int wr, int wc, int fr, int fq) const {
        fr = opq(fr); fq = opq(fq);
        float* base = PV + (size_t)((u.pm * 8 + (u.pn - 58)) * 4 + u.ks) * 65536;
#pragma unroll
        for (int ai = 0; ai < 2; ++ai)
#pragma unroll
            for (int m = 0; m < 4; ++m) { const int r = ai * 128 + wr * 64 + m * 16 + fr;
#pragma unroll
                for (int bj = 0; bj < 2; ++bj) { float* o = base + r * 256 + bj * 128 + wc * 32 + 8 * fq; *(f32x4*)o = acc[ai][bj][m][0]; *(f32x4*)(o + 4) = acc[ai][bj][m][1]; } }
    }
};
struct EpiE {
    float* E;
    __device__ __forceinline__ void operator()(AccRef acc, const Unit& u, int wr, int wc, int fr, int fq) const {
        fr = opq(fr); fq = opq(fq);
#pragma unroll
        for (int ai = 0; ai < 2; ++ai)
#pragma unroll
            for (int m = 0; m < 4; ++m) { const int gq = u.pm / 5, chunk = (u.pm - gq * 5) * 256 + ai * 128 + wr * 64 + m * 16 + fr;
                { float* o = E + ((size_t)gq * CHP + chunk) * 128 + wc * 32 + 8 * fq; *(f32x4*)o = acc[ai][0][m][0]; *(f32x4*)(o + 4) = acc[ai][0][m][1]; } }
    }
};
struct EpiZ {
    bf16_t* Z;
    __device__ __forceinline__ void operator()(AccRef acc, const Unit& u, int wr, int wc, int fr, int fq) const {
        fr = opq(fr); fq = opq(fq);
#pragma unroll
        for (int ai = 0; ai < 2; ++ai)
#pragma unroll
            for (int m = 0; m < 4; ++m) { const int gq = u.pm / 5, chunk = (u.pm - gq * 5) * 256 + ai * 128 + wr * 64 + m * 16 + fr;
                {
#pragma unroll
                    for (int bj = 0; bj < 2; ++bj) { const int n = bj * 128 + wc * 32 + 8 * fq, t = n >> 4, m0 = n & 15;
                        f32x4 v0 = acc[ai][bj][m][0], v1 = acc[ai][bj][m][1];
#pragma unroll
                        for (int j = 0; j < 4; ++j) { v0[j] = gelu_f(v0[j]); v1[j] = gelu_f(v1[j]); }
                        *(u32x4*)(Z + (size_t)(chunk * 16 + t) * 512 + gq * 16 + m0) = pack8(v0, v1); __builtin_amdgcn_sched_barrier(0); } } }
    }
};
struct EpiGlu {
    const bf16_t* Z; bf16_t* MIX;
    __device__ __forceinline__ void operator()(AccRef acc, const Unit& u, int wr, int wc, int fr, int fq) const {
        fr = opq(fr); fq = opq(fq);
#pragma unroll
        for (int ai = 0; ai < 2; ++ai)
#pragma unroll
            for (int m = 0; m < 4; ++m) { const int r = u.pm * 256 + ai * 128 + wr * 64 + m * 16 + fr;
#pragma unroll
                for (int bj = 0; bj < 2; ++bj) { const int c = u.pn * 256 + bj * 128 + wc * 32 + 8 * fq;
                    const u32x4 zz = *(const u32x4*)(Z + (size_t)r * 512 + c);
                    f32x4 v0 = acc[ai][bj][m][0], v1 = acc[ai][bj][m][1];
#pragma unroll
                    for (int j = 0; j < 4; ++j) { const unsigned w0 = zz[j >> 1], w1 = zz[2 + (j >> 1)];
                        const float z0 = (j & 1) ? __uint_as_float(w0 & 0xffff0000u) : __uint_as_float(w0 << 16);
                        const float z1 = (j & 1) ? __uint_as_float(w1 & 0xffff0000u) : __uint_as_float(w1 << 16);
                        v0[j] = z0 * sigm(v0[j]); v1[j] = z1 * sigm(v1[j]); }
                    *(u32x4*)(MIX + (size_t)r * 1024 + 512 + c) = pack8(v0, v1); } }
    }
};
struct EpiAtomic {
    float* FS;
    __device__ __forceinline__ void operator()(AccRef acc, const Unit& u, int wr, int wc, int fr, int fq) const {
        fr = opq(fr); fq = opq(fq);
#pragma unroll
        for (int ai = 0; ai < 2; ++ai)
#pragma unroll
            for (int m = 0; m < 4; ++m) { const int r = (u.pm - 64) * 256 + ai * 128 + wr * 64 + m * 16 + fr;
#pragma unroll
                for (int bj = 0; bj < 2; ++bj) { float* o = FS + ((size_t)u.ks * 512 + r) * 1024 + u.pn * 256 + bj * 128 + wc * 32 + 8 * fq;
                    *(f32x4*)o = acc[ai][bj][m][0]; *(f32x4*)(o + 4) = acc[ai][bj][m][1]; } }
    }
};
struct EpiSwi {
    bf16_t* H;
    __device__ __forceinline__ void operator()(AccRef acc, const Unit& u, int wr, int wc, int fr, int fq) const {
        fr = opq(fr); fq = opq(fq);
#pragma unroll
        for (int ai = 0; ai < 2; ++ai)
#pragma unroll
            for (int m = 0; m < 4; ++m) { const int r = u.pm * 256 + ai * 128 + wr * 64 + m * 16 + fr; const int c = u.pn * 128 + wc * 32 + 8 * fq;
                f32x4 v0 = acc[ai][0][m][0], v1 = acc[ai][0][m][1]; const f32x4 u0 = acc[ai][1][m][0], u1 = acc[ai][1][m][1];
#pragma unroll
                for (int j = 0; j < 4; ++j) { v0[j] = silu_f(v0[j]) * u0[j]; v1[j] = silu_f(v1[j]) * u1[j]; }
                *(u32x4*)(H + (size_t)r * DFF + c) = pack8(v0, v1); }
    }
};

struct EpiA {
    EpiIn in; EpiVT vt; EpiVtPart vp;
    __device__ __forceinline__ void operator()(AccRef acc, const Unit& u, int wr, int wc, int fr, int fq) const {
        if (u.kind == 0) in(acc, u, wr, wc, fr, fq); else if (u.nt == 16) vt(acc, u, wr, wc, fr, fq); else vp(acc, u, wr, wc, fr, fq);
    }
};
struct EpiMS {
    EpiPlain p; EpiAtomic q;
    __device__ __forceinline__ void operator()(AccRef acc, const Unit& u, int wr, int wc, int fr, int fq) const {
        if (u.pm < 64) p(acc, u, wr, wc, fr, fq); else q(acc, u, wr, wc, fr, fq);
    }
};
struct Args { const float* in[30]; float* out; unsigned char* ws; };
struct Ctx {
    LAS unsigned char* lds; int tid, lane, wave, G, c;
    const float* const* in; float* out; unsigned char* ws;
};
#define INP(i) (a.in[i])

__device__ __forceinline__ void tr_item(const float* W, size_t ldw, int k0, int sc0, bf16_t* WT, size_t ldo, int dr0, LAS float* scr, int lane) {
    f32x4 tv[8];
#pragma unroll
    for (int i = 0; i < 8; ++i) { const int kk = 8 * i + (lane >> 3); tv[i] = *(const f32x4*)(W + (size_t)(k0 + kk) * ldw + sc0 + 4 * (lane & 7)); }
#pragma unroll
    for (int i = 0; i < 8; ++i) { const int kk = 8 * i + (lane >> 3); LAS float* d = scr + kk * 33 + 4 * (lane & 7); d[0] = tv[i][0]; d[1] = tv[i][1]; d[2] = tv[i][2]; d[3] = tv[i][3]; }
    asm volatile("s_waitcnt lgkmcnt(0)" ::: "memory");
    const int c = lane & 7;
#pragma unroll
    for (int j = 0; j < 4; ++j) { const int n = (lane >> 3) + 8 * j; const LAS float* s = scr + (8 * c) * 33 + n;
        u32x4 o; o.x = cvt_pk_bf16(s[0 * 33], s[1 * 33]); o.y = cvt_pk_bf16(s[2 * 33], s[3 * 33]); o.z = cvt_pk_bf16(s[4 * 33], s[5 * 33]); o.w = cvt_pk_bf16(s[6 * 33], s[7 * 33]);
        *(u32x4*)(WT + (size_t)(dr0 + n) * ldo + k0 + 8 * c) = o; }
    asm volatile("s_waitcnt lgkmcnt(0)" ::: "memory");
}

__device__ __forceinline__ void sincos_d(double x, double& s, double& c) {
    const double k = rint(x * 0.63661977236758134308);
    const double r = (x - k * 1.57079632679489655800) - k * 6.123233995736766036e-17;
    const double r2 = r * r;
    double sp = 1.0 / 6227020800.0; sp = sp * r2 - 1.0 / 39916800.0; sp = sp * r2 + 1.0 / 362880.0; sp = sp * r2 - 1.0 / 5040.0; sp = sp * r2 + 1.0 / 120.0; sp = sp * r2 - 1.0 / 6.0; sp = sp * r2 + 1.0;
    const double sr = r * sp;
    double cp = 1.0 / 87178291200.0; cp = cp * r2 - 1.0 / 479001600.0; cp = cp * r2 + 1.0 / 3628800.0; cp = cp * r2 - 1.0 / 40320.0; cp = cp * r2 + 1.0 / 720.0; cp = cp * r2 - 1.0 / 24.0; cp = cp * r2 + 0.5;
    const double cr = 1.0 - r2 * cp;
    const int q = ((int)k) & 3;
    s = (q == 0) ? sr : (q == 1) ? cr : (q == 2) ? -sr : -cr;
    c = (q == 0) ? cr : (q == 1) ? -sr : (q == 2) ? -cr : sr;
}

__device__ __forceinline__ void p0_weights(const Args& a, int lw, bool do_wg, LAS unsigned char* lds, int wave, int lane, int gw, int NGW) {
    LAS float* scr = (LAS float*)(lds + wave * 16384);
    constexpr int I_IN = 16 * 16, I_GLU = 8 * 16, I_OUT = 16 * 32, I_G = 16 * 88, I_D = 44 * 32;
    constexpr int PER_L = 4 * I_IN + I_GLU + I_OUT + 2 * I_G + I_D;
    for (int it = gw; it < PER_L; it += NGW) {
        const int l = lw; int r = it;
        const float* win = INP(15) + (size_t)l * DM * DIN;
        bf16_t* WIN = (bf16_t*)(a.ws + WS_WIN) + (size_t)l * 1536 * 1024;
        if (r < 4 * I_IN) { const int part = r / I_IN, rr = r % I_IN, kb = rr / 16, nb = rr % 16;
            if (part == 0) tr_item(win, DIN, 64 * kb, 32 * nb, WIN, 1024, 32 * nb, scr, lane);
            else if (part == 1) tr_item(win, DIN, 64 * kb, 512 + 32 * nb, WIN, 1024, 512 + 32 * nb, scr, lane);
            else if (part == 2) tr_item(win, DIN, 64 * kb, 1544 + 32 * nb, WIN, 1024, 1024 + 32 * nb, scr, lane);
            else tr_item(win, DIN, 64 * kb, 1024 + 32 * nb, (bf16_t*)(a.ws + WS_WV) + (size_t)l * 512 * 1024, 1024, 32 * nb, scr, lane);
            continue; }
        r -= 4 * I_IN;
        if (r < I_GLU) { tr_item(INP(25) + (size_t)l * 512 * 512, 512, 64 * (r / 16), 32 * (r % 16), (bf16_t*)(a.ws + WS_WGLU) + (size_t)l * 512 * 512, 512, 32 * (r % 16), scr, lane); continue; }
        r -= I_GLU;
        if (r < I_OUT) { tr_item(INP(26) + (size_t)l * 1024 * 1024, 1024, 64 * (r / 32), 32 * (r % 32), (bf16_t*)(a.ws + WS_WOUT) + (size_t)l * 1024 * 1024, 1024, 32 * (r % 32), scr, lane); continue; }
        r -= I_OUT;
        if (r < 2 * I_G) { const int up = r / I_G, rr = r % I_G, kb = rr / 88, nb = rr % 88, c0 = 32 * nb;
            tr_item(INP(27 + up) + (size_t)l * DM * DFF, DFF, 64 * kb, c0, (bf16_t*)(a.ws + WS_WGU) + (size_t)l * 5632 * 1024, 1024, (c0 >> 7) * 256 + up * 128 + (c0 & 127), scr, lane);
            continue; }
        r -= 2 * I_G;
        tr_item(INP(29) + (size_t)l * DFF * DM, DM, 64 * (r / 32), 32 * (r % 32), (bf16_t*)(a.ws + WS_WD) + (size_t)l * 1024 * DFF, DFF, 32 * (r % 32), scr, lane);
    }
    float* WG = (float*)(a.ws + WS_WG);
    if (do_wg) for (int i = gw * 64 + lane; i < NL * 8 * 1024; i += NGW * 64) { const int l = i >> 13, h = (i >> 10) & 7, k = i & 1023; WG[i] = INP(15)[((size_t)l * DM + k) * DIN + 1536 + h]; }
}
__device__ __forceinline__ void p0_adaln(const Args& a, LAS unsigned char* lds, int tid, int wave, int lane, int c, int G) {
    LAS float* sc = (LAS float*)(lds);
    LAS float* red = (LAS float*)(lds + 49152);
    for (int i = tid; i < 12 * 1024; i += 512) { const float v = (i < 4096) ? INP(2)[i] : INP(3)[i - 4096]; sc[i] = silu_f(v); }
    __syncthreads();
    float* MOD = (float*)(a.ws + WS_MOD);
    for (int it = c; it < NL * 96; it += G) {
        const int l = it / 96, n0 = (it % 96) * 64;
        const float* W = INP(9) + (size_t)l * DM * 6144 + n0 + lane;
        float acc[12];
#pragma unroll
        for (int b = 0; b < 12; ++b) acc[b] = 0.f;
        for (int k = wave * 128; k < wave * 128 + 128; k += 16) {
            float w[16];
#pragma unroll
            for (int j = 0; j < 16; ++j) w[j] = W[(size_t)(k + j) * 6144];
#pragma unroll
            for (int j = 0; j < 16; ++j)
#pragma unroll
                for (int b = 0; b < 12; ++b) acc[b] += sc[b * 1024 + k + j] * w[j];
        }
#pragma unroll
        for (int b = 0; b < 12; ++b) red[(wave * 12 + b) * 64 + lane] = acc[b];
        __syncthreads();
        for (int i = tid; i < 768; i += 512) { const int b = i >> 6, cc = i & 63; float s = 0.f;
#pragma unroll
            for (int w = 0; w < 8; ++w) s += red[(w * 12 + b) * 64 + cc];
            MOD[((size_t)l * 12 + b) * 6144 + n0 + cc] = s + INP(10)[(size_t)l * 6144 + n0 + cc]; }
        __syncthreads();
    }
}
__device__ __forceinline__ void p0_ssm(const Args& a, LAS unsigned char* lds, int tid, int c, int G) {
    LAS float* ap_re = (LAS float*)(lds + 65536);
    LAS float* ap_im = ap_re + 17 * 64;
    LAS float* bb_re = ap_im + 17 * 64;
    LAS float* bb_im = bb_re + 1024;
    LAS float* cc_re = bb_im + 1024;
    LAS float* cc_im = cc_re + 1024;
    LAS float* ktab = cc_im + 1024;
    for (int it = c; it < NL * NG; it += G) {
        const int l = it >> 5, gq = it & 31;
        const double dt = exp((double)INP(19)[l * 32 + gq]);
        for (int idx = tid; idx < 17 * 64; idx += 512) { const int d = idx >> 6, p = idx & 63;
            const double ar = (double)INP(17)[(l * 32 + gq) * 64 + p], ai = (double)INP(18)[(l * 32 + gq) * 64 + p];
            double s, co; sincos_d((double)d * ai * dt, s, co); const double er = exp((double)d * ar * dt);
            ap_re[idx] = (float)(er * co); ap_im[idx] = (float)(er * s); }
        for (int idx = tid; idx < 1024; idx += 512) { const int p = idx >> 4, m = idx & 15;
            const double ar = (double)INP(17)[(l * 32 + gq) * 64 + p], ai = (double)INP(18)[(l * 32 + gq) * 64 + p];
            double s, co; sincos_d(ai * dt, s, co); const double er = exp(ar * dt);
            const double xr = er * co - 1.0, xi = er * s, den = 1.0 / (ar * ar + ai * ai);
            const double qr = (xr * ar + xi * ai) * den, qi = (xi * ar - xr * ai) * den;
            const double br = (double)INP(20)[((size_t)(l * 32 + gq) * 64 + p) * 16 + m], bi = (double)INP(21)[((size_t)(l * 32 + gq) * 64 + p) * 16 + m];
            bb_re[idx] = (float)(qr * br - qi * bi); bb_im[idx] = (float)(qr * bi + qi * br);
            cc_re[idx] = INP(22)[(size_t)(l * 32 + gq) * 1024 + idx]; cc_im[idx] = INP(23)[(size_t)(l * 32 + gq) * 1024 + idx]; }
        __syncthreads();
        for (int idx = tid; idx < 4096; idx += 512) { const int d = idx >> 8, m = (idx >> 4) & 15, m2 = idx & 15; float s = 0.f;
            for (int p = 0; p < 64; ++p) { const float cr = cc_re[m * 64 + p], ci = cc_im[m * 64 + p], pr = ap_re[d * 64 + p], pi = ap_im[d * 64 + p];
                const float re = cr * pr - ci * pi, im = cr * pi + ci * pr; s += re * bb_re[p * 16 + m2] - im * bb_im[p * 16 + m2]; }
            if (d == 0 && m == m2) s += INP(24)[l * 512 + gq * 16 + m];
            ktab[idx] = s; }
        __syncthreads();
        bf16_t* BT3 = (bf16_t*)(a.ws + WS_BT3) + (size_t)(l * 32 + gq) * 256 * UAK;
        for (int grp = tid; grp < 256 * 48; grp += 512) { const int n = grp / 48, k0 = (grp % 48) * 8, t = n >> 4, m = n & 15; float v[8];
            if (k0 < 256) { const int s = k0 >> 4, m20 = k0 & 15;
#pragma unroll
                for (int j = 0; j < 8; ++j) v[j] = (s <= t) ? ktab[((t - s) * 16 + m) * 16 + m20 + j] : 0.f; }
            else { const int kk = k0 - 256, ri = kk >> 6, p0 = kk & 63;
#pragma unroll
                for (int j = 0; j < 8; ++j) { const int p = p0 + j; const float cr = cc_re[m * 64 + p], ci = cc_im[m * 64 + p], pr = ap_re[(t + 1) * 64 + p], pi = ap_im[(t + 1) * 64 + p];
                    v[j] = ri ? -(cr * pi + ci * pr) : (cr * pr - ci * pi); } }
            u32x4 w; w.x = cvt_pk_bf16(v[0], v[1]); w.y = cvt_pk_bf16(v[2], v[3]); w.z = cvt_pk_bf16(v[4], v[5]); w.w = cvt_pk_bf16(v[6], v[7]);
            *(u32x4*)(BT3 + (size_t)n * UAK + k0) = w; }
        bf16_t* BT1 = (bf16_t*)(a.ws + WS_BT1) + (size_t)(l * 32 + gq) * 128 * 256;
        for (int grp = tid; grp < 128 * 32; grp += 512) { const int n = grp >> 5, k0 = (grp & 31) * 8, s = k0 >> 4, m0 = k0 & 15, ri = n >> 6, p = n & 63; float v[8];
            const float pr = ap_re[(15 - s) * 64 + p], pi = ap_im[(15 - s) * 64 + p];
#pragma unroll
            for (int j = 0; j < 8; ++j) { const float br = bb_re[p * 16 + m0 + j], bi = bb_im[p * 16 + m0 + j]; v[j] = ri ? (pr * bi + pi * br) : (pr * br - pi * bi); }
            u32x4 w; w.x = cvt_pk_bf16(v[0], v[1]); w.y = cvt_pk_bf16(v[2], v[3]); w.z = cvt_pk_bf16(v[4], v[5]); w.w = cvt_pk_bf16(v[6], v[7]);
            *(u32x4*)(BT1 + (size_t)n * 256 + k0) = w; }
        if (tid < 64) { float* A16 = (float*)(a.ws + WS_A16) + (size_t)(l * 32 + gq) * 128; A16[tid] = ap_re[16 * 64 + tid]; A16[64 + tid] = ap_im[16 * 64 + tid]; }
        __syncthreads();
    }
}

__device__ __forceinline__ void cache_convert(const Args& a, int l, LAS unsigned char* lds, int wave, int lane, int gw, int NGW) {
    bf16_t* KS = (bf16_t*)(a.ws + WS_KS); bf16_t* VTS = (bf16_t*)(a.ws + WS_VTS);
    const float* ck = INP(4) + (size_t)l * 64 * PAST * 64; const float* cv = INP(5) + (size_t)l * 64 * PAST * 64;
    for (int i = gw * 64 + lane; i < 64 * PAST * 8; i += NGW * 64) {
        const int bh = i >> 13, rem = i & 8191;
        const f32x4 v0 = *(const f32x4*)(ck + (size_t)i * 8), v1 = *(const f32x4*)(ck + (size_t)i * 8 + 4);
        *(u32x4*)(KS + (size_t)bh * KVS * 64 + (size_t)rem * 8) = pack8(v0, v1); }
    LAS float* scr = (LAS float*)(lds + wave * 16384);
    for (int it = gw; it < 64 * 32; it += NGW) { const int bh = it >> 5, r = it & 31, kb = r >> 1, nb = r & 1;
        tr_item(cv + (size_t)bh * PAST * 64, 64, 64 * kb, 32 * nb, VTS + (size_t)bh * 64 * KVS, KVS, 32 * nb, scr, lane); }
}

template <int NSPLIT>
__device__ __forceinline__ void rowpass(const float* xsrc_p, const float* xsrc_s, const bf16_t* xsrc_b, const bf16_t* Fb, const float* FS, int nsplit, const float* gate, const float* wpost, float* xdst, bf16_t* xdst_b,
                                        const float* wpre, const float* sc, const float* sh, bf16_t* HMb, const float* WGl, const float* bfor, float* out, int lnext,
                                        int lane, int gw, int NGW) {
    f32x4 wg[8][4];
    if (WGl) {
#pragma unroll
        for (int h = 0; h < 8; ++h)
#pragma unroll
            for (int j = 0; j < 4; ++j) wg[h][j] = *(const f32x4*)(WGl + h * 1024 + 4 * lane + 256 * j);
    }
#define LOADX(dst, rr, xr, j) do { if (xsrc_b) { const u32x2 w_ = *(const u32x2*)(xsrc_b + (size_t)(rr) * DM + 4 * lane + 256 * (j)); \
        dst = (f32x4){__uint_as_float(w_.x << 16), __uint_as_float(w_.x & 0xffff0000u), __uint_as_float(w_.y << 16), __uint_as_float(w_.y & 0xffff0000u)}; } \
        else dst = *(const f32x4*)((xr) + 4 * lane + 256 * (j)); } while (0)
    for (int r = gw; r < MT; r += NGW) {
        const bool prompt = r < NPR; const int bm = prompt ? (r >> 12) : 4 + ((r - NPR) >> 6);
        f32x4 x[4]; u32x2 fw[4];
        { const float* xr = prompt ? xsrc_p + (size_t)r * DM : xsrc_s + (size_t)(r - NPR) * DM;
#pragma unroll
          for (int j = 0; j < 4; ++j) { LOADX(x[j], r, xr, j); fw[j] = (Fb && prompt) ? *(const u32x2*)(Fb + (size_t)r * DM + 4 * lane + 256 * j) : (u32x2){0u, 0u}; } }
        if (Fb) {
            f32x4 f[4]; float ss = 0.f;
#pragma unroll
            for (int j = 0; j < 4; ++j) {
                if (prompt) { const u32x2 w = fw[j];
                    f[j] = (f32x4){__uint_as_float(w.x << 16), __uint_as_float(w.x & 0xffff0000u), __uint_as_float(w.y << 16), __uint_as_float(w.y & 0xffff0000u)}; }
                else { const float* fp = FS + (size_t)(r - NPR) * DM + 4 * lane + 256 * j; f32x4 part[NSPLIT > 0 ? NSPLIT : 1];
#pragma unroll
                    for (int sp = 0; sp < NSPLIT; ++sp) part[sp] = *(const f32x4*)(fp + (size_t)sp * 512 * 1024);
                    f32x4 sacc = part[0];
#pragma unroll
                    for (int sp = 1; sp < NSPLIT; ++sp) sacc = sacc + part[sp];
                    f[j] = sacc; }
                ss += (f[j][0] * f[j][0] + f[j][1] * f[j][1]) + (f[j][2] * f[j][2] + f[j][3] * f[j][3]); }
            const float rstd = rsqrtf(wave_sum(ss, lane) * (1.f / DM) + EPS);
#pragma unroll
            for (int j = 0; j < 4; ++j) { const f32x4 gt = *(const f32x4*)(gate + (size_t)bm * 6144 + 4 * lane + 256 * j), wp = *(const f32x4*)(wpost + 4 * lane + 256 * j);
                x[j] = x[j] + gt * (f[j] * rstd * wp); }
        }
        if (xdst) {
#pragma unroll
            for (int j = 0; j < 4; ++j) *(f32x4*)(xdst + (size_t)r * DM + 4 * lane + 256 * j) = x[j];
        }
        if (xdst_b) {
#pragma unroll
            for (int j = 0; j < 4; ++j) { u32x2 w; w.x = cvt_pk_bf16(x[j][0], x[j][1]); w.y = cvt_pk_bf16(x[j][2], x[j][3]); *(u32x2*)(xdst_b + (size_t)r * DM + 4 * lane + 256 * j) = w;
                x[j] = (f32x4){__uint_as_float(w.x << 16), __uint_as_float(w.x & 0xffff0000u), __uint_as_float(w.y << 16), __uint_as_float(w.y & 0xffff0000u)}; }
        }
        if (wpre) {
            float ss = 0.f;
#pragma unroll
            for (int j = 0; j < 4; ++j) ss += (x[j][0] * x[j][0] + x[j][1] * x[j][1]) + (x[j][2] * x[j][2] + x[j][3] * x[j][3]);
            const float rstd = rsqrtf(wave_sum(ss, lane) * (1.f / DM) + EPS);
            f32x4 hm[4];
#pragma unroll
            for (int j = 0; j < 4; ++j) { const int cidx = 4 * lane + 256 * j;
                const f32x4 wv = *(const f32x4*)(wpre + cidx), s1 = *(const f32x4*)(sc + (size_t)bm * 6144 + cidx), s0 = *(const f32x4*)(sh + (size_t)bm * 6144 + cidx);
                hm[j] = (x[j] * rstd * wv) * (1.f + s1) + s0;
                u32x2 w; w.x = cvt_pk_bf16(hm[j][0], hm[j][1]); w.y = cvt_pk_bf16(hm[j][2], hm[j][3]);
                *(u32x2*)(HMb + (size_t)r * DM + cidx) = w; }
            if (WGl) {
                float mine = 0.f;
#pragma unroll
                for (int h = 0; h < 8; ++h) { float d = 0.f;
#pragma unroll
                    for (int j = 0; j < 4; ++j) { const f32x4 wv = wg[h][j]; d += (hm[j][0] * wv[0] + hm[j][1] * wv[1]) + (hm[j][2] * wv[2] + hm[j][3] * wv[3]); }
                    d = wave_sum(d, lane); if (lane == h) mine = d; }
                if (lane < 8) { const float lf = logsig(mine + bfor[lane]);
                    if (prompt) out[O_LP + ((size_t)((lnext * 4 + (r >> 12)) * 8 + lane)) * 4096 + (r & 4095)] = lf;
                    else { const int rr = r - NPR; out[O_LS + ((size_t)((lnext * 8 + (rr >> 6)) * 8 + lane)) * 64 + (rr & 63)] = lf; } }
            }
        }
    }
}

__device__ __forceinline__ void vt_finalize(const Args& a, int l, int lane, int gwi, int nw) {
    const float* PV = (const float*)(a.ws + WS_F1); bf16_t* VTP = (bf16_t*)(a.ws + WS_VTP); bf16_t* VTS = (bf16_t*)(a.ws + WS_VTS);
    for (int it = gwi; it < 16 * 128; it += nw) {
        const int tile = it >> 7, rem = it & 127, hb = rem >> 5, to = rem & 31, hdl = hb * 64 + lane, pm = tile >> 3, pn = 58 + (tile & 7);
        const int hd = pm * 256 + hdl, h = hd >> 6, d = hd & 63, tok = pn * 256 + to * 8;
        f32x4 v0 = {0.f, 0.f, 0.f, 0.f}, v1 = {0.f, 0.f, 0.f, 0.f};
#pragma unroll
        for (int ks = 0; ks < 4; ++ks) { const float* p = PV + ((size_t)(tile * 4 + ks) * 256 + hdl) * 256 + to * 8; v0 = v0 + *(const f32x4*)p; v1 = v1 + *(const f32x4*)(p + 4); }
        const u32x4 w = pack8(v0, v1);
        if (pn < 64) { const int b = tok >> 12, t = tok & 4095;
            *(u32x4*)(VTP + ((size_t)(b * 8 + h) * 64 + d) * 4096 + t) = w;
            float* o = a.out + O_VP + ((size_t)((l * 4 + b) * 8 + h) * 4096 + t) * 64 + d;
#pragma unroll
            for (int j = 0; j < 4; ++j) { o[(size_t)j * 64] = v0[j]; o[(size_t)(j + 4) * 64] = v1[j]; } }
        else { const int tt = tok - NPR, b = tt >> 6, t = tt & 63;
            *(u32x4*)(VTS + ((size_t)(b * 8 + h) * 64 + d) * KVS + PAST + t) = w;
            float* o = a.out + O_VS + ((size_t)((l * 8 + b) * 8 + h) * 64 + t) * 64 + d;
#pragma unroll
            for (int j = 0; j < 4; ++j) { o[(size_t)j * 64] = v0[j]; o[(size_t)(j + 4) * 64] = v1[j]; } }
    }
}
__device__ __forceinline__ void cumsum_items(const Args& a, int l, LAS unsigned char* lds, int tid, int wave, int lane, int c, int G) {
    LAS float* wt = (LAS float*)(lds);
    for (int it = c - 64; it >= 0 && it < 96; it += G) {
        const bool prompt = it < 32;
        float v[8]; float run = 0.f; int i0, cnt;
        if (prompt) { i0 = tid * 8; cnt = 8;
            const float* src = a.out + O_LP + (size_t)(l * 32 + it) * 4096 + i0;
            const f32x4 p0 = *(const f32x4*)src, p1 = *(const f32x4*)(src + 4);
            v[0] = p0[0]; v[1] = p0[1]; v[2] = p0[2]; v[3] = p0[3]; v[4] = p1[0]; v[5] = p1[1]; v[6] = p1[2]; v[7] = p1[3]; }
        else { const int sq = it - 32; i0 = tid * 4; cnt = tid < 272 ? 4 : 0;
            const float* src = tid < 256 ? INP(6) + (size_t)(l * 64 + sq) * PAST + i0 : a.out + O_LS + (size_t)(l * 64 + sq) * 64 + (tid < 272 ? i0 - PAST : 0);
            const f32x4 p0 = *(const f32x4*)src;
            v[0] = p0[0]; v[1] = p0[1]; v[2] = p0[2]; v[3] = p0[3]; v[4] = 0.f; v[5] = 0.f; v[6] = 0.f; v[7] = 0.f;
            if (tid >= 272) { v[0] = 0.f; v[1] = 0.f; v[2] = 0.f; v[3] = 0.f; } }
#pragma unroll
        for (int j = 0; j < 8; ++j) { run += v[j]; v[j] = run; }
        float incl = run;
#pragma unroll
        for (int o = 1; o < 64; o <<= 1) { const float t = bperm(incl, lane >= o ? lane - o : lane); if (lane >= o) incl += t; }
        if (lane == 63) wt[wave] = incl;
        __syncthreads();
        float off = incl - run;
        for (int w = 0; w < wave; ++w) off += wt[w];
        float* dst = (prompt ? (float*)(a.ws + WS_BIASP) + (size_t)it * 4096 : (float*)(a.ws + WS_BIASS) + (size_t)(it - 32) * KVS) + i0;
        if (cnt == 8) { *(f32x4*)dst = (f32x4){-(off + v[0]) * LOG2E, -(off + v[1]) * LOG2E, -(off + v[2]) * LOG2E, -(off + v[3]) * LOG2E};
                        *(f32x4*)(dst + 4) = (f32x4){-(off + v[4]) * LOG2E, -(off + v[5]) * LOG2E, -(off + v[6]) * LOG2E, -(off + v[7]) * LOG2E}; }
        else if (cnt == 4) *(f32x4*)dst = (f32x4){-(off + v[0]) * LOG2E, -(off + v[1]) * LOG2E, -(off + v[2]) * LOG2E, -(off + v[3]) * LOG2E};
        __syncthreads();
    }
}

__device__ __forceinline__ void ssm_scan(const Args& a, int l, LAS unsigned char* lds, int wave, int lane, int c, int G) {
    const float* E = (const float*)(a.ws + WS_E); bf16_t* UA = (bf16_t*)(a.ws + WS_UA); const float* A16 = (const float*)(a.ws + WS_A16);
    LAS float* endst = (LAS float*)(lds);
    for (int it = c; it < 128; it += G) {
        const int b = it >> 5, gq = it & 31, p = lane;
        const float ar = A16[(l * 32 + gq) * 128 + p], ai = A16[(l * 32 + gq) * 128 + 64 + p];
        float er[32], ei[32];
        const int ch0 = b * 256 + wave * 32;
#pragma unroll
        for (int i = 0; i < 32; ++i) { const float* e = E + ((size_t)gq * CHP + ch0 + i) * 128; er[i] = e[p]; ei[i] = e[64 + p]; }
        float hr = 0.f, hi = 0.f;
#pragma unroll
        for (int i = 0; i < 32; ++i) { const float nr = ar * hr - ai * hi + er[i], ni = ar * hi + ai * hr + ei[i]; hr = nr; hi = ni; }
        endst[(wave * 2) * 64 + p] = hr; endst[(wave * 2 + 1) * 64 + p] = hi;
        float pr = ar, pi = ai;
#pragma unroll
        for (int s = 0; s < 5; ++s) { const float nr = pr * pr - pi * pi, ni = 2.f * pr * pi; pr = nr; pi = ni; }
        __syncthreads();
        hr = 0.f; hi = 0.f;
        for (int w = 0; w < wave; ++w) { const float xr = endst[(w * 2) * 64 + p], xi = endst[(w * 2 + 1) * 64 + p];
            const float nr = pr * hr - pi * hi + xr, ni = pr * hi + pi * hr + xi; hr = nr; hi = ni; }
#pragma unroll
        for (int i = 0; i < 32; ++i) { bf16_t* u = UA + ((size_t)gq * CHP + ch0 + i) * UAK + 256; u[p] = f2bf(hr); u[64 + p] = f2bf(hi);
            const float nr = ar * hr - ai * hi + er[i], ni = ar * hi + ai * hr + ei[i]; hr = nr; hi = ni; }
        if (wave == 7) { a.out[O_RP + (size_t)((l * 4 + b) * 32 + gq) * 64 + p] = hr; a.out[O_IP + (size_t)((l * 4 + b) * 32 + gq) * 64 + p] = hi; }
        __syncthreads();
    }
    for (int it = (G - 1 - c) * 8 + wave; it < 256; it += G * 8) {
        const int b = it >> 5, gq = it & 31, p = lane;
        const float ar = A16[(l * 32 + gq) * 128 + p], ai = A16[(l * 32 + gq) * 128 + 64 + p];
        float hr = INP(7)[(size_t)((l * 8 + b) * 32 + gq) * 64 + p], hi = INP(8)[(size_t)((l * 8 + b) * 32 + gq) * 64 + p];
        const int ch0 = 1024 + b * 4;
#pragma unroll
        for (int i = 0; i < 4; ++i) { const float* e = E + ((size_t)gq * CHP + ch0 + i) * 128; const float xr = e[p], xi = e[64 + p];
            bf16_t* u = UA + ((size_t)gq * CHP + ch0 + i) * UAK + 256; u[p] = f2bf(hr); u[64 + p] = f2bf(hi);
            const float nr = ar * hr - ai * hi + xr, ni = ar * hi + ai * hr + xi; hr = nr; hi = ni; }
        a.out[O_RS + (size_t)((l * 8 + b) * 32 + gq) * 64 + p] = hr; a.out[O_IS + (size_t)((l * 8 + b) * 32 + gq) * 64 + p] = hi;
    }
}

#define DPPMAX(v, ctrl) v = fmaxf(v, __int_as_float(__builtin_amdgcn_update_dpp(0, __float_as_int(v), ctrl, 0xF, 0xF, true)))
__device__ __forceinline__ float wave_max_nonneg(float v) {
    DPPMAX(v, 0xB1); DPPMAX(v, 0x4E); DPPMAX(v, 0x141); DPPMAX(v, 0x140);
    const float r0 = __int_as_float(__builtin_amdgcn_readlane(__float_as_int(v), 0)), r1 = __int_as_float(__builtin_amdgcn_readlane(__float_as_int(v), 16));
    const float r2 = __int_as_float(__builtin_amdgcn_readlane(__float_as_int(v), 32)), r3 = __int_as_float(__builtin_amdgcn_readlane(__float_as_int(v), 48));
    return fmaxf(fmaxf(r0, r1), fmaxf(r2, r3));
}
__device__ __forceinline__ void kmax_items(const Args& a, int lane, int gw, int NGW) {
    float* KM = (float*)(a.ws + WS_KMAX);
    for (int it = NGW - 1 - gw; it < 2048 + 1088; it += NGW) {
        const bf16_t* kp; int oidx;
        if (it < 2048) { const int bh = it >> 6, t = it & 63; kp = (const bf16_t*)(a.ws + WS_KP) + ((size_t)bh * 4096 + t * 64) * 64; oidx = it; }
        else { const int r = it - 2048, sq = r / 17, t = r - sq * 17; kp = (const bf16_t*)(a.ws + WS_KS) + ((size_t)sq * KVS + t * 64) * 64; oidx = (32 + sq) * 64 + t; }
        float ss = 0.f;
#pragma unroll
        for (int i = 0; i < 8; ++i) { const u32x4 w = *(const u32x4*)(kp + (size_t)lane * 64 + i * 8);
#pragma unroll
            for (int j = 0; j < 4; ++j) { const float lo = __uint_as_float(w[j] << 16), hi = __uint_as_float(w[j] & 0xffff0000u); ss += lo * lo + hi * hi; } }
        const float m = wave_max_nonneg(ss);
        if (lane == 0) KM[oidx] = sqrtf(m) * 1.001f;
    }
}
constexpr int AT_ROW = 144, AT_TILE = 64 * AT_ROW  , AT_KB = 0, AT_VB = 4 * AT_TILE, AT_BB = 8 * AT_TILE;
__device__ __forceinline__ void attn_tile(const LAS unsigned char* Kb, const LAS unsigned char* Vb, const LAS float* Bb, const bf16x8 (&qf)[4], f32x16& o0, f32x16& o1, float& lsum,
                                          float bq, int myq, int key0, bool domask, int ka_off, int va_off, int hi) {
    f32x16 s0, s1;
#pragma unroll
    for (int a2 = 0; a2 < 2; ++a2) { const f32x4 b0 = *(const LAS f32x4*)(Bb + a2 * 16 + hi * 8), b1 = *(const LAS f32x4*)(Bb + a2 * 16 + hi * 8 + 4);
        const f32x4 c0 = *(const LAS f32x4*)(Bb + 32 + a2 * 16 + hi * 8), c1 = *(const LAS f32x4*)(Bb + 32 + a2 * 16 + hi * 8 + 4);
#pragma unroll
        for (int j = 0; j < 4; ++j) { s0[a2 * 8 + j] = b0[j]; s0[a2 * 8 + 4 + j] = b1[j]; s1[a2 * 8 + j] = c0[j]; s1[a2 * 8 + 4 + j] = c1[j]; } }
#pragma unroll
    for (int ks = 0; ks < 4; ++ks) {
        const bf16x8 k0 = *(const LAS bf16x8*)(Kb + ka_off + ks * 32), k1 = *(const LAS bf16x8*)(Kb + 32 * AT_ROW + ka_off + ks * 32);
        s0 = __builtin_amdgcn_mfma_f32_32x32x16_bf16(k0, qf[ks], s0, 0, 0, 0);
        s1 = __builtin_amdgcn_mfma_f32_32x32x16_bf16(k1, qf[ks], s1, 0, 0, 0);
    }
    if (domask) {
#pragma unroll
        for (int r = 0; r < 16; ++r) { const int kj = key0 + 16 * (r >> 3) + 8 * hi + (r & 7);
            if (kj > myq) s0[r] = -INFINITY; if (kj + 32 > myq) s1[r] = -INFINITY; }
    }
    s0 = s0 - bq; s1 = s1 - bq;
#pragma unroll
    for (int r = 0; r < 16; ++r) { s0[r] = __builtin_amdgcn_exp2f(s0[r]); s1[r] = __builtin_amdgcn_exp2f(s1[r]); }
    { const f32x16 e = s0 + s1;
      const f32x8 e8 = __builtin_shufflevector(e, e, 0, 1, 2, 3, 4, 5, 6, 7) + __builtin_shufflevector(e, e, 8, 9, 10, 11, 12, 13, 14, 15);
      const f32x4 e4 = __builtin_shufflevector(e8, e8, 0, 1, 2, 3) + __builtin_shufflevector(e8, e8, 4, 5, 6, 7);
      lsum += (e4[0] + e4[1]) + (e4[2] + e4[3]); }
    bf16x8 pa[4];
#pragma unroll
    for (int a2 = 0; a2 < 2; ++a2) {
        u32x4 w0, w1;
        w0.x = cvt_pk_bf16(s0[a2 * 8 + 0], s0[a2 * 8 + 1]); w0.y = cvt_pk_bf16(s0[a2 * 8 + 2], s0[a2 * 8 + 3]); w0.z = cvt_pk_bf16(s0[a2 * 8 + 4], s0[a2 * 8 + 5]); w0.w = cvt_pk_bf16(s0[a2 * 8 + 6], s0[a2 * 8 + 7]);
        w1.x = cvt_pk_bf16(s1[a2 * 8 + 0], s1[a2 * 8 + 1]); w1.y = cvt_pk_bf16(s1[a2 * 8 + 2], s1[a2 * 8 + 3]); w1.z = cvt_pk_bf16(s1[a2 * 8 + 4], s1[a2 * 8 + 5]); w1.w = cvt_pk_bf16(s1[a2 * 8 + 6], s1[a2 * 8 + 7]);
        pa[a2] = __builtin_bit_cast(bf16x8, w0); pa[2 + a2] = __builtin_bit_cast(bf16x8, w1);
    }
#pragma unroll
    for (int kk = 0; kk < 4; ++kk) {
        const bf16x8 v0 = *(const LAS bf16x8*)(Vb + va_off + kk * 32), v1 = *(const LAS bf16x8*)(Vb + 32 * AT_ROW + va_off + kk * 32);
        o0 = __builtin_amdgcn_mfma_f32_32x32x16_bf16(v0, pa[kk], o0, 0, 0, 0);
        o1 = __builtin_amdgcn_mfma_f32_32x32x16_bf16(v1, pa[kk], o1, 0, 0, 0);
    }
}
__device__ __forceinline__ void attn_unit(LAS unsigned char* lds, const bf16_t* Qrow0, int h, int nrows, int qpos0, int NT,
                                          const bf16_t* Kp, const bf16_t* VTp, int vpitch, const float* biasp, const float* kmaxp, bf16_t* Orow0, int tid, int wave, int lane) {
    const int q = lane & 31, hi = lane >> 5;
    const bool active = wave * 32 < nrows;
    bf16x8 qf[4];
#pragma unroll
    for (int ks = 0; ks < 4; ++ks) qf[ks] = active ? *(const bf16x8*)(Qrow0 + (size_t)(wave * 32 + q) * 512 + h * 64 + ks * 16 + hi * 8) : (bf16x8){0, 0, 0, 0, 0, 0, 0, 0};
    f32x16 o0 = {}, o1 = {};
    float lsum = 0.f;
    const int myq = qpos0 + wave * 32 + q;
    const int wq_lo = qpos0 + wave * 32, wq_hi = wq_lo + 31;
    const float bq = active ? biasp[myq] : 0.f;
    const int NS = (NT + 1) >> 1;
    int s_first;
    { float ssq = 0.f;
#pragma unroll
      for (int ks = 0; ks < 4; ++ks)
#pragma unroll
          for (int e = 0; e < 8; ++e) { const float v = __uint_as_float(((unsigned)(unsigned short)qf[ks][e]) << 16); ssq += v * v; }
      ssq += bperm(ssq, lane ^ 32);
      const float wm = wave_max_nonneg(ssq);
      volatile LAS float* qm = (volatile LAS float*)(lds + 131072 + 512);
      volatile LAS int* tst = (volatile LAS int*)(lds + 131072 + 576);
      if (lane == 0) qm[wave] = wm;
      __syncthreads();
      if (wave == 0) {
          float m2 = 0.f;
#pragma unroll
          for (int w = 0; w < 8; ++w) m2 = fmaxf(m2, qm[w]);
          const float QN = sqrtf(m2) * 1.001f;
          bool fail = true;
          if (lane < NT) fail = !(QN * kmaxp[lane] + biasp[64 * lane + 63] - biasp[qpos0] < -160.f);
          const unsigned long long mask = __builtin_amdgcn_ballot_w64(fail);
          const int tfirst = mask ? (int)__builtin_ctzll(mask) : 0;
          if (lane == 0) tst[0] = tfirst >> 1;
      }
      __syncthreads();
      s_first = tst[0]; }
    const int krow = tid >> 3, kch = tid & 7;
    const bf16_t* kg = Kp + (size_t)tid * 8;
    const bf16_t* vg = VTp + (size_t)krow * vpitch + kch * 8;
    const int st_off = krow * AT_ROW + kch * 16;
    const int kap = (q & 19) | ((q & 4) << 1) | ((q & 8) >> 1);
    const int ka_off = kap * AT_ROW + hi * 16, va_off = q * AT_ROW + hi * 16;
    u32x4 kr0, kr1, vr0, vr1; f32x4 br = {0.f, 0.f, 0.f, 0.f};
    { const int tb = 2 * s_first; kr0 = *(const u32x4*)(kg + (size_t)tb * 4096); kr1 = *(const u32x4*)(kg + (size_t)(tb + 1) * 4096); vr0 = *(const u32x4*)(vg + tb * 64); vr1 = *(const u32x4*)(vg + (tb + 1) * 64); if (tid < 32) br = *(const f32x4*)(biasp + tb * 64 + tid * 4); }
    *(LAS u32x4*)(lds + AT_KB + st_off) = kr0; *(LAS u32x4*)(lds + AT_KB + AT_TILE + st_off) = kr1;
    *(LAS u32x4*)(lds + AT_VB + st_off) = vr0; *(LAS u32x4*)(lds + AT_VB + AT_TILE + st_off) = vr1; if (tid < 32) *(LAS f32x4*)(lds + AT_BB + tid * 16) = br;
    __syncthreads();
    for (int sidx = s_first; sidx < NS; ++sidx) {
        const int buf = (sidx - s_first) & 1, t0 = 2 * sidx;
        const bool more = sidx + 1 < NS;
        if (more) { kr0 = *(const u32x4*)(kg + (size_t)(t0 + 2) * 4096); kr1 = *(const u32x4*)(kg + (size_t)(t0 + 3) * 4096); vr0 = *(const u32x4*)(vg + (t0 + 2) * 64); vr1 = *(const u32x4*)(vg + (t0 + 3) * 64);
            if (tid < 32) br = *(const f32x4*)(biasp + (t0 + 2) * 64 + tid * 4); }
        if (active) {
            const LAS unsigned char* Kb = lds + AT_KB + buf * 2 * AT_TILE;
            const LAS unsigned char* Vb = lds + AT_VB + buf * 2 * AT_TILE;
            const LAS float* Bb = (const LAS float*)(lds + AT_BB + buf * 512);
            if (t0 * 64 <= wq_hi) attn_tile(Kb, Vb, Bb, qf, o0, o1, lsum, bq, myq, t0 * 64, t0 * 64 + 63 > wq_lo, ka_off, va_off, hi);
            if ((t0 + 1) * 64 <= wq_hi) attn_tile(Kb + AT_TILE, Vb + AT_TILE, Bb + 64, qf, o0, o1, lsum, bq, myq, (t0 + 1) * 64, (t0 + 1) * 64 + 63 > wq_lo, ka_off, va_off, hi);
        }
        if (more) { const int nb = buf ^ 1;
            *(LAS u32x4*)(lds + AT_KB + nb * 2 * AT_TILE + st_off) = kr0; *(LAS u32x4*)(lds + AT_KB + nb * 2 * AT_TILE + AT_TILE + st_off) = kr1;
            *(LAS u32x4*)(lds + AT_VB + nb * 2 * AT_TILE + st_off) = vr0; *(LAS u32x4*)(lds + AT_VB + nb * 2 * AT_TILE + AT_TILE + st_off) = vr1;
            if (tid < 32) *(LAS f32x4*)(lds + AT_BB + nb * 512 + tid * 16) = br; }
        __syncthreads();
    }
    if (active) {
        lsum += bperm(lsum, lane ^ 32);
        const float inv = 1.f / lsum;
        bf16_t* orow = Orow0 + (size_t)(wave * 32 + q) * 1024 + h * 64;
#pragma unroll
        for (int i = 0; i < 4; ++i) { u32x2 w0, w1;
            w0.x = cvt_pk_bf16(o0[4 * i] * inv, o0[4 * i + 1] * inv); w0.y = cvt_pk_bf16(o0[4 * i + 2] * inv, o0[4 * i + 3] * inv);
            w1.x = cvt_pk_bf16(o1[4 * i] * inv, o1[4 * i + 1] * inv); w1.y = cvt_pk_bf16(o1[4 * i + 2] * inv, o1[4 * i + 3] * inv);
            *(u32x2*)(orow + 8 * i + 4 * hi) = w0; *(u32x2*)(orow + 32 + 8 * i + 4 * hi) = w1; }
    }
}
__device__ __forceinline__ void attn_phase(const Args& a, int l, LAS unsigned char* lds, int tid, int wave, int lane) {
    const bf16_t* Q = (const bf16_t*)(a.ws + WS_Q); bf16_t* MIX = (bf16_t*)(a.ws + WS_MIX);
    unsigned* ctr = (unsigned*)(a.ws + WS_CTL) + 3600 + 64 * l;
    volatile LAS unsigned* slot = (volatile LAS unsigned*)(lds + 131072 + 256);
    for (;;) {
        if (tid == 0) slot[0] = __hip_atomic_fetch_add(ctr, 1u, __ATOMIC_RELAXED, __HIP_MEMORY_SCOPE_AGENT);
        __syncthreads();
        const int idx = (int)slot[0];
        __syncthreads();
        if (idx >= 576) break;
        if (idx < 512) { const int qb = 15 - (idx >> 5), bh = idx & 31, b = bh >> 3, h = bh & 7; const size_t row0 = (size_t)b * 4096 + qb * 256;
            attn_unit(lds, Q + row0 * 512, h, 256, qb * 256, 4 * qb + 4, (const bf16_t*)(a.ws + WS_KP) + (size_t)bh * 4096 * 64, (const bf16_t*)(a.ws + WS_VTP) + (size_t)bh * 64 * 4096, 4096,
                      (const float*)(a.ws + WS_BIASP) + (size_t)bh * 4096, (const float*)(a.ws + WS_KMAX) + bh * 64, MIX + row0 * 1024, tid, wave, lane); }
        else { const int sidx = idx - 512, b = sidx >> 3, h = sidx & 7;
            attn_unit(lds, Q + (size_t)(NPR + b * 64) * 512, h, 64, PAST, 17, (const bf16_t*)(a.ws + WS_KS) + (size_t)sidx * KVS * 64, (const bf16_t*)(a.ws + WS_VTS) + (size_t)sidx * 64 * KVS, KVS,
                      (const float*)(a.ws + WS_BIASS) + (size_t)sidx * KVS, (const float*)(a.ws + WS_KMAX) + (32 + sidx) * 64, MIX + (size_t)(NPR + b * 64) * 1024, tid, wave, lane); }
    }
}

#define XB_TMO      128
#define XB_XCNT(j)  (256  + 64 * (j))
#define XB_XSUB(j)  (1280 + 64 * (j))
#define XB_XGEN(j)  (2304 + 64 * (j))
#define XB_TOP      3328
#define XB_TOPGEN   3392
#define XCD_BAR_WORDS 3456
#define XB_SPIN_CAP (1u << 18)
__device__ __forceinline__ unsigned xb_ld(unsigned* p)              { return __hip_atomic_load(p, __ATOMIC_RELAXED, __HIP_MEMORY_SCOPE_AGENT); }
__device__ __forceinline__ unsigned xb_add(unsigned* p, unsigned v) { return __hip_atomic_fetch_add(p, v, __ATOMIC_RELAXED, __HIP_MEMORY_SCOPE_AGENT); }
__device__ __forceinline__ unsigned xb_xcc_id() { return (unsigned)__builtin_amdgcn_s_getreg((3 << 11) | 20) & 0xFu; }
#define XB_SPIN(cond, bar) do { unsigned _sp = 0; while (cond) { __builtin_amdgcn_s_sleep(1); \
    if ((++_sp & 255u) == 0u) { if (xb_ld(&(bar)[XB_TMO])) break; if (_sp > XB_SPIN_CAP) { atomicAdd(&(bar)[XB_TMO], 1u); break; } } } } while (0)
__device__ __forceinline__ void xcd_barrier_complete(unsigned* bar, unsigned x, unsigned G, unsigned& nloc, unsigned& nx) {
    unsigned sum, cnt, mine, sp = 0u;
    for (;;) {
        sum = 0u; cnt = 0u; mine = 0u;
#pragma unroll
        for (unsigned j = 0; j < 16; ++j) { const unsigned c = xb_ld(&bar[XB_XCNT(j)]); sum += c; cnt += (c > 0u) ? 1u : 0u; mine = (j == x) ? c : mine; }
        if (sum == G) break;
        __builtin_amdgcn_s_sleep(1);
        if ((++sp & 255u) == 0u) { if (xb_ld(&bar[XB_TMO])) break; if (sp > XB_SPIN_CAP) { atomicAdd(&bar[XB_TMO], 1u); break; } }
    }
    nloc = mine > 0u ? mine : 1u; nx = cnt > 0u ? cnt : 1u;
}
__device__ __forceinline__ void xcd_barrier(unsigned* bar, volatile LAS unsigned* st, bool leader, unsigned G) {
    asm volatile("s_waitcnt vmcnt(0)" ::: "memory");
    __syncthreads();
    if (leader) {
        const unsigned x = xb_xcc_id();
        __builtin_amdgcn_s_waitcnt(0);
        unsigned nloc = st[0], nx = st[1];
        if (nloc == 0u) { xcd_barrier_complete(bar, x, G, nloc, nx); st[0] = nloc; st[1] = nx; }
        const unsigned old = xb_add(&bar[XB_XSUB(x)], 1u);
        const unsigned gen = old / nloc;
        if (old + 1u == (gen + 1u) * nloc) {
            __builtin_amdgcn_fence(__ATOMIC_RELEASE, "agent");
            asm volatile("s_waitcnt vmcnt(0)" ::: "memory");
            const unsigned og = xb_add(&bar[XB_TOP], 1u);
            const unsigned tg = og / nx;
            if (og + 1u == (tg + 1u) * nx) xb_add(&bar[XB_TOPGEN], 1u);
            else XB_SPIN(xb_ld(&bar[XB_TOPGEN]) == tg, bar);
            __builtin_amdgcn_fence(__ATOMIC_ACQUIRE, "agent");
            xb_add(&bar[XB_XGEN(x)], 1u);
            asm volatile("s_waitcnt vmcnt(0)" ::: "memory");
        } else {
            XB_SPIN(xb_ld(&bar[XB_XGEN(x)]) == gen, bar);
            __builtin_amdgcn_fence(__ATOMIC_ACQUIRE, "agent");
            asm volatile("s_waitcnt vmcnt(0)" ::: "memory");
        }
    }
    __syncthreads();
}

constexpr int NS5 = 160, CW_SUB = 3520;
__device__ __forceinline__ void sub_barrier(unsigned* ctr, unsigned target, bool leader) {
    asm volatile("s_waitcnt vmcnt(0)" ::: "memory");
    __syncthreads();
    if (leader) {
        __builtin_amdgcn_fence(__ATOMIC_RELEASE, "agent");
        asm volatile("s_waitcnt vmcnt(0)" ::: "memory");
        (void)xb_add(ctr, 1u);
        unsigned sp = 0u;
        while (xb_ld(ctr) < target) { __builtin_amdgcn_s_sleep(1); if (++sp > (1u << 22)) break; }
        __builtin_amdgcn_fence(__ATOMIC_ACQUIRE, "agent");
        asm volatile("s_waitcnt vmcnt(0)" ::: "memory");
    }
    __syncthreads();
}
#undef INP
#define INP(i) (al.in[i])
typedef const __attribute__((address_space(4))) unsigned char* kptr_t;
__device__ __forceinline__ kptr_t opq_k(kptr_t p) { asm volatile("" : "+s"(p)); return p; }
__device__ __forceinline__ Args load_args(kptr_t kp) {
    typedef const __attribute__((address_space(4))) unsigned long long* q_t; q_t q = (q_t)kp; Args r;
    typedef __attribute__((address_space(1))) const float* gcf_t; typedef __attribute__((address_space(1))) float* gf_t; typedef __attribute__((address_space(1))) unsigned char* gu8_t;
#pragma unroll
    for (int i = 0; i < 30; ++i) r.in[i] = (const float*)(gcf_t)q[i];
    r.out = (float*)(gf_t)q[30]; r.ws = (unsigned char*)(gu8_t)q[31]; return r;
}
#define FRESH() const Args al = load_args(opq_k((kptr_t)__builtin_amdgcn_kernarg_segment_ptr())); unsigned char* ws = al.ws; \
    const int G = __builtin_amdgcn_readfirstlane(opq((int)gridDim.x)); const int NGW = G * 8; (void)NGW; \
    const int wave = __builtin_amdgcn_readfirstlane(opq(wave0)); const int c = __builtin_amdgcn_readfirstlane(opq((int)blockIdx.x)); const int gw = c * 8 + wave; \
    float* MOD = (float*)(ws + WS_MOD); float* X = (float*)(ws + WS_X); bf16_t* HM = (bf16_t*)(ws + WS_HM); bf16_t* F1 = (bf16_t*)(ws + WS_F1); bf16_t* MIX = (bf16_t*)(ws + WS_MIX); \
    (void)MOD; (void)X; (void)HM; (void)F1; (void)MIX; (void)gw;
#define LAYER_BODY(l) { \
        { FRESH(); PH(5) cumsum_items(al, l, lds, tid, wave, lane, c, G); } \
        PH(6) { FRESH(); pg8::Gemm g{HM, (const bf16_t*)(ws + WS_WIN) + (size_t)l * 1536 * 1024, MT, 1536, 1024, 1024, 1024, 1 << 20, 0, 512u, (const bf16_t*)(ws + WS_WV) + (size_t)l * 512 * 1024, HM}; \
          pg8::PhaseAOrder S; S.init(G, c); \
          EpiA E{EpiIn{(bf16_t*)(ws + WS_Q), (bf16_t*)(ws + WS_KP), (bf16_t*)(ws + WS_KS), (bf16_t*)(ws + WS_UA), al.out, l}, EpiVT{(bf16_t*)(ws + WS_VTP), (bf16_t*)(ws + WS_VTS), al.out, l, lds}, EpiVtPart{(float*)(ws + WS_F1)}}; \
          pg8::gemm_phase(lds, g, S, E, wave); } \
        GSYNC(); \
        { FRESH(); kmax_items(al, lane, gw, NGW); vt_finalize(al, l, lane, gw, NGW); } \
        GSYNC(); \
        if (INS5) { \
        PH(8) { FRESH(); pg8::Gemm g{(const bf16_t*)(ws + WS_UA), (const bf16_t*)(ws + WS_BT1) + (size_t)l * 32 * 128 * 256, NG * CHP, 256, 256, UAK, 256, 5, (size_t)128 * 256, 0u}; \
          pg8::StaticOrder S; S.init(NG * CHP, 256, NS5, c); \
          EpiE E{(float*)(ws + WS_E)}; \
          pg8::gemm_phase(lds, g, S, E, wave); } \
        SUBBAR((l) * 3 + 1); \
        { FRESH(); PH(9) ssm_scan(al, l, lds, wave, lane, c, NS5); } \
        SUBBAR((l) * 3 + 2); \
        PH(10) { FRESH(); pg8::Gemm g{(const bf16_t*)(ws + WS_UA), (const bf16_t*)(ws + WS_BT3) + (size_t)l * 32 * 256 * UAK, NG * CHP, 256, UAK, UAK, UAK, 5, (size_t)256 * UAK, 0u}; \
          pg8::StaticOrder S; S.init(NG * CHP, 256, NS5, c); \
          EpiZ E{(bf16_t*)(ws + WS_Z)}; \
          pg8::gemm_phase(lds, g, S, E, wave); } \
        SUBBAR((l) * 3 + 3); \
        PH(11) { FRESH(); pg8::Gemm g{(const bf16_t*)(ws + WS_Z), (const bf16_t*)(ws + WS_WGLU) + (size_t)l * 512 * 512, MT, 512, 512, 512, 512, 1 << 20, 0, 0u}; \
          pg8::StaticOrder S; S.init(MT, 512, NS5, c); \
          EpiGlu E{(const bf16_t*)(ws + WS_Z), MIX}; \
          pg8::gemm_phase(lds, g, S, E, wave); } \
        __syncthreads(); \
        } \
        { FRESH(); PH(12) attn_phase(al, l, lds, tid, wave, lane); } \
        GSYNC(); \
        PH(13) { FRESH(); pg8::Gemm g{MIX, (const bf16_t*)(ws + WS_WOUT) + (size_t)l * 1024 * 1024, MT, 1024, 1024, 1024, 1024, 1 << 20, 0, 256u}; \
          pg8::MainSplitOrder S; S.init(G, c, 8, 2); \
          EpiMS E{EpiPlain{F1, 1024}, EpiAtomic{(float*)(ws + WS_Q)}}; \
          pg8::gemm_phase(lds, g, S, E, wave); } \
        GSYNC(); \
        { FRESH(); const float* modl = MOD + (size_t)l * 12 * 6144; \
          PH(14) rowpass<8>(INP(0), INP(1), l == 0 ? (const bf16_t*)nullptr : (const bf16_t*)X, F1, (const float*)(ws + WS_Q), 8, modl + 2 * 1024, INP(12) + l * 1024, nullptr, (bf16_t*)X, \
                INP(13) + l * 1024, modl + 4 * 1024, modl + 3 * 1024, HM, nullptr, nullptr, al.out, 0, lane, gw, NGW); } \
        GSYNC(); \
        PH(15) { FRESH(); pg8::Gemm g{HM, (const bf16_t*)(ws + WS_WGU) + (size_t)l * 5632 * 1024, MT, 5632, 1024, 1024, 1024, 1 << 20, 0, 0u}; \
          pg8::StaticOrder S; S.init(MT, 5632, G, c); \
          EpiSwi E{(bf16_t*)(ws + WS_H)}; \
          pg8::gemm_phase(lds, g, S, E, wave); } \
        { FRESH(); if ((l) + 1 < NL && c >= 172) { __syncthreads(); p0_weights(al, (l) + 1, false, lds, wave, lane, (c - 172) * 8 + wave, (G - 172) * 8); } } \
        GSYNC(); \
        PH(16) { FRESH(); pg8::Gemm g{(const bf16_t*)(ws + WS_H), (const bf16_t*)(ws + WS_WD) + (size_t)l * 1024 * DFF, MT, 1024, DFF, DFF, DFF, 1 << 20, 0, 512u}; \
          pg8::MainSplitOrder S; S.init(G, c, 11, 4); \
          EpiMS E{EpiPlain{F1, 1024}, EpiAtomic{(float*)(ws + WS_FS2)}}; \
          pg8::gemm_phase(lds, g, S, E, wave); } \
        GSYNC(); \
        if (l + 1 < NL) { \
            { FRESH(); const float* modl = MOD + (size_t)l * 12 * 6144; const float* modn = MOD + (size_t)(l + 1) * 12 * 6144; \
              PH(17) rowpass<11>(INP(0), INP(1), (const bf16_t*)X, F1, (const float*)(ws + WS_FS2), 11, modl + 5 * 1024, INP(14) + l * 1024, nullptr, (bf16_t*)X, INP(11) + (l + 1) * 1024, modn + 1024, modn, HM, \
                    (const float*)(ws + WS_WG) + (size_t)(l + 1) * 8 * 1024, INP(16) + (l + 1) * 8, al.out, l + 1, lane, gw, NGW); \
              PH(1) cache_convert(al, l + 1, lds, wave, lane, gw, NGW); } \
            GSYNC(); \
        } else { \
            FRESH(); const float* modl = MOD + (size_t)l * 12 * 6144; \
            PH(18) rowpass<11>(INP(0), INP(1), (const bf16_t*)X, F1, (const float*)(ws + WS_FS2), 11, modl + 5 * 1024, INP(14) + l * 1024, al.out, nullptr, nullptr, nullptr, nullptr, nullptr, nullptr, nullptr, al.out, 0, lane, gw, NGW); \
        } \
    }
__global__ void __launch_bounds__(512, 2) mega(Args a) {
    extern __shared__ __attribute__((aligned(16))) unsigned char lds_raw[];
    LAS unsigned char* lds = (LAS unsigned char*)lds_raw;
    cg::grid_group grid = cg::this_grid();
    const int wave0 = __builtin_amdgcn_readfirstlane((int)threadIdx.x >> 6);
#define GSYNC() do { const Args alb = load_args(opq_k((kptr_t)__builtin_amdgcn_kernarg_segment_ptr())); \
        const int ln_ = (int)__builtin_amdgcn_mbcnt_hi(~0u, __builtin_amdgcn_mbcnt_lo(~0u, (unsigned)opq(0))); \
        xcd_barrier((unsigned*)(alb.ws + WS_CTL), (volatile LAS unsigned*)(lds + LDS_MISC), wave0 == 0 && ln_ == 0, (unsigned)gridDim.x); } while (0)
#define SUBBAR(seq) do { const Args alb = load_args(opq_k((kptr_t)__builtin_amdgcn_kernarg_segment_ptr())); \
        const int ln_ = (int)__builtin_amdgcn_mbcnt_hi(~0u, __builtin_amdgcn_mbcnt_lo(~0u, (unsigned)opq(0))); \
        xcd_barrier((unsigned*)(alb.ws + WS_CTL) + 4096, (volatile LAS unsigned*)(lds + LDS_MISC + 16), wave0 == 0 && ln_ == 0, (unsigned)NS5); } while (0)
#define INS5 (__builtin_amdgcn_readfirstlane(opq((int)blockIdx.x)) < NS5)
    if (threadIdx.x < 8) ((volatile LAS unsigned*)(lds + LDS_MISC))[threadIdx.x] = 0u;
    if (threadIdx.x == 0) (void)xb_add((unsigned*)(a.ws + WS_CTL) + XB_XCNT(xb_xcc_id()), 1u);
    if (threadIdx.x == 0 && blockIdx.x < NS5) (void)xb_add((unsigned*)(a.ws + WS_CTL) + 4096 + XB_XCNT(xb_xcc_id()), 1u);
    __syncthreads();
#define lane ((int)__builtin_amdgcn_mbcnt_hi(~0u, __builtin_amdgcn_mbcnt_lo(~0u, (unsigned)opq(0))))
#define tid (wave * 64 + lane)

    { FRESH();
      PH(0) p0_weights(al, 0, true, lds, wave, lane, gw, NGW);
      PH(1) cache_convert(al, 0, lds, wave, lane, gw, NGW);
      __syncthreads();
      PH(2) p0_adaln(al, lds, tid, wave, lane, c, G);
      PH(3) p0_ssm(al, lds, tid, (c + 128) % G, G); }
    grid.sync();
    { FRESH();
      PH(4) rowpass<0>(INP(0), INP(1), nullptr, nullptr, nullptr, 0, nullptr, nullptr, nullptr, nullptr, INP(11), MOD + 1024, MOD, HM, (const float*)(ws + WS_WG), INP(16), al.out, 0, lane, gw, NGW); }
    GSYNC();

    LAYER_BODY(0)
    LAYER_BODY(1)
    LAYER_BODY(2)
    LAYER_BODY(3)
}
#undef tid
#undef lane

extern "C" void kernel_launch(void* const* d_in, const int* in_sizes, int n_in, void* d_out, int out_size, void* d_ws, size_t ws_size, hipStream_t stream) {
    static int grid = 0;
    if (grid == 0) {
        if (n_in != 30 || (size_t)out_size != O_END || ws_size < WS_END) { fprintf(stderr, "kernel_launch: unexpected sizes n_in %d out %d ws %zu\n", n_in, out_size, ws_size); grid = -1; return; }
        int dev = 0, cus = 0, per_cu = 0;
        hipGetDevice(&dev); hipDeviceGetAttribute(&cus, hipDeviceAttributeMultiprocessorCount, dev);
        hipFuncSetAttribute((const void*)mega, hipFuncAttributeMaxDynamicSharedMemorySize, LDS_BYTES);
        hipOccupancyMaxActiveBlocksPerMultiprocessor(&per_cu, (const void*)mega, 512, LDS_BYTES);
        if (per_cu < 1) { fprintf(stderr, "kernel_launch: occupancy query reports %d blocks per CU\n", per_cu); grid = -1; return; }
        if (cus != 256) { fprintf(stderr, "kernel_launch: this build's static unit orders need 256 CUs (found %d)\n", cus); grid = -1; return; }
        grid = cus;
    }
    if (grid < 0) return;
    if (hipMemsetAsync((char*)d_ws + WS_CTL, 0, CTL_BYTES, stream) != hipSuccess) { fprintf(stderr, "kernel_launch: memset failed\n"); return; }
    Args a{};
    for (int i = 0; i < 30; ++i) a.in[i] = (const float*)d_in[i];
    a.out = (float*)d_out; a.ws = (unsigned char*)d_ws;
    void* args[] = {&a};
    hipError_t e = hipLaunchCooperativeKernel((const void*)mega, dim3(grid), dim3(512), args, LDS_BYTES, stream);
    if (e != hipSuccess) fprintf(stderr, "cooperative launch failed: %s (grid %d)\n", hipGetErrorString(e), grid);
}
```

```cpp
#include <hip/hip_runtime.h>
#include <hip/hip_cooperative_groups.h>
#include <cstdio>
#include <cstdint>
namespace cg = cooperative_groups;

#define LAS __attribute__((address_space(3)))
typedef unsigned short bf16_t;
typedef short bf16x8 __attribute__((ext_vector_type(8)));
typedef float f32x4 __attribute__((ext_vector_type(4)));
typedef float f32x16 __attribute__((ext_vector_type(16)));
typedef float f32x8 __attribute__((ext_vector_type(8)));
typedef unsigned u32x4 __attribute__((ext_vector_type(4)));
typedef unsigned u32x2 __attribute__((ext_vector_type(2)));

constexpr int DM = 1024, NPR = 16384, NSM = 512, MT = 16896, NL = 4, NH = 8, HD = 64;
constexpr int SEQ = 4096, PAST = 1024, DSEQ = 64, KVS = 1088, DFF = 2816, DIN = 2056;
constexpr int NG = 32, NP = 64, MG = 16, LC = 16, NCH = MT / LC  , CHP = 1280  , UAK = 384;
constexpr float C2 = 0.125f * 1.4426950408889634f, LOG2E = 1.4426950408889634f, EPS = 1e-6f;
constexpr size_t O_YP = 0, O_KP = 17301504, O_VP = 50855936, O_LP = 84410368, O_RP = 84934656, O_IP = 84967424,
                 O_KS = 85000192, O_VS = 86048768, O_LS = 87097344, O_RS = 87113728, O_IS = 87179264, O_END = 87244800;
constexpr size_t MiB = 1u << 20;
constexpr size_t WS_CTL = 1536 * 1024, CTL_BYTES = 32768;
constexpr int LDS_MISC = 131072 + 64;
constexpr size_t WS_MOD = 0, WS_WG = 2 * MiB, WS_A16 = 2 * MiB + 256 * 1024, WS_BIASP = 3 * MiB, WS_BIASS = 3 * MiB + 512 * 1024, WS_KMAX = 2 * MiB + 384 * 1024;
constexpr size_t WS_WIN = 4 * MiB, WS_WV = 16 * MiB, WS_WGLU = 20 * MiB, WS_WOUT = 22 * MiB, WS_WGU = 30 * MiB, WS_WD = 74 * MiB;
constexpr size_t WS_BT3 = 96 * MiB, WS_BT1 = 120 * MiB, WS_HM = 130 * MiB, WS_X = 164 * MiB, WS_F1 = 230 * MiB, WS_MIX = 264 * MiB;
constexpr size_t WS_Q = 298 * MiB, WS_KP = 315 * MiB, WS_VTP = 331 * MiB, WS_KS = 347 * MiB, WS_VTS = 356 * MiB, WS_UA = 365 * MiB,
                 WS_E = 395 * MiB, WS_Z = 415 * MiB, WS_H = 298 * MiB, WS_FS1 = 435 * MiB, WS_FS2 = 443 * MiB, WS_END = 465 * MiB;
constexpr int LDS_BYTES = 151552;
#ifndef PH_MASK
#define PH_MASK 0xffffffffu
#endif
#define PH(k) if (PH_MASK & (1u << (k)))

__device__ __forceinline__ unsigned cvt_pk_bf16(float lo, float hi) { unsigned r; asm volatile("v_cvt_pk_bf16_f32 %0, %1, %2" : "=v"(r) : "v"(lo), "v"(hi)); return r; }
__device__ __forceinline__ bf16_t f2bf(float f) { return (bf16_t)(cvt_pk_bf16(f, 0.f) & 0xffffu); }
__device__ __forceinline__ float bf2f(unsigned short b) { return __uint_as_float(((unsigned)b) << 16); }
__device__ __forceinline__ int opq(int x) { asm volatile("" : "+v"(x)); return x; }
__device__ __forceinline__ float bperm(float v, int srclane) { return __int_as_float(__builtin_amdgcn_ds_bpermute(srclane << 2, __float_as_int(v))); }
__device__ __forceinline__ float dpp_f(float v, const int ctrl) { return v; }
#define DPPADD(v, ctrl) v += __int_as_float(__builtin_amdgcn_update_dpp(0, __float_as_int(v), ctrl, 0xF, 0xF, true))
__device__ __forceinline__ float wave_sum(float v, int ln) {
    (void)ln;
    DPPADD(v, 0xB1);
    DPPADD(v, 0x4E);
    DPPADD(v, 0x141);
    DPPADD(v, 0x140);
    const float r0 = __int_as_float(__builtin_amdgcn_readlane(__float_as_int(v), 0)), r1 = __int_as_float(__builtin_amdgcn_readlane(__float_as_int(v), 16));
    const float r2 = __int_as_float(__builtin_amdgcn_readlane(__float_as_int(v), 32)), r3 = __int_as_float(__builtin_amdgcn_readlane(__float_as_int(v), 48));
    return (r0 + r1) + (r2 + r3);
}
__device__ __forceinline__ float sigm(float x) { return __builtin_amdgcn_rcpf(1.f + __builtin_amdgcn_exp2f(-1.4426950408889634f * x)); }
__device__ __forceinline__ float silu_f(float x) { return x * sigm(x); }
__device__ __forceinline__ float gelu_f(float x) { const float u = 0.7978845608028654f * (x + 0.044715f * x * x * x); return x * sigm(2.f * u); }
__device__ __forceinline__ float logsig(float x) { return fminf(x, 0.f) - log1pf(__expf(-fabsf(x))); }

namespace pg8 {
constexpr int BM = 256, BK = 64, HALF = 128, HTB = HALF * BK * 2, STAGE_BYTES = 8 * HTB, NXCD = 8, WGM = 8;
__host__ __device__ __forceinline__ int lds_byte(int r, int c) { const int st = (r >> 4) * 2 + (c >> 5), rr = r & 15, cc = c & 31, ob = rr * 64 + cc * 2; return st * 1024 + (ob ^ (((ob >> 9) & 1) << 5)); }
__host__ __device__ __forceinline__ void stage_rc(int b, int& R, int& C) { const int st = b / 1024, sb = b % 1024, swz = sb ^ (((sb >> 9) & 1) << 5); R = (st >> 1) * 16 + swz / 64; C = (st & 1) * 32 + (swz % 64) / 2; }
__host__ __device__ __forceinline__ int perm32(int rho) { const int n = rho >> 4, i = rho & 15; return 8 * (i >> 2) + 4 * n + (i & 3); }
struct Unit { int pm, pn, ks, kind, nt; };
struct Gemm { const bf16_t* A; const bf16_t* Bt; int M, N, K, lda, ldb, gdiv; size_t gstrideB; unsigned kcb; const bf16_t* A1; const bf16_t* Bt1; };
struct StaticOrder {
    int nM, nN, nwg, G, c;
    __device__ __forceinline__ void init(int M, int N, int G_, int c_) { nM = M / BM; nN = N / BM; nwg = nM * nN; G = G_; c = c_; }
    __device__ __forceinline__ bool next(int i, Unit& u) const {
        const long L = (long)i * G + c; if (L >= nwg) return false;
        int wgid = (int)L; { const int q = nwg / NXCD, r = nwg % NXCD, xcd = wgid % NXCD, off = wgid / NXCD; wgid = (xcd < r ? xcd * (q + 1) : r * (q + 1) + (xcd - r) * q) + off; }
        const int nig = WGM * nN, gid = wgid / nig, fm = gid * WGM, gsz = (nM - fm) < WGM ? (nM - fm) : WGM;
        u.pm = fm + ((wgid % nig) % gsz); u.pn = (wgid % nig) / gsz; u.ks = 0; u.kind = 0; u.nt = 0; return true;
    }
};
struct SplitOrder {
    int nsub, G, c, S;
    __device__ __forceinline__ void init(int S_, int G_, int c_) { S = S_; nsub = 8 * S_; G = G_; c = c_; }
    __device__ __forceinline__ bool next(int i, Unit& u) const { const int idx = i * G + c; if (idx >= nsub) return false; u.ks = idx % S; const int t = idx / S; u.pn = t & 3; u.pm = 64 + (t >> 2); u.kind = 0; u.nt = 0; return true; }
};
struct VtOrder {
    int idx;
    __device__ __forceinline__ void init(int G_, int c_) { idx = c_ - (G_ - 116); }
    __device__ __forceinline__ bool next(int i, Unit& u) const { if (i != 0 || idx < 0 || idx >= 116) return false; u.pm = idx / 58; u.pn = idx - u.pm * 58; u.ks = 0; u.kind = 0; u.nt = 0; return true; }
};
struct VtSplitOrder {
    int c;
    __device__ __forceinline__ void init(int c_) { c = c_; }
    __device__ __forceinline__ bool next(int i, Unit& u) const { if (i != 0 || c >= 64) return false; const int tile = c >> 2; u.ks = c & 3; u.pm = tile >> 3; u.pn = 58 + (tile & 7); u.kind = 0; u.nt = 0; return true; }
};
struct PhaseAOrder {
    StaticOrder so; int c;
    __device__ __forceinline__ void init(int G_, int c_) { so.init(MT, 1536, G_, c_); c = c_; }
    __device__ __forceinline__ bool next(int i, Unit& u) const {
        Unit t = {0, 0, 0, 0, 0}; bool ok = false;
        if (i <= 1) ok = so.next(i, t);
        int pm = t.pm, pn = t.pn, ks = 0, kind = 0, nt = 0;
        if (i == 1 && !ok) { const int idx = c - 140; ok = idx >= 0 && idx < 116; pm = idx / 58; pn = idx - pm * 58; kind = 1; nt = 16; }
        if (i == 2) { ok = c < 64; const int tile = c >> 2; ks = c & 3; pm = tile >> 3; pn = 58 + (tile & 7); kind = 1; nt = 4; }
        u.pm = pm; u.pn = pn; u.ks = ks; u.kind = kind; u.nt = nt;
        return ok;
    }
};
struct MainSplitOrder {
    StaticOrder so; int c, S, nts;
    __device__ __forceinline__ void init(int G_, int c_, int S_, int nts_) { so.init(NPR, 1024, G_, c_); c = c_; S = S_; nts = nts_; }
    __device__ __forceinline__ bool next(int i, Unit& u) const {
        Unit t = {0, 0, 0, 0, 0}; bool ok = false;
        if (i == 0) ok = so.next(0, t);
        int pm = t.pm, pn = t.pn, ks = 0, nt = 0;
        if (i == 1) { ok = c < 8 * S; ks = c % S; const int tt = c / S; pn = tt & 3; pm = 64 + (tt >> 2); nt = nts; }
        u.pm = pm; u.pn = pn; u.ks = ks; u.kind = 0; u.nt = nt;
        return ok;
    }
};
template <class Epi, class Sched>
__device__ __forceinline__ void gemm_phase(LAS unsigned char* lds, const Gemm g, const Sched& S, const Epi& E, const int wave_id) {
    const int lane = (int)__builtin_amdgcn_mbcnt_hi(~0u, __builtin_amdgcn_mbcnt_lo(~0u, (unsigned)opq(0))), wid = wave_id, tid = wid * 64 + lane, wr = wid >> 2, wc = wid & 3, fr = lane & 15, fq = lane >> 4;
    unsigned voffA[2], voffB[2];
#pragma unroll
    for (int i = 0; i < 2; ++i) { int R, C; stage_rc(tid * 16 + i * 8192, R, C); const int Rb = (R & ~31) + perm32(R & 31);
        voffA[i] = (unsigned)(R * g.lda + C) * 2u; voffB[i] = (unsigned)(Rb * g.ldb + C) * 2u; }
    const unsigned kstep = (unsigned)(BK * 2);
    const unsigned hstepA = (unsigned)HALF * g.lda * 2, hstepB = (unsigned)HALF * g.ldb * 2, tstepA = 2 * hstepA, tstepB = 2 * hstepB;
    const unsigned ldsw = (unsigned)wid * 1024u;
    const int aoff = lds_byte(wr * 64 + fr, fq * 8), boff = lds_byte(wc * 32 + fr, fq * 8);
#define PG8_SA(b, h) (((b) * 2 + (h)) * HTB)
#define PG8_SB(b, h) ((4 + (b) * 2 + (h)) * HTB)
#define PG8_STAGE(bufoff, gbase, voff) do { _Pragma("unroll") for (int _i = 0; _i < 2; ++_i) \
        __builtin_amdgcn_global_load_lds((const unsigned*)((const char*)(gbase) + (voff)[_i]), (LAS unsigned*)(lds + (bufoff) + ldsw + _i * 8192), 16, 0, 0); } while (0)
#define PG8_LDA(dst, b, h) do { _Pragma("unroll") for (int m = 0; m < 4; ++m) _Pragma("unroll") for (int k = 0; k < 2; ++k) dst[m][k] = *(const LAS bf16x8*)(lds + PG8_SA(b, h) + aoff + m * 2048 + k * 1024); } while (0)
#define PG8_LDB(dst, b, h) do { _Pragma("unroll") for (int n = 0; n < 2; ++n) _Pragma("unroll") for (int k = 0; k < 2; ++k) dst[n][k] = *(const LAS bf16x8*)(lds + PG8_SB(b, h) + boff + n * 2048 + k * 1024); } while (0)
#define PG8_MMA(ai, bj, At, Bt) do { __builtin_amdgcn_s_setprio(1); _Pragma("unroll") for (int m = 0; m < 4; ++m) _Pragma("unroll") for (int n = 0; n < 2; ++n) _Pragma("unroll") for (int k = 0; k < 2; ++k) \
        acc[ai][bj][m][n] = __builtin_amdgcn_mfma_f32_16x16x32_bf16(Bt[n][k], At[m][k], acc[ai][bj][m][n], 0, 0, 0); __builtin_amdgcn_s_setprio(0); } while (0)
#define PG8_WAIT_V(n) asm volatile("s_waitcnt vmcnt(" #n ")" ::: "memory")
#define PG8_WAIT_L(n) asm volatile("s_waitcnt lgkmcnt(" #n ")" ::: "memory")
#define PG8_BAR __builtin_amdgcn_s_barrier()
#define PG8_SCHED __builtin_amdgcn_sched_barrier(0)
    Unit cur = {0, 0, 0, 0, 0}, nxt = {0, 0, 0, 0, 0}; int ui = 0;
    if (!S.next(0, cur)) return;
    f32x4 acc[2][2][4][2];
    const float zf = __int_as_float(opq(0)); const f32x4 zero4 = (f32x4){zf, zf, zf, zf};
#pragma unroll
    for (int a = 0; a < 2; ++a)
#pragma unroll
        for (int b = 0; b < 2; ++b)
#pragma unroll
            for (int m = 0; m < 4; ++m)
#pragma unroll
                for (int n = 0; n < 2; ++n) acc[a][b][m][n] = zero4;
    bf16x8 At[4][2], B0[2][2], B1[2][2];
    const char* cA = (const char*)(cur.kind ? g.A1 : g.A) + (size_t)cur.pm * tstepA + (size_t)cur.ks * g.kcb;
    const char* cB = (const char*)(cur.kind ? g.Bt1 : g.Bt) + (size_t)(cur.pm / g.gdiv) * g.gstrideB * 2 + (size_t)cur.pn * tstepB + (size_t)cur.ks * g.kcb;
    int nt = cur.nt ? cur.nt : g.K / BK;
    PG8_STAGE(PG8_SB(0, 0), cB, voffB); PG8_STAGE(PG8_SB(0, 1), cB + hstepB, voffB); PG8_STAGE(PG8_SA(0, 0), cA, voffA); PG8_STAGE(PG8_SA(0, 1), cA + hstepA, voffA);
    if (wr == 1) PG8_BAR;
    PG8_WAIT_V(2); PG8_BAR;
    PG8_STAGE(PG8_SB(1, 0), cB + kstep, voffB); PG8_STAGE(PG8_SA(1, 0), cA + kstep, voffA); PG8_STAGE(PG8_SB(1, 1), cB + hstepB + kstep, voffB);
    PG8_WAIT_V(6); PG8_BAR;
    for (;;) {
        nxt.pm = 0; nxt.pn = 0; nxt.ks = 0; nxt.kind = 0; nxt.nt = 0;
        const bool has_next = S.next(ui + 1, nxt);
        const char* nA = has_next ? (const char*)(nxt.kind ? g.A1 : g.A) + (size_t)nxt.pm * tstepA + (size_t)nxt.ks * g.kcb : cA;
        const char* nB = has_next ? (const char*)(nxt.kind ? g.Bt1 : g.Bt) + (size_t)(nxt.pm / g.gdiv) * g.gstrideB * 2 + (size_t)nxt.pn * tstepB + (size_t)nxt.ks * g.kcb : cB;
#pragma unroll 1
        for (int t = 0; t < nt; t += 2) {
            const bool last = (t == nt - 2);
            const char* a1 = cA + (unsigned)(t + 1) * kstep;
            const char* a2 = last ? nA : cA + (unsigned)(t + 2) * kstep; const char* b2 = last ? nB : cB + (unsigned)(t + 2) * kstep;
            const char* a3 = a2 + kstep; const char* b3 = b2 + kstep;
            PG8_LDB(B0, 0, 0); PG8_LDB(B1, 0, 1); PG8_SCHED; PG8_LDA(At, 0, 0); PG8_STAGE(PG8_SA(1, 1), a1 + hstepA, voffA);
            PG8_WAIT_V(8); PG8_WAIT_L(0); PG8_BAR; PG8_MMA(0, 0, At, B0); PG8_MMA(0, 1, At, B1); PG8_BAR; PG8_SCHED;
            PG8_LDA(At, 0, 1); PG8_STAGE(PG8_SB(0, 0), b2, voffB); PG8_STAGE(PG8_SB(0, 1), b2 + hstepB, voffB); PG8_STAGE(PG8_SA(0, 0), a2, voffA);
            PG8_WAIT_V(8); PG8_WAIT_L(0); PG8_BAR; PG8_MMA(1, 0, At, B0); PG8_MMA(1, 1, At, B1); PG8_BAR; PG8_SCHED;
            PG8_LDB(B0, 1, 0); PG8_LDB(B1, 1, 1); PG8_SCHED; PG8_LDA(At, 1, 0); PG8_STAGE(PG8_SA(0, 1), a2 + hstepA, voffA);
            PG8_WAIT_V(8); PG8_WAIT_L(0); PG8_BAR; PG8_MMA(0, 0, At, B0); PG8_MMA(0, 1, At, B1); PG8_BAR; PG8_SCHED;
            PG8_LDA(At, 1, 1); PG8_STAGE(PG8_SB(1, 0), b3, voffB); PG8_STAGE(PG8_SB(1, 1), b3 + hstepB, voffB); PG8_STAGE(PG8_SA(1, 0), a3, voffA);
            PG8_WAIT_V(8); PG8_WAIT_L(0); PG8_BAR; PG8_MMA(1, 0, At, B0); PG8_MMA(1, 1, At, B1); PG8_BAR; PG8_SCHED;
        }
        if (wr == 0) PG8_BAR;
        E(acc, cur, wr, wc, fr, fq);
        if (!has_next) break;
#pragma unroll
        for (int a = 0; a < 2; ++a)
#pragma unroll
            for (int b = 0; b < 2; ++b)
#pragma unroll
                for (int m = 0; m < 4; ++m)
#pragma unroll
                    for (int n = 0; n < 2; ++n) acc[a][b][m][n] = zero4;
        cur = nxt; cA = nA; cB = nB; ++ui; nt = cur.nt ? cur.nt : g.K / BK;
        if (wr == 1) PG8_BAR;
    }
    PG8_WAIT_V(0);
    PG8_BAR;
#undef PG8_SA
#undef PG8_SB
#undef PG8_STAGE
#undef PG8_LDA
#undef PG8_LDB
#undef PG8_MMA
#undef PG8_WAIT_V
#undef PG8_WAIT_L
#undef PG8_BAR
#undef PG8_SCHED
}
}
using pg8::Unit;
typedef const f32x4 (&AccRef)[2][2][4][2];
__device__ __forceinline__ u32x4 pack8(f32x4 v0, f32x4 v1) { u32x4 w; w.x = cvt_pk_bf16(v0[0], v0[1]); w.y = cvt_pk_bf16(v0[2], v0[3]); w.z = cvt_pk_bf16(v1[0], v1[1]); w.w = cvt_pk_bf16(v1[2], v1[3]); return w; }

struct EpiPlain {
    bf16_t* O; int ldc;
    __device__ __forceinline__ void operator()(AccRef acc, const Unit& u, int wr, int wc, int fr, int fq) const {
        fr = opq(fr); fq = opq(fq);
#pragma unroll
        for (int ai = 0; ai < 2; ++ai)
#pragma unroll
            for (int m = 0; m < 4; ++m) { const int r = u.pm * 256 + ai * 128 + wr * 64 + m * 16 + fr;
#pragma unroll
                for (int bj = 0; bj < 2; ++bj) { const int c = u.pn * 256 + bj * 128 + wc * 32 + 8 * fq;
                    *(u32x4*)(O + (size_t)r * ldc + c) = pack8(acc[ai][bj][m][0], acc[ai][bj][m][1]); } }
    }
};
struct EpiIn {
    bf16_t *Q, *KP, *KS, *UA; float* out; int l;
    __device__ __forceinline__ void operator()(AccRef acc, const Unit& u, int wr, int wc, int fr, int fq) const {
        fr = opq(fr); fq = opq(fq);
        const bool prompt = u.pm < 64;
#pragma unroll
        for (int ai = 0; ai < 2; ++ai)
#pragma unroll
            for (int m = 0; m < 4; ++m) { const int r = u.pm * 256 + ai * 128 + wr * 64 + m * 16 + fr;
#pragma unroll
                for (int bj = 0; bj < 2; ++bj) { const int c = u.pn * 256 + bj * 128 + wc * 32 + 8 * fq;
                    const f32x4 v0 = acc[ai][bj][m][0], v1 = acc[ai][bj][m][1];
                    if (u.pn < 2) { *(u32x4*)(Q + (size_t)r * 512 + c) = pack8(v0 * C2, v1 * C2); }
                    else if (u.pn < 4) { const int ck = c - 512, h = ck >> 6, d = ck & 63; const u32x4 w = pack8(v0, v1);
                        if (prompt) { const int b = r >> 12, t = r & 4095;
                            *(u32x4*)(KP + ((size_t)(b * 8 + h) * 4096 + t) * 64 + d) = w;
                            float* o = out + O_KP + ((size_t)((l * 4 + b) * 8 + h) * 4096 + t) * 64 + d; *(f32x4*)o = v0; *(f32x4*)(o + 4) = v1; }
                        else { const int rr = r - NPR, b = rr >> 6, t = rr & 63;
                            *(u32x4*)(KS + ((size_t)(b * 8 + h) * KVS + PAST + t) * 64 + d) = w;
                            float* o = out + O_KS + ((size_t)((l * 8 + b) * 8 + h) * 64 + t) * 64 + d; *(f32x4*)o = v0; *(f32x4*)(o + 4) = v1; } }
                    else { const int cu = c - 1024, gq = cu >> 4, m0 = cu & 15, chunk = r >> 4, s = r & 15;
                        *(u32x4*)(UA + ((size_t)gq * CHP + chunk) * UAK + s * 16 + m0) = pack8(v0, v1); }
                    asm volatile("" ::: "memory"); } }
    }
};
struct EpiVT {
    bf16_t *VTP, *VTS; float* out; int l; LAS unsigned char* lds;
    __device__ __forceinline__ void operator()(AccRef acc, const Unit& u, int wr, int wc, int fr, int fq) const {
        fr = opq(fr); fq = opq(fq);
        const bool prompt = u.pn < 64; const int ln = fq * 16 + fr;
        LAS float* stg = (LAS float*)(lds + 131072 + 1024 + (wr * 4 + wc) * 2080);
#pragma unroll
        for (int ai = 0; ai < 2; ++ai)
#pragma unroll
            for (int bj = 0; bj < 2; ++bj) {
                const int h = (u.pm * 256 + ai * 128 + wr * 64) >> 6, tok0 = u.pn * 256 + bj * 128 + wc * 32;
                float* obase; bf16_t* vbase; size_t vpitch;
                if (prompt) { const int b = tok0 >> 12, t0 = tok0 & 4095; obase = out + O_VP + ((size_t)((l * 4 + b) * 8 + h) * 4096 + t0) * 64; vbase = VTP + (size_t)(b * 8 + h) * 64 * 4096 + t0; vpitch = 4096; }
                else { const int tt = tok0 - NPR, b = tt >> 6, t0 = tt & 63; obase = out + O_VS + ((size_t)((l * 8 + b) * 8 + h) * 64 + t0) * 64; vbase = VTS + (size_t)(b * 8 + h) * 64 * KVS + PAST + t0; vpitch = KVS; }
#pragma unroll
                for (int m = 0; m < 4; ++m) *(u32x4*)(vbase + (size_t)(m * 16 + fr) * vpitch + 8 * fq) = pack8(acc[ai][bj][m][0], acc[ai][bj][m][1]);
#pragma unroll
                for (int n = 0; n < 2; ++n)
#pragma unroll
                    for (int j0 = 0; j0 < 4; j0 += 2) {
#pragma unroll
                        for (int m = 0; m < 4; ++m) { stg[(2 * fq) * 65 + 16 * m + fr] = acc[ai][bj][m][n][j0]; stg[(2 * fq + 1) * 65 + 16 * m + fr] = acc[ai][bj][m][n][j0 + 1]; }
                        asm volatile("s_waitcnt lgkmcnt(0)" ::: "memory");
#pragma unroll
                        for (int sl = 0; sl < 8; ++sl) { const float v = stg[sl * 65 + ln]; obase[(size_t)(8 * (sl >> 1) + 4 * n + j0 + (sl & 1)) * 64 + ln] = v; }
                        asm volatile("s_waitcnt lgkmcnt(0)" ::: "memory");
                    }
            }
    }
};
struct EpiVtPart {
    float* PV;
    __device__ __forceinline__ void operator()(AccRef acc, const Unit& u, int wr, int wc, int fr, int fq) const {
        fr = opq(fr); fq = opq(fq);
        float* base = PV + (size_t)((u.pm * 8 + (u.pn - 58)) * 4 + u.ks) * 65536;
#pragma unroll
        for (int ai = 0; ai < 2; ++ai)
#pragma unroll
            for (int m = 0; m < 4; ++m) { const int r = ai * 128 + wr * 64 + m * 16 + fr;
#pragma unroll
                for (int bj = 0; bj < 2; ++bj) { float* o = base + r * 256 + bj * 128 + wc * 32 + 8 * fq; *(f32x4*)o = acc[ai][bj][m][0]; *(f32x4*)(o + 4) = acc[ai][bj][m][1]; } }
    }
};
struct EpiE {
    float* E;
    __device__ __forceinline__ void operator()(AccRef acc, const Unit& u, int wr, int wc, int fr, int fq) const {
        fr = opq(fr); fq = opq(fq);
#pragma unroll
        for (int ai = 0; ai < 2; ++ai)
#pragma unroll
            for (int m = 0; m < 4; ++m) { const int gq = u.pm / 5, chunk = (u.pm - gq * 5) * 256 + ai * 128 + wr * 64 + m * 16 + fr;
                { float* o = E + ((size_t)gq * CHP + chunk) * 128 + wc * 32 + 8 * fq; *(f32x4*)o = acc[ai][0][m][0]; *(f32x4*)(o + 4) = acc[ai][0][m][1]; } }
    }
};
struct EpiZ {
    bf16_t* Z;
    __device__ __forceinline__ void operator()(AccRef acc, const Unit& u, int wr, int wc, int fr, int fq) const {
        fr = opq(fr); fq = opq(fq);
#pragma unroll
        for (int ai = 0; ai < 2; ++ai)
#pragma unroll
            for (int m = 0; m < 4; ++m) { const int gq = u.pm / 5, chunk = (u.pm - gq * 5) * 256 + ai * 128 + wr * 64 + m * 16 + fr;
                {
#pragma unroll
                    for (int bj = 0; bj < 2; ++bj) { const int n = bj * 128 + wc * 32 + 8 * fq, t = n >> 4, m0 = n & 15;
                        f32x4 v0 = acc[ai][bj][m][0], v1 = acc[ai][bj][m][1];
#pragma unroll
                        for (int j = 0; j < 4; ++j) { v0[j] = gelu_f(v0[j]); v1[j] = gelu_f(v1[j]); }
                        *(u32x4*)(Z + (size_t)(chunk * 16 + t) * 512 + gq * 16 + m0) = pack8(v0, v1); __builtin_amdgcn_sched_barrier(0); } } }
    }
};
struct EpiGlu {
    const bf16_t* Z; bf16_t* MIX;
    __device__ __forceinline__ void operator()(AccRef acc, const Unit& u, int wr, int wc, int fr, int fq) const {
        fr = opq(fr); fq = opq(fq);
#pragma unroll
        for (int ai = 0; ai < 2; ++ai)
#pragma unroll
            for (int m = 0; m < 4; ++m) { const int r = u.pm * 256 + ai * 128 + wr * 64 + m * 16 + fr;
#pragma unroll
                for (int bj = 0; bj < 2; ++bj) { const int c = u.pn * 256 + bj * 128 + wc * 32 + 8 * fq;
                    const u32x4 zz = *(const u32x4*)(Z + (size_t)r * 512 + c);
                    f32x4 v0 = acc[ai][bj][m][0], v1 = acc[ai][bj][m][1];
#pragma unroll
                    for (int j = 0; j < 4; ++j) { const unsigned w0 = zz[j >> 1], w1 = zz[2 + (j >> 1)];
                        const float z0 = (j & 1) ? __uint_as_float(w0 & 0xffff0000u) : __uint_as_float(w0 << 16);
                        const float z1 = (j & 1) ? __uint_as_float(w1 & 0xffff0000u) : __uint_as_float(w1 << 16);
                        v0[j] = z0 * sigm(v0[j]); v1[j] = z1 * sigm(v1[j]); }
                    *(u32x4*)(MIX + (size_t)r * 1024 + 512 + c) = pack8(v0, v1); } }
    }
};
struct EpiAtomic {
    float* FS;
    __device__ __forceinline__ void operator()(AccRef acc, const Unit& u, int wr, int wc, int fr, int fq) const {
        fr = opq(fr); fq = opq(fq);
#pragma unroll
        for (int ai = 0; ai < 2; ++ai)
#pragma unroll
            for (int m = 0; m < 4; ++m) { const int r = (u.pm - 64) * 256 + ai * 128 + wr * 64 + m * 16 + fr;
#pragma unroll
                for (int bj = 0; bj < 2; ++bj) { float* o = FS + ((size_t)u.ks * 512 + r) * 1024 + u.pn * 256 + bj * 128 + wc * 32 + 8 * fq;
                    *(f32x4*)o = acc[ai][bj][m][0]; *(f32x4*)(o + 4) = acc[ai][bj][m][1]; } }
    }
};
struct EpiSwi {
    bf16_t* H;
    __device__ __forceinline__ void operator()(AccRef acc, const Unit& u, int wr, int wc, int fr, int fq) const {
        fr = opq(fr); fq = opq(fq);
#pragma unroll
        for (int ai = 0; ai < 2; ++ai)
#pragma unroll
            for (int m = 0; m < 4; ++m) { const int r = u.pm * 256 + ai * 128 + wr * 64 + m * 16 + fr; const int c = u.pn * 128 + wc * 32 + 8 * fq;
                f32x4 v0 = acc[ai][0][m][0], v1 = acc[ai][0][m][1]; const f32x4 u0 = acc[ai][1][m][0], u1 = acc[ai][1][m][1];
#pragma unroll
                for (int j = 0; j < 4; ++j) { v0[j] = silu_f(v0[j]) * u0[j]; v1[j] = silu_f(v1[j]) * u1[j]; }
                *(u32x4*)(H + (size_t)r * DFF + c) = pack8(v0, v1); }
    }
};

struct EpiA {
    EpiIn in; EpiVT vt; EpiVtPart vp;
    __device__ __forceinline__ void operator()(AccRef acc, const Unit& u, int wr, int wc, int fr, int fq) const {
        if (u.kind == 0) in(acc, u, wr, wc, fr, fq); else if (u.nt == 16) vt(acc, u, wr, wc, fr, fq); else vp(acc, u, wr, wc, fr, fq);
    }
};
struct EpiMS {
    EpiPlain p; EpiAtomic q;
    __device__ __forceinline__ void operator()(AccRef acc, const Unit& u, int wr, int wc, int fr, int fq) const {
        if (u.pm < 64) p(acc, u, wr, wc, fr, fq); else q(acc, u, wr, wc, fr, fq);
    }
};
struct Args { const float* in[30]; float* out; unsigned char* ws; };
struct Ctx {
    LAS unsigned char* lds; int tid, lane, wave, G, c;
    const float* const* in; float* out; unsigned char* ws;
};
#define INP(i) (a.in[i])

__device__ __forceinline__ void tr_item(const float* W, size_t ldw, int k0, int sc0, bf16_t* WT, size_t ldo, int dr0, LAS float* scr, int lane) {
    f32x4 tv[8];
#pragma unroll
    for (int i = 0; i < 8; ++i) { const int kk = 8 * i + (lane >> 3); tv[i] = *(const f32x4*)(W + (size_t)(k0 + kk) * ldw + sc0 + 4 * (lane & 7)); }
#pragma unroll
    for (int i = 0; i < 8; ++i) { const int kk = 8 * i + (lane >> 3); LAS float* d = scr + kk * 33 + 4 * (lane & 7); d[0] = tv[i][0]; d[1] = tv[i][1]; d[2] = tv[i][2]; d[3] = tv[i][3]; }
    asm volatile("s_waitcnt lgkmcnt(0)" ::: "memory");
    const int c = lane & 7;
#pragma unroll
    for (int j = 0; j < 4; ++j) { const int n = (lane >> 3) + 8 * j; const LAS float* s = scr + (8 * c) * 33 + n;
        u32x4 o; o.x = cvt_pk_bf16(s[0 * 33], s[1 * 33]); o.y = cvt_pk_bf16(s[2 * 33], s[3 * 33]); o.z = cvt_pk_bf16(s[4 * 33], s[5 * 33]); o.w = cvt_pk_bf16(s[6 * 33], s[7 * 33]);
        *(u32x4*)(WT + (size_t)(dr0 + n) * ldo + k0 + 8 * c) = o; }
    asm volatile("s_waitcnt lgkmcnt(0)" ::: "memory");
}

__device__ __forceinline__ void sincos_d(double x, double& s, double& c) {
    const double k = rint(x * 0.63661977236758134308);
    const double r = (x - k * 1.57079632679489655800) - k * 6.123233995736766036e-17;
    const double r2 = r * r;
    double sp = 1.0 / 6227020800.0; sp = sp * r2 - 1.0 / 39916800.0; sp = sp * r2 + 1.0 / 362880.0; sp = sp * r2 - 1.0 / 5040.0; sp = sp * r2 + 1.0 / 120.0; sp = sp * r2 - 1.0 / 6.0; sp = sp * r2 + 1.0;
    const double sr = r * sp;
    double cp = 1.0 / 87178291200.0; cp = cp * r2 - 1.0 / 479001600.0; cp = cp * r2 + 1.0 / 3628800.0; cp = cp * r2 - 1.0 / 40320.0; cp = cp * r2 + 1.0 / 720.0; cp = cp * r2 - 1.0 / 24.0; cp = cp * r2 + 0.5;
    const double cr = 1.0 - r2 * cp;
    const int q = ((int)k) & 3;
    s = (q == 0) ? sr : (q == 1) ? cr : (q == 2) ? -sr : -cr;
    c = (q == 0) ? cr : (q == 1) ? -sr : (q == 2) ? -cr : sr;
}

__device__ __forceinline__ void p0_weights(const Args& a, int lw, bool do_wg, LAS unsigned char* lds, int wave, int lane, int gw, int NGW) {
    LAS float* scr = (LAS float*)(lds + wave * 16384);
    constexpr int I_IN = 16 * 16, I_GLU = 8 * 16, I_OUT = 16 * 32, I_G = 16 * 88, I_D = 44 * 32;
    constexpr int PER_L = 4 * I_IN + I_GLU + I_OUT + 2 * I_G + I_D;
    for (int it = gw; it < PER_L; it += NGW) {
        const int l = lw; int r = it;
        const float* win = INP(15) + (size_t)l * DM * DIN;
        bf16_t* WIN = (bf16_t*)(a.ws + WS_WIN) + (size_t)l * 1536 * 1024;
        if (r < 4 * I_IN) { const int part = r / I_IN, rr = r % I_IN, kb = rr / 16, nb = rr % 16;
            if (part == 0) tr_item(win, DIN, 64 * kb, 32 * nb, WIN, 1024, 32 * nb, scr, lane);
            else if (part == 1) tr_item(win, DIN, 64 * kb, 512 + 32 * nb, WIN, 1024, 512 + 32 * nb, scr, lane);
            else if (part == 2) tr_item(win, DIN, 64 * kb, 1544 + 32 * nb, WIN, 1024, 1024 + 32 * nb, scr, lane);
            else tr_item(win, DIN, 64 * kb, 1024 + 32 * nb, (bf16_t*)(a.ws + WS_WV) + (size_t)l * 512 * 1024, 1024, 32 * nb, scr, lane);
            continue; }
        r -= 4 * I_IN;
        if (r < I_GLU) { tr_item(INP(25) + (size_t)l * 512 * 512, 512, 64 * (r / 16), 32 * (r % 16), (bf16_t*)(a.ws + WS_WGLU) + (size_t)l * 512 * 512, 512, 32 * (r % 16), scr, lane); continue; }
        r -= I_GLU;
        if (r < I_OUT) { tr_item(INP(26) + (size_t)l * 1024 * 1024, 1024, 64 * (r / 32), 32 * (r % 32), (bf16_t*)(a.ws + WS_WOUT) + (size_t)l * 1024 * 1024, 1024, 32 * (r % 32), scr, lane); continue; }
        r -= I_OUT;
        if (r < 2 * I_G) { const int up = r / I_G, rr = r % I_G, kb = rr / 88, nb = rr % 88, c0 = 32 * nb;
            tr_item(INP(27 + up) + (size_t)l * DM * DFF, DFF, 64 * kb, c0, (bf16_t*)(a.ws + WS_WGU) + (size_t)l * 5632 * 1024, 1024, (c0 >> 7) * 256 + up * 128 + (c0 & 127), scr, lane);
            continue; }
        r -= 2 * I_G;
        tr_item(INP(29) + (size_t)l * DFF * DM, DM, 64 * (r / 32), 32 * (r % 32), (bf16_t*)(a.ws + WS_WD) + (size_t)l * 1024 * DFF, DFF, 32 * (r % 32), scr, lane);
    }
    float* WG = (float*)(a.ws + WS_WG);
    if (do_wg) for (int i = gw * 64 + lane; i < NL * 8 * 1024; i += NGW * 64) { const int l = i >> 13, h = (i >> 10) & 7, k = i & 1023; WG[i] = INP(15)[((size_t)l * DM + k) * DIN + 1536 + h]; }
}
__device__ __forceinline__ void p0_adaln(const Args& a, LAS unsigned char* lds, int tid, int wave, int lane, int c, int G) {
    LAS float* sc = (LAS float*)(lds);
    LAS float* red = (LAS float*)(lds + 49152);
    for (int i = tid; i < 12 * 1024; i += 512) { const float v = (i < 4096) ? INP(2)[i] : INP(3)[i - 4096]; sc[i] = silu_f(v); }
    __syncthreads();
    float* MOD = (float*)(a.ws + WS_MOD);
    for (int it = c; it < NL * 96; it += G) {
        const int l = it / 96, n0 = (it % 96) * 64;
        const float* W = INP(9) + (size_t)l * DM * 6144 + n0 + lane;
        float acc[12];
#pragma unroll
        for (int b = 0; b < 12; ++b) acc[b] = 0.f;
        for (int k = wave * 128; k < wave * 128 + 128; k += 16) {
            float w[16];
#pragma unroll
            for (int j = 0; j < 16; ++j) w[j] = W[(size_t)(k + j) * 6144];
#pragma unroll
            for (int j = 0; j < 16; ++j)
#pragma unroll
                for (int b = 0; b < 12; ++b) acc[b] += sc[b * 1024 + k + j] * w[j];
        }
#pragma unroll
        for (int b = 0; b < 12; ++b) red[(wave * 12 + b) * 64 + lane] = acc[b];
        __syncthreads();
        for (int i = tid; i < 768; i += 512) { const int b = i >> 6, cc = i & 63; float s = 0.f;
#pragma unroll
            for (int w = 0; w < 8; ++w) s += red[(w * 12 + b) * 64 + cc];
            MOD[((size_t)l * 12 + b) * 6144 + n0 + cc] = s + INP(10)[(size_t)l * 6144 + n0 + cc]; }
        __syncthreads();
    }
}
__device__ __forceinline__ void p0_ssm(const Args& a, LAS unsigned char* lds, int tid, int c, int G) {
    LAS float* ap_re = (LAS float*)(lds + 65536);
    LAS float* ap_im = ap_re + 17 * 64;
    LAS float* bb_re = ap_im + 17 * 64;
    LAS float* bb_im = bb_re + 1024;
    LAS float* cc_re = bb_im + 1024;
    LAS float* cc_im = cc_re + 1024;
    LAS float* ktab = cc_im + 1024;
    for (int it = c; it < NL * NG; it += G) {
        const int l = it >> 5, gq = it & 31;
        const double dt = exp((double)INP(19)[l * 32 + gq]);
        for (int idx = tid; idx < 17 * 64; idx += 512) { const int d = idx >> 6, p = idx & 63;
            const double ar = (double)INP(17)[(l * 32 + gq) * 64 + p], ai = (double)INP(18)[(l * 32 + gq) * 64 + p];
            double s, co; sincos_d((double)d * ai * dt, s, co); const double er = exp((double)d * ar * dt);
            ap_re[idx] = (float)(er * co); ap_im[idx] = (float)(er * s); }
        for (int idx = tid; idx < 1024; idx += 512) { const int p = idx >> 4, m = idx & 15;
            const double ar = (double)INP(17)[(l * 32 + gq) * 64 + p], ai = (double)INP(18)[(l * 32 + gq) * 64 + p];
            double s, co; sincos_d(ai * dt, s, co); const double er = exp(ar * dt);
            const double xr = er * co - 1.0, xi = er * s, den = 1.0 / (ar * ar + ai * ai);
            const double qr = (xr * ar + xi * ai) * den, qi = (xi * ar - xr * ai) * den;
            const double br = (double)INP(20)[((size_t)(l * 32 + gq) * 64 + p) * 16 + m], bi = (double)INP(21)[((size_t)(l * 32 + gq) * 64 + p) * 16 + m];
            bb_re[idx] = (float)(qr * br - qi * bi); bb_im[idx] = (float)(qr * bi + qi * br);
            cc_re[idx] = INP(22)[(size_t)(l * 32 + gq) * 1024 + idx]; cc_im[idx] = INP(23)[(size_t)(l * 32 + gq) * 1024 + idx]; }
        __syncthreads();
        for (int idx = tid; idx < 4096; idx += 512) { const int d = idx >> 8, m = (idx >> 4) & 15, m2 = idx & 15; float s = 0.f;
            for (int p = 0; p < 64; ++p) { const float cr = cc_re[m * 64 + p], ci = cc_im[m * 64 + p], pr = ap_re[d * 64 + p], pi = ap_im[d * 64 + p];
                const float re = cr * pr - ci * pi, im = cr * pi + ci * pr; s += re * bb_re[p * 16 + m2] - im * bb_im[p * 16 + m2]; }
            if (d == 0 && m == m2) s += INP(24)[l * 512 + gq * 16 + m];
            ktab[idx] = s; }
        __syncthreads();
        bf16_t* BT3 = (bf16_t*)(a.ws + WS_BT3) + (size_t)(l * 32 + gq) * 256 * UAK;
        for (int grp = tid; grp < 256 * 48; grp += 512) { const int n = grp / 48, k0 = (grp % 48) * 8, t = n >> 4, m = n & 15; float v[8];
            if (k0 < 256) { const int s = k0 >> 4, m20 = k0 & 15;
#pragma unroll
                for (int j = 0; j < 8; ++j) v[j] = (s <= t) ? ktab[((t - s) * 16 + m) * 16 + m20 + j] : 0.f; }
            else { const int kk = k0 - 256, ri = kk >> 6, p0 = kk & 63;
#pragma unroll
                for (int j = 0; j < 8; ++j) { const int p = p0 + j; const float cr = cc_re[m * 64 + p], ci = cc_im[m * 64 + p], pr = ap_re[(t + 1) * 64 + p], pi = ap_im[(t + 1) * 64 + p];
                    v[j] = ri ? -(cr * pi + ci * pr) : (cr * pr - ci * pi); } }
            u32x4 w; w.x = cvt_pk_bf16(v[0], v[1]); w.y = cvt_pk_bf16(v[2], v[3]); w.z = cvt_pk_bf16(v[4], v[5]); w.w = cvt_pk_bf16(v[6], v[7]);
            *(u32x4*)(BT3 + (size_t)n * UAK + k0) = w; }
        bf16_t* BT1 = (bf16_t*)(a.ws + WS_BT1) + (size_t)(l * 32 + gq) * 128 * 256;
        for (int grp = tid; grp < 128 * 32; grp += 512) { const int n = grp >> 5, k0 = (grp & 31) * 8, s = k0 >> 4, m0 = k0 & 15, ri = n >> 6, p = n & 63; float v[8];
            const float pr = ap_re[(15 - s) * 64 + p], pi = ap_im[(15 - s) * 64 + p];
#pragma unroll
            for (int j = 0; j < 8; ++j) { const float br = bb_re[p * 16 + m0 + j], bi = bb_im[p * 16 + m0 + j]; v[j] = ri ? (pr * bi + pi * br) : (pr * br - pi * bi); }
            u32x4 w; w.x = cvt_pk_bf16(v[0], v[1]); w.y = cvt_pk_bf16(v[2], v[3]); w.z = cvt_pk_bf16(v[4], v[5]); w.w = cvt_pk_bf16(v[6], v[7]);
            *(u32x4*)(BT1 + (size_t)n * 256 + k0) = w; }
        if (tid < 64) { float* A16 = (float*)(a.ws + WS_A16) + (size_t)(l * 32 + gq) * 128; A16[tid] = ap_re[16 * 64 + tid]; A16[64 + tid] = ap_im[16 * 64 + tid]; }
        __syncthreads();
    }
}

__device__ __forceinline__ void cache_convert(const Args& a, int l, LAS unsigned char* lds, int wave, int lane, int gw, int NGW) {
    bf16_t* KS = (bf16_t*)(a.ws + WS_KS); bf16_t* VTS = (bf16_t*)(a.ws + WS_VTS);
    const float* ck = INP(4) + (size_t)l * 64 * PAST * 64; const float* cv = INP(5) + (size_t)l * 64 * PAST * 64;
    for (int i = gw * 64 + lane; i < 64 * PAST * 8; i += NGW * 64) {
        const int bh = i >> 13, rem = i & 8191;
        const f32x4 v0 = *(const f32x4*)(ck + (size_t)i * 8), v1 = *(const f32x4*)(ck + (size_t)i * 8 + 4);
        *(u32x4*)(KS + (size_t)bh * KVS * 64 + (size_t)rem * 8) = pack8(v0, v1); }
    LAS float* scr = (LAS float*)(lds + wave * 16384);
    for (int it = gw; it < 64 * 32; it += NGW) { const int bh = it >> 5, r = it & 31, kb = r >> 1, nb = r & 1;
        tr_item(cv + (size_t)bh * PAST * 64, 64, 64 * kb, 32 * nb, VTS + (size_t)bh * 64 * KVS, KVS, 32 * nb, scr, lane); }
}

template <int NSPLIT>
__device__ __forceinline__ void rowpass(const float* xsrc_p, const float* xsrc_s, const bf16_t* xsrc_b, const bf16_t* Fb, const float* FS, int nsplit, const float* gate, const float* wpost, float* xdst, bf16_t* xdst_b,
                                        const float* wpre, const float* sc, const float* sh, bf16_t* HMb, const float* WGl, const float* bfor, float* out, int lnext,
                                        int lane, int gw, int NGW) {
    f32x4 wg[8][4];
    if (WGl) {
#pragma unroll
        for (int h = 0; h < 8; ++h)
#pragma unroll
            for (int j = 0; j < 4; ++j) wg[h][j] = *(const f32x4*)(WGl + h * 1024 + 4 * lane + 256 * j);
    }
#define LOADX(dst, rr, xr, j) do { if (xsrc_b) { const u32x2 w_ = __builtin_nontemporal_load((const u32x2*)(xsrc_b + (size_t)(rr) * DM + 4 * lane + 256 * (j))); \
        dst = (f32x4){__uint_as_float(w_.x << 16), __uint_as_float(w_.x & 0xffff0000u), __uint_as_float(w_.y << 16), __uint_as_float(w_.y & 0xffff0000u)}; } \
        else dst = __builtin_nontemporal_load((const f32x4*)((xr) + 4 * lane + 256 * (j))); } while (0)
    for (int r = gw; r < MT; r += NGW) {
        const bool prompt = r < NPR; const int bm = prompt ? (r >> 12) : 4 + ((r - NPR) >> 6);
        f32x4 x[4]; u32x2 fw[4];
        { const float* xr = prompt ? xsrc_p + (size_t)r * DM : xsrc_s + (size_t)(r - NPR) * DM;
#pragma unroll
          for (int j = 0; j < 4; ++j) { LOADX(x[j], r, xr, j); fw[j] = (Fb && prompt) ? __builtin_nontemporal_load((const u32x2*)(Fb + (size_t)r * DM + 4 * lane + 256 * j)) : (u32x2){0u, 0u}; } }
        if (Fb) {
            f32x4 f[4]; float ss = 0.f;
#pragma unroll
            for (int j = 0; j < 4; ++j) {
                if (prompt) { const u32x2 w = fw[j];
                    f[j] = (f32x4){__uint_as_float(w.x << 16), __uint_as_float(w.x & 0xffff0000u), __uint_as_float(w.y << 16), __uint_as_float(w.y & 0xffff0000u)}; }
                else { const float* fp = FS + (size_t)(r - NPR) * DM + 4 * lane + 256 * j; f32x4 part[NSPLIT > 0 ? NSPLIT : 1];
#pragma unroll
                    for (int sp = 0; sp < NSPLIT; ++sp) part[sp] = *(const f32x4*)(fp + (size_t)sp * 512 * 1024);
                    f32x4 sacc = part[0];
#pragma unroll
                    for (int sp = 1; sp < NSPLIT; ++sp) sacc = sacc + part[sp];
                    f[j] = sacc; }
                ss += (f[j][0] * f[j][0] + f[j][1] * f[j][1]) + (f[j][2] * f[j][2] + f[j][3] * f[j][3]); }
            const float rstd = rsqrtf(wave_sum(ss, lane) * (1.f / DM) + EPS);
#pragma unroll
            for (int j = 0; j < 4; ++j) { const f32x4 gt = *(const f32x4*)(gate + (size_t)bm * 6144 + 4 * lane + 256 * j), wp = *(const f32x4*)(wpost + 4 * lane + 256 * j);
                x[j] = x[j] + gt * (f[j] * rstd * wp); }
        }
        if (xdst) {
#pragma unroll
            for (int j = 0; j < 4; ++j) __builtin_nontemporal_store(x[j], (f32x4*)(xdst + (size_t)r * DM + 4 * lane + 256 * j));
        }
        if (xdst_b) {
#pragma unroll
            for (int j = 0; j < 4; ++j) { u32x2 w; w.x = cvt_pk_bf16(x[j][0], x[j][1]); w.y = cvt_pk_bf16(x[j][2], x[j][3]); __builtin_nontemporal_store(w, (u32x2*)(xdst_b + (size_t)r * DM + 4 * lane + 256 * j));
                x[j] = (f32x4){__uint_as_float(w.x << 16), __uint_as_float(w.x & 0xffff0000u), __uint_as_float(w.y << 16), __uint_as_float(w.y & 0xffff0000u)}; }
        }
        if (wpre) {
            float ss = 0.f;
#pragma unroll
            for (int j = 0; j < 4; ++j) ss += (x[j][0] * x[j][0] + x[j][1] * x[j][1]) + (x[j][2] * x[j][2] + x[j][3] * x[j][3]);
            const float rstd = rsqrtf(wave_sum(ss, lane) * (1.f / DM) + EPS);
            f32x4 hm[4];
#pragma unroll
            for (int j = 0; j < 4; ++j) { const int cidx = 4 * lane + 256 * j;
                const f32x4 wv = *(const f32x4*)(wpre + cidx), s1 = *(const f32x4*)(sc + (size_t)bm * 6144 + cidx), s0 = *(const f32x4*)(sh + (size_t)bm * 6144 + cidx);
                hm[j] = (x[j] * rstd * wv) * (1.f + s1) + s0;
                u32x2 w; w.x = cvt_pk_bf16(hm[j][0], hm[j][1]); w.y = cvt_pk_bf16(hm[j][2], hm[j][3]);
                *(u32x2*)(HMb + (size_t)r * DM + cidx) = w; }
            if (WGl) {
                float mine = 0.f;
#pragma unroll
                for (int h = 0; h < 8; ++h) { float d = 0.f;
#pragma unroll
                    for (int j = 0; j < 4; ++j) { const f32x4 wv = wg[h][j]; d += (hm[j][0] * wv[0] + hm[j][1] * wv[1]) + (hm[j][2] * wv[2] + hm[j][3] * wv[3]); }
                    d = wave_sum(d, lane); if (lane == h) mine = d; }
                if (lane < 8) { const float lf = logsig(mine + bfor[lane]);
                    if (prompt) out[O_LP + ((size_t)((lnext * 4 + (r >> 12)) * 8 + lane)) * 4096 + (r & 4095)] = lf;
                    else { const int rr = r - NPR; out[O_LS + ((size_t)((lnext * 8 + (rr >> 6)) * 8 + lane)) * 64 + (rr & 63)] = lf; } }
            }
        }
    }
}

__device__ __forceinline__ void vt_finalize(const Args& a, int l, int lane, int gwi, int nw) {
    const float* PV = (const float*)(a.ws + WS_F1); bf16_t* VTP = (bf16_t*)(a.ws + WS_VTP); bf16_t* VTS = (bf16_t*)(a.ws + WS_VTS);
    for (int it = gwi; it < 16 * 128; it += nw) {
        const int tile = it >> 7, rem = it & 127, hb = rem >> 5, to = rem & 31, hdl = hb * 64 + lane, pm = tile >> 3, pn = 58 + (tile & 7);
        const int hd = pm * 256 + hdl, h = hd >> 6, d = hd & 63, tok = pn * 256 + to * 8;
        f32x4 v0 = {0.f, 0.f, 0.f, 0.f}, v1 = {0.f, 0.f, 0.f, 0.f};
#pragma unroll
        for (int ks = 0; ks < 4; ++ks) { const float* p = PV + ((size_t)(tile * 4 + ks) * 256 + hdl) * 256 + to * 8; v0 = v0 + *(const f32x4*)p; v1 = v1 + *(const f32x4*)(p + 4); }
        const u32x4 w = pack8(v0, v1);
        if (pn < 64) { const int b = tok >> 12, t = tok & 4095;
            *(u32x4*)(VTP + ((size_t)(b * 8 + h) * 64 + d) * 4096 + t) = w;
            float* o = a.out + O_VP + ((size_t)((l * 4 + b) * 8 + h) * 4096 + t) * 64 + d;
#pragma unroll
            for (int j = 0; j < 4; ++j) { o[(size_t)j * 64] = v0[j]; o[(size_t)(j + 4) * 64] = v1[j]; } }
        else { const int tt = tok - NPR, b = tt >> 6, t = tt & 63;
            *(u32x4*)(VTS + ((size_t)(b * 8 + h) * 64 + d) * KVS + PAST + t) = w;
            float* o = a.out + O_VS + ((size_t)((l * 8 + b) * 8 + h) * 64 + t) * 64 + d;
#pragma unroll
            for (int j = 0; j < 4; ++j) { o[(size_t)j * 64] = v0[j]; o[(size_t)(j + 4) * 64] = v1[j]; } }
    }
}
__device__ __forceinline__ void cumsum_items(const Args& a, int l, LAS unsigned char* lds, int tid, int wave, int lane, int c, int G) {
    LAS float* wt = (LAS float*)(lds);
    for (int it = c - 64; it >= 0 && it < 96; it += G) {
        const bool prompt = it < 32;
        float v[8]; float run = 0.f; int i0, cnt;
        if (prompt) { i0 = tid * 8; cnt = 8;
            const float* src = a.out + O_LP + (size_t)(l * 32 + it) * 4096 + i0;
            const f32x4 p0 = *(const f32x4*)src, p1 = *(const f32x4*)(src + 4);
            v[0] = p0[0]; v[1] = p0[1]; v[2] = p0[2]; v[3] = p0[3]; v[4] = p1[0]; v[5] = p1[1]; v[6] = p1[2]; v[7] = p1[3]; }
        else { const int sq = it - 32; i0 = tid * 4; cnt = tid < 272 ? 4 : 0;
            const float* src = tid < 256 ? INP(6) + (size_t)(l * 64 + sq) * PAST + i0 : a.out + O_LS + (size_t)(l * 64 + sq) * 64 + (tid < 272 ? i0 - PAST : 0);
            const f32x4 p0 = *(const f32x4*)src;
            v[0] = p0[0]; v[1] = p0[1]; v[2] = p0[2]; v[3] = p0[3]; v[4] = 0.f; v[5] = 0.f; v[6] = 0.f; v[7] = 0.f;
            if (tid >= 272) { v[0] = 0.f; v[1] = 0.f; v[2] = 0.f; v[3] = 0.f; } }
#pragma unroll
        for (int j = 0; j < 8; ++j) { run += v[j]; v[j] = run; }
        float incl = run;
#pragma unroll
        for (int o = 1; o < 64; o <<= 1) { const float t = bperm(incl, lane >= o ? lane - o : lane); if (lane >= o) incl += t; }
        if (lane == 63) wt[wave] = incl;
        __syncthreads();
        float off = incl - run;
        for (int w = 0; w < wave; ++w) off += wt[w];
        float* dst = (prompt ? (float*)(a.ws + WS_BIASP) + (size_t)it * 4096 : (float*)(a.ws + WS_BIASS) + (size_t)(it - 32) * KVS) + i0;
        if (cnt == 8) { *(f32x4*)dst = (f32x4){-(off + v[0]) * LOG2E, -(off + v[1]) * LOG2E, -(off + v[2]) * LOG2E, -(off + v[3]) * LOG2E};
                        *(f32x4*)(dst + 4) = (f32x4){-(off + v[4]) * LOG2E, -(off + v[5]) * LOG2E, -(off + v[6]) * LOG2E, -(off + v[7]) * LOG2E}; }
        else if (cnt == 4) *(f32x4*)dst = (f32x4){-(off + v[0]) * LOG2E, -(off + v[1]) * LOG2E, -(off + v[2]) * LOG2E, -(off + v[3]) * LOG2E};
        __syncthreads();
    }
}

__device__ __forceinline__ void ssm_scan(const Args& a, int l, LAS unsigned char* lds, int wave, int lane, int c, int G) {
    const float* E = (const float*)(a.ws + WS_E); bf16_t* UA = (bf16_t*)(a.ws + WS_UA); const float* A16 = (const float*)(a.ws + WS_A16);
    LAS float* endst = (LAS float*)(lds);
    for (int it = c; it < 128; it += G) {
        const int b = it >> 5, gq = it & 31, p = lane;
        const float ar = A16[(l * 32 + gq) * 128 + p], ai = A16[(l * 32 + gq) * 128 + 64 + p];
        float er[32], ei[32];
        const int ch0 = b * 256 + wave * 32;
#pragma unroll
        for (int i = 0; i < 32; ++i) { const float* e = E + ((size_t)gq * CHP + ch0 + i) * 128; er[i] = e[p]; ei[i] = e[64 + p]; }
        float hr = 0.f, hi = 0.f;
#pragma unroll
        for (int i = 0; i < 32; ++i) { const float nr = ar * hr - ai * hi + er[i], ni = ar * hi + ai * hr + ei[i]; hr = nr; hi = ni; }
        endst[(wave * 2) * 64 + p] = hr; endst[(wave * 2 + 1) * 64 + p] = hi;
        float pr = ar, pi = ai;
#pragma unroll
        for (int s = 0; s < 5; ++s) { const float nr = pr * pr - pi * pi, ni = 2.f * pr * pi; pr = nr; pi = ni; }
        __syncthreads();
        hr = 0.f; hi = 0.f;
        for (int w = 0; w < wave; ++w) { const float xr = endst[(w * 2) * 64 + p], xi = endst[(w * 2 + 1) * 64 + p];
            const float nr = pr * hr - pi * hi + xr, ni = pr * hi + pi * hr + xi; hr = nr; hi = ni; }
#pragma unroll
        for (int i = 0; i < 32; ++i) { bf16_t* u = UA + ((size_t)gq * CHP + ch0 + i) * UAK + 256; u[p] = f2bf(hr); u[64 + p] = f2bf(hi);
            const float nr = ar * hr - ai * hi + er[i], ni = ar * hi + ai * hr + ei[i]; hr = nr; hi = ni; }
        if (wave == 7) { a.out[O_RP + (size_t)((l * 4 + b) * 32 + gq) * 64 + p] = hr; a.out[O_IP + (size_t)((l * 4 + b) * 32 + gq) * 64 + p] = hi; }
        __syncthreads();
    }
    for (int it = (G - 1 - c) * 8 + wave; it < 256; it += G * 8) {
        const int b = it >> 5, gq = it & 31, p = lane;
        const float ar = A16[(l * 32 + gq) * 128 + p], ai = A16[(l * 32 + gq) * 128 + 64 + p];
        float hr = INP(7)[(size_t)((l * 8 + b) * 32 + gq) * 64 + p], hi = INP(8)[(size_t)((l * 8 + b) * 32 + gq) * 64 + p];
        const int ch0 = 1024 + b * 4;
#pragma unroll
        for (int i = 0; i < 4; ++i) { const float* e = E + ((size_t)gq * CHP + ch0 + i) * 128; const float xr = e[p], xi = e[64 + p];
            bf16_t* u = UA + ((size_t)gq * CHP + ch0 + i) * UAK + 256; u[p] = f2bf(hr); u[64 + p] = f2bf(hi);
            const float nr = ar * hr - ai * hi + xr, ni = ar * hi + ai * hr + xi; hr = nr; hi = ni; }
        a.out[O_RS + (size_t)((l * 8 + b) * 32 + gq) * 64 + p] = hr; a.out[O_IS + (size_t)((l * 8 + b) * 32 + gq) * 64 + p] = hi;
    }
}

#define DPPMAX(v, ctrl) v = fmaxf(v, __int_as_float(__builtin_amdgcn_update_dpp(0, __float_as_int(v), ctrl, 0xF, 0xF, true)))
__device__ __forceinline__ float wave_max_nonneg(float v) {
    DPPMAX(v, 0xB1); DPPMAX(v, 0x4E); DPPMAX(v, 0x141); DPPMAX(v, 0x140);
    const float r0 = __int_as_float(__builtin_amdgcn_readlane(__float_as_int(v), 0)), r1 = __int_as_float(__builtin_amdgcn_readlane(__float_as_int(v), 16));
    const float r2 = __int_as_float(__builtin_amdgcn_readlane(__float_as_int(v), 32)), r3 = __int_as_float(__builtin_amdgcn_readlane(__float_as_int(v), 48));
    return fmaxf(fmaxf(r0, r1), fmaxf(r2, r3));
}
__device__ __forceinline__ void kmax_items(const Args& a, int lane, int gw, int NGW) {
    float* KM = (float*)(a.ws + WS_KMAX);
    for (int it = NGW - 1 - gw; it < 2048 + 1088; it += NGW) {
        const bf16_t* kp; int oidx;
        if (it < 2048) { const int bh = it >> 6, t = it & 63; kp = (const bf16_t*)(a.ws + WS_KP) + ((size_t)bh * 4096 + t * 64) * 64; oidx = it; }
        else { const int r = it - 2048, sq = r / 17, t = r - sq * 17; kp = (const bf16_t*)(a.ws + WS_KS) + ((size_t)sq * KVS + t * 64) * 64; oidx = (32 + sq) * 64 + t; }
        float ss = 0.f;
#pragma unroll
        for (int i = 0; i < 8; ++i) { const u32x4 w = *(const u32x4*)(kp + (size_t)lane * 64 + i * 8);
#pragma unroll
            for (int j = 0; j < 4; ++j) { const float lo = __uint_as_float(w[j] << 16), hi = __uint_as_float(w[j] & 0xffff0000u); ss += lo * lo + hi * hi; } }
        const float m = wave_max_nonneg(ss);
        if (lane == 0) KM[oidx] = sqrtf(m) * 1.001f;
    }
}
constexpr int AT_ROW = 144, AT_TILE = 64 * AT_ROW  , AT_KB = 0, AT_VB = 4 * AT_TILE, AT_BB = 8 * AT_TILE;
__device__ __forceinline__ void attn_tile(const LAS unsigned char* Kb, const LAS unsigned char* Vb, const LAS float* Bb, const bf16x8 (&qf)[4], f32x16& o0, f32x16& o1, float& lsum,
                                          float bq, int myq, int key0, bool domask, int ka_off, int va_off, int hi) {
    f32x16 s0, s1;
#pragma unroll
    for (int a2 = 0; a2 < 2; ++a2) { const f32x4 b0 = *(const LAS f32x4*)(Bb + a2 * 16 + hi * 8), b1 = *(const LAS f32x4*)(Bb + a2 * 16 + hi * 8 + 4);
        const f32x4 c0 = *(const LAS f32x4*)(Bb + 32 + a2 * 16 + hi * 8), c1 = *(const LAS f32x4*)(Bb + 32 + a2 * 16 + hi * 8 + 4);
#pragma unroll
        for (int j = 0; j < 4; ++j) { s0[a2 * 8 + j] = b0[j]; s0[a2 * 8 + 4 + j] = b1[j]; s1[a2 * 8 + j] = c0[j]; s1[a2 * 8 + 4 + j] = c1[j]; } }
#pragma unroll
    for (int ks = 0; ks < 4; ++ks) {
        const bf16x8 k0 = *(const LAS bf16x8*)(Kb + ka_off + ks * 32), k1 = *(const LAS bf16x8*)(Kb + 32 * AT_ROW + ka_off + ks * 32);
        s0 = __builtin_amdgcn_mfma_f32_32x32x16_bf16(k0, qf[ks], s0, 0, 0, 0);
        s1 = __builtin_amdgcn_mfma_f32_32x32x16_bf16(k1, qf[ks], s1, 0, 0, 0);
    }
    if (domask) {
#pragma unroll
        for (int r = 0; r < 16; ++r) { const int kj = key0 + 16 * (r >> 3) + 8 * hi + (r & 7);
            if (kj > myq) s0[r] = -INFINITY; if (kj + 32 > myq) s1[r] = -INFINITY; }
    }
    s0 = s0 - bq; s1 = s1 - bq;
#pragma unroll
    for (int r = 0; r < 16; ++r) { s0[r] = __builtin_amdgcn_exp2f(s0[r]); s1[r] = __builtin_amdgcn_exp2f(s1[r]); }
    { const f32x16 e = s0 + s1;
      const f32x8 e8 = __builtin_shufflevector(e, e, 0, 1, 2, 3, 4, 5, 6, 7) + __builtin_shufflevector(e, e, 8, 9, 10, 11, 12, 13, 14, 15);
      const f32x4 e4 = __builtin_shufflevector(e8, e8, 0, 1, 2, 3) + __builtin_shufflevector(e8, e8, 4, 5, 6, 7);
      lsum += (e4[0] + e4[1]) + (e4[2] + e4[3]); }
    bf16x8 pa[4];
#pragma unroll
    for (int a2 = 0; a2 < 2; ++a2) {
        u32x4 w0, w1;
        w0.x = cvt_pk_bf16(s0[a2 * 8 + 0], s0[a2 * 8 + 1]); w0.y = cvt_pk_bf16(s0[a2 * 8 + 2], s0[a2 * 8 + 3]); w0.z = cvt_pk_bf16(s0[a2 * 8 + 4], s0[a2 * 8 + 5]); w0.w = cvt_pk_bf16(s0[a2 * 8 + 6], s0[a2 * 8 + 7]);
        w1.x = cvt_pk_bf16(s1[a2 * 8 + 0], s1[a2 * 8 + 1]); w1.y = cvt_pk_bf16(s1[a2 * 8 + 2], s1[a2 * 8 + 3]); w1.z = cvt_pk_bf16(s1[a2 * 8 + 4], s1[a2 * 8 + 5]); w1.w = cvt_pk_bf16(s1[a2 * 8 + 6], s1[a2 * 8 + 7]);
        pa[a2] = __builtin_bit_cast(bf16x8, w0); pa[2 + a2] = __builtin_bit_cast(bf16x8, w1);
    }
#pragma unroll
    for (int kk = 0; kk < 4; ++kk) {
        const bf16x8 v0 = *(const LAS bf16x8*)(Vb + va_off + kk * 32), v1 = *(const LAS bf16x8*)(Vb + 32 * AT_ROW + va_off + kk * 32);
        o0 = __builtin_amdgcn_mfma_f32_32x32x16_bf16(v0, pa[kk], o0, 0, 0, 0);
        o1 = __builtin_amdgcn_mfma_f32_32x32x16_bf16(v1, pa[kk], o1, 0, 0, 0);
    }
}
__device__ __forceinline__ void attn_unit(LAS unsigned char* lds, const bf16_t* Qrow0, int h, int nrows, int qpos0, int NT,
                                          const bf16_t* Kp, const bf16_t* VTp, int vpitch, const float* biasp, const float* kmaxp, bf16_t* Orow0, int tid, int wave, int lane) {
    const int q = lane & 31, hi = lane >> 5;
    const bool active = wave * 32 < nrows;
    bf16x8 qf[4];
#pragma unroll
    for (int ks = 0; ks < 4; ++ks) qf[ks] = active ? *(const bf16x8*)(Qrow0 + (size_t)(wave * 32 + q) * 512 + h * 64 + ks * 16 + hi * 8) : (bf16x8){0, 0, 0, 0, 0, 0, 0, 0};
    f32x16 o0 = {}, o1 = {};
    float lsum = 0.f;
    const int myq = qpos0 + wave * 32 + q;
    const int wq_lo = qpos0 + wave * 32, wq_hi = wq_lo + 31;
    const float bq = active ? biasp[myq] : 0.f;
    const int NS = (NT + 1) >> 1;
    int s_first;
    { float ssq = 0.f;
#pragma unroll
      for (int ks = 0; ks < 4; ++ks)
#pragma unroll
          for (int e = 0; e < 8; ++e) { const float v = __uint_as_float(((unsigned)(unsigned short)qf[ks][e]) << 16); ssq += v * v; }
      ssq += bperm(ssq, lane ^ 32);
      const float wm = wave_max_nonneg(ssq);
      volatile LAS float* qm = (volatile LAS float*)(lds + 131072 + 512);
      volatile LAS int* tst = (volatile LAS int*)(lds + 131072 + 576);
      if (lane == 0) qm[wave] = wm;
      __syncthreads();
      if (wave == 0) {
          float m2 = 0.f;
#pragma unroll
          for (int w = 0; w < 8; ++w) m2 = fmaxf(m2, qm[w]);
          const float QN = sqrtf(m2) * 1.001f;
          bool fail = true;
          if (lane < NT) fail = !(QN * kmaxp[lane] + biasp[64 * lane + 63] - biasp[qpos0] < -160.f);
          const unsigned long long mask = __builtin_amdgcn_ballot_w64(fail);
          const int tfirst = mask ? (int)__builtin_ctzll(mask) : 0;
          if (lane == 0) tst[0] = tfirst >> 1;
      }
      __syncthreads();
      s_first = tst[0]; }
    const int krow = tid >> 3, kch = tid & 7;
    const bf16_t* kg = Kp + (size_t)tid * 8;
    const bf16_t* vg = VTp + (size_t)krow * vpitch + kch * 8;
    const int st_off = krow * AT_ROW + kch * 16;
    const int kap = (q & 19) | ((q & 4) << 1) | ((q & 8) >> 1);
    const int ka_off = kap * AT_ROW + hi * 16, va_off = q * AT_ROW + hi * 16;
    u32x4 kr0, kr1, vr0, vr1; f32x4 br = {0.f, 0.f, 0.f, 0.f};
    { const int tb = 2 * s_first; kr0 = *(const u32x4*)(kg + (size_t)tb * 4096); kr1 = *(const u32x4*)(kg + (size_t)(tb + 1) * 4096); vr0 = *(const u32x4*)(vg + tb * 64); vr1 = *(const u32x4*)(vg + (tb + 1) * 64); if (tid < 32) br = *(const f32x4*)(biasp + tb * 64 + tid * 4); }
    *(LAS u32x4*)(lds + AT_KB + st_off) = kr0; *(LAS u32x4*)(lds + AT_KB + AT_TILE + st_off) = kr1;
    *(LAS u32x4*)(lds + AT_VB + st_off) = vr0; *(LAS u32x4*)(lds + AT_VB + AT_TILE + st_off) = vr1; if (tid < 32) *(LAS f32x4*)(lds + AT_BB + tid * 16) = br;
    __syncthreads();
    for (int sidx = s_first; sidx < NS; ++sidx) {
        const int buf = (sidx - s_first) & 1, t0 = 2 * sidx;
        const bool more = sidx + 1 < NS;
        if (more) { kr0 = *(const u32x4*)(kg + (size_t)(t0 + 2) * 4096); kr1 = *(const u32x4*)(kg + (size_t)(t0 + 3) * 4096); vr0 = *(const u32x4*)(vg + (t0 + 2) * 64); vr1 = *(const u32x4*)(vg + (t0 + 3) * 64);
            if (tid < 32) br = *(const f32x4*)(biasp + (t0 + 2) * 64 + tid * 4); }
        if (active) {
            const LAS unsigned char* Kb = lds + AT_KB + buf * 2 * AT_TILE;
            const LAS unsigned char* Vb = lds + AT_VB + buf * 2 * AT_TILE;
            const LAS float* Bb = (const LAS float*)(lds + AT_BB + buf * 512);
            if (t0 * 64 <= wq_hi) attn_tile(Kb, Vb, Bb, qf, o0, o1, lsum, bq, myq, t0 * 64, t0 * 64 + 63 > wq_lo, ka_off, va_off, hi);
            if ((t0 + 1) * 64 <= wq_hi) attn_tile(Kb + AT_TILE, Vb + AT_TILE, Bb + 64, qf, o0, o1, lsum, bq, myq, (t0 + 1) * 64, (t0 + 1) * 64 + 63 > wq_lo, ka_off, va_off, hi);
        }
        if (more) { const int nb = buf ^ 1;
            *(LAS u32x4*)(lds + AT_KB + nb * 2 * AT_TILE + st_off) = kr0; *(LAS u32x4*)(lds + AT_KB + nb * 2 * AT_TILE + AT_TILE + st_off) = kr1;
            *(LAS u32x4*)(lds + AT_VB + nb * 2 * AT_TILE + st_off) = vr0; *(LAS u32x4*)(lds + AT_VB + nb * 2 * AT_TILE + AT_TILE + st_off) = vr1;
            if (tid < 32) *(LAS f32x4*)(lds + AT_BB + nb * 512 + tid * 16) = br; }
        __syncthreads();
    }
    if (active) {
        lsum += bperm(lsum, lane ^ 32);
        const float inv = 1.f / lsum;
        bf16_t* orow = Orow0 + (size_t)(wave * 32 + q) * 1024 + h * 64;
#pragma unroll
        for (int i = 0; i < 4; ++i) { u32x2 w0, w1;
            w0.x = cvt_pk_bf16(o0[4 * i] * inv, o0[4 * i + 1] * inv); w0.y = cvt_pk_bf16(o0[4 * i + 2] * inv, o0[4 * i + 3] * inv);
            w1.x = cvt_pk_bf16(o1[4 * i] * inv, o1[4 * i + 1] * inv); w1.y = cvt_pk_bf16(o1[4 * i + 2] * inv, o1[4 * i + 3] * inv);
            *(u32x2*)(orow + 8 * i + 4 * hi) = w0; *(u32x2*)(orow + 32 + 8 * i + 4 * hi) = w1; }
    }
}
__device__ __forceinline__ void attn_phase(const Args& a, int l, LAS unsigned char* lds, int tid, int wave, int lane) {
    const bf16_t* Q = (const bf16_t*)(a.ws + WS_Q); bf16_t* MIX = (bf16_t*)(a.ws + WS_MIX);
    unsigned* ctr = (unsigned*)(a.ws + WS_CTL) + 3600 + 64 * l;
    volatile LAS unsigned* slot = (volatile LAS unsigned*)(lds + 131072 + 256);
    for (;;) {
        if (tid == 0) slot[0] = __hip_atomic_fetch_add(ctr, 1u, __ATOMIC_RELAXED, __HIP_MEMORY_SCOPE_AGENT);
        __syncthreads();
        const int idx = (int)slot[0];
        __syncthreads();
        if (idx >= 576) break;
        if (idx < 512) { const int qb = 15 - (idx >> 5), bh = idx & 31, b = bh >> 3, h = bh & 7; const size_t row0 = (size_t)b * 4096 + qb * 256;
            attn_unit(lds, Q + row0 * 512, h, 256, qb * 256, 4 * qb + 4, (const bf16_t*)(a.ws + WS_KP) + (size_t)bh * 4096 * 64, (const bf16_t*)(a.ws + WS_VTP) + (size_t)bh * 64 * 4096, 4096,
                      (const float*)(a.ws + WS_BIASP) + (size_t)bh * 4096, (const float*)(a.ws + WS_KMAX) + bh * 64, MIX + row0 * 1024, tid, wave, lane); }
        else { const int sidx = idx - 512, b = sidx >> 3, h = sidx & 7;
            attn_unit(lds, Q + (size_t)(NPR + b * 64) * 512, h, 64, PAST, 17, (const bf16_t*)(a.ws + WS_KS) + (size_t)sidx * KVS * 64, (const bf16_t*)(a.ws + WS_VTS) + (size_t)sidx * 64 * KVS, KVS,
                      (const float*)(a.ws + WS_BIASS) + (size_t)sidx * KVS, (const float*)(a.ws + WS_KMAX) + (32 + sidx) * 64, MIX + (size_t)(NPR + b * 64) * 1024, tid, wave, lane); }
    }
}

#define XB_TMO      128
#define XB_XCNT(j)  (256  + 64 * (j))
#define XB_XSUB(j)  (1280 + 64 * (j))
#define XB_XGEN(j)  (2304 + 64 * (j))
#define XB_TOP      3328
#define XB_TOPGEN   3392
#define XCD_BAR_WORDS 3456
#define XB_SPIN_CAP (1u << 18)
__device__ __forceinline__ unsigned xb_ld(unsigned* p)              { return __hip_atomic_load(p, __ATOMIC_RELAXED, __HIP_MEMORY_SCOPE_AGENT); }
__device__ __forceinline__ unsigned xb_add(unsigned* p, unsigned v) { return __hip_atomic_fetch_add(p, v, __ATOMIC_RELAXED, __HIP_MEMORY_SCOPE_AGENT); }
__device__ __forceinline__ unsigned xb_xcc_id() { return (unsigned)__builtin_amdgcn_s_getreg((3 << 11) | 20) & 0xFu; }
#define XB_SPIN(cond, bar) do { unsigned _sp = 0; while (cond) { __builtin_amdgcn_s_sleep(1); \
    if ((++_sp & 255u) == 0u) { if (xb_ld(&(bar)[XB_TMO])) break; if (_sp > XB_SPIN_CAP) { atomicAdd(&(bar)[XB_TMO], 1u); break; } } } } while (0)
__device__ __forceinline__ void xcd_barrier_complete(unsigned* bar, unsigned x, unsigned G, unsigned& nloc, unsigned& nx) {
    unsigned sum, cnt, mine, sp = 0u;
    for (;;) {
        sum = 0u; cnt = 0u; mine = 0u;
#pragma unroll
        for (unsigned j = 0; j < 16; ++j) { const unsigned c = xb_ld(&bar[XB_XCNT(j)]); sum += c; cnt += (c > 0u) ? 1u : 0u; mine = (j == x) ? c : mine; }
        if (sum == G) break;
        __builtin_amdgcn_s_sleep(1);
        if ((++sp & 255u) == 0u) { if (xb_ld(&bar[XB_TMO])) break; if (sp > XB_SPIN_CAP) { atomicAdd(&bar[XB_TMO], 1u); break; } }
    }
    nloc = mine > 0u ? mine : 1u; nx = cnt > 0u ? cnt : 1u;
}
__device__ __forceinline__ void xcd_barrier(unsigned* bar, volatile LAS unsigned* st, bool leader, unsigned G) {
    asm volatile("s_waitcnt vmcnt(0)" ::: "memory");
    __syncthreads();
    if (leader) {
        const unsigned x = xb_xcc_id();
        __builtin_amdgcn_s_waitcnt(0);
        unsigned nloc = st[0], nx = st[1];
        if (nloc == 0u) { xcd_barrier_complete(bar, x, G, nloc, nx); st[0] = nloc; st[1] = nx; }
        const unsigned old = xb_add(&bar[XB_XSUB(x)], 1u);
        const unsigned gen = old / nloc;
        if (old + 1u == (gen + 1u) * nloc) {
            __builtin_amdgcn_fence(__ATOMIC_RELEASE, "agent");
            asm volatile("s_waitcnt vmcnt(0)" ::: "memory");
            const unsigned og = xb_add(&bar[XB_TOP], 1u);
            const unsigned tg = og / nx;
            if (og + 1u == (tg + 1u) * nx) xb_add(&bar[XB_TOPGEN], 1u);
            else XB_SPIN(xb_ld(&bar[XB_TOPGEN]) == tg, bar);
            __builtin_amdgcn_fence(__ATOMIC_ACQUIRE, "agent");
            xb_add(&bar[XB_XGEN(x)], 1u);
            asm volatile("s_waitcnt vmcnt(0)" ::: "memory");
        } else {
            XB_SPIN(xb_ld(&bar[XB_XGEN(x)]) == gen, bar);
            __builtin_amdgcn_fence(__ATOMIC_ACQUIRE, "agent");
            asm volatile("s_waitcnt vmcnt(0)" ::: "memory");
        }
    }
    __syncthreads();
}

constexpr int NS5 = 160, CW_SUB = 3520;
__device__ __forceinline__ void sub_barrier(unsigned* ctr, unsigned target, bool leader) {
    asm volatile("s_waitcnt vmcnt(0)" ::: "memory");
    __syncthreads();
    if (leader) {
        __builtin_amdgcn_fence(__ATOMIC_RELEASE, "agent");
        asm volatile("s_waitcnt vmcnt(0)" ::: "memory");
        (void)xb_add(ctr, 1u);
        unsigned sp = 0u;
        while (xb_ld(ctr) < target) { __builtin_amdgcn_s_sleep(1); if (++sp > (1u << 22)) break; }
        __builtin_amdgcn_fence(__ATOMIC_ACQUIRE, "agent");
        asm volatile("s_waitcnt vmcnt(0)" ::: "memory");
    }
    __syncthreads();
}
#undef INP
#define INP(i) (al.in[i])
typedef const __attribute__((address_space(4))) unsigned char* kptr_t;
__device__ __forceinline__ kptr_t opq_k(kptr_t p) { asm volatile("" : "+s"(p)); return p; }
__device__ __forceinline__ Args load_args(kptr_t kp) {
    typedef const __attribute__((address_space(4))) unsigned long long* q_t; q_t q = (q_t)kp; Args r;
    typedef __attribute__((address_space(1))) const float* gcf_t; typedef __attribute__((address_space(1))) float* gf_t; typedef __attribute__((address_space(1))) unsigned char* gu8_t;
#pragma unroll
    for (int i = 0; i < 30; ++i) r.in[i] = (const float*)(gcf_t)q[i];
    r.out = (float*)(gf_t)q[30]; r.ws = (unsigned char*)(gu8_t)q[31]; return r;
}
#define FRESH() const Args al = load_args(opq_k((kptr_t)__builtin_amdgcn_kernarg_segment_ptr())); unsigned char* ws = al.ws; \
    const int G = __builtin_amdgcn_readfirstlane(opq((int)gridDim.x)); const int NGW = G * 8; (void)NGW; \
    const int wave = __builtin_amdgcn_readfirstlane(opq(wave0)); const int c = __builtin_amdgcn_readfirstlane(opq((int)blockIdx.x)); const int gw = c * 8 + wave; \
    float* MOD = (float*)(ws + WS_MOD); float* X = (float*)(ws + WS_X); bf16_t* HM = (bf16_t*)(ws + WS_HM); bf16_t* F1 = (bf16_t*)(ws + WS_F1); bf16_t* MIX = (bf16_t*)(ws + WS_MIX); \
    (void)MOD; (void)X; (void)HM; (void)F1; (void)MIX; (void)gw;
#define LAYER_BODY(l) { \
        { FRESH(); PH(5) cumsum_items(al, l, lds, tid, wave, lane, c, G); } \
        PH(6) { FRESH(); pg8::Gemm g{HM, (const bf16_t*)(ws + WS_WIN) + (size_t)l * 1536 * 1024, MT, 1536, 1024, 1024, 1024, 1 << 20, 0, 512u, (const bf16_t*)(ws + WS_WV) + (size_t)l * 512 * 1024, HM}; \
          pg8::PhaseAOrder S; S.init(G, c); \
          EpiA E{EpiIn{(bf16_t*)(ws + WS_Q), (bf16_t*)(ws + WS_KP), (bf16_t*)(ws + WS_KS), (bf16_t*)(ws + WS_UA), al.out, l}, EpiVT{(bf16_t*)(ws + WS_VTP), (bf16_t*)(ws + WS_VTS), al.out, l, lds}, EpiVtPart{(float*)(ws + WS_F1)}}; \
          pg8::gemm_phase(lds, g, S, E, wave); } \
        GSYNC(); \
        { FRESH(); kmax_items(al, lane, gw, NGW); vt_finalize(al, l, lane, gw, NGW); } \
        GSYNC(); \
        if (INS5) { \
        PH(8) { FRESH(); pg8::Gemm g{(const bf16_t*)(ws + WS_UA), (const bf16_t*)(ws + WS_BT1) + (size_t)l * 32 * 128 * 256, NG * CHP, 256, 256, UAK, 256, 5, (size_t)128 * 256, 0u}; \
          pg8::StaticOrder S; S.init(NG * CHP, 256, NS5, c); \
          EpiE E{(float*)(ws + WS_E)}; \
          pg8::gemm_phase(lds, g, S, E, wave); } \
        SUBBAR((l) * 3 + 1); \
        { FRESH(); PH(9) ssm_scan(al, l, lds, wave, lane, c, NS5); } \
        SUBBAR((l) * 3 + 2); \
        PH(10) { FRESH(); pg8::Gemm g{(const bf16_t*)(ws + WS_UA), (const bf16_t*)(ws + WS_BT3) + (size_t)l * 32 * 256 * UAK, NG * CHP, 256, UAK, UAK, UAK, 5, (size_t)256 * UAK, 0u}; \
          pg8::StaticOrder S; S.init(NG * CHP, 256, NS5, c); \
          EpiZ E{(bf16_t*)(ws + WS_Z)}; \
          pg8::gemm_phase(lds, g, S, E, wave); } \
        SUBBAR((l) * 3 + 3); \
        PH(11) { FRESH(); pg8::Gemm g{(const bf16_t*)(ws + WS_Z), (const bf16_t*)(ws + WS_WGLU) + (size_t)l * 512 * 512, MT, 512, 512, 512, 512, 1 << 20, 0, 0u}; \
          pg8::StaticOrder S; S.init(MT, 512, NS5, c); \
          EpiGlu E{(const bf16_t*)(ws + WS_Z), MIX}; \
          pg8::gemm_phase(lds, g, S, E, wave); } \
        __syncthreads(); \
        } \
        { FRESH(); PH(12) attn_phase(al, l, lds, tid, wave, lane); } \
        GSYNC(); \
        PH(13) { FRESH(); pg8::Gemm g{MIX, (const bf16_t*)(ws + WS_WOUT) + (size_t)l * 1024 * 1024, MT, 1024, 1024, 1024, 1024, 1 << 20, 0, 256u}; \
          pg8::MainSplitOrder S; S.init(G, c, 8, 2); \
          EpiMS E{EpiPlain{F1, 1024}, EpiAtomic{(float*)(ws + WS_Q)}}; \
          pg8::gemm_phase(lds, g, S, E, wave); } \
        GSYNC(); \
        { FRESH(); const float* modl = MOD + (size_t)l * 12 * 6144; \
          PH(14) rowpass<8>(INP(0), INP(1), l == 0 ? (const bf16_t*)nullptr : (const bf16_t*)X, F1, (const float*)(ws + WS_Q), 8, modl + 2 * 1024, INP(12) + l * 1024, nullptr, (bf16_t*)X, \
                INP(13) + l * 1024, modl + 4 * 1024, modl + 3 * 1024, HM, nullptr, nullptr, al.out, 0, lane, gw, NGW); } \
        GSYNC(); \
        PH(15) { FRESH(); pg8::Gemm g{HM, (const bf16_t*)(ws + WS_WGU) + (size_t)l * 5632 * 1024, MT, 5632, 1024, 1024, 1024, 1 << 20, 0, 0u}; \
          pg8::StaticOrder S; S.init(MT, 5632, G, c); \
          EpiSwi E{(bf16_t*)(ws + WS_H)}; \
          pg8::gemm_phase(lds, g, S, E, wave); } \
        { FRESH(); if ((l) + 1 < NL && c >= 172) { __syncthreads(); p0_weights(al, (l) + 1, false, lds, wave, lane, (c - 172) * 8 + wave, (G - 172) * 8); } } \
        GSYNC(); \
        PH(16) { FRESH(); pg8::Gemm g{(const bf16_t*)(ws + WS_H), (const bf16_t*)(ws + WS_WD) + (size_t)l * 1024 * DFF, MT, 1024, DFF, DFF, DFF, 1 << 20, 0, 512u}; \
          pg8::MainSplitOrder S; S.init(G, c, 11, 4); \
          EpiMS E{EpiPlain{F1, 1024}, EpiAtomic{(float*)(ws + WS_FS2)}}; \
          pg8::gemm_phase(lds, g, S, E, wave); } \
        GSYNC(); \
        if (l + 1 < NL) { \
            { FRESH(); const float* modl = MOD + (size_t)l * 12 * 6144; const float* modn = MOD + (size_t)(l + 1) * 12 * 6144; \
              PH(17) rowpass<11>(INP(0), INP(1), (const bf16_t*)X, F1, (const float*)(ws + WS_FS2), 11, modl + 5 * 1024, INP(14) + l * 1024, nullptr, (bf16_t*)X, INP(11) + (l + 1) * 1024, modn + 1024, modn, HM, \
                    (const float*)(ws + WS_WG) + (size_t)(l + 1) * 8 * 1024, INP(16) + (l + 1) * 8, al.out, l + 1, lane, gw, NGW); \
              PH(1) cache_convert(al, l + 1, lds, wave, lane, gw, NGW); } \
            GSYNC(); \
        } else { \
            FRESH(); const float* modl = MOD + (size_t)l * 12 * 6144; \
            PH(18) rowpass<11>(INP(0), INP(1), (const bf16_t*)X, F1, (const float*)(ws + WS_FS2), 11, modl + 5 * 1024, INP(14) + l * 1024, al.out, nullptr, nullptr, nullptr, nullptr, nullptr, nullptr, nullptr, al.out, 0, lane, gw, NGW); \
        } \
    }
__global__ void __launch_bounds__(512, 2) mega(Args a) {
    extern __shared__ __attribute__((aligned(16))) unsigned char lds_raw[];
    LAS unsigned char* lds = (LAS unsigned char*)lds_raw;
    cg::grid_group grid = cg::this_grid();
    const int wave0 = __builtin_amdgcn_readfirstlane((int)threadIdx.x >> 6);
#define GSYNC() do { const Args alb = load_args(opq_k((kptr_t)__builtin_amdgcn_kernarg_segment_ptr())); \
        const int ln_ = (int)__builtin_amdgcn_mbcnt_hi(~0u, __builtin_amdgcn_mbcnt_lo(~0u, (unsigned)opq(0))); \
        xcd_barrier((unsigned*)(alb.ws + WS_CTL), (volatile LAS unsigned*)(lds + LDS_MISC), wave0 == 0 && ln_ == 0, (unsigned)gridDim.x); } while (0)
#define SUBBAR(seq) do { const Args alb = load_args(opq_k((kptr_t)__builtin_amdgcn_kernarg_segment_ptr())); \
        const int ln_ = (int)__builtin_amdgcn_mbcnt_hi(~0u, __builtin_amdgcn_mbcnt_lo(~0u, (unsigned)opq(0))); \
        xcd_barrier((unsigned*)(alb.ws + WS_CTL) + 4096, (volatile LAS unsigned*)(lds + LDS_MISC + 16), wave0 == 0 && ln_ == 0, (unsigned)NS5); } while (0)
#define INS5 (__builtin_amdgcn_readfirstlane(opq((int)blockIdx.x)) < NS5)
    if (threadIdx.x < 8) ((volatile LAS unsigned*)(lds + LDS_MISC))[threadIdx.x] = 0u;
    if (threadIdx.x == 0) (void)xb_add((unsigned*)(a.ws + WS_CTL) + XB_XCNT(xb_xcc_id()), 1u);
    if (threadIdx.x == 0 && blockIdx.x < NS5) (void)xb_add((unsigned*)(a.ws + WS_CTL) + 4096 + XB_XCNT(xb_xcc_id()), 1u);
    __syncthreads();
#define lane ((int)__builtin_amdgcn_mbcnt_hi(~0u, __builtin_amdgcn_mbcnt_lo(~0u, (unsigned)opq(0))))
#define tid (wave * 64 + lane)

    { FRESH();
      PH(0) p0_weights(al, 0, true, lds, wave, lane, gw, NGW);
      PH(1) cache_convert(al, 0, lds, wave, lane, gw, NGW);
      __syncthreads();
      PH(2) p0_adaln(al, lds, tid, wave, lane, c, G);
      PH(3) p0_ssm(al, lds, tid, (c + 128) % G, G); }
    grid.sync();
    { FRESH();
      PH(4) rowpass<0>(INP(0), INP(1), nullptr, nullptr, nullptr, 0, nullptr, nullptr, nullptr, nullptr, INP(11), MOD + 1024, MOD, HM, (const float*)(ws + WS_WG), INP(16), al.out, 0, lane, gw, NGW); }
    GSYNC();

    LAYER_BODY(0)
    LAYER_BODY(1)
    LAYER_BODY(2)
    LAYER_BODY(3)
}
#undef tid
#undef lane

extern "C" void kernel_launch(void* const* d_in, const int* in_sizes, int n_in, void* d_out, int out_size, void* d_ws, size_t ws_size, hipStream_t stream) {
    static int grid = 0;
    if (grid == 0) {
        if (n_in != 30 || (size_t)out_size != O_END || ws_size < WS_END) { fprintf(stderr, "kernel_launch: unexpected sizes n_in %d out %d ws %zu\n", n_in, out_size, ws_size); grid = -1; return; }
        int dev = 0, cus = 0, per_cu = 0;
        hipGetDevice(&dev); hipDeviceGetAttribute(&cus, hipDeviceAttributeMultiprocessorCount, dev);
        hipFuncSetAttribute((const void*)mega, hipFuncAttributeMaxDynamicSharedMemorySize, LDS_BYTES);
        hipOccupancyMaxActiveBlocksPerMultiprocessor(&per_cu, (const void*)mega, 512, LDS_BYTES);
        if (per_cu < 1) { fprintf(stderr, "kernel_launch: occupancy query reports %d blocks per CU\n", per_cu); grid = -1; return; }
        if (cus != 256) { fprintf(stderr, "kernel_launch: this build's static unit orders need 256 CUs (found %d)\n", cus); grid = -1; return; }
        grid = cus;
    }
    if (grid < 0) return;
    if (hipMemsetAsync((char*)d_ws + WS_CTL, 0, CTL_BYTES, stream) != hipSuccess) { fprintf(stderr, "kernel_launch: memset failed\n"); return; }
    Args a{};
    for (int i = 0; i < 30; ++i) a.in[i] = (const float*)d_in[i];
    a.out = (float*)d_out; a.ws = (unsigned char*)d_ws;
    void* args[] = {&a};
    hipError_t e = hipLaunchCooperativeKernel((const void*)mega, dim3(grid), dim3(512), args, LDS_BYTES, stream);
    if (e != hipSuccess) fprintf(stderr, "cooperative launch failed: %s (grid %d)\n", hipGetErrorString(e), grid);
}
```

```cpp
#include <hip/hip_runtime.h>
#include <hip/hip_cooperative_groups.h>
#include <cstdio>
#include <cstdint>
namespace cg = cooperative_groups;

#define LAS __attribute__((address_space(3)))
typedef unsigned short bf16_t;
typedef short bf16x8 __attribute__((ext_vector_type(8)));
typedef float f32x4 __attribute__((ext_vector_type(4)));
typedef float f32x16 __attribute__((ext_vector_type(16)));
typedef float f32x8 __attribute__((ext_vector_type(8)));
typedef unsigned u32x4 __attribute__((ext_vector_type(4)));
typedef unsigned u32x2 __attribute__((ext_vector_type(2)));

constexpr int DM = 1024, NPR = 16384, NSM = 512, MT = 16896, NL = 4, NH = 8, HD = 64;
constexpr int SEQ = 4096, PAST = 1024, DSEQ = 64, KVS = 1088, DFF = 2816, DIN = 2056;
constexpr int NG = 32, NP = 64, MG = 16, LC = 16, NCH = MT / LC  , CHP = 1280  , UAK = 384;
constexpr float C2 = 0.125f * 1.4426950408889634f, LOG2E = 1.4426950408889634f, EPS = 1e-6f;
constexpr size_t O_YP = 0, O_KP = 17301504, O_VP = 50855936, O_LP = 84410368, O_RP = 84934656, O_IP = 84967424,
                 O_KS = 85000192, O_VS = 86048768, O_LS = 87097344, O_RS = 87113728, O_IS = 87179264, O_END = 87244800;
constexpr size_t MiB = 1u << 20;
constexpr size_t WS_CTL = 1536 * 1024, CTL_BYTES = 32768;
constexpr int LDS_MISC = 131072 + 64;
constexpr size_t WS_MOD = 0, WS_WG = 2 * MiB, WS_A16 = 2 * MiB + 256 * 1024, WS_BIASP = 3 * MiB, WS_BIASS = 3 * MiB + 512 * 1024, WS_KMAX = 2 * MiB + 384 * 1024;
constexpr size_t WS_WIN = 4 * MiB, WS_WV = 16 * MiB, WS_WGLU = 20 * MiB, WS_WOUT = 22 * MiB, WS_WGU = 30 * MiB, WS_WD = 74 * MiB;
constexpr size_t WS_BT3 = 96 * MiB, WS_BT1 = 120 * MiB, WS_HM = 130 * MiB, WS_X = 164 * MiB, WS_F1 = 230 * MiB, WS_MIX = 264 * MiB;
constexpr size_t WS_Q = 298 * MiB, WS_KP = 315 * MiB, WS_VTP = 331 * MiB, WS_KS = 347 * MiB, WS_VTS = 356 * MiB, WS_UA = 365 * MiB,
                 WS_E = 395 * MiB, WS_Z = 415 * MiB, WS_H = 298 * MiB, WS_FS1 = 435 * MiB, WS_FS2 = 443 * MiB, WS_END = 465 * MiB;
constexpr int LDS_BYTES = 151552;
#ifndef PH_MASK
#define PH_MASK 0xffffffffu
#endif
#define PH(k) if (PH_MASK & (1u << (k)))

__device__ __forceinline__ unsigned cvt_pk_bf16(float lo, float hi) { unsigned r; asm volatile("v_cvt_pk_bf16_f32 %0, %1, %2" : "=v"(r) : "v"(lo), "v"(hi)); return r; }
__device__ __forceinline__ bf16_t f2bf(float f) { return (bf16_t)(cvt_pk_bf16(f, 0.f) & 0xffffu); }
__device__ __forceinline__ float bf2f(unsigned short b) { return __uint_as_float(((unsigned)b) << 16); }
__device__ __forceinline__ int opq(int x) { asm volatile("" : "+v"(x)); return x; }
__device__ __forceinline__ float bperm(float v, int srclane) { return __int_as_float(__builtin_amdgcn_ds_bpermute(srclane << 2, __float_as_int(v))); }
__device__ __forceinline__ float dpp_f(float v, const int ctrl) { return v; }
#define DPPADD(v, ctrl) v += __int_as_float(__builtin_amdgcn_update_dpp(0, __float_as_int(v), ctrl, 0xF, 0xF, true))
__device__ __forceinline__ float wave_sum(float v, int ln) {
    (void)ln;
    DPPADD(v, 0xB1);
    DPPADD(v, 0x4E);
    DPPADD(v, 0x141);
    DPPADD(v, 0x140);
    const float r0 = __int_as_float(__builtin_amdgcn_readlane(__float_as_int(v), 0)), r1 = __int_as_float(__builtin_amdgcn_readlane(__float_as_int(v), 16));
    const float r2 = __int_as_float(__builtin_amdgcn_readlane(__float_as_int(v), 32)), r3 = __int_as_float(__builtin_amdgcn_readlane(__float_as_int(v), 48));
    return (r0 + r1) + (r2 + r3);
}
__device__ __forceinline__ float sigm(float x) { return __builtin_amdgcn_rcpf(1.f + __builtin_amdgcn_exp2f(-1.4426950408889634f * x)); }
__device__ __forceinline__ float silu_f(float x) { return x * sigm(x); }
__device__ __forceinline__ float gelu_f(float x) { const float u = 0.7978845608028654f * (x + 0.044715f * x * x * x); return x * sigm(2.f * u); }
__device__ __forceinline__ float logsig(float x) { return fminf(x, 0.f) - log1pf(__expf(-fabsf(x))); }

namespace pg8 {
constexpr int BM = 256, BK = 64, HALF = 128, HTB = HALF * BK * 2, STAGE_BYTES = 8 * HTB, NXCD = 8, WGM = 8;
__host__ __device__ __forceinline__ int lds_byte(int r, int c) { const int st = (r >> 4) * 2 + (c >> 5), rr = r & 15, cc = c & 31, ob = rr * 64 + cc * 2; return st * 1024 + (ob ^ (((ob >> 9) & 1) << 5)); }
__host__ __device__ __forceinline__ void stage_rc(int b, int& R, int& C) { const int st = b / 1024, sb = b % 1024, swz = sb ^ (((sb >> 9) & 1) << 5); R = (st >> 1) * 16 + swz / 64; C = (st & 1) * 32 + (swz % 64) / 2; }
__host__ __device__ __forceinline__ int perm32(int rho) { const int n = rho >> 4, i = rho & 15; return 8 * (i >> 2) + 4 * n + (i & 3); }
struct Unit { int pm, pn, ks, kind, nt; };
struct Gemm { const bf16_t* A; const bf16_t* Bt; int M, N, K, lda, ldb, gdiv; size_t gstrideB; unsigned kcb; const bf16_t* A1; const bf16_t* Bt1; };
struct StaticOrder {
    int nM, nN, nwg, G, c;
    __device__ __forceinline__ void init(int M, int N, int G_, int c_) { nM = M / BM; nN = N / BM; nwg = nM * nN; G = G_; c = c_; }
    __device__ __forceinline__ bool next(int i, Unit& u) const {
        const long L = (long)i * G + c; if (L >= nwg) return false;
        int wgid = (int)L; { const int q = nwg / NXCD, r = nwg % NXCD, xcd = wgid % NXCD, off = wgid / NXCD; wgid = (xcd < r ? xcd * (q + 1) : r * (q + 1) + (xcd - r) * q) + off; }
        const int nig = WGM * nN, gid = wgid / nig, fm = gid * WGM, gsz = (nM - fm) < WGM ? (nM - fm) : WGM;
        u.pm = fm + ((wgid % nig) % gsz); u.pn = (wgid % nig) / gsz; u.ks = 0; u.kind = 0; u.nt = 0; return true;
    }
};
struct SplitOrder {
    int nsub, G, c, S;
    __device__ __forceinline__ void init(int S_, int G_, int c_) { S = S_; nsub = 8 * S_; G = G_; c = c_; }
    __device__ __forceinline__ bool next(int i, Unit& u) const { const int idx = i * G + c; if (idx >= nsub) return false; u.ks = idx % S; const int t = idx / S; u.pn = t & 3; u.pm = 64 + (t >> 2); u.kind = 0; u.nt = 0; return true; }
};
struct VtOrder {
    int idx;
    __device__ __forceinline__ void init(int G_, int c_) { idx = c_ - (G_ - 116); }
    __device__ __forceinline__ bool next(int i, Unit& u) const { if (i != 0 || idx < 0 || idx >= 116) return false; u.pm = idx / 58; u.pn = idx - u.pm * 58; u.ks = 0; u.kind = 0; u.nt = 0; return true; }
};
struct VtSplitOrder {
    int c;
    __device__ __forceinline__ void init(int c_) { c = c_; }
    __device__ __forceinline__ bool next(int i, Unit& u) const { if (i != 0 || c >= 64) return false; const int tile = c >> 2; u.ks = c & 3; u.pm = tile >> 3; u.pn = 58 + (tile & 7); u.kind = 0; u.nt = 0; return true; }
};
struct PhaseAOrder {
    StaticOrder so; int c;
    __device__ __forceinline__ void init(int G_, int c_) { so.init(MT, 1536, G_, c_); c = c_; }
    __device__ __forceinline__ bool next(int i, Unit& u) const {
        Unit t = {0, 0, 0, 0, 0}; bool ok = false;
        if (i <= 1) ok = so.next(i, t);
        int pm = t.pm, pn = t.pn, ks = 0, kind = 0, nt = 0;
        if (i == 1 && !ok) { const int idx = c - 140; ok = idx >= 0 && idx < 116; pm = idx / 58; pn = idx - pm * 58; kind = 1; nt = 16; }
        if (i == 2) { ok = c < 64; const int tile = c >> 2; ks = c & 3; pm = tile >> 3; pn = 58 + (tile & 7); kind = 1; nt = 4; }
        u.pm = pm; u.pn = pn; u.ks = ks; u.kind = kind; u.nt = nt;
        return ok;
    }
};
struct MainSplitOrder {
    StaticOrder so; int c, S, nts;
    __device__ __forceinline__ void init(int G_, int c_, int S_, int nts_) { so.init(NPR, 1024, G_, c_); c = c_; S = S_; nts = nts_; }
    __device__ __forceinline__ bool next(int i, Unit& u) const {
        Unit t = {0, 0, 0, 0, 0}; bool ok = false;
        if (i == 0) ok = so.next(0, t);
        int pm = t.pm, pn = t.pn, ks = 0, nt = 0;
        if (i == 1) { ok = c < 8 * S; ks = c % S; const int tt = c / S; pn = tt & 3; pm = 64 + (tt >> 2); nt = nts; }
        u.pm = pm; u.pn = pn; u.ks = ks; u.kind = 0; u.nt = nt;
        return ok;
    }
};
template <class Epi, class Sched>
__device__ __forceinline__ void gemm_phase(LAS unsigned char* lds, const Gemm g, const Sched& S, const Epi& E, const int wave_id) {
    const int lane = (int)__builtin_amdgcn_mbcnt_hi(~0u, __builtin_amdgcn_mbcnt_lo(~0u, (unsigned)opq(0))), wid = wave_id, tid = wid * 64 + lane, wr = wid >> 2, wc = wid & 3, fr = lane & 15, fq = lane >> 4;
    unsigned voffA[2], voffB[2];
#pragma unroll
    for (int i = 0; i < 2; ++i) { int R, C; stage_rc(tid * 16 + i * 8192, R, C); const int Rb = (R & ~31) + perm32(R & 31);
        voffA[i] = (unsigned)(R * g.lda + C) * 2u; voffB[i] = (unsigned)(Rb * g.ldb + C) * 2u; }
    const unsigned kstep = (unsigned)(BK * 2);
    const unsigned hstepA = (unsigned)HALF * g.lda * 2, hstepB = (unsigned)HALF * g.ldb * 2, tstepA = 2 * hstepA, tstepB = 2 * hstepB;
    const unsigned ldsw = (unsigned)wid * 1024u;
    const int aoff = lds_byte(wr * 64 + fr, fq * 8), boff = lds_byte(wc * 32 + fr, fq * 8);
#define PG8_SA(b, h) (((b) * 2 + (h)) * HTB)
#define PG8_SB(b, h) ((4 + (b) * 2 + (h)) * HTB)
#define PG8_STAGE(bufoff, gbase, voff) do { _Pragma("unroll") for (int _i = 0; _i < 2; ++_i) \
        __builtin_amdgcn_global_load_lds((const unsigned*)((const char*)(gbase) + (voff)[_i]), (LAS unsigned*)(lds + (bufoff) + ldsw + _i * 8192), 16, 0, 0); } while (0)
#define PG8_LDA(dst, b, h) do { _Pragma("unroll") for (int m = 0; m < 4; ++m) _Pragma("unroll") for (int k = 0; k < 2; ++k) dst[m][k] = *(const LAS bf16x8*)(lds + PG8_SA(b, h) + aoff + m * 2048 + k * 1024); } while (0)
#define PG8_LDB(dst, b, h) do { _Pragma("unroll") for (int n = 0; n < 2; ++n) _Pragma("unroll") for (int k = 0; k < 2; ++k) dst[n][k] = *(const LAS bf16x8*)(lds + PG8_SB(b, h) + boff + n * 2048 + k * 1024); } while (0)
#define PG8_MMA(ai, bj, At, Bt) do { __builtin_amdgcn_s_setprio(1); _Pragma("unroll") for (int m = 0; m < 4; ++m) _Pragma("unroll") for (int n = 0; n < 2; ++n) _Pragma("unroll") for (int k = 0; k < 2; ++k) \
        acc[ai][bj][m][n] = __builtin_amdgcn_mfma_f32_16x16x32_bf16(Bt[n][k], At[m][k], acc[ai][bj][m][n], 0, 0, 0); __builtin_amdgcn_s_setprio(0); } while (0)
#define PG8_WAIT_V(n) asm volatile("s_waitcnt vmcnt(" #n ")" ::: "memory")
#define PG8_WAIT_L(n) asm volatile("s_waitcnt lgkmcnt(" #n ")" ::: "memory")
#define PG8_BAR __builtin_amdgcn_s_barrier()
#define PG8_SCHED __builtin_amdgcn_sched_barrier(0)
    Unit cur = {0, 0, 0, 0, 0}, nxt = {0, 0, 0, 0, 0}; int ui = 0;
    if (!S.next(0, cur)) return;
    f32x4 acc[2][2][4][2];
    const float zf = __int_as_float(opq(0)); const f32x4 zero4 = (f32x4){zf, zf, zf, zf};
#pragma unroll
    for (int a = 0; a < 2; ++a)
#pragma unroll
        for (int b = 0; b < 2; ++b)
#pragma unroll
            for (int m = 0; m < 4; ++m)
#pragma unroll
                for (int n = 0; n < 2; ++n) acc[a][b][m][n] = zero4;
    bf16x8 At[4][2], B0[2][2], B1[2][2];
    const char* cA = (const char*)(cur.kind ? g.A1 : g.A) + (size_t)cur.pm * tstepA + (size_t)cur.ks * g.kcb;
    const char* cB = (const char*)(cur.kind ? g.Bt1 : g.Bt) + (size_t)(cur.pm / g.gdiv) * g.gstrideB * 2 + (size_t)cur.pn * tstepB + (size_t)cur.ks * g.kcb;
    int nt = cur.nt ? cur.nt : g.K / BK;
    PG8_STAGE(PG8_SB(0, 0), cB, voffB); PG8_STAGE(PG8_SB(0, 1), cB + hstepB, voffB); PG8_STAGE(PG8_SA(0, 0), cA, voffA); PG8_STAGE(PG8_SA(0, 1), cA + hstepA, voffA);
    if (wr == 1) PG8_BAR;
    PG8_WAIT_V(2); PG8_BAR;
    PG8_STAGE(PG8_SB(1, 0), cB + kstep, voffB); PG8_STAGE(PG8_SA(1, 0), cA + kstep, voffA); PG8_STAGE(PG8_SB(1, 1), cB + hstepB + kstep, voffB);
    PG8_WAIT_V(6); PG8_BAR;
    for (;;) {
        nxt.pm = 0; nxt.pn = 0; nxt.ks = 0; nxt.kind = 0; nxt.nt = 0;
        const bool has_next = S.next(ui + 1, nxt);
        const char* nA = has_next ? (const char*)(nxt.kind ? g.A1 : g.A) + (size_t)nxt.pm * tstepA + (size_t)nxt.ks * g.kcb : cA;
        const char* nB = has_next ? (const char*)(nxt.kind ? g.Bt1 : g.Bt) + (size_t)(nxt.pm / g.gdiv) * g.gstrideB * 2 + (size_t)nxt.pn * tstepB + (size_t)nxt.ks * g.kcb : cB;
#pragma unroll 1
        for (int t = 0; t < nt; t += 2) {
            const bool last = (t == nt - 2);
            const char* a1 = cA + (unsigned)(t + 1) * kstep;
            const char* a2 = last ? nA : cA + (unsigned)(t + 2) * kstep; const char* b2 = last ? nB : cB + (unsigned)(t + 2) * kstep;
            const char* a3 = a2 + kstep; const char* b3 = b2 + kstep;
            PG8_LDB(B0, 0, 0); PG8_LDB(B1, 0, 1); PG8_SCHED; PG8_LDA(At, 0, 0); PG8_STAGE(PG8_SA(1, 1), a1 + hstepA, voffA);
            PG8_WAIT_V(8); PG8_WAIT_L(0); PG8_BAR; PG8_MMA(0, 0, At, B0); PG8_MMA(0, 1, At, B1); PG8_BAR; PG8_SCHED;
            PG8_LDA(At, 0, 1); PG8_STAGE(PG8_SB(0, 0), b2, voffB); PG8_STAGE(PG8_SB(0, 1), b2 + hstepB, voffB); PG8_STAGE(PG8_SA(0, 0), a2, voffA);
            PG8_WAIT_V(8); PG8_WAIT_L(0); PG8_BAR; PG8_MMA(1, 0, At, B0); PG8_MMA(1, 1, At, B1); PG8_BAR; PG8_SCHED;
            PG8_LDB(B0, 1, 0); PG8_LDB(B1, 1, 1); PG8_SCHED; PG8_LDA(At, 1, 0); PG8_STAGE(PG8_SA(0, 1), a2 + hstepA, voffA);
            PG8_WAIT_V(8); PG8_WAIT_L(0); PG8_BAR; PG8_MMA(0, 0, At, B0); PG8_MMA(0, 1, At, B1); PG8_BAR; PG8_SCHED;
            PG8_LDA(At, 1, 1); PG8_STAGE(PG8_SB(1, 0), b3, voffB); PG8_STAGE(PG8_SB(1, 1), b3 + hstepB, voffB); PG8_STAGE(PG8_SA(1, 0), a3, voffA);
            PG8_WAIT_V(8); PG8_WAIT_L(0); PG8_BAR; PG8_MMA(1, 0, At, B0); PG8_MMA(1, 1, At, B1); PG8_BAR; PG8_SCHED;
        }
        if (wr == 0) PG8_BAR;
        E(acc, cur, wr, wc, fr, fq);
        if (!has_next) break;
#pragma unroll
        for (int a = 0; a < 2; ++a)
#pragma unroll
            for (int b = 0; b < 2; ++b)
#pragma unroll
                for (int m = 0; m < 4; ++m)
#pragma unroll
                    for (int n = 0; n < 2; ++n) acc[a][b][m][n] = zero4;
        cur = nxt; cA = nA; cB = nB; ++ui; nt = cur.nt ? cur.nt : g.K / BK;
        if (wr == 1) PG8_BAR;
    }
    PG8_WAIT_V(0);
    PG8_BAR;
#undef PG8_SA
#undef PG8_SB
#undef PG8_STAGE
#undef PG8_LDA
#undef PG8_LDB
#undef PG8_MMA
#undef PG8_WAIT_V
#undef PG8_WAIT_L
#undef PG8_BAR
#undef PG8_SCHED
}
}
using pg8::Unit;
typedef const f32x4 (&AccRef)[2][2][4][2];
__device__ __forceinline__ u32x4 pack8(f32x4 v0, f32x4 v1) { u32x4 w; w.x = cvt_pk_bf16(v0[0], v0[1]); w.y = cvt_pk_bf16(v0[2], v0[3]); w.z = cvt_pk_bf16(v1[0], v1[1]); w.w = cvt_pk_bf16(v1[2], v1[3]); return w; }

struct EpiPlain {
    bf16_t* O; int ldc;
    __device__ __forceinline__ void operator()(AccRef acc, const Unit& u, int wr, int wc, int fr, int fq) const {
        fr = opq(fr); fq = opq(fq);
#pragma unroll
        for (int ai = 0; ai < 2; ++ai)
#pragma unroll
            for (int m = 0; m < 4; ++m) { const int r = u.pm * 256 + ai * 128 + wr * 64 + m * 16 + fr;
#pragma unroll
                for (int bj = 0; bj < 2; ++bj) { const int c = u.pn * 256 + bj * 128 + wc * 32 + 8 * fq;
                    *(u32x4*)(O + (size_t)r * ldc + c) = pack8(acc[ai][bj][m][0], acc[ai][bj][m][1]); } }
    }
};
struct EpiIn {
    bf16_t *Q, *KP, *KS, *UA; float* out; int l;
    __device__ __forceinline__ void operator()(AccRef acc, const Unit& u, int wr, int wc, int fr, int fq) const {
        fr = opq(fr); fq = opq(fq);
        const bool prompt = u.pm < 64;
#pragma unroll
        for (int ai = 0; ai < 2; ++ai)
#pragma unroll
            for (int m = 0; m < 4; ++m) { const int r = u.pm * 256 + ai * 128 + wr * 64 + m * 16 + fr;
#pragma unroll
                for (int bj = 0; bj < 2; ++bj) { const int c = u.pn * 256 + bj * 128 + wc * 32 + 8 * fq;
                    const f32x4 v0 = acc[ai][bj][m][0], v1 = acc[ai][bj][m][1];
                    if (u.pn < 2) { *(u32x4*)(Q + (size_t)r * 512 + c) = pack8(v0 * C2, v1 * C2); }
                    else if (u.pn < 4) { const int ck = c - 512, h = ck >> 6, d = ck & 63; const u32x4 w = pack8(v0, v1);
                        if (prompt) { const int b = r >> 12, t = r & 4095;
                            *(u32x4*)(KP + ((size_t)(b * 8 + h) * 4096 + t) * 64 + d) = w;
                            float* o = out + O_KP + ((size_t)((l * 4 + b) * 8 + h) * 4096 + t) * 64 + d; __builtin_nontemporal_store(v0, (f32x4*)o); __builtin_nontemporal_store(v1, (f32x4*)(o + 4)); }
                        else { const int rr = r - NPR, b = rr >> 6, t = rr & 63;
                            *(u32x4*)(KS + ((size_t)(b * 8 + h) * KVS + PAST + t) * 64 + d) = w;
                            float* o = out + O_KS + ((size_t)((l * 8 + b) * 8 + h) * 64 + t) * 64 + d; __builtin_nontemporal_store(v0, (f32x4*)o); __builtin_nontemporal_store(v1, (f32x4*)(o + 4)); } }
                    else { const int cu = c - 1024, gq = cu >> 4, m0 = cu & 15, chunk = r >> 4, s = r & 15;
                        *(u32x4*)(UA + ((size_t)gq * CHP + chunk) * UAK + s * 16 + m0) = pack8(v0, v1); }
                    asm volatile("" ::: "memory"); } }
    }
};
struct EpiVT {
    bf16_t *VTP, *VTS; float* out; int l; LAS unsigned char* lds;
    __device__ __forceinline__ void operator()(AccRef acc, const Unit& u, int wr, int wc, int fr, int fq) const {
        fr = opq(fr); fq = opq(fq);
        const bool prompt = u.pn < 64; const int ln = fq * 16 + fr;
        LAS float* stg = (LAS float*)(lds + 131072 + 1024 + (wr * 4 + wc) * 2080);
#pragma unroll
        for (int ai = 0; ai < 2; ++ai)
#pragma unroll
            for (int bj = 0; bj < 2; ++bj) {
                const int h = (u.pm * 256 + ai * 128 + wr * 64) >> 6, tok0 = u.pn * 256 + bj * 128 + wc * 32;
                float* obase; bf16_t* vbase; size_t vpitch;
                if (prompt) { const int b = tok0 >> 12, t0 = tok0 & 4095; obase = out + O_VP + ((size_t)((l * 4 + b) * 8 + h) * 4096 + t0) * 64; vbase = VTP + (size_t)(b * 8 + h) * 64 * 4096 + t0; vpitch = 4096; }
                else { const int tt = tok0 - NPR, b = tt >> 6, t0 = tt & 63; obase = out + O_VS + ((size_t)((l * 8 + b) * 8 + h) * 64 + t0) * 64; vbase = VTS + (size_t)(b * 8 + h) * 64 * KVS + PAST + t0; vpitch = KVS; }
#pragma unroll
                for (int m = 0; m < 4; ++m) *(u32x4*)(vbase + (size_t)(m * 16 + fr) * vpitch + 8 * fq) = pack8(acc[ai][bj][m][0], acc[ai][bj][m][1]);
#pragma unroll
                for (int n = 0; n < 2; ++n)
#pragma unroll
                    for (int j0 = 0; j0 < 4; j0 += 2) {
#pragma unroll
                        for (int m = 0; m < 4; ++m) { stg[(2 * fq) * 65 + 16 * m + fr] = acc[ai][bj][m][n][j0]; stg[(2 * fq + 1) * 65 + 16 * m + fr] = acc[ai][bj][m][n][j0 + 1]; }
                        asm volatile("s_waitcnt lgkmcnt(0)" ::: "memory");
#pragma unroll
                        for (int sl = 0; sl < 8; ++sl) { const float v = stg[sl * 65 + ln]; __builtin_nontemporal_store(v, obase + (size_t)(8 * (sl >> 1) + 4 * n + j0 + (sl & 1)) * 64 + ln); }
                        asm volatile("s_waitcnt lgkmcnt(0)" ::: "memory");
                    }
            }
    }
};
struct EpiVtPart {
    float* PV;
    __device__ __forceinline__ void operator()(AccRef acc, const Unit& u, int wr, int wc, int fr, int fq) const {
        fr = opq(fr); fq = opq(fq);
        float* base = PV + (size_t)((u.pm * 8 + (u.pn - 58)) * 4 + u.ks) * 65536;
#pragma unroll
        for (int ai = 0; ai < 2; ++ai)
#pragma unroll
            for (int m = 0; m < 4; ++m) { const int r = ai * 128 + wr * 64 + m * 16 + fr;
#pragma unroll
                for (int bj = 0; bj < 2; ++bj) { float* o = base + r * 256 + bj * 128 + wc * 32 + 8 * fq; *(f32x4*)o = acc[ai][bj][m][0]; *(f32x4*)(o + 4) = acc[ai][bj][m][1]; } }
    }
};
struct EpiE {
    float* E;
    __device__ __forceinline__ void operator()(AccRef acc, const Unit& u, int wr, int wc, int fr, int fq) const {
        fr = opq(fr); fq = opq(fq);
#pragma unroll
        for (int ai = 0; ai < 2; ++ai)
#pragma unroll
            for (int m = 0; m < 4; ++m) { const int gq = u.pm / 5, chunk = (u.pm - gq * 5) * 256 + ai * 128 + wr * 64 + m * 16 + fr;
                { float* o = E + ((size_t)gq * CHP + chunk) * 128 + wc * 32 + 8 * fq; *(f32x4*)o = acc[ai][0][m][0]; *(f32x4*)(o + 4) = acc[ai][0][m][1]; } }
    }
};
struct EpiZ {
    bf16_t* Z;
    __device__ __forceinline__ void operator()(AccRef acc, const Unit& u, int wr, int wc, int fr, int fq) const {
        fr = opq(fr); fq = opq(fq);
#pragma unroll
        for (int ai = 0; ai < 2; ++ai)
#pragma unroll
            for (int m = 0; m < 4; ++m) { const int gq = u.pm / 5, chunk = (u.pm - gq * 5) * 256 + ai * 128 + wr * 64 + m * 16 + fr;
                {
#pragma unroll
                    for (int bj = 0; bj < 2; ++bj) { const int n = bj * 128 + wc * 32 + 8 * fq, t = n >> 4, m0 = n & 15;
                        f32x4 v0 = acc[ai][bj][m][0], v1 = acc[ai][bj][m][1];
#pragma unroll
                        for (int j = 0; j < 4; ++j) { v0[j] = gelu_f(v0[j]); v1[j] = gelu_f(v1[j]); }
                        *(u32x4*)(Z + (size_t)(chunk * 16 + t) * 512 + gq * 16 + m0) = pack8(v0, v1); __builtin_amdgcn_sched_barrier(0); } } }
    }
};
struct EpiGlu {
    const bf16_t* Z; bf16_t* MIX;
    __device__ __forceinline__ void operator()(AccRef acc, const Unit& u, int wr, int wc, int fr, int fq) const {
        fr = opq(fr); fq = opq(fq);
#pragma unroll
        for (int ai = 0; ai < 2; ++ai)
#pragma unroll
            for (int m = 0; m < 4; ++m) { const int r = u.pm * 256 + ai * 128 + wr * 64 + m * 16 + fr;
#pragma unroll
                for (int bj = 0; bj < 2; ++bj) { const int c = u.pn * 256 + bj * 128 + wc * 32 + 8 * fq;
                    const u32x4 zz = *(const u32x4*)(Z + (size_t)r * 512 + c);
                    f32x4 v0 = acc[ai][bj][m][0], v1 = acc[ai][bj][m][1];
#pragma unroll
                    for (int j = 0; j < 4; ++j) { const unsigned w0 = zz[j >> 1], w1 = zz[2 + (j >> 1)];
                        const float z0 = (j & 1) ? __uint_as_float(w0 & 0xffff0000u) : __uint_as_float(w0 << 16);
                        const float z1 = (j & 1) ? __uint_as_float(w1 & 0xffff0000u) : __uint_as_float(w1 << 16);
                        v0[j] = z0 * sigm(v0[j]); v1[j] = z1 * sigm(v1[j]); }
                    *(u32x4*)(MIX + (size_t)r * 1024 + 512 + c) = pack8(v0, v1); } }
    }
};
struct EpiAtomic {
    float* FS;
    __device__ __forceinline__ void operator()(AccRef acc, const Unit& u, int wr, int wc, int fr, int fq) const {
        fr = opq(fr); fq = opq(fq);
#pragma unroll
        for (int ai = 0; ai < 2; ++ai)
#pragma unroll
            for (int m = 0; m < 4; ++m) { const int r = (u.pm - 64) * 256 + ai * 128 + wr * 64 + m * 16 + fr;
#pragma unroll
                for (int bj = 0; bj < 2; ++bj) { float* o = FS + ((size_t)u.ks * 512 + r) * 1024 + u.pn * 256 + bj * 128 + wc * 32 + 8 * fq;
                    *(f32x4*)o = acc[ai][bj][m][0]; *(f32x4*)(o + 4) = acc[ai][bj][m][1]; } }
    }
};
struct EpiSwi {
    bf16_t* H;
    __device__ __forceinline__ void operator()(AccRef acc, const Unit& u, int wr, int wc, int fr, int fq) const {
        fr = opq(fr); fq = opq(fq);
#pragma unroll
        for (int ai = 0; ai < 2; ++ai)
#pragma unroll
            for (int m = 0; m < 4; ++m) { const int r = u.pm * 256 + ai * 128 + wr * 64 + m * 16 + fr; const int c = u.pn * 128 + wc * 32 + 8 * fq;
                f32x4 v0 = acc[ai][0][m][0], v1 = acc[ai][0][m][1]; const f32x4 u0 = acc[ai][1][m][0], u1 = acc[ai][1][m][1];
#pragma unroll
                for (int j = 0; j < 4; ++j) { v0[j] = silu_f(v0[j]) * u0[j]; v1[j] = silu_f(v1[j]) * u1[j]; }
                *(u32x4*)(H + (size_t)r * DFF + c) = pack8(v0, v1); }
    }
};

struct EpiA {
    EpiIn in; EpiVT vt; EpiVtPart vp;
    __device__ __forceinline__ void operator()(AccRef acc, const Unit& u, int wr, int wc, int fr, int fq) const {
        if (u.kind == 0) in(acc, u, wr, wc, fr, fq); else if (u.nt == 16) vt(acc, u, wr, wc, fr, fq); else vp(acc, u, wr, wc, fr, fq);
    }
};
struct EpiMS {
    EpiPlain p; EpiAtomic q;
    __device__ __forceinline__ void operator()(AccRef acc, const Unit& u, int wr, int wc, int fr, int fq) const {
        if (u.pm < 64) p(acc, u, wr, wc, fr, fq); else q(acc, u, wr, wc, fr, fq);
    }
};
struct Args { const float* in[30]; float* out; unsigned char* ws; };
struct Ctx {
    LAS unsigned char* lds; int tid, lane, wave, G, c;
    const float* const* in; float* out; unsigned char* ws;
};
#define INP(i) (a.in[i])

__device__ __forceinline__ void tr_item(const float* W, size_t ldw, int k0, int sc0, bf16_t* WT, size_t ldo, int dr0, LAS float* scr, int lane) {
    f32x4 tv[8];
#pragma unroll
    for (int i = 0; i < 8; ++i) { const int kk = 8 * i + (lane >> 3); tv[i] = __builtin_nontemporal_load((const f32x4*)(W + (size_t)(k0 + kk) * ldw + sc0 + 4 * (lane & 7))); }
#pragma unroll
    for (int i = 0; i < 8; ++i) { const int kk = 8 * i + (lane >> 3); LAS float* d = scr + kk * 33 + 4 * (lane & 7); d[0] = tv[i][0]; d[1] = tv[i][1]; d[2] = tv[i][2]; d[3] = tv[i][3]; }
    asm volatile("s_waitcnt lgkmcnt(0)" ::: "memory");
    const int c = lane & 7;
#pragma unroll
    for (int j = 0; j < 4; ++j) { const int n = (lane >> 3) + 8 * j; const LAS float* s = scr + (8 * c) * 33 + n;
        u32x4 o; o.x = cvt_pk_bf16(s[0 * 33], s[1 * 33]); o.y = cvt_pk_bf16(s[2 * 33], s[3 * 33]); o.z = cvt_pk_bf16(s[4 * 33], s[5 * 33]); o.w = cvt_pk_bf16(s[6 * 33], s[7 * 33]);
        *(u32x4*)(WT + (size_t)(dr0 + n) * ldo + k0 + 8 * c) = o; }
    asm volatile("s_waitcnt lgkmcnt(0)" ::: "memory");
}

__device__ __forceinline__ void sincos_d(double x, double& s, double& c) {
    const double k = rint(x * 0.63661977236758134308);
    const double r = (x - k * 1.57079632679489655800) - k * 6.123233995736766036e-17;
    const double r2 = r * r;
    double sp = 1.0 / 6227020800.0; sp = sp * r2 - 1.0 / 39916800.0; sp = sp * r2 + 1.0 / 362880.0; sp = sp * r2 - 1.0 / 5040.0; sp = sp * r2 + 1.0 / 120.0; sp = sp * r2 - 1.0 / 6.0; sp = sp * r2 + 1.0;
    const double sr = r * sp;
    double cp = 1.0 / 87178291200.0; cp = cp * r2 - 1.0 / 479001600.0; cp = cp * r2 + 1.0 / 3628800.0; cp = cp * r2 - 1.0 / 40320.0; cp = cp * r2 + 1.0 / 720.0; cp = cp * r2 - 1.0 / 24.0; cp = cp * r2 + 0.5;
    const double cr = 1.0 - r2 * cp;
    const int q = ((int)k) & 3;
    s = (q == 0) ? sr : (q == 1) ? cr : (q == 2) ? -sr : -cr;
    c = (q == 0) ? cr : (q == 1) ? -sr : (q == 2) ? -cr : sr;
}

__device__ __forceinline__ void p0_weights(const Args& a, int lw, bool do_wg, LAS unsigned char* lds, int wave, int lane, int gw, int NGW) {
    LAS float* scr = (LAS float*)(lds + wave * 16384);
    constexpr int I_IN = 16 * 16, I_GLU = 8 * 16, I_OUT = 16 * 32, I_G = 16 * 88, I_D = 44 * 32;
    constexpr int PER_L = 4 * I_IN + I_GLU + I_OUT + 2 * I_G + I_D;
    for (int it = gw; it < PER_L; it += NGW) {
        const int l = lw; int r = it;
        const float* win = INP(15) + (size_t)l * DM * DIN;
        bf16_t* WIN = (bf16_t*)(a.ws + WS_WIN) + (size_t)l * 1536 * 1024;
        if (r < 4 * I_IN) { const int part = r / I_IN, rr = r % I_IN, kb = rr / 16, nb = rr % 16;
            if (part == 0) tr_item(win, DIN, 64 * kb, 32 * nb, WIN, 1024, 32 * nb, scr, lane);
            else if (part == 1) tr_item(win, DIN, 64 * kb, 512 + 32 * nb, WIN, 1024, 512 + 32 * nb, scr, lane);
            else if (part == 2) tr_item(win, DIN, 64 * kb, 1544 + 32 * nb, WIN, 1024, 1024 + 32 * nb, scr, lane);
            else tr_item(win, DIN, 64 * kb, 1024 + 32 * nb, (bf16_t*)(a.ws + WS_WV) + (size_t)l * 512 * 1024, 1024, 32 * nb, scr, lane);
            continue; }
        r -= 4 * I_IN;
        if (r < I_GLU) { tr_item(INP(25) + (size_t)l * 512 * 512, 512, 64 * (r / 16), 32 * (r % 16), (bf16_t*)(a.ws + WS_WGLU) + (size_t)l * 512 * 512, 512, 32 * (r % 16), scr, lane); continue; }
        r -= I_GLU;
        if (r < I_OUT) { tr_item(INP(26) + (size_t)l * 1024 * 1024, 1024, 64 * (r / 32), 32 * (r % 32), (bf16_t*)(a.ws + WS_WOUT) + (size_t)l * 1024 * 1024, 1024, 32 * (r % 32), scr, lane); continue; }
        r -= I_OUT;
        if (r < 2 * I_G) { const int up = r / I_G, rr = r % I_G, kb = rr / 88, nb = rr % 88, c0 = 32 * nb;
            tr_item(INP(27 + up) + (size_t)l * DM * DFF, DFF, 64 * kb, c0, (bf16_t*)(a.ws + WS_WGU) + (size_t)l * 5632 * 1024, 1024, (c0 >> 7) * 256 + up * 128 + (c0 & 127), scr, lane);
            continue; }
        r -= 2 * I_G;
        tr_item(INP(29) + (size_t)l * DFF * DM, DM, 64 * (r / 32), 32 * (r % 32), (bf16_t*)(a.ws + WS_WD) + (size_t)l * 1024 * DFF, DFF, 32 * (r % 32), scr, lane);
    }
    float* WG = (float*)(a.ws + WS_WG);
    if (do_wg) for (int i = gw * 64 + lane; i < NL * 8 * 1024; i += NGW * 64) { const int l = i >> 13, h = (i >> 10) & 7, k = i & 1023; WG[i] = INP(15)[((size_t)l * DM + k) * DIN + 1536 + h]; }
}
__device__ __forceinline__ void p0_adaln(const Args& a, LAS unsigned char* lds, int tid, int wave, int lane, int c, int G) {
    LAS float* sc = (LAS float*)(lds);
    LAS float* red = (LAS float*)(lds + 49152);
    for (int i = tid; i < 12 * 1024; i += 512) { const float v = (i < 4096) ? INP(2)[i] : INP(3)[i - 4096]; sc[i] = silu_f(v); }
    __syncthreads();
    float* MOD = (float*)(a.ws + WS_MOD);
    for (int it = c; it < NL * 96; it += G) {
        const int l = it / 96, n0 = (it % 96) * 64;
        const float* W = INP(9) + (size_t)l * DM * 6144 + n0 + lane;
        float acc[12];
#pragma unroll
        for (int b = 0; b < 12; ++b) acc[b] = 0.f;
        for (int k = wave * 128; k < wave * 128 + 128; k += 16) {
            float w[16];
#pragma unroll
            for (int j = 0; j < 16; ++j) w[j] = __builtin_nontemporal_load(W + (size_t)(k + j) * 6144);
#pragma unroll
            for (int j = 0; j < 16; ++j)
#pragma unroll
                for (int b = 0; b < 12; ++b) acc[b] += sc[b * 1024 + k + j] * w[j];
        }
#pragma unroll
        for (int b = 0; b < 12; ++b) red[(wave * 12 + b) * 64 + lane] = acc[b];
        __syncthreads();
        for (int i = tid; i < 768; i += 512) { const int b = i >> 6, cc = i & 63; float s = 0.f;
#pragma unroll
            for (int w = 0; w < 8; ++w) s += red[(w * 12 + b) * 64 + cc];
            MOD[((size_t)l * 12 + b) * 6144 + n0 + cc] = s + INP(10)[(size_t)l * 6144 + n0 + cc]; }
        __syncthreads();
    }
}
__device__ __forceinline__ void p0_ssm(const Args& a, LAS unsigned char* lds, int tid, int c, int G) {
    LAS float* ap_re = (LAS float*)(lds + 65536);
    LAS float* ap_im = ap_re + 17 * 64;
    LAS float* bb_re = ap_im + 17 * 64;
    LAS float* bb_im = bb_re + 1024;
    LAS float* cc_re = bb_im + 1024;
    LAS float* cc_im = cc_re + 1024;
    LAS float* ktab = cc_im + 1024;
    for (int it = c; it < NL * NG; it += G) {
        const int l = it >> 5, gq = it & 31;
        const double dt = exp((double)INP(19)[l * 32 + gq]);
        for (int idx = tid; idx < 17 * 64; idx += 512) { const int d = idx >> 6, p = idx & 63;
            const double ar = (double)INP(17)[(l * 32 + gq) * 64 + p], ai = (double)INP(18)[(l * 32 + gq) * 64 + p];
            double s, co; sincos_d((double)d * ai * dt, s, co); const double er = exp((double)d * ar * dt);
            ap_re[idx] = (float)(er * co); ap_im[idx] = (float)(er * s); }
        for (int idx = tid; idx < 1024; idx += 512) { const int p = idx >> 4, m = idx & 15;
            const double ar = (double)INP(17)[(l * 32 + gq) * 64 + p], ai = (double)INP(18)[(l * 32 + gq) * 64 + p];
            double s, co; sincos_d(ai * dt, s, co); const double er = exp(ar * dt);
            const double xr = er * co - 1.0, xi = er * s, den = 1.0 / (ar * ar + ai * ai);
            const double qr = (xr * ar + xi * ai) * den, qi = (xi * ar - xr * ai) * den;
            const double br = (double)INP(20)[((size_t)(l * 32 + gq) * 64 + p) * 16 + m], bi = (double)INP(21)[((size_t)(l * 32 + gq) * 64 + p) * 16 + m];
            bb_re[idx] = (float)(qr * br - qi * bi); bb_im[idx] = (float)(qr * bi + qi * br);
            cc_re[idx] = INP(22)[(size_t)(l * 32 + gq) * 1024 + idx]; cc_im[idx] = INP(23)[(size_t)(l * 32 + gq) * 1024 + idx]; }
        __syncthreads();
        for (int idx = tid; idx < 4096; idx += 512) { const int d = idx >> 8, m = (idx >> 4) & 15, m2 = idx & 15; float s = 0.f;
            for (int p = 0; p < 64; ++p) { const float cr = cc_re[m * 64 + p], ci = cc_im[m * 64 + p], pr = ap_re[d * 64 + p], pi = ap_im[d * 64 + p];
                const float re = cr * pr - ci * pi, im = cr * pi + ci * pr; s += re * bb_re[p * 16 + m2] - im * bb_im[p * 16 + m2]; }
            if (d == 0 && m == m2) s += INP(24)[l * 512 + gq * 16 + m];
            ktab[idx] = s; }
        __syncthreads();
        bf16_t* BT3 = (bf16_t*)(a.ws + WS_BT3) + (size_t)(l * 32 + gq) * 256 * UAK;
        for (int grp = tid; grp < 256 * 48; grp += 512) { const int n = grp / 48, k0 = (grp % 48) * 8, t = n >> 4, m = n & 15; float v[8];
            if (k0 < 256) { const int s = k0 >> 4, m20 = k0 & 15;
#pragma unroll
                for (int j = 0; j < 8; ++j) v[j] = (s <= t) ? ktab[((t - s) * 16 + m) * 16 + m20 + j] : 0.f; }
            else { const int kk = k0 - 256, ri = kk >> 6, p0 = kk & 63;
#pragma unroll
                for (int j = 0; j < 8; ++j) { const int p = p0 + j; const float cr = cc_re[m * 64 + p], ci = cc_im[m * 64 + p], pr = ap_re[(t + 1) * 64 + p], pi = ap_im[(t + 1) * 64 + p];
                    v[j] = ri ? -(cr * pi + ci * pr) : (cr * pr - ci * pi); } }
            u32x4 w; w.x = cvt_pk_bf16(v[0], v[1]); w.y = cvt_pk_bf16(v[2], v[3]); w.z = cvt_pk_bf16(v[4], v[5]); w.w = cvt_pk_bf16(v[6], v[7]);
            *(u32x4*)(BT3 + (size_t)n * UAK + k0) = w; }
        bf16_t* BT1 = (bf16_t*)(a.ws + WS_BT1) + (size_t)(l * 32 + gq) * 128 * 256;
        for (int grp = tid; grp < 128 * 32; grp += 512) { const int n = grp >> 5, k0 = (grp & 31) * 8, s = k0 >> 4, m0 = k0 & 15, ri = n >> 6, p = n & 63; float v[8];
            const float pr = ap_re[(15 - s) * 64 + p], pi = ap_im[(15 - s) * 64 + p];
#pragma unroll
            for (int j = 0; j < 8; ++j) { const float br = bb_re[p * 16 + m0 + j], bi = bb_im[p * 16 + m0 + j]; v[j] = ri ? (pr * bi + pi * br) : (pr * br - pi * bi); }
            u32x4 w; w.x = cvt_pk_bf16(v[0], v[1]); w.y = cvt_pk_bf16(v[2], v[3]); w.z = cvt_pk_bf16(v[4], v[5]); w.w = cvt_pk_bf16(v[6], v[7]);
            *(u32x4*)(BT1 + (size_t)n * 256 + k0) = w; }
        if (tid < 64) { float* A16 = (float*)(a.ws + WS_A16) + (size_t)(l * 32 + gq) * 128; A16[tid] = ap_re[16 * 64 + tid]; A16[64 + tid] = ap_im[16 * 64 + tid]; }
        __syncthreads();
    }
}

__device__ __forceinline__ void cache_convert(const Args& a, int l, LAS unsigned char* lds, int wave, int lane, int gw, int NGW) {
    bf16_t* KS = (bf16_t*)(a.ws + WS_KS); bf16_t* VTS = (bf16_t*)(a.ws + WS_VTS);
    const float* ck = INP(4) + (size_t)l * 64 * PAST * 64; const float* cv = INP(5) + (size_t)l * 64 * PAST * 64;
    for (int i = gw * 64 + lane; i < 64 * PAST * 8; i += NGW * 64) {
        const int bh = i >> 13, rem = i & 8191;
        const f32x4 v0 = __builtin_nontemporal_load((const f32x4*)(ck + (size_t)i * 8)), v1 = __builtin_nontemporal_load((const f32x4*)(ck + (size_t)i * 8 + 4));
        *(u32x4*)(KS + (size_t)bh * KVS * 64 + (size_t)rem * 8) = pack8(v0, v1); }
    LAS float* scr = (LAS float*)(lds + wave * 16384);
    for (int it = gw; it < 64 * 32; it += NGW) { const int bh = it >> 5, r = it & 31, kb = r >> 1, nb = r & 1;
        tr_item(cv + (size_t)bh * PAST * 64, 64, 64 * kb, 32 * nb, VTS + (size_t)bh * 64 * KVS, KVS, 32 * nb, scr, lane); }
}

template <int NSPLIT>
__device__ __forceinline__ void rowpass(const float* xsrc_p, const float* xsrc_s, const bf16_t* xsrc_b, const bf16_t* Fb, const float* FS, int nsplit, const float* gate, const float* wpost, float* xdst, bf16_t* xdst_b,
                                        const float* wpre, const float* sc, const float* sh, bf16_t* HMb, const float* WGl, const float* bfor, float* out, int lnext,
                                        int lane, int gw, int NGW) {
    f32x4 wg[8][4];
    if (WGl) {
#pragma unroll
        for (int h = 0; h < 8; ++h)
#pragma unroll
            for (int j = 0; j < 4; ++j) wg[h][j] = *(const f32x4*)(WGl + h * 1024 + 4 * lane + 256 * j);
    }
#define LOADX(dst, rr, xr, j) do { if (xsrc_b) { const u32x2 w_ = __builtin_nontemporal_load((const u32x2*)(xsrc_b + (size_t)(rr) * DM + 4 * lane + 256 * (j))); \
        dst = (f32x4){__uint_as_float(w_.x << 16), __uint_as_float(w_.x & 0xffff0000u), __uint_as_float(w_.y << 16), __uint_as_float(w_.y & 0xffff0000u)}; } \
        else dst = __builtin_nontemporal_load((const f32x4*)((xr) + 4 * lane + 256 * (j))); } while (0)
    for (int r = gw; r < MT; r += NGW) {
        const bool prompt = r < NPR; const int bm = prompt ? (r >> 12) : 4 + ((r - NPR) >> 6);
        f32x4 x[4]; u32x2 fw[4];
        { const float* xr = prompt ? xsrc_p + (size_t)r * DM : xsrc_s + (size_t)(r - NPR) * DM;
#pragma unroll
          for (int j = 0; j < 4; ++j) { LOADX(x[j], r, xr, j); fw[j] = (Fb && prompt) ? __builtin_nontemporal_load((const u32x2*)(Fb + (size_t)r * DM + 4 * lane + 256 * j)) : (u32x2){0u, 0u}; } }
        if (Fb) {
            f32x4 f[4]; float ss = 0.f;
#pragma unroll
            for (int j = 0; j < 4; ++j) {
                if (prompt) { const u32x2 w = fw[j];
                    f[j] = (f32x4){__uint_as_float(w.x << 16), __uint_as_float(w.x & 0xffff0000u), __uint_as_float(w.y << 16), __uint_as_float(w.y & 0xffff0000u)}; }
                else { const float* fp = FS + (size_t)(r - NPR) * DM + 4 * lane + 256 * j; f32x4 part[NSPLIT > 0 ? NSPLIT : 1];
#pragma unroll
                    for (int sp = 0; sp < NSPLIT; ++sp) part[sp] = *(const f32x4*)(fp + (size_t)sp * 512 * 1024);
                    f32x4 sacc = part[0];
#pragma unroll
                    for (int sp = 1; sp < NSPLIT; ++sp) sacc = sacc + part[sp];
                    f[j] = sacc; }
                ss += (f[j][0] * f[j][0] + f[j][1] * f[j][1]) + (f[j][2] * f[j][2] + f[j][3] * f[j][3]); }
            const float rstd = rsqrtf(wave_sum(ss, lane) * (1.f / DM) + EPS);
#pragma unroll
            for (int j = 0; j < 4; ++j) { const f32x4 gt = *(const f32x4*)(gate + (size_t)bm * 6144 + 4 * lane + 256 * j), wp = *(const f32x4*)(wpost + 4 * lane + 256 * j);
                x[j] = x[j] + gt * (f[j] * rstd * wp); }
        }
        if (xdst) {
#pragma unroll
            for (int j = 0; j < 4; ++j) __builtin_nontemporal_store(x[j], (f32x4*)(xdst + (size_t)r * DM + 4 * lane + 256 * j));
        }
        if (xdst_b) {
#pragma unroll
            for (int j = 0; j < 4; ++j) { u32x2 w; w.x = cvt_pk_bf16(x[j][0], x[j][1]); w.y = cvt_pk_bf16(x[j][2], x[j][3]); __builtin_nontemporal_store(w, (u32x2*)(xdst_b + (size_t)r * DM + 4 * lane + 256 * j));
                x[j] = (f32x4){__uint_as_float(w.x << 16), __uint_as_float(w.x & 0xffff0000u), __uint_as_float(w.y << 16), __uint_as_float(w.y & 0xffff0000u)}; }
        }
        if (wpre) {
            float ss = 0.f;
#pragma unroll
            for (int j = 0; j < 4; ++j) ss += (x[j][0] * x[j][0] + x[j][1] * x[j][1]) + (x[j][2] * x[j][2] + x[j][3] * x[j][3]);
            const float rstd = rsqrtf(wave_sum(ss, lane) * (1.f / DM) + EPS);
            f32x4 hm[4];
#pragma unroll
            for (int j = 0; j < 4; ++j) { const int cidx = 4 * lane + 256 * j;
                const f32x4 wv = *(const f32x4*)(wpre + cidx), s1 = *(const f32x4*)(sc + (size_t)bm * 6144 + cidx), s0 = *(const f32x4*)(sh + (size_t)bm * 6144 + cidx);
                hm[j] = (x[j] * rstd * wv) * (1.f + s1) + s0;
                u32x2 w; w.x = cvt_pk_bf16(hm[j][0], hm[j][1]); w.y = cvt_pk_bf16(hm[j][2], hm[j][3]);
                *(u32x2*)(HMb + (size_t)r * DM + cidx) = w; }
            if (WGl) {
                float mine = 0.f;
#pragma unroll
                for (int h = 0; h < 8; ++h) { float d = 0.f;
#pragma unroll
                    for (int j = 0; j < 4; ++j) { const f32x4 wv = wg[h][j]; d += (hm[j][0] * wv[0] + hm[j][1] * wv[1]) + (hm[j][2] * wv[2] + hm[j][3] * wv[3]); }
                    d = wave_sum(d, lane); if (lane == h) mine = d; }
                if (lane < 8) { const float lf = logsig(mine + bfor[lane]);
                    if (prompt) out[O_LP + ((size_t)((lnext * 4 + (r >> 12)) * 8 + lane)) * 4096 + (r & 4095)] = lf;
                    else { const int rr = r - NPR; out[O_LS + ((size_t)((lnext * 8 + (rr >> 6)) * 8 + lane)) * 64 + (rr & 63)] = lf; } }
            }
        }
    }
}

__device__ __forceinline__ void vt_finalize(const Args& a, int l, int lane, int gwi, int nw) {
    const float* PV = (const float*)(a.ws + WS_F1); bf16_t* VTP = (bf16_t*)(a.ws + WS_VTP); bf16_t* VTS = (bf16_t*)(a.ws + WS_VTS);
    for (int it = gwi; it < 16 * 128; it += nw) {
        const int tile = it >> 7, rem = it & 127, hb = rem >> 5, to = rem & 31, hdl = hb * 64 + lane, pm = tile >> 3, pn = 58 + (tile & 7);
        const int hd = pm * 256 + hdl, h = hd >> 6, d = hd & 63, tok = pn * 256 + to * 8;
        f32x4 v0 = {0.f, 0.f, 0.f, 0.f}, v1 = {0.f, 0.f, 0.f, 0.f};
#pragma unroll
        for (int ks = 0; ks < 4; ++ks) { const float* p = PV + ((size_t)(tile * 4 + ks) * 256 + hdl) * 256 + to * 8; v0 = v0 + *(const f32x4*)p; v1 = v1 + *(const f32x4*)(p + 4); }
        const u32x4 w = pack8(v0, v1);
        if (pn < 64) { const int b = tok >> 12, t = tok & 4095;
            *(u32x4*)(VTP + ((size_t)(b * 8 + h) * 64 + d) * 4096 + t) = w;
            float* o = a.out + O_VP + ((size_t)((l * 4 + b) * 8 + h) * 4096 + t) * 64 + d;
#pragma unroll
            for (int j = 0; j < 4; ++j) { __builtin_nontemporal_store(v0[j], o + (size_t)j * 64); __builtin_nontemporal_store(v1[j], o + (size_t)(j + 4) * 64); } }
        else { const int tt = tok - NPR, b = tt >> 6, t = tt & 63;
            *(u32x4*)(VTS + ((size_t)(b * 8 + h) * 64 + d) * KVS + PAST + t) = w;
            float* o = a.out + O_VS + ((size_t)((l * 8 + b) * 8 + h) * 64 + t) * 64 + d;
#pragma unroll
            for (int j = 0; j < 4; ++j) { __builtin_nontemporal_store(v0[j], o + (size_t)j * 64); __builtin_nontemporal_store(v1[j], o + (size_t)(j + 4) * 64); } }
    }
}
__device__ __forceinline__ void cumsum_items(const Args& a, int l, LAS unsigned char* lds, int tid, int wave, int lane, int c, int G) {
    LAS float* wt = (LAS float*)(lds);
    for (int it = c - 64; it >= 0 && it < 96; it += G) {
        const bool prompt = it < 32;
        float v[8]; float run = 0.f; int i0, cnt;
        if (prompt) { i0 = tid * 8; cnt = 8;
            const float* src = a.out + O_LP + (size_t)(l * 32 + it) * 4096 + i0;
            const f32x4 p0 = *(const f32x4*)src, p1 = *(const f32x4*)(src + 4);
            v[0] = p0[0]; v[1] = p0[1]; v[2] = p0[2]; v[3] = p0[3]; v[4] = p1[0]; v[5] = p1[1]; v[6] = p1[2]; v[7] = p1[3]; }
        else { const int sq = it - 32; i0 = tid * 4; cnt = tid < 272 ? 4 : 0;
            const float* src = tid < 256 ? INP(6) + (size_t)(l * 64 + sq) * PAST + i0 : a.out + O_LS + (size_t)(l * 64 + sq) * 64 + (tid < 272 ? i0 - PAST : 0);
            const f32x4 p0 = *(const f32x4*)src;
            v[0] = p0[0]; v[1] = p0[1]; v[2] = p0[2]; v[3] = p0[3]; v[4] = 0.f; v[5] = 0.f; v[6] = 0.f; v[7] = 0.f;
            if (tid >= 272) { v[0] = 0.f; v[1] = 0.f; v[2] = 0.f; v[3] = 0.f; } }
#pragma unroll
        for (int j = 0; j < 8; ++j) { run += v[j]; v[j] = run; }
        float incl = run;
#pragma unroll
        for (int o = 1; o < 64; o <<= 1) { const float t = bperm(incl, lane >= o ? lane - o : lane); if (lane >= o) incl += t; }
        if (lane == 63) wt[wave] = incl;
        __syncthreads();
        float off = incl - run;
        for (int w = 0; w < wave; ++w) off += wt[w];
        float* dst = (prompt ? (float*)(a.ws + WS_BIASP) + (size_t)it * 4096 : (float*)(a.ws + WS_BIASS) + (size_t)(it - 32) * KVS) + i0;
        if (cnt == 8) { *(f32x4*)dst = (f32x4){-(off + v[0]) * LOG2E, -(off + v[1]) * LOG2E, -(off + v[2]) * LOG2E, -(off + v[3]) * LOG2E};
                        *(f32x4*)(dst + 4) = (f32x4){-(off + v[4]) * LOG2E, -(off + v[5]) * LOG2E, -(off + v[6]) * LOG2E, -(off + v[7]) * LOG2E}; }
        else if (cnt == 4) *(f32x4*)dst = (f32x4){-(off + v[0]) * LOG2E, -(off + v[1]) * LOG2E, -(off + v[2]) * LOG2E, -(off + v[3]) * LOG2E};
        __syncthreads();
    }
}

__device__ __forceinline__ void ssm_scan(const Args& a, int l, LAS unsigned char* lds, int wave, int lane, int c, int G) {
    const float* E = (const float*)(a.ws + WS_E); bf16_t* UA = (bf16_t*)(a.ws + WS_UA); const float* A16 = (const float*)(a.ws + WS_A16);
    LAS float* endst = (LAS float*)(lds);
    for (int it = c; it < 128; it += G) {
        const int b = it >> 5, gq = it & 31, p = lane;
        const float ar = A16[(l * 32 + gq) * 128 + p], ai = A16[(l * 32 + gq) * 128 + 64 + p];
        float er[32], ei[32];
        const int ch0 = b * 256 + wave * 32;
#pragma unroll
        for (int i = 0; i < 32; ++i) { const float* e = E + ((size_t)gq * CHP + ch0 + i) * 128; er[i] = e[p]; ei[i] = e[64 + p]; }
        float hr = 0.f, hi = 0.f;
#pragma unroll
        for (int i = 0; i < 32; ++i) { const float nr = ar * hr - ai * hi + er[i], ni = ar * hi + ai * hr + ei[i]; hr = nr; hi = ni; }
        endst[(wave * 2) * 64 + p] = hr; endst[(wave * 2 + 1) * 64 + p] = hi;
        float pr = ar, pi = ai;
#pragma unroll
        for (int s = 0; s < 5; ++s) { const float nr = pr * pr - pi * pi, ni = 2.f * pr * pi; pr = nr; pi = ni; }
        __syncthreads();
        hr = 0.f; hi = 0.f;
        for (int w = 0; w < wave; ++w) { const float xr = endst[(w * 2) * 64 + p], xi = endst[(w * 2 + 1) * 64 + p];
            const float nr = pr * hr - pi * hi + xr, ni = pr * hi + pi * hr + xi; hr = nr; hi = ni; }
#pragma unroll
        for (int i = 0; i < 32; ++i) { bf16_t* u = UA + ((size_t)gq * CHP + ch0 + i) * UAK + 256; u[p] = f2bf(hr); u[64 + p] = f2bf(hi);
            const float nr = ar * hr - ai * hi + er[i], ni = ar * hi + ai * hr + ei[i]; hr = nr; hi = ni; }
        if (wave == 7) { a.out[O_RP + (size_t)((l * 4 + b) * 32 + gq) * 64 + p] = hr; a.out[O_IP + (size_t)((l * 4 + b) * 32 + gq) * 64 + p] = hi; }
        __syncthreads();
    }
    for (int it = (G - 1 - c) * 8 + wave; it < 256; it += G * 8) {
        const int b = it >> 5, gq = it & 31, p = lane;
        const float ar = A16[(l * 32 + gq) * 128 + p], ai = A16[(l * 32 + gq) * 128 + 64 + p];
        float hr = INP(7)[(size_t)((l * 8 + b) * 32 + gq) * 64 + p], hi = INP(8)[(size_t)((l * 8 + b) * 32 + gq) * 64 + p];
        const int ch0 = 1024 + b * 4;
#pragma unroll
        for (int i = 0; i < 4; ++i) { const float* e = E + ((size_t)gq * CHP + ch0 + i) * 128; const float xr = e[p], xi = e[64 + p];
            bf16_t* u = UA + ((size_t)gq * CHP + ch0 + i) * UAK + 256; u[p] = f2bf(hr); u[64 + p] = f2bf(hi);
            const float nr = ar * hr - ai * hi + xr, ni = ar * hi + ai * hr + xi; hr = nr; hi = ni; }
        a.out[O_RS + (size_t)((l * 8 + b) * 32 + gq) * 64 + p] = hr; a.out[O_IS + (size_t)((l * 8 + b) * 32 + gq) * 64 + p] = hi;
    }
}

#define DPPMAX(v, ctrl) v = fmaxf(v, __int_as_float(__builtin_amdgcn_update_dpp(0, __float_as_int(v), ctrl, 0xF, 0xF, true)))
__device__ __forceinline__ float wave_max_nonneg(float v) {
    DPPMAX(v, 0xB1); DPPMAX(v, 0x4E); DPPMAX(v, 0x141); DPPMAX(v, 0x140);
    const float r0 = __int_as_float(__builtin_amdgcn_readlane(__float_as_int(v), 0)), r1 = __int_as_float(__builtin_amdgcn_readlane(__float_as_int(v), 16));
    const float r2 = __int_as_float(__builtin_amdgcn_readlane(__float_as_int(v), 32)), r3 = __int_as_float(__builtin_amdgcn_readlane(__float_as_int(v), 48));
    return fmaxf(fmaxf(r0, r1), fmaxf(r2, r3));
}
__device__ __forceinline__ void kmax_items(const Args& a, int lane, int gw, int NGW) {
    float* KM = (float*)(a.ws + WS_KMAX);
    for (int it = NGW - 1 - gw; it < 2048 + 1088; it += NGW) {
        const bf16_t* kp; int oidx;
        if (it < 2048) { const int bh = it >> 6, t = it & 63; kp = (const bf16_t*)(a.ws + WS_KP) + ((size_t)bh * 4096 + t * 64) * 64; oidx = it; }
        else { const int r = it - 2048, sq = r / 17, t = r - sq * 17; kp = (const bf16_t*)(a.ws + WS_KS) + ((size_t)sq * KVS + t * 64) * 64; oidx = (32 + sq) * 64 + t; }
        float ss = 0.f;
#pragma unroll
        for (int i = 0; i < 8; ++i) { const u32x4 w = *(const u32x4*)(kp + (size_t)lane * 64 + i * 8);
#pragma unroll
            for (int j = 0; j < 4; ++j) { const float lo = __uint_as_float(w[j] << 16), hi = __uint_as_float(w[j] & 0xffff0000u); ss += lo * lo + hi * hi; } }
        const float m = wave_max_nonneg(ss);
        if (lane == 0) KM[oidx] = sqrtf(m) * 1.001f;
    }
}
constexpr int AT_ROW = 144, AT_TILE = 64 * AT_ROW  , AT_KB = 0, AT_VB = 4 * AT_TILE, AT_BB = 8 * AT_TILE;
__device__ __forceinline__ void attn_tile(const LAS unsigned char* Kb, const LAS unsigned char* Vb, const LAS float* Bb, const bf16x8 (&qf)[4], f32x16& o0, f32x16& o1, float& lsum,
                                          float bq, int myq, int key0, bool domask, int ka_off, int va_off, int hi) {
    f32x16 s0, s1;
#pragma unroll
    for (int a2 = 0; a2 < 2; ++a2) { const f32x4 b0 = *(const LAS f32x4*)(Bb + a2 * 16 + hi * 8), b1 = *(const LAS f32x4*)(Bb + a2 * 16 + hi * 8 + 4);
        const f32x4 c0 = *(const LAS f32x4*)(Bb + 32 + a2 * 16 + hi * 8), c1 = *(const LAS f32x4*)(Bb + 32 + a2 * 16 + hi * 8 + 4);
#pragma unroll
        for (int j = 0; j < 4; ++j) { s0[a2 * 8 + j] = b0[j]; s0[a2 * 8 + 4 + j] = b1[j]; s1[a2 * 8 + j] = c0[j]; s1[a2 * 8 + 4 + j] = c1[j]; } }
#pragma unroll
    for (int ks = 0; ks < 4; ++ks) {
        const bf16x8 k0 = *(const LAS bf16x8*)(Kb + ka_off + ks * 32), k1 = *(const LAS bf16x8*)(Kb + 32 * AT_ROW + ka_off + ks * 32);
        s0 = __builtin_amdgcn_mfma_f32_32x32x16_bf16(k0, qf[ks], s0, 0, 0, 0);
        s1 = __builtin_amdgcn_mfma_f32_32x32x16_bf16(k1, qf[ks], s1, 0, 0, 0);
    }
    if (domask) {
#pragma unroll
        for (int r = 0; r < 16; ++r) { const int kj = key0 + 16 * (r >> 3) + 8 * hi + (r & 7);
            if (kj > myq) s0[r] = -INFINITY; if (kj + 32 > myq) s1[r] = -INFINITY; }
    }
    s0 = s0 - bq; s1 = s1 - bq;
#pragma unroll
    for (int r = 0; r < 16; ++r) { s0[r] = __builtin_amdgcn_exp2f(s0[r]); s1[r] = __builtin_amdgcn_exp2f(s1[r]); }
    { const f32x16 e = s0 + s1;
      const f32x8 e8 = __builtin_shufflevector(e, e, 0, 1, 2, 3, 4, 5, 6, 7) + __builtin_shufflevector(e, e, 8, 9, 10, 11, 12, 13, 14, 15);
      const f32x4 e4 = __builtin_shufflevector(e8, e8, 0, 1, 2, 3) + __builtin_shufflevector(e8, e8, 4, 5, 6, 7);
      lsum += (e4[0] + e4[1]) + (e4[2] + e4[3]); }
    bf16x8 pa[4];
#pragma unroll
    for (int a2 = 0; a2 < 2; ++a2) {
        u32x4 w0, w1;
        w0.x = cvt_pk_bf16(s0[a2 * 8 + 0], s0[a2 * 8 + 1]); w0.y = cvt_pk_bf16(s0[a2 * 8 + 2], s0[a2 * 8 + 3]); w0.z = cvt_pk_bf16(s0[a2 * 8 + 4], s0[a2 * 8 + 5]); w0.w = cvt_pk_bf16(s0[a2 * 8 + 6], s0[a2 * 8 + 7]);
        w1.x = cvt_pk_bf16(s1[a2 * 8 + 0], s1[a2 * 8 + 1]); w1.y = cvt_pk_bf16(s1[a2 * 8 + 2], s1[a2 * 8 + 3]); w1.z = cvt_pk_bf16(s1[a2 * 8 + 4], s1[a2 * 8 + 5]); w1.w = cvt_pk_bf16(s1[a2 * 8 + 6], s1[a2 * 8 + 7]);
        pa[a2] = __builtin_bit_cast(bf16x8, w0); pa[2 + a2] = __builtin_bit_cast(bf16x8, w1);
    }
#pragma unroll
    for (int kk = 0; kk < 4; ++kk) {
        const bf16x8 v0 = *(const LAS bf16x8*)(Vb + va_off + kk * 32), v1 = *(const LAS bf16x8*)(Vb + 32 * AT_ROW + va_off + kk * 32);
        o0 = __builtin_amdgcn_mfma_f32_32x32x16_bf16(v0, pa[kk], o0, 0, 0, 0);
        o1 = __builtin_amdgcn_mfma_f32_32x32x16_bf16(v1, pa[kk], o1, 0, 0, 0);
    }
}
__device__ __forceinline__ void attn_unit(LAS unsigned char* lds, const bf16_t* Qrow0, int h, int nrows, int qpos0, int NT,
                                          const bf16_t* Kp, const bf16_t* VTp, int vpitch, const float* biasp, const float* kmaxp, bf16_t* Orow0, int tid, int wave, int lane) {
    const int q = lane & 31, hi = lane >> 5;
    const bool active = wave * 32 < nrows;
    bf16x8 qf[4];
#pragma unroll
    for (int ks = 0; ks < 4; ++ks) qf[ks] = active ? *(const bf16x8*)(Qrow0 + (size_t)(wave * 32 + q) * 512 + h * 64 + ks * 16 + hi * 8) : (bf16x8){0, 0, 0, 0, 0, 0, 0, 0};
    f32x16 o0 = {}, o1 = {};
    float lsum = 0.f;
    const int myq = qpos0 + wave * 32 + q;
    const int wq_lo = qpos0 + wave * 32, wq_hi = wq_lo + 31;
    const float bq = active ? biasp[myq] : 0.f;
    const int NS = (NT + 1) >> 1;
    int s_first;
    { float ssq = 0.f;
#pragma unroll
      for (int ks = 0; ks < 4; ++ks)
#pragma unroll
          for (int e = 0; e < 8; ++e) { const float v = __uint_as_float(((unsigned)(unsigned short)qf[ks][e]) << 16); ssq += v * v; }
      ssq += bperm(ssq, lane ^ 32);
      const float wm = wave_max_nonneg(ssq);
      volatile LAS float* qm = (volatile LAS float*)(lds + 131072 + 512);
      volatile LAS int* tst = (volatile LAS int*)(lds + 131072 + 576);
      if (lane == 0) qm[wave] = wm;
      __syncthreads();
      if (wave == 0) {
          float m2 = 0.f;
#pragma unroll
          for (int w = 0; w < 8; ++w) m2 = fmaxf(m2, qm[w]);
          const float QN = sqrtf(m2) * 1.001f;
          bool fail = true;
          if (lane < NT) fail = !(QN * kmaxp[lane] + biasp[64 * lane + 63] - biasp[qpos0] < -160.f);
          const unsigned long long mask = __builtin_amdgcn_ballot_w64(fail);
          const int tfirst = mask ? (int)__builtin_ctzll(mask) : 0;
          if (lane == 0) tst[0] = tfirst >> 1;
      }
      __syncthreads();
      s_first = tst[0]; }
    const int krow = tid >> 3, kch = tid & 7;
    const bf16_t* kg = Kp + (size_t)tid * 8;
    const bf16_t* vg = VTp + (size_t)krow * vpitch + kch * 8;
    const int st_off = krow * AT_ROW + kch * 16;
    const int kap = (q & 19) | ((q & 4) << 1) | ((q & 8) >> 1);
    const int ka_off = kap * AT_ROW + hi * 16, va_off = q * AT_ROW + hi * 16;
    u32x4 kr0, kr1, vr0, vr1; f32x4 br = {0.f, 0.f, 0.f, 0.f};
    { const int tb = 2 * s_first; kr0 = *(const u32x4*)(kg + (size_t)tb * 4096); kr1 = *(const u32x4*)(kg + (size_t)(tb + 1) * 4096); vr0 = *(const u32x4*)(vg + tb * 64); vr1 = *(const u32x4*)(vg + (tb + 1) * 64); if (tid < 32) br = *(const f32x4*)(biasp + tb * 64 + tid * 4); }
    *(LAS u32x4*)(lds + AT_KB + st_off) = kr0; *(LAS u32x4*)(lds + AT_KB + AT_TILE + st_off) = kr1;
    *(LAS u32x4*)(lds + AT_VB + st_off) = vr0; *(LAS u32x4*)(lds + AT_VB + AT_TILE + st_off) = vr1; if (tid < 32) *(LAS f32x4*)(lds + AT_BB + tid * 16) = br;
    __syncthreads();
    for (int sidx = s_first; sidx < NS; ++sidx) {
        const int buf = (sidx - s_first) & 1, t0 = 2 * sidx;
        const bool more = sidx + 1 < NS;
        if (more) { kr0 = *(const u32x4*)(kg + (size_t)(t0 + 2) * 4096); kr1 = *(const u32x4*)(kg + (size_t)(t0 + 3) * 4096); vr0 = *(const u32x4*)(vg + (t0 + 2) * 64); vr1 = *(const u32x4*)(vg + (t0 + 3) * 64);
            if (tid < 32) br = *(const f32x4*)(biasp + (t0 + 2) * 64 + tid * 4); }
        if (active) {
            const LAS unsigned char* Kb = lds + AT_KB + buf * 2 * AT_TILE;
            const LAS unsigned char* Vb = lds + AT_VB + buf * 2 * AT_TILE;
            const LAS float* Bb = (const LAS float*)(lds + AT_BB + buf * 512);
            if (t0 * 64 <= wq_hi) attn_tile(Kb, Vb, Bb, qf, o0, o1, lsum, bq, myq, t0 * 64, t0 * 64 + 63 > wq_lo, ka_off, va_off, hi);
            if ((t0 + 1) * 64 <= wq_hi) attn_tile(Kb + AT_TILE, Vb + AT_TILE, Bb + 64, qf, o0, o1, lsum, bq, myq, (t0 + 1) * 64, (t0 + 1) * 64 + 63 > wq_lo, ka_off, va_off, hi);
        }
        if (more) { const int nb = buf ^ 1;
            *(LAS u32x4*)(lds + AT_KB + nb * 2 * AT_TILE + st_off) = kr0; *(LAS u32x4*)(lds + AT_KB + nb * 2 * AT_TILE + AT_TILE + st_off) = kr1;
            *(LAS u32x4*)(lds + AT_VB + nb * 2 * AT_TILE + st_off) = vr0; *(LAS u32x4*)(lds + AT_VB + nb * 2 * AT_TILE + AT_TILE + st_off) = vr1;
            if (tid < 32) *(LAS f32x4*)(lds + AT_BB + nb * 512 + tid * 16) = br; }
        __syncthreads();
    }
    if (active) {
        lsum += bperm(lsum, lane ^ 32);
        const float inv = 1.f / lsum;
        bf16_t* orow = Orow0 + (size_t)(wave * 32 + q) * 1024 + h * 64;
#pragma unroll
        for (int i = 0; i < 4; ++i) { u32x2 w0, w1;
            w0.x = cvt_pk_bf16(o0[4 * i] * inv, o0[4 * i + 1] * inv); w0.y = cvt_pk_bf16(o0[4 * i + 2] * inv, o0[4 * i + 3] * inv);
            w1.x = cvt_pk_bf16(o1[4 * i] * inv, o1[4 * i + 1] * inv); w1.y = cvt_pk_bf16(o1[4 * i + 2] * inv, o1[4 * i + 3] * inv);
            *(u32x2*)(orow + 8 * i + 4 * hi) = w0; *(u32x2*)(orow + 32 + 8 * i + 4 * hi) = w1; }
    }
}
__device__ __forceinline__ void attn_phase(const Args& a, int l, LAS unsigned char* lds, int tid, int wave, int lane) {
    const bf16_t* Q = (const bf16_t*)(a.ws + WS_Q); bf16_t* MIX = (bf16_t*)(a.ws + WS_MIX);
    unsigned* ctr = (unsigned*)(a.ws + WS_CTL) + 3600 + 64 * l;
    volatile LAS unsigned* slot = (volatile LAS unsigned*)(lds + 131072 + 256);
    for (;;) {
        if (tid == 0) slot[0] = __hip_atomic_fetch_add(ctr, 1u, __ATOMIC_RELAXED, __HIP_MEMORY_SCOPE_AGENT);
        __syncthreads();
        const int idx = (int)slot[0];
        __syncthreads();
        if (idx >= 576) break;
        if (idx < 512) { const int qb = 15 - (idx >> 5), bh = idx & 31, b = bh >> 3, h = bh & 7; const size_t row0 = (size_t)b * 4096 + qb * 256;
            attn_unit(lds, Q + row0 * 512, h, 256, qb * 256, 4 * qb + 4, (const bf16_t*)(a.ws + WS_KP) + (size_t)bh * 4096 * 64, (const bf16_t*)(a.ws + WS_VTP) + (size_t)bh * 64 * 4096, 4096,
                      (const float*)(a.ws + WS_BIASP) + (size_t)bh * 4096, (const float*)(a.ws + WS_KMAX) + bh * 64, MIX + row0 * 1024, tid, wave, lane); }
        else { const int sidx = idx - 512, b = sidx >> 3, h = sidx & 7;
            attn_unit(lds, Q + (size_t)(NPR + b * 64) * 512, h, 64, PAST, 17, (const bf16_t*)(a.ws + WS_KS) + (size_t)sidx * KVS * 64, (const bf16_t*)(a.ws + WS_VTS) + (size_t)sidx * 64 * KVS, KVS,
                      (const float*)(a.ws + WS_BIASS) + (size_t)sidx * KVS, (const float*)(a.ws + WS_KMAX) + (32 + sidx) * 64, MIX + (size_t)(NPR + b * 64) * 1024, tid, wave, lane); }
    }
}

#define XB_TMO      128
#define XB_XCNT(j)  (256  + 64 * (j))
#define XB_XSUB(j)  (1280 + 64 * (j))
#define XB_XGEN(j)  (2304 + 64 * (j))
#define XB_TOP      3328
#define XB_TOPGEN   3392
#define XCD_BAR_WORDS 3456
#define XB_SPIN_CAP (1u << 18)
__device__ __forceinline__ unsigned xb_ld(unsigned* p)              { return __hip_atomic_load(p, __ATOMIC_RELAXED, __HIP_MEMORY_SCOPE_AGENT); }
__device__ __forceinline__ unsigned xb_add(unsigned* p, unsigned v) { return __hip_atomic_fetch_add(p, v, __ATOMIC_RELAXED, __HIP_MEMORY_SCOPE_AGENT); }
__device__ __forceinline__ unsigned xb_xcc_id() { return (unsigned)__builtin_amdgcn_s_getreg((3 << 11) | 20) & 0xFu; }
#define XB_SPIN(cond, bar) do { unsigned _sp = 0; while (cond) { __builtin_amdgcn_s_sleep(1); \
    if ((++_sp & 255u) == 0u) { if (xb_ld(&(bar)[XB_TMO])) break; if (_sp > XB_SPIN_CAP) { atomicAdd(&(bar)[XB_TMO], 1u); break; } } } } while (0)
__device__ __forceinline__ void xcd_barrier_complete(unsigned* bar, unsigned x, unsigned G, unsigned& nloc, unsigned& nx) {
    unsigned sum, cnt, mine, sp = 0u;
    for (;;) {
        sum = 0u; cnt = 0u; mine = 0u;
#pragma unroll
        for (unsigned j = 0; j < 16; ++j) { const unsigned c = xb_ld(&bar[XB_XCNT(j)]); sum += c; cnt += (c > 0u) ? 1u : 0u; mine = (j == x) ? c : mine; }
        if (sum == G) break;
        __builtin_amdgcn_s_sleep(1);
        if ((++sp & 255u) == 0u) { if (xb_ld(&bar[XB_TMO])) break; if (sp > XB_SPIN_CAP) { atomicAdd(&bar[XB_TMO], 1u); break; } }
    }
    nloc = mine > 0u ? mine : 1u; nx = cnt > 0u ? cnt : 1u;
}
__device__ __forceinline__ void xcd_barrier(unsigned* bar, volatile LAS unsigned* st, bool leader, unsigned G) {
    asm volatile("s_waitcnt vmcnt(0)" ::: "memory");
    __syncthreads();
    if (leader) {
        const unsigned x = xb_xcc_id();
        __builtin_amdgcn_s_waitcnt(0);
        unsigned nloc = st[0], nx = st[1];
        if (nloc == 0u) { xcd_barrier_complete(bar, x, G, nloc, nx); st[0] = nloc; st[1] = nx; }
        const unsigned old = xb_add(&bar[XB_XSUB(x)], 1u);
        const unsigned gen = old / nloc;
        if (old + 1u == (gen + 1u) * nloc) {
            __builtin_amdgcn_fence(__ATOMIC_RELEASE, "agent");
            asm volatile("s_waitcnt vmcnt(0)" ::: "memory");
            const unsigned og = xb_add(&bar[XB_TOP], 1u);
            const unsigned tg = og / nx;
            if (og + 1u == (tg + 1u) * nx) xb_add(&bar[XB_TOPGEN], 1u);
            else XB_SPIN(xb_ld(&bar[XB_TOPGEN]) == tg, bar);
            __builtin_amdgcn_fence(__ATOMIC_ACQUIRE, "agent");
            xb_add(&bar[XB_XGEN(x)], 1u);
            asm volatile("s_waitcnt vmcnt(0)" ::: "memory");
        } else {
            XB_SPIN(xb_ld(&bar[XB_XGEN(x)]) == gen, bar);
            __builtin_amdgcn_fence(__ATOMIC_ACQUIRE, "agent");
            asm volatile("s_waitcnt vmcnt(0)" ::: "memory");
        }
    }
    __syncthreads();
}

constexpr int NS5 = 160, CW_SUB = 3520;
__device__ __forceinline__ void sub_barrier(unsigned* ctr, unsigned target, bool leader) {
    asm volatile("s_waitcnt vmcnt(0)" ::: "memory");
    __syncthreads();
    if (leader) {
        __builtin_amdgcn_fence(__ATOMIC_RELEASE, "agent");
        asm volatile("s_waitcnt vmcnt(0)" ::: "memory");
        (void)xb_add(ctr, 1u);
        unsigned sp = 0u;
        while (xb_ld(ctr) < target) { __builtin_amdgcn_s_sleep(1); if (++sp > (1u << 22)) break; }
        __builtin_amdgcn_fence(__ATOMIC_ACQUIRE, "agent");
        asm volatile("s_waitcnt vmcnt(0)" ::: "memory");
    }
    __syncthreads();
}
#undef INP
#define INP(i) (al.in[i])
typedef const __attribute__((address_space(4))) unsigned char* kptr_t;
__device__ __forceinline__ kptr_t opq_k(kptr_t p) { asm volatile("" : "+s"(p)); return p; }
__device__ __forceinline__ Args load_args(kptr_t kp) {
    typedef const __attribute__((address_space(4))) unsigned long long* q_t; q_t q = (q_t)kp; Args r;
    typedef __attribute__((address_space(1))) const float* gcf_t; typedef __attribute__((address_space(1))) float* gf_t; typedef __attribute__((address_space(1))) unsigned char* gu8_t;
#pragma unroll
    for (int i = 0; i < 30; ++i) r.in[i] = (const float*)(gcf_t)q[i];
    r.out = (float*)(gf_t)q[30]; r.ws = (unsigned char*)(gu8_t)q[31]; return r;
}
#define FRESH() const Args al = load_args(opq_k((kptr_t)__builtin_amdgcn_kernarg_segment_ptr())); unsigned char* ws = al.ws; \
    const int G = __builtin_amdgcn_readfirstlane(opq((int)gridDim.x)); const int NGW = G * 8; (void)NGW; \
    const int wave = __builtin_amdgcn_readfirstlane(opq(wave0)); const int c = __builtin_amdgcn_readfirstlane(opq((int)blockIdx.x)); const int gw = c * 8 + wave; \
    float* MOD = (float*)(ws + WS_MOD); float* X = (float*)(ws + WS_X); bf16_t* HM = (bf16_t*)(ws + WS_HM); bf16_t* F1 = (bf16_t*)(ws + WS_F1); bf16_t* MIX = (bf16_t*)(ws + WS_MIX); \
    (void)MOD; (void)X; (void)HM; (void)F1; (void)MIX; (void)gw;
#define LAYER_BODY(l) { \
        { FRESH(); PH(5) cumsum_items(al, l, lds, tid, wave, lane, c, G); } \
        PH(6) { FRESH(); pg8::Gemm g{HM, (const bf16_t*)(ws + WS_WIN) + (size_t)l * 1536 * 1024, MT, 1536, 1024, 1024, 1024, 1 << 20, 0, 512u, (const bf16_t*)(ws + WS_WV) + (size_t)l * 512 * 1024, HM}; \
          pg8::PhaseAOrder S; S.init(G, c); \
          EpiA E{EpiIn{(bf16_t*)(ws + WS_Q), (bf16_t*)(ws + WS_KP), (bf16_t*)(ws + WS_KS), (bf16_t*)(ws + WS_UA), al.out, l}, EpiVT{(bf16_t*)(ws + WS_VTP), (bf16_t*)(ws + WS_VTS), al.out, l, lds}, EpiVtPart{(float*)(ws + WS_F1)}}; \
          pg8::gemm_phase(lds, g, S, E, wave); } \
        GSYNC(); \
        { FRESH(); kmax_items(al, lane, gw, NGW); vt_finalize(al, l, lane, gw, NGW); } \
        GSYNC(); \
        if (INS5) { \
        PH(8) { FRESH(); pg8::Gemm g{(const bf16_t*)(ws + WS_UA), (const bf16_t*)(ws + WS_BT1) + (size_t)l * 32 * 128 * 256, NG * CHP, 256, 256, UAK, 256, 5, (size_t)128 * 256, 0u}; \
          pg8::StaticOrder S; S.init(NG * CHP, 256, NS5, c); \
          EpiE E{(float*)(ws + WS_E)}; \
          pg8::gemm_phase(lds, g, S, E, wave); } \
        SUBBAR((l) * 3 + 1); \
        { FRESH(); PH(9) ssm_scan(al, l, lds, wave, lane, c, NS5); } \
        SUBBAR((l) * 3 + 2); \
        PH(10) { FRESH(); pg8::Gemm g{(const bf16_t*)(ws + WS_UA), (const bf16_t*)(ws + WS_BT3) + (size_t)l * 32 * 256 * UAK, NG * CHP, 256, UAK, UAK, UAK, 5, (size_t)256 * UAK, 0u}; \
          pg8::StaticOrder S; S.init(NG * CHP, 256, NS5, c); \
          EpiZ E{(bf16_t*)(ws + WS_Z)}; \
          pg8::gemm_phase(lds, g, S, E, wave); } \
        SUBBAR((l) * 3 + 3); \
        PH(11) { FRESH(); pg8::Gemm g{(const bf16_t*)(ws + WS_Z), (const bf16_t*)(ws + WS_WGLU) + (size_t)l * 512 * 512, MT, 512, 512, 512, 512, 1 << 20, 0, 0u}; \
          pg8::StaticOrder S; S.init(MT, 512, NS5, c); \
          EpiGlu E{(const bf16_t*)(ws + WS_Z), MIX}; \
          pg8::gemm_phase(lds, g, S, E, wave); } \
        __syncthreads(); \
        } \
        { FRESH(); PH(12) attn_phase(al, l, lds, tid, wave, lane); } \
        GSYNC(); \
        PH(13) { FRESH(); pg8::Gemm g{MIX, (const bf16_t*)(ws + WS_WOUT) + (size_t)l * 1024 * 1024, MT, 1024, 1024, 1024, 1024, 1 << 20, 0, 256u}; \
          pg8::MainSplitOrder S; S.init(G, c, 8, 2); \
          EpiMS E{EpiPlain{F1, 1024}, EpiAtomic{(float*)(ws + WS_Q)}}; \
          pg8::gemm_phase(lds, g, S, E, wave); } \
        GSYNC(); \
        { FRESH(); const float* modl = MOD + (size_t)l * 12 * 6144; \
          PH(14) rowpass<8>(INP(0), INP(1), l == 0 ? (const bf16_t*)nullptr : (const bf16_t*)X, F1, (const float*)(ws + WS_Q), 8, modl + 2 * 1024, INP(12) + l * 1024, nullptr, (bf16_t*)X, \
                INP(13) + l * 1024, modl + 4 * 1024, modl + 3 * 1024, HM, nullptr, nullptr, al.out, 0, lane, gw, NGW); } \
        GSYNC(); \
        PH(15) { FRESH(); pg8::Gemm g{HM, (const bf16_t*)(ws + WS_WGU) + (size_t)l * 5632 * 1024, MT, 5632, 1024, 1024, 1024, 1 << 20, 0, 0u}; \
          pg8::StaticOrder S; S.init(MT, 5632, G, c); \
          EpiSwi E{(bf16_t*)(ws + WS_H)}; \
          pg8::gemm_phase(lds, g, S, E, wave); } \
        { FRESH(); if ((l) + 1 < NL && c >= 172) { __syncthreads(); p0_weights(al, (l) + 1, false, lds, wave, lane, (c - 172) * 8 + wave, (G - 172) * 8); } } \
        GSYNC(); \
        PH(16) { FRESH(); pg8::Gemm g{(const bf16_t*)(ws + WS_H), (const bf16_t*)(ws + WS_WD) + (size_t)l * 1024 * DFF, MT, 1024, DFF, DFF, DFF, 1 << 20, 0, 512u}; \
          pg8::MainSplitOrder S; S.init(G, c, 11, 4); \
          EpiMS E{EpiPlain{F1, 1024}, EpiAtomic{(float*)(ws + WS_FS2)}}; \
          pg8::gemm_phase(lds, g, S, E, wave); } \
        GSYNC(); \
        if (l + 1 < NL) { \
            { FRESH(); const float* modl = MOD + (size_t)l * 12 * 6144; const float* modn = MOD + (size_t)(l + 1) * 12 * 6144; \
              PH(17) rowpass<11>(INP(0), INP(1), (const bf16_t*)X, F1, (const float*)(ws + WS_FS2), 11, modl + 5 * 1024, INP(14) + l * 1024, nullptr, (bf16_t*)X, INP(11) + (l + 1) * 1024, modn + 1024, modn, HM, \
                    (const float*)(ws + WS_WG) + (size_t)(l + 1) * 8 * 1024, INP(16) + (l + 1) * 8, al.out, l + 1, lane, gw, NGW); \
              PH(1) cache_convert(al, l + 1, lds, wave, lane, gw, NGW); } \
            GSYNC(); \
        } else { \
            FRESH(); const float* modl = MOD + (size_t)l * 12 * 6144; \
            PH(18) rowpass<11>(INP(0), INP(1), (const bf16_t*)X, F1, (const float*)(ws + WS_FS2), 11, modl + 5 * 1024, INP(14) + l * 1024, al.out, nullptr, nullptr, nullptr, nullptr, nullptr, nullptr, nullptr, al.out, 0, lane, gw, NGW); \
        } \
    }
__global__ void __launch_bounds__(512, 2) mega(Args a) {
    extern __shared__ __attribute__((aligned(16))) unsigned char lds_raw[];
    LAS unsigned char* lds = (LAS unsigned char*)lds_raw;
    cg::grid_group grid = cg::this_grid();
    const int wave0 = __builtin_amdgcn_readfirstlane((int)threadIdx.x >> 6);
#define GSYNC() do { const Args alb = load_args(opq_k((kptr_t)__builtin_amdgcn_kernarg_segment_ptr())); \
        const int ln_ = (int)__builtin_amdgcn_mbcnt_hi(~0u, __builtin_amdgcn_mbcnt_lo(~0u, (unsigned)opq(0))); \
        xcd_barrier((unsigned*)(alb.ws + WS_CTL), (volatile LAS unsigned*)(lds + LDS_MISC), wave0 == 0 && ln_ == 0, (unsigned)gridDim.x); } while (0)
#define SUBBAR(seq) do { const Args alb = load_args(opq_k((kptr_t)__builtin_amdgcn_kernarg_segment_ptr())); \
        const int ln_ = (int)__builtin_amdgcn_mbcnt_hi(~0u, __builtin_amdgcn_mbcnt_lo(~0u, (unsigned)opq(0))); \
        xcd_barrier((unsigned*)(alb.ws + WS_CTL) + 4096, (volatile LAS unsigned*)(lds + LDS_MISC + 16), wave0 == 0 && ln_ == 0, (unsigned)NS5); } while (0)
#define INS5 (__builtin_amdgcn_readfirstlane(opq((int)blockIdx.x)) < NS5)
    if (threadIdx.x < 8) ((volatile LAS unsigned*)(lds + LDS_MISC))[threadIdx.x] = 0u;
    if (threadIdx.x == 0) (void)xb_add((unsigned*)(a.ws + WS_CTL) + XB_XCNT(xb_xcc_id()), 1u);
    if (threadIdx.x == 0 && blockIdx.x < NS5) (void)xb_add((unsigned*)(a.ws + WS_CTL) + 4096 + XB_XCNT(xb_xcc_id()), 1u);
    __syncthreads();
#define lane ((int)__builtin_amdgcn_mbcnt_hi(~0u, __builtin_amdgcn_mbcnt_lo(~0u, (unsigned)opq(0))))
#define tid (wave * 64 + lane)

    { FRESH();
      PH(0) p0_weights(al, 0, true, lds, wave, lane, gw, NGW);
      PH(1) cache_convert(al, 0, lds, wave, lane, gw, NGW);
      __syncthreads();
      PH(2) p0_adaln(al, lds, tid, wave, lane, c, G);
      PH(3) p0_ssm(al, lds, tid, (c + 128) % G, G); }
    grid.sync();
    { FRESH();
      PH(4) rowpass<0>(INP(0), INP(1), nullptr, nullptr, nullptr, 0, nullptr, nullptr, nullptr, nullptr, INP(11), MOD + 1024, MOD, HM, (const float*)(ws + WS_WG), INP(16), al.out, 0, lane, gw, NGW); }
    GSYNC();

    LAYER_BODY(0)
    LAYER_BODY(1)
    LAYER_BODY(2)
    LAYER_BODY(3)
}
#undef tid
#undef lane

extern "C" void kernel_launch(void* const* d_in, const int* in_sizes, int n_in, void* d_out, int out_size, void* d_ws, size_t ws_size, hipStream_t stream) {
    static int grid = 0;
    if (grid == 0) {
        if (n_in != 30 || (size_t)out_size != O_END || ws_size < WS_END) { fprintf(stderr, "kernel_launch: unexpected sizes n_in %d out %d ws %zu\n", n_in, out_size, ws_size); grid = -1; return; }
        int dev = 0, cus = 0, per_cu = 0;
        hipGetDevice(&dev); hipDeviceGetAttribute(&cus, hipDeviceAttributeMultiprocessorCount, dev);
        hipFuncSetAttribute((const void*)mega, hipFuncAttributeMaxDynamicSharedMemorySize, LDS_BYTES);
        hipOccupancyMaxActiveBlocksPerMultiprocessor(&per_cu, (const void*)mega, 512, LDS_BYTES);
        if (per_cu < 1) { fprintf(stderr, "kernel_launch: occupancy query reports %d blocks per CU\n", per_cu); grid = -1; return; }
        if (cus != 256) { fprintf(stderr, "kernel_launch: this build's static unit orders need 256 CUs (found %d)\n", cus); grid = -1; return; }
        grid = cus;
    }
    if (grid < 0) return;
    if (hipMemsetAsync((char*)d_ws + WS_CTL, 0, CTL_BYTES, stream) != hipSuccess) { fprintf(stderr, "kernel_launch: memset failed\n"); return; }
    Args a{};
    for (int i = 0; i < 30; ++i) a.in[i] = (const float*)d_in[i];
    a.out = (float*)d_out; a.ws = (unsigned char*)d_ws;
    void* args[] = {&a};
    hipError_t e = hipLaunchCooperativeKernel((const void*)mega, dim3(grid), dim3(512), args, LDS_BYTES, stream);
    if (e != hipSuccess) fprintf(stderr, "cooperative launch failed: %s (grid %d)\n", hipGetErrorString(e), grid);
}
```

```cpp
#include <hip/hip_runtime.h>
#include <hip/hip_cooperative_groups.h>
#include <cstdio>
#include <cstdint>
namespace cg = cooperative_groups;

#define LAS __attribute__((address_space(3)))
typedef unsigned short bf16_t;
typedef short bf16x8 __attribute__((ext_vector_type(8)));
typedef float f32x4 __attribute__((ext_vector_type(4)));
typedef float f32x16 __attribute__((ext_vector_type(16)));
typedef float f32x8 __attribute__((ext_vector_type(8)));
typedef unsigned u32x4 __attribute__((ext_vector_type(4)));
typedef unsigned u32x2 __attribute__((ext_vector_type(2)));

constexpr int DM = 1024, NPR = 16384, NSM = 512, MT = 16896, NL = 4, NH = 8, HD = 64;
constexpr int SEQ = 4096, PAST = 1024, DSEQ = 64, KVS = 1088, DFF = 2816, DIN = 2056;
constexpr int NG = 32, NP = 64, MG = 16, LC = 16, NCH = MT / LC  , CHP = 1280  , UAK = 384;
constexpr float C2 = 0.125f * 1.4426950408889634f, LOG2E = 1.4426950408889634f, EPS = 1e-6f;
constexpr size_t O_YP = 0, O_KP = 17301504, O_VP = 50855936, O_LP = 84410368, O_RP = 84934656, O_IP = 84967424,
                 O_KS = 85000192, O_VS = 86048768, O_LS = 87097344, O_RS = 87113728, O_IS = 87179264, O_END = 87244800;
constexpr size_t MiB = 1u << 20;
constexpr size_t WS_CTL = 1536 * 1024, CTL_BYTES = 32768;
constexpr int LDS_MISC = 131072 + 64;
constexpr size_t WS_MOD = 0, WS_WG = 2 * MiB, WS_A16 = 2 * MiB + 256 * 1024, WS_BIASP = 3 * MiB, WS_BIASS = 3 * MiB + 512 * 1024, WS_KMAX = 2 * MiB + 384 * 1024;
constexpr size_t WS_WIN = 4 * MiB, WS_WV = 16 * MiB, WS_WGLU = 20 * MiB, WS_WOUT = 22 * MiB, WS_WGU = 30 * MiB, WS_WD = 74 * MiB;
constexpr size_t WS_BT3 = 96 * MiB, WS_BT1 = 120 * MiB, WS_HM = 130 * MiB, WS_X = 164 * MiB, WS_F1 = 230 * MiB, WS_MIX = 264 * MiB;
constexpr size_t WS_Q = 298 * MiB, WS_KP = 315 * MiB, WS_VTP = 331 * MiB, WS_KS = 347 * MiB, WS_VTS = 356 * MiB, WS_UA = 365 * MiB,
                 WS_E = 395 * MiB, WS_Z = 415 * MiB, WS_H = 298 * MiB, WS_FS1 = 435 * MiB, WS_FS2 = 443 * MiB, WS_END = 465 * MiB;
constexpr int LDS_BYTES = 151552;
#ifndef PH_MASK
#define PH_MASK 0xffffffffu
#endif
#define PH(k) if (PH_MASK & (1u << (k)))

__device__ __forceinline__ unsigned cvt_pk_bf16(float lo, float hi) { unsigned r; asm volatile("v_cvt_pk_bf16_f32 %0, %1, %2" : "=v"(r) : "v"(lo), "v"(hi)); return r; }
__device__ __forceinline__ bf16_t f2bf(float f) { return (bf16_t)(cvt_pk_bf16(f, 0.f) & 0xffffu); }
__device__ __forceinline__ float bf2f(unsigned short b) { return __uint_as_float(((unsigned)b) << 16); }
__device__ __forceinline__ int opq(int x) { asm volatile("" : "+v"(x)); return x; }
__device__ __forceinline__ float bperm(float v, int srclane) { return __int_as_float(__builtin_amdgcn_ds_bpermute(srclane << 2, __float_as_int(v))); }
__device__ __forceinline__ float dpp_f(float v, const int ctrl) { return v; }
#define DPPADD(v, ctrl) v += __int_as_float(__builtin_amdgcn_update_dpp(0, __float_as_int(v), ctrl, 0xF, 0xF, true))
__device__ __forceinline__ float wave_sum(float v, int ln) {
    (void)ln;
    DPPADD(v, 0xB1);
    DPPADD(v, 0x4E);
    DPPADD(v, 0x141);
    DPPADD(v, 0x140);
    const float r0 = __int_as_float(__builtin_amdgcn_readlane(__float_as_int(v), 0)), r1 = __int_as_float(__builtin_amdgcn_readlane(__float_as_int(v), 16));
    const float r2 = __int_as_float(__builtin_amdgcn_readlane(__float_as_int(v), 32)), r3 = __int_as_float(__builtin_amdgcn_readlane(__float_as_int(v), 48));
    return (r0 + r1) + (r2 + r3);
}
__device__ __forceinline__ float sigm(float x) { return __builtin_amdgcn_rcpf(1.f + __builtin_amdgcn_exp2f(-1.4426950408889634f * x)); }
__device__ __forceinline__ float silu_f(float x) { return x * sigm(x); }
__device__ __forceinline__ float gelu_f(float x) { const float u = 0.7978845608028654f * (x + 0.044715f * x * x * x); return x * sigm(2.f * u); }
__device__ __forceinline__ float logsig(float x) { return fminf(x, 0.f) - log1pf(__expf(-fabsf(x))); }

namespace pg8 {
constexpr int BM = 256, BK = 64, HALF = 128, HTB = HALF * BK * 2, STAGE_BYTES = 8 * HTB, NXCD = 8, WGM = 8;
__host__ __device__ __forceinline__ int lds_byte(int r, int c) { const int st = (r >> 4) * 2 + (c >> 5), rr = r & 15, cc = c & 31, ob = rr * 64 + cc * 2; return st * 1024 + (ob ^ (((ob >> 9) & 1) << 5)); }
__host__ __device__ __forceinline__ void stage_rc(int b, int& R, int& C) { const int st = b / 1024, sb = b % 1024, swz = sb ^ (((sb >> 9) & 1) << 5); R = (st >> 1) * 16 + swz / 64; C = (st & 1) * 32 + (swz % 64) / 2; }
__host__ __device__ __forceinline__ int perm32(int rho) { const int n = rho >> 4, i = rho & 15; return 8 * (i >> 2) + 4 * n + (i & 3); }
struct Unit { int pm, pn, ks, kind, nt; };
struct Gemm { const bf16_t* A; const bf16_t* Bt; int M, N, K, lda, ldb, gdiv; size_t gstrideB; unsigned kcb; const bf16_t* A1; const bf16_t* Bt1; };
struct StaticOrder {
    int nM, nN, nwg, G, c;
    __device__ __forceinline__ void init(int M, int N, int G_, int c_) { nM = M / BM; nN = N / BM; nwg = nM * nN; G = G_; c = c_; }
    __device__ __forceinline__ bool next(int i, Unit& u) const {
        const long L = (long)i * G + c; if (L >= nwg) return false;
        int wgid = (int)L; { const int q = nwg / NXCD, r = nwg % NXCD, xcd = wgid % NXCD, off = wgid / NXCD; wgid = (xcd < r ? xcd * (q + 1) : r * (q + 1) + (xcd - r) * q) + off; }
        const int nig = WGM * nN, gid = wgid / nig, fm = gid * WGM, gsz = (nM - fm) < WGM ? (nM - fm) : WGM;
        u.pm = fm + ((wgid % nig) % gsz); u.pn = (wgid % nig) / gsz; u.ks = 0; u.kind = 0; u.nt = 0; return true;
    }
};
struct SplitOrder {
    int nsub, G, c, S;
    __device__ __forceinline__ void init(int S_, int G_, int c_) { S = S_; nsub = 8 * S_; G = G_; c = c_; }
    __device__ __forceinline__ bool next(int i, Unit& u) const { const int idx = i * G + c; if (idx >= nsub) return false; u.ks = idx % S; const int t = idx / S; u.pn = t & 3; u.pm = 64 + (t >> 2); u.kind = 0; u.nt = 0; return true; }
};
struct VtOrder {
    int idx;
    __device__ __forceinline__ void init(int G_, int c_) { idx = c_ - (G_ - 116); }
    __device__ __forceinline__ bool next(int i, Unit& u) const { if (i != 0 || idx < 0 || idx >= 116) return false; u.pm = idx / 58; u.pn = idx - u.pm * 58; u.ks = 0; u.kind = 0; u.nt = 0; return true; }
};
struct VtSplitOrder {
    int c;
    __device__ __forceinline__ void init(int c_) { c = c_; }
    __device__ __forceinline__ bool next(int i, Unit& u) const { if (i != 0 || c >= 64) return false; const int tile = c >> 2; u.ks = c & 3; u.pm = tile >> 3; u.pn = 58 + (tile & 7); u.kind = 0; u.nt = 0; return true; }
};
struct PhaseAOrder {
    StaticOrder so; int c;
    __device__ __forceinline__ void init(int G_, int c_) { so.init(MT, 1536, G_, c_); c = c_; }
    __device__ __forceinline__ bool next(int i, Unit& u) const {
        Unit t = {0, 0, 0, 0, 0}; bool ok = false;
        if (i <= 1) ok = so.next(i, t);
        int pm = t.pm, pn = t.pn, ks = 0, kind = 0, nt = 0;
        if (i == 1 && !ok) { const int idx = c - 140; ok = idx >= 0 && idx < 116; pm = idx / 58; pn = idx - pm * 58; kind = 1; nt = 16; }
        if (i == 2) { ok = c < 64; const int tile = c >> 2; ks = c & 3; pm = tile >> 3; pn = 58 + (tile & 7); kind = 1; nt = 4; }
        u.pm = pm; u.pn = pn; u.ks = ks; u.kind = kind; u.nt = nt;
        return ok;
    }
};
struct MainSplitOrder {
    StaticOrder so; int c, S, nts;
    __device__ __forceinline__ void init(int G_, int c_, int S_, int nts_) { so.init(NPR, 1024, G_, c_); c = c_; S = S_; nts = nts_; }
    __device__ __forceinline__ bool next(int i, Unit& u) const {
        Unit t = {0, 0, 0, 0, 0}; bool ok = false;
        if (i == 0) ok = so.next(0, t);
        int pm = t.pm, pn = t.pn, ks = 0, nt = 0;
        if (i == 1) { ok = c < 8 * S; ks = c % S; const int tt = c / S; pn = tt & 3; pm = 64 + (tt >> 2); nt = nts; }
        u.pm = pm; u.pn = pn; u.ks = ks; u.kind = 0; u.nt = nt;
        return ok;
    }
};
template <class Epi, class Sched>
__device__ __forceinline__ void gemm_phase(LAS unsigned char* lds, const Gemm g, const Sched& S, const Epi& E, const int wave_id) {
    const int lane = (int)__builtin_amdgcn_mbcnt_hi(~0u, __builtin_amdgcn_mbcnt_lo(~0u, (unsigned)opq(0))), wid = wave_id, tid = wid * 64 + lane, wr = wid >> 2, wc = wid & 3, fr = lane & 15, fq = lane >> 4;
    unsigned voffA[2], voffB[2];
#pragma unroll
    for (int i = 0; i < 2; ++i) { int R, C; stage_rc(tid * 16 + i * 8192, R, C); const int Rb = (R & ~31) + perm32(R & 31);
        voffA[i] = (unsigned)(R * g.lda + C) * 2u; voffB[i] = (unsigned)(Rb * g.ldb + C) * 2u; }
    const unsigned kstep = (unsigned)(BK * 2);
    const unsigned hstepA = (unsigned)HALF * g.lda * 2, hstepB = (unsigned)HALF * g.ldb * 2, tstepA = 2 * hstepA, tstepB = 2 * hstepB;
    const unsigned ldsw = (unsigned)wid * 1024u;
    const int aoff = lds_byte(wr * 64 + fr, fq * 8), boff = lds_byte(wc * 32 + fr, fq * 8);
#define PG8_SA(b, h) (((b) * 2 + (h)) * HTB)
#define PG8_SB(b, h) ((4 + (b) * 2 + (h)) * HTB)
#define PG8_STAGE(bufoff, gbase, voff) do { _Pragma("unroll") for (int _i = 0; _i < 2; ++_i) \
        __builtin_amdgcn_global_load_lds((const unsigned*)((const char*)(gbase) + (voff)[_i]), (LAS unsigned*)(lds + (bufoff) + ldsw + _i * 8192), 16, 0, 0); } while (0)
#define PG8_LDA(dst, b, h) do { _Pragma("unroll") for (int m = 0; m < 4; ++m) _Pragma("unroll") for (int k = 0; k < 2; ++k) dst[m][k] = *(const LAS bf16x8*)(lds + PG8_SA(b, h) + aoff + m * 2048 + k * 1024); } while (0)
#define PG8_LDB(dst, b, h) do { _Pragma("unroll") for (int n = 0; n < 2; ++n) _Pragma("unroll") for (int k = 0; k < 2; ++k) dst[n][k] = *(const LAS bf16x8*)(lds + PG8_SB(b, h) + boff + n * 2048 + k * 1024); } while (0)
#define PG8_MMA(ai, bj, At, Bt) do { __builtin_amdgcn_s_setprio(1); _Pragma("unroll") for (int m = 0; m < 4; ++m) _Pragma("unroll") for (int n = 0; n < 2; ++n) _Pragma("unroll") for (int k = 0; k < 2; ++k) \
        acc[ai][bj][m][n] = __builtin_amdgcn_mfma_f32_16x16x32_bf16(Bt[n][k], At[m][k], acc[ai][bj][m][n], 0, 0, 0); __builtin_amdgcn_s_setprio(0); } while (0)
#define PG8_WAIT_V(n) asm volatile("s_waitcnt vmcnt(" #n ")" ::: "memory")
#define PG8_WAIT_L(n) asm volatile("s_waitcnt lgkmcnt(" #n ")" ::: "memory")
#define PG8_BAR __builtin_amdgcn_s_barrier()
#define PG8_SCHED __builtin_amdgcn_sched_barrier(0)
    Unit cur = {0, 0, 0, 0, 0}, nxt = {0, 0, 0, 0, 0}; int ui = 0;
    if (!S.next(0, cur)) return;
    f32x4 acc[2][2][4][2];
    const float zf = __int_as_float(opq(0)); const f32x4 zero4 = (f32x4){zf, zf, zf, zf};
#pragma unroll
    for (int a = 0; a < 2; ++a)
#pragma unroll
        for (int b = 0; b < 2; ++b)
#pragma unroll
            for (int m = 0; m < 4; ++m)
#pragma unroll
                for (int n = 0; n < 2; ++n) acc[a][b][m][n] = zero4;
    bf16x8 At[4][2], B0[2][2], B1[2][2];
    const char* cA = (const char*)(cur.kind ? g.A1 : g.A) + (size_t)cur.pm * tstepA + (size_t)cur.ks * g.kcb;
    const char* cB = (const char*)(cur.kind ? g.Bt1 : g.Bt) + (size_t)(cur.pm / g.gdiv) * g.gstrideB * 2 + (size_t)cur.pn * tstepB + (size_t)cur.ks * g.kcb;
    int nt = cur.nt ? cur.nt : g.K / BK;
    PG8_STAGE(PG8_SB(0, 0), cB, voffB); PG8_STAGE(PG8_SB(0, 1), cB + hstepB, voffB); PG8_STAGE(PG8_SA(0, 0), cA, voffA); PG8_STAGE(PG8_SA(0, 1), cA + hstepA, voffA);
    if (wr == 1) PG8_BAR;
    PG8_WAIT_V(2); PG8_BAR;
    PG8_STAGE(PG8_SB(1, 0), cB + kstep, voffB); PG8_STAGE(PG8_SA(1, 0), cA + kstep, voffA); PG8_STAGE(PG8_SB(1, 1), cB + hstepB + kstep, voffB);
    PG8_WAIT_V(6); PG8_BAR;
    for (;;) {
        nxt.pm = 0; nxt.pn = 0; nxt.ks = 0; nxt.kind = 0; nxt.nt = 0;
        const bool has_next = S.next(ui + 1, nxt);
        const char* nA = has_next ? (const char*)(nxt.kind ? g.A1 : g.A) + (size_t)nxt.pm * tstepA + (size_t)nxt.ks * g.kcb : cA;
        const char* nB = has_next ? (const char*)(nxt.kind ? g.Bt1 : g.Bt) + (size_t)(nxt.pm / g.gdiv) * g.gstrideB * 2 + (size_t)nxt.pn * tstepB + (size_t)nxt.ks * g.kcb : cB;
#pragma unroll 1
        for (int t = 0; t < nt; t += 2) {
            const bool last = (t == nt - 2);
            const char* a1 = cA + (unsigned)(t + 1) * kstep;
            const char* a2 = last ? nA : cA + (unsigned)(t + 2) * kstep; const char* b2 = last ? nB : cB + (unsigned)(t + 2) * kstep;
            const char* a3 = a2 + kstep; const char* b3 = b2 + kstep;
            PG8_LDB(B0, 0, 0); PG8_LDB(B1, 0, 1); PG8_SCHED; PG8_LDA(At, 0, 0); PG8_STAGE(PG8_SA(1, 1), a1 + hstepA, voffA);
            PG8_WAIT_V(8); PG8_WAIT_L(0); PG8_BAR; PG8_MMA(0, 0, At, B0); PG8_MMA(0, 1, At, B1); PG8_BAR; PG8_SCHED;
            PG8_LDA(At, 0, 1); PG8_STAGE(PG8_SB(0, 0), b2, voffB); PG8_STAGE(PG8_SB(0, 1), b2 + hstepB, voffB); PG8_STAGE(PG8_SA(0, 0), a2, voffA);
            PG8_WAIT_V(8); PG8_WAIT_L(0); PG8_BAR; PG8_MMA(1, 0, At, B0); PG8_MMA(1, 1, At, B1); PG8_BAR; PG8_SCHED;
            PG8_LDB(B0, 1, 0); PG8_LDB(B1, 1, 1); PG8_SCHED; PG8_LDA(At, 1, 0); PG8_STAGE(PG8_SA(0, 1), a2 + hstepA, voffA);
            PG8_WAIT_V(8); PG8_WAIT_L(0); PG8_BAR; PG8_MMA(0, 0, At, B0); PG8_MMA(0, 1, At, B1); PG8_BAR; PG8_SCHED;
            PG8_LDA(At, 1, 1); PG8_STAGE(PG8_SB(1, 0), b3, voffB); PG8_STAGE(PG8_SB(1, 1), b3 + hstepB, voffB); PG8_STAGE(PG8_SA(1, 0), a3, voffA);
            PG8_WAIT_V(8); PG8_WAIT_L(0); PG8_BAR; PG8_MMA(1, 0, At, B0); PG8_MMA(1, 1, At, B1); PG8_BAR; PG8_SCHED;
        }
        if (wr == 0) PG8_BAR;
        E(acc, cur, wr, wc, fr, fq);
        if (!has_next) break;
#pragma unroll
        for (int a = 0; a < 2; ++a)
#pragma unroll
            for (int b = 0; b < 2; ++b)
#pragma unroll
                for (int m = 0; m < 4; ++m)
#pragma unroll
                    for (int n = 0; n < 2; ++n) acc[a][b][m][n] = zero4;
        cur = nxt; cA = nA; cB = nB; ++ui; nt = cur.nt ? cur.nt : g.K / BK;
        if (wr == 1) PG8_BAR;
    }
    PG8_WAIT_V(0);
    PG8_BAR;
#undef PG8_SA
#undef PG8_SB
#undef PG8_STAGE
#undef PG8_LDA
#undef PG8_LDB
#undef PG8_MMA
#undef PG8_WAIT_V
#undef PG8_WAIT_L
#undef PG8_BAR
#undef PG8_SCHED
}
}
using pg8::Unit;
typedef const f32x4 (&AccRef)[2][2][4][2];
__device__ __forceinline__ u32x4 pack8(f32x4 v0, f32x4 v1) { u32x4 w; w.x = cvt_pk_bf16(v0[0], v0[1]); w.y = cvt_pk_bf16(v0[2], v0[3]); w.z = cvt_pk_bf16(v1[0], v1[1]); w.w = cvt_pk_bf16(v1[2], v1[3]); return w; }

struct EpiPlain {
    bf16_t* O; int ldc;
    __device__ __forceinline__ void operator()(AccRef acc, const Unit& u, int wr, int wc, int fr, int fq) const {
        fr = opq(fr); fq = opq(fq);
#pragma unroll
        for (int ai = 0; ai < 2; ++ai)
#pragma unroll
            for (int m = 0; m < 4; ++m) { const int r = u.pm * 256 + ai * 128 + wr * 64 + m * 16 + fr;
#pragma unroll
                for (int bj = 0; bj < 2; ++bj) { const int c = u.pn * 256 + bj * 128 + wc * 32 + 8 * fq;
                    *(u32x4*)(O + (size_t)r * ldc + c) = pack8(acc[ai][bj][m][0], acc[ai][bj][m][1]); } }
    }
};
struct EpiIn {
    bf16_t *Q, *KP, *KS, *UA; float* out; int l;
    __device__ __forceinline__ void operator()(AccRef acc, const Unit& u, int wr, int wc, int fr, int fq) const {
        fr = opq(fr); fq = opq(fq);
        const bool prompt = u.pm < 64;
#pragma unroll
        for (int ai = 0; ai < 2; ++ai)
#pragma unroll
            for (int m = 0; m < 4; ++m) { const int r = u.pm * 256 + ai * 128 + wr * 64 + m * 16 + fr;
#pragma unroll
                for (int bj = 0; bj < 2; ++bj) { const int c = u.pn * 256 + bj * 128 + wc * 32 + 8 * fq;
                    const f32x4 v0 = acc[ai][bj][m][0], v1 = acc[ai][bj][m][1];
                    if (u.pn < 2) { *(u32x4*)(Q + (size_t)r * 512 + c) = pack8(v0 * C2, v1 * C2); }
                    else if (u.pn < 4) { const int ck = c - 512, h = ck >> 6, d = ck & 63; const u32x4 w = pack8(v0, v1);
                        if (prompt) { const int b = r >> 12, t = r & 4095;
                            *(u32x4*)(KP + ((size_t)(b * 8 + h) * 4096 + t) * 64 + d) = w;
                            float* o = out + O_KP + ((size_t)((l * 4 + b) * 8 + h) * 4096 + t) * 64 + d; __builtin_nontemporal_store(v0, (f32x4*)o); __builtin_nontemporal_store(v1, (f32x4*)(o + 4)); }
                        else { const int rr = r - NPR, b = rr >> 6, t = rr & 63;
                            *(u32x4*)(KS + ((size_t)(b * 8 + h) * KVS + PAST + t) * 64 + d) = w;
                            float* o = out + O_KS + ((size_t)((l * 8 + b) * 8 + h) * 64 + t) * 64 + d; __builtin_nontemporal_store(v0, (f32x4*)o); __builtin_nontemporal_store(v1, (f32x4*)(o + 4)); } }
                    else { const int cu = c - 1024, gq = cu >> 4, m0 = cu & 15, chunk = r >> 4, s = r & 15;
                        *(u32x4*)(UA + ((size_t)gq * CHP + chunk) * UAK + s * 16 + m0) = pack8(v0, v1); }
                    asm volatile("" ::: "memory"); } }
    }
};
struct EpiVT {
    bf16_t *VTP, *VTS; float* out; int l; LAS unsigned char* lds;
    __device__ __forceinline__ void operator()(AccRef acc, const Unit& u, int wr, int wc, int fr, int fq) const {
        fr = opq(fr); fq = opq(fq);
        const bool prompt = u.pn < 64; const int ln = fq * 16 + fr;
        LAS float* stg = (LAS float*)(lds + 131072 + 1024 + (wr * 4 + wc) * 2080);
#pragma unroll
        for (int ai = 0; ai < 2; ++ai)
#pragma unroll
            for (int bj = 0; bj < 2; ++bj) {
                const int h = (u.pm * 256 + ai * 128 + wr * 64) >> 6, tok0 = u.pn * 256 + bj * 128 + wc * 32;
                float* obase; bf16_t* vbase; size_t vpitch;
                if (prompt) { const int b = tok0 >> 12, t0 = tok0 & 4095; obase = out + O_VP + ((size_t)((l * 4 + b) * 8 + h) * 4096 + t0) * 64; vbase = VTP + (size_t)(b * 8 + h) * 64 * 4096 + t0; vpitch = 4096; }
                else { const int tt = tok0 - NPR, b = tt >> 6, t0 = tt & 63; obase = out + O_VS + ((size_t)((l * 8 + b) * 8 + h) * 64 + t0) * 64; vbase = VTS + (size_t)(b * 8 + h) * 64 * KVS + PAST + t0; vpitch = KVS; }
#pragma unroll
                for (int m = 0; m < 4; ++m) *(u32x4*)(vbase + (size_t)(m * 16 + fr) * vpitch + 8 * fq) = pack8(acc[ai][bj][m][0], acc[ai][bj][m][1]);
#pragma unroll
                for (int n = 0; n < 2; ++n)
#pragma unroll
                    for (int j0 = 0; j0 < 4; j0 += 2) {
#pragma unroll
                        for (int m = 0; m < 4; ++m) { stg[(2 * fq) * 65 + 16 * m + fr] = acc[ai][bj][m][n][j0]; stg[(2 * fq + 1) * 65 + 16 * m + fr] = acc[ai][bj][m][n][j0 + 1]; }
                        asm volatile("s_waitcnt lgkmcnt(0)" ::: "memory");
#pragma unroll
                        for (int sl = 0; sl < 8; ++sl) { const float v = stg[sl * 65 + ln]; __builtin_nontemporal_store(v, obase + (size_t)(8 * (sl >> 1) + 4 * n + j0 + (sl & 1)) * 64 + ln); }
                        asm volatile("s_waitcnt lgkmcnt(0)" ::: "memory");
                    }
            }
    }
};
struct EpiVtPart {
    float* PV;
    __device__ __forceinline__ void operator()(AccRef acc, const Unit& u, int wr, int wc, int fr, int fq) const {
        fr = opq(fr); fq = opq(fq);
        float* base = PV + (size_t)((u.pm * 8 + (u.pn - 58)) * 4 + u.ks) * 65536;
#pragma unroll
        for (int ai = 0; ai < 2; ++ai)
#pragma unroll
            for (int m = 0; m < 4; ++m) { const int r = ai * 128 + wr * 64 + m * 16 + fr;
#pragma unroll
                for (int bj = 0; bj < 2; ++bj) { float* o = base + r * 256 + bj * 128 + wc * 32 + 8 * fq; *(f32x4*)o = acc[ai][bj][m][0]; *(f32x4*)(o + 4) = acc[ai][bj][m][1]; } }
    }
};
struct EpiE {
    float* E;
    __device__ __forceinline__ void operator()(AccRef acc, const Unit& u, int wr, int wc, int fr, int fq) const {
        fr = opq(fr); fq = opq(fq);
#pragma unroll
        for (int ai = 0; ai < 2; ++ai)
#pragma unroll
            for (int m = 0; m < 4; ++m) { const int gq = u.pm / 5, chunk = (u.pm - gq * 5) * 256 + ai * 128 + wr * 64 + m * 16 + fr;
                { float* o = E + ((size_t)gq * CHP + chunk) * 128 + wc * 32 + 8 * fq; *(f32x4*)o = acc[ai][0][m][0]; *(f32x4*)(o + 4) = acc[ai][0][m][1]; } }
    }
};
struct EpiZ {
    bf16_t* Z;
    __device__ __forceinline__ void operator()(AccRef acc, const Unit& u, int wr, int wc, int fr, int fq) const {
        fr = opq(fr); fq = opq(fq);
#pragma unroll
        for (int ai = 0; ai < 2; ++ai)
#pragma unroll
            for (int m = 0; m < 4; ++m) { const int gq = u.pm / 5, chunk = (u.pm - gq * 5) * 256 + ai * 128 + wr * 64 + m * 16 + fr;
                {
#pragma unroll
                    for (int bj = 0; bj < 2; ++bj) { const int n = bj * 128 + wc * 32 + 8 * fq, t = n >> 4, m0 = n & 15;
                        f32x4 v0 = acc[ai][bj][m][0], v1 = acc[ai][bj][m][1];
#pragma unroll
                        for (int j = 0; j < 4; ++j) { v0[j] = gelu_f(v0[j]); v1[j] = gelu_f(v1[j]); }
                        *(u32x4*)(Z + (size_t)(chunk * 16 + t) * 512 + gq * 16 + m0) = pack8(v0, v1); __builtin_amdgcn_sched_barrier(0); } } }
    }
};
struct EpiGlu {
    const bf16_t* Z; bf16_t* MIX;
    __device__ __forceinline__ void operator()(AccRef acc, const Unit& u, int wr, int wc, int fr, int fq) const {
        fr = opq(fr); fq = opq(fq);
#pragma unroll
        for (int ai = 0; ai < 2; ++ai)
#pragma unroll
            for (int m = 0; m < 4; ++m) { const int r = u.pm * 256 + ai * 128 + wr * 64 + m * 16 + fr;
#pragma unroll
                for (int bj = 0; bj < 2; ++bj) { const int c = u.pn * 256 + bj * 128 + wc * 32 + 8 * fq;
                    const u32x4 zz = *(const u32x4*)(Z + (size_t)r * 512 + c);
                    f32x4 v0 = acc[ai][bj][m][0], v1 = acc[ai][bj][m][1];
#pragma unroll
                    for (int j = 0; j < 4; ++j) { const unsigned w0 = zz[j >> 1], w1 = zz[2 + (j >> 1)];
                        const float z0 = (j & 1) ? __uint_as_float(w0 & 0xffff0000u) : __uint_as_float(w0 << 16);
                        const float z1 = (j & 1) ? __uint_as_float(w1 & 0xffff0000u) : __uint_as_float(w1 << 16);
                        v0[j] = z0 * sigm(v0[j]); v1[j] = z1 * sigm(v1[j]); }
                    *(u32x4*)(MIX + (size_t)r * 1024 + 512 + c) = pack8(v0, v1); } }
    }
};
struct EpiAtomic {
    float* FS;
    __device__ __forceinline__ void operator()(AccRef acc, const Unit& u, int wr, int wc, int fr, int fq) const {
        fr = opq(fr); fq = opq(fq);
#pragma unroll
        for (int ai = 0; ai < 2; ++ai)
#pragma unroll
            for (int m = 0; m < 4; ++m) { const int r = (u.pm - 64) * 256 + ai * 128 + wr * 64 + m * 16 + fr;
#pragma unroll
                for (int bj = 0; bj < 2; ++bj) { float* o = FS + ((size_t)u.ks * 512 + r) * 1024 + u.pn * 256 + bj * 128 + wc * 32 + 8 * fq;
                    *(f32x4*)o = acc[ai][bj][m][0]; *(f32x4*)(o + 4) = acc[ai][bj][m][1]; } }
    }
};
struct EpiSwi {
    bf16_t* H;
    __device__ __forceinline__ void operator()(AccRef acc, const Unit& u, int wr, int wc, int fr, int fq) const {
        fr = opq(fr); fq = opq(fq);
#pragma unroll
        for (int ai = 0; ai < 2; ++ai)
#pragma unroll
            for (int m = 0; m < 4; ++m) { const int r = u.pm * 256 + ai * 128 + wr * 64 + m * 16 + fr; const int c = u.pn * 128 + wc * 32 + 8 * fq;
                f32x4 v0 = acc[ai][0][m][0], v1 = acc[ai][0][m][1]; const f32x4 u0 = acc[ai][1][m][0], u1 = acc[ai][1][m][1];
#pragma unroll
                for (int j = 0; j < 4; ++j) { v0[j] = silu_f(v0[j]) * u0[j]; v1[j] = silu_f(v1[j]) * u1[j]; }
                *(u32x4*)(H + (size_t)r * DFF + c) = pack8(v0, v1); }
    }
};

struct EpiA {
    EpiIn in; EpiVT vt; EpiVtPart vp;
    __device__ __forceinline__ void operator()(AccRef acc, const Unit& u, int wr, int wc, int fr, int fq) const {
        if (u.kind == 0) in(acc, u, wr, wc, fr, fq); else if (u.nt == 16) vt(acc, u, wr, wc, fr, fq); else vp(acc, u, wr, wc, fr, fq);
    }
};
struct EpiMS {
    EpiPlain p; EpiAtomic q;
    __device__ __forceinline__ void operator()(AccRef acc, const Unit& u, int wr, int wc, int fr, int fq) const {
        if (u.pm < 64) p(acc, u, wr, wc, fr, fq); else q(acc, u, wr, wc, fr, fq);
    }
};
struct Args { const float* in[30]; float* out; unsigned char* ws; };
struct Ctx {
    LAS unsigned char* lds; int tid, lane, wave, G, c;
    const float* const* in; float* out; unsigned char* ws;
};
#define INP(i) (a.in[i])

__device__ __forceinline__ void tr_item(const float* W, size_t ldw, int k0, int sc0, bf16_t* WT, size_t ldo, int dr0, LAS float* scr, int lane) {
    f32x4 tv[8];
#pragma unroll
    for (int i = 0; i < 8; ++i) { const int kk = 8 * i + (lane >> 3); tv[i] = __builtin_nontemporal_load((const f32x4*)(W + (size_t)(k0 + kk) * ldw + sc0 + 4 * (lane & 7))); }
#pragma unroll
    for (int i = 0; i < 8; ++i) { const int kk = 8 * i + (lane >> 3); LAS float* d = scr + kk * 33 + 4 * (lane & 7); d[0] = tv[i][0]; d[1] = tv[i][1]; d[2] = tv[i][2]; d[3] = tv[i][3]; }
    asm volatile("s_waitcnt lgkmcnt(0)" ::: "memory");
    const int c = lane & 7;
#pragma unroll
    for (int j = 0; j < 4; ++j) { const int n = (lane >> 3) + 8 * j; const LAS float* s = scr + (8 * c) * 33 + n;
        u32x4 o; o.x = cvt_pk_bf16(s[0 * 33], s[1 * 33]); o.y = cvt_pk_bf16(s[2 * 33], s[3 * 33]); o.z = cvt_pk_bf16(s[4 * 33], s[5 * 33]); o.w = cvt_pk_bf16(s[6 * 33], s[7 * 33]);
        *(u32x4*)(WT + (size_t)(dr0 + n) * ldo + k0 + 8 * c) = o; }
    asm volatile("s_waitcnt lgkmcnt(0)" ::: "memory");
}

__device__ __forceinline__ void sincos_d(double x, double& s, double& c) {
    const double k = rint(x * 0.63661977236758134308);
    const double r = (x - k * 1.57079632679489655800) - k * 6.123233995736766036e-17;
    const double r2 = r * r;
    double sp = 1.0 / 6227020800.0; sp = sp * r2 - 1.0 / 39916800.0; sp = sp * r2 + 1.0 / 362880.0; sp = sp * r2 - 1.0 / 5040.0; sp = sp * r2 + 1.0 / 120.0; sp = sp * r2 - 1.0 / 6.0; sp = sp * r2 + 1.0;
    const double sr = r * sp;
    double cp = 1.0 / 87178291200.0; cp = cp * r2 - 1.0 / 479001600.0; cp = cp * r2 + 1.0 / 3628800.0; cp = cp * r2 - 1.0 / 40320.0; cp = cp * r2 + 1.0 / 720.0; cp = cp * r2 - 1.0 / 24.0; cp = cp * r2 + 0.5;
    const double cr = 1.0 - r2 * cp;
    const int q = ((int)k) & 3;
    s = (q == 0) ? sr : (q == 1) ? cr : (q == 2) ? -sr : -cr;
    c = (q == 0) ? cr : (q == 1) ? -sr : (q == 2) ? -cr : sr;
}

__device__ __forceinline__ void p0_weights(const Args& a, int lw, bool do_wg, LAS unsigned char* lds, int wave, int lane, int gw, int NGW) {
    LAS float* scr = (LAS float*)(lds + wave * 16384);
    constexpr int I_IN = 16 * 16, I_GLU = 8 * 16, I_OUT = 16 * 32, I_G = 16 * 88, I_D = 44 * 32;
    constexpr int PER_L = 4 * I_IN + I_GLU + I_OUT + 2 * I_G + I_D;
    for (int it = gw; it < PER_L; it += NGW) {
        const int l = lw; int r = it;
        const float* win = INP(15) + (size_t)l * DM * DIN;
        bf16_t* WIN = (bf16_t*)(a.ws + WS_WIN) + (size_t)l * 1536 * 1024;
        if (r < 4 * I_IN) { const int part = r / I_IN, rr = r % I_IN, kb = rr / 16, nb = rr % 16;
            if (part == 0) tr_item(win, DIN, 64 * kb, 32 * nb, WIN, 1024, 32 * nb, scr, lane);
            else if (part == 1) tr_item(win, DIN, 64 * kb, 512 + 32 * nb, WIN, 1024, 512 + 32 * nb, scr, lane);
            else if (part == 2) tr_item(win, DIN, 64 * kb, 1544 + 32 * nb, WIN, 1024, 1024 + 32 * nb, scr, lane);
            else tr_item(win, DIN, 64 * kb, 1024 + 32 * nb, (bf16_t*)(a.ws + WS_WV) + (size_t)l * 512 * 1024, 1024, 32 * nb, scr, lane);
            continue; }
        r -= 4 * I_IN;
        if (r < I_GLU) { tr_item(INP(25) + (size_t)l * 512 * 512, 512, 64 * (r / 16), 32 * (r % 16), (bf16_t*)(a.ws + WS_WGLU) + (size_t)l * 512 * 512, 512, 32 * (r % 16), scr, lane); continue; }
        r -= I_GLU;
        if (r < I_OUT) { tr_item(INP(26) + (size_t)l * 1024 * 1024, 1024, 64 * (r / 32), 32 * (r % 32), (bf16_t*)(a.ws + WS_WOUT) + (size_t)l * 1024 * 1024, 1024, 32 * (r % 32), scr, lane); continue; }
        r -= I_OUT;
        if (r < 2 * I_G) { const int up = r / I_G, rr = r % I_G, kb = rr / 88, nb = rr % 88, c0 = 32 * nb;
            tr_item(INP(27 + up) + (size_t)l * DM * DFF, DFF, 64 * kb, c0, (bf16_t*)(a.ws + WS_WGU) + (size_t)l * 5632 * 1024, 1024, (c0 >> 7) * 256 + up * 128 + (c0 & 127), scr, lane);
            continue; }
        r -= 2 * I_G;
        tr_item(INP(29) + (size_t)l * DFF * DM, DM, 64 * (r / 32), 32 * (r % 32), (bf16_t*)(a.ws + WS_WD) + (size_t)l * 1024 * DFF, DFF, 32 * (r % 32), scr, lane);
    }
    float* WG = (float*)(a.ws + WS_WG);
    if (do_wg) for (int i = gw * 64 + lane; i < NL * 8 * 1024; i += NGW * 64) { const int l = i >> 13, h = (i >> 10) & 7, k = i & 1023; WG[i] = INP(15)[((size_t)l * DM + k) * DIN + 1536 + h]; }
}
__device__ __forceinline__ void p0_adaln(const Args& a, LAS unsigned char* lds, int tid, int wave, int lane, int c, int G) {
    LAS float* sc = (LAS float*)(lds);
    LAS float* red = (LAS float*)(lds + 49152);
    for (int i = tid; i < 12 * 1024; i += 512) { const float v = (i < 4096) ? INP(2)[i] : INP(3)[i - 4096]; sc[i] = silu_f(v); }
    __syncthreads();
    float* MOD = (float*)(a.ws + WS_MOD);
    for (int it = c; it < NL * 96; it += G) {
        const int l = it / 96, n0 = (it % 96) * 64;
        const float* W = INP(9) + (size_t)l * DM * 6144 + n0 + lane;
        float acc[12];
#pragma unroll
        for (int b = 0; b < 12; ++b) acc[b] = 0.f;
        for (int k = wave * 128; k < wave * 128 + 128; k += 16) {
            float w[16];
#pragma unroll
            for (int j = 0; j < 16; ++j) w[j] = __builtin_nontemporal_load(W + (size_t)(k + j) * 6144);
#pragma unroll
            for (int j = 0; j < 16; ++j)
#pragma unroll
                for (int b = 0; b < 12; ++b) acc[b] += sc[b * 1024 + k + j] * w[j];
        }
#pragma unroll
        for (int b = 0; b < 12; ++b) red[(wave * 12 + b) * 64 + lane] = acc[b];
        __syncthreads();
        for (int i = tid; i < 768; i += 512) { const int b = i >> 6, cc = i & 63; float s = 0.f;
#pragma unroll
            for (int w = 0; w < 8; ++w) s += red[(w * 12 + b) * 64 + cc];
            MOD[((size_t)l * 12 + b) * 6144 + n0 + cc] = s + INP(10)[(size_t)l * 6144 + n0 + cc]; }
        __syncthreads();
    }
}
__device__ __forceinline__ void p0_ssm(const Args& a, LAS unsigned char* lds, int tid, int c, int G) {
    LAS float* ap_re = (LAS float*)(lds + 65536);
    LAS float* ap_im = ap_re + 17 * 64;
    LAS float* bb_re = ap_im + 17 * 64;
    LAS float* bb_im = bb_re + 1024;
    LAS float* cc_re = bb_im + 1024;
    LAS float* cc_im = cc_re + 1024;
    LAS float* ktab = cc_im + 1024;
    for (int it = c; it < NL * NG; it += G) {
        const int l = it >> 5, gq = it & 31;
        const double dt = exp((double)INP(19)[l * 32 + gq]);
        for (int idx = tid; idx < 17 * 64; idx += 512) { const int d = idx >> 6, p = idx & 63;
            const double ar = (double)INP(17)[(l * 32 + gq) * 64 + p], ai = (double)INP(18)[(l * 32 + gq) * 64 + p];
            double s, co; sincos_d((double)d * ai * dt, s, co); const double er = exp((double)d * ar * dt);
            ap_re[idx] = (float)(er * co); ap_im[idx] = (float)(er * s); }
        for (int idx = tid; idx < 1024; idx += 512) { const int p = idx >> 4, m = idx & 15;
            const double ar = (double)INP(17)[(l * 32 + gq) * 64 + p], ai = (double)INP(18)[(l * 32 + gq) * 64 + p];
            double s, co; sincos_d(ai * dt, s, co); const double er = exp(ar * dt);
            const double xr = er * co - 1.0, xi = er * s, den = 1.0 / (ar * ar + ai * ai);
            const double qr = (xr * ar + xi * ai) * den, qi = (xi * ar - xr * ai) * den;
            const double br = (double)INP(20)[((size_t)(l * 32 + gq) * 64 + p) * 16 + m], bi = (double)INP(21)[((size_t)(l * 32 + gq) * 64 + p) * 16 + m];
            bb_re[idx] = (float)(qr * br - qi * bi); bb_im[idx] = (float)(qr * bi + qi * br);
            cc_re[idx] = INP(22)[(size_t)(l * 32 + gq) * 1024 + idx]; cc_im[idx] = INP(23)[(size_t)(l * 32 + gq) * 1024 + idx]; }
        __syncthreads();
        for (int idx = tid; idx < 4096; idx += 512) { const int d = idx >> 8, m = (idx >> 4) & 15, m2 = idx & 15; float s = 0.f;
            for (int p = 0; p < 64; ++p) { const float cr = cc_re[m * 64 + p], ci = cc_im[m * 64 + p], pr = ap_re[d * 64 + p], pi = ap_im[d * 64 + p];
                const float re = cr * pr - ci * pi, im = cr * pi + ci * pr; s += re * bb_re[p * 16 + m2] - im * bb_im[p * 16 + m2]; }
            if (d == 0 && m == m2) s += INP(24)[l * 512 + gq * 16 + m];
            ktab[idx] = s; }
        __syncthreads();
        bf16_t* BT3 = (bf16_t*)(a.ws + WS_BT3) + (size_t)(l * 32 + gq) * 256 * UAK;
        for (int grp = tid; grp < 256 * 48; grp += 512) { const int n = grp / 48, k0 = (grp % 48) * 8, t = n >> 4, m = n & 15; float v[8];
            if (k0 < 256) { const int s = k0 >> 4, m20 = k0 & 15;
#pragma unroll
                for (int j = 0; j < 8; ++j) v[j] = (s <= t) ? ktab[((t - s) * 16 + m) * 16 + m20 + j] : 0.f; }
            else { const int kk = k0 - 256, ri = kk >> 6, p0 = kk & 63;
#pragma unroll
                for (int j = 0; j < 8; ++j) { const int p = p0 + j; const float cr = cc_re[m * 64 + p], ci = cc_im[m * 64 + p], pr = ap_re[(t + 1) * 64 + p], pi = ap_im[(t + 1) * 64 + p];
                    v[j] = ri ? -(cr * pi + ci * pr) : (cr * pr - ci * pi); } }
            u32x4 w; w.x = cvt_pk_bf16(v[0], v[1]); w.y = cvt_pk_bf16(v[2], v[3]); w.z = cvt_pk_bf16(v[4], v[5]); w.w = cvt_pk_bf16(v[6], v[7]);
            *(u32x4*)(BT3 + (size_t)n * UAK + k0) = w; }
        bf16_t* BT1 = (bf16_t*)(a.ws + WS_BT1) + (size_t)(l * 32 + gq) * 128 * 256;
        for (int grp = tid; grp < 128 * 32; grp += 512) { const int n = grp >> 5, k0 = (grp & 31) * 8, s = k0 >> 4, m0 = k0 & 15, ri = n >> 6, p = n & 63; float v[8];
            const float pr = ap_re[(15 - s) * 64 + p], pi = ap_im[(15 - s) * 64 + p];
#pragma unroll
            for (int j = 0; j < 8; ++j) { const float br = bb_re[p * 16 + m0 + j], bi = bb_im[p * 16 + m0 + j]; v[j] = ri ? (pr * bi + pi * br) : (pr * br - pi * bi); }
            u32x4 w; w.x = cvt_pk_bf16(v[0], v[1]); w.y = cvt_pk_bf16(v[2], v[3]); w.z = cvt_pk_bf16(v[4], v[5]); w.w = cvt_pk_bf16(v[6], v[7]);
            *(u32x4*)(BT1 + (size_t)n * 256 + k0) = w; }
        if (tid < 64) { float* A16 = (float*)(a.ws + WS_A16) + (size_t)(l * 32 + gq) * 128; A16[tid] = ap_re[16 * 64 + tid]; A16[64 + tid] = ap_im[16 * 64 + tid]; }
        __syncthreads();
    }
}

__device__ __forceinline__ void cache_convert(const Args& a, int l, LAS unsigned char* lds, int wave, int lane, int gw, int NGW) {
    bf16_t* KS = (bf16_t*)(a.ws + WS_KS); bf16_t* VTS = (bf16_t*)(a.ws + WS_VTS);
    const float* ck = INP(4) + (size_t)l * 64 * PAST * 64; const float* cv = INP(5) + (size_t)l * 64 * PAST * 64;
    for (int i = gw * 64 + lane; i < 64 * PAST * 8; i += NGW * 64) {
        const int bh = i >> 13, rem = i & 8191;
        const f32x4 v0 = __builtin_nontemporal_load((const f32x4*)(ck + (size_t)i * 8)), v1 = __builtin_nontemporal_load((const f32x4*)(ck + (size_t)i * 8 + 4));
        *(u32x4*)(KS + (size_t)bh * KVS * 64 + (size_t)rem * 8) = pack8(v0, v1); }
    LAS float* scr = (LAS float*)(lds + wave * 16384);
    for (int it = gw; it < 64 * 32; it += NGW) { const int bh = it >> 5, r = it & 31, kb = r >> 1, nb = r & 1;
        tr_item(cv + (size_t)bh * PAST * 64, 64, 64 * kb, 32 * nb, VTS + (size_t)bh * 64 * KVS, KVS, 32 * nb, scr, lane); }
}

template <int NSPLIT>
__device__ __forceinline__ void rowpass(const float* xsrc_p, const float* xsrc_s, const bf16_t* xsrc_b, const bf16_t* Fb, const float* FS, int nsplit, const float* gate, const float* wpost, float* xdst, bf16_t* xdst_b,
                                        const float* wpre, const float* sc, const float* sh, bf16_t* HMb, const float* WGl, const float* bfor, float* out, int lnext,
                                        int lane, int gw, int NGW) {
    f32x4 wg[8][4];
    if (WGl) {
#pragma unroll
        for (int h = 0; h < 8; ++h)
#pragma unroll
            for (int j = 0; j < 4; ++j) wg[h][j] = *(const f32x4*)(WGl + h * 1024 + 4 * lane + 256 * j);
    }
#define LOADX(dst, rr, xr, j) do { if (xsrc_b) { const u32x2 w_ = __builtin_nontemporal_load((const u32x2*)(xsrc_b + (size_t)(rr) * DM + 4 * lane + 256 * (j))); \
        dst = (f32x4){__uint_as_float(w_.x << 16), __uint_as_float(w_.x & 0xffff0000u), __uint_as_float(w_.y << 16), __uint_as_float(w_.y & 0xffff0000u)}; } \
        else dst = __builtin_nontemporal_load((const f32x4*)((xr) + 4 * lane + 256 * (j))); } while (0)
    for (int r = gw; r < MT; r += NGW) {
        const bool prompt = r < NPR; const int bm = prompt ? (r >> 12) : 4 + ((r - NPR) >> 6);
        f32x4 x[4]; u32x2 fw[4];
        { const float* xr = prompt ? xsrc_p + (size_t)r * DM : xsrc_s + (size_t)(r - NPR) * DM;
#pragma unroll
          for (int j = 0; j < 4; ++j) { LOADX(x[j], r, xr, j); fw[j] = (Fb && prompt) ? __builtin_nontemporal_load((const u32x2*)(Fb + (size_t)r * DM + 4 * lane + 256 * j)) : (u32x2){0u, 0u}; } }
        if (Fb) {
            f32x4 f[4]; float ss = 0.f;
#pragma unroll
            for (int j = 0; j < 4; ++j) {
                if (prompt) { const u32x2 w = fw[j];
                    f[j] = (f32x4){__uint_as_float(w.x << 16), __uint_as_float(w.x & 0xffff0000u), __uint_as_float(w.y << 16), __uint_as_float(w.y & 0xffff0000u)}; }
                else { const float* fp = FS + (size_t)(r - NPR) * DM + 4 * lane + 256 * j; f32x4 part[NSPLIT > 0 ? NSPLIT : 1];
#pragma unroll
                    for (int sp = 0; sp < NSPLIT; ++sp) part[sp] = *(const f32x4*)(fp + (size_t)sp * 512 * 1024);
                    f32x4 sacc = part[0];
#pragma unroll
                    for (int sp = 1; sp < NSPLIT; ++sp) sacc = sacc + part[sp];
                    f[j] = sacc; }
                ss += (f[j][0] * f[j][0] + f[j][1] * f[j][1]) + (f[j][2] * f[j][2] + f[j][3] * f[j][3]); }
            const float rstd = rsqrtf(wave_sum(ss, lane) * (1.f / DM) + EPS);
#pragma unroll
            for (int j = 0; j < 4; ++j) { const f32x4 gt = *(const f32x4*)(gate + (size_t)bm * 6144 + 4 * lane + 256 * j), wp = *(const f32x4*)(wpost + 4 * lane + 256 * j);
                x[j] = x[j] + gt * (f[j] * rstd * wp); }
        }
        if (xdst) {
#pragma unroll
            for (int j = 0; j < 4; ++j) __builtin_nontemporal_store(x[j], (f32x4*)(xdst + (size_t)r * DM + 4 * lane + 256 * j));
        }
        if (xdst_b) {
#pragma unroll
            for (int j = 0; j < 4; ++j) { u32x2 w; w.x = cvt_pk_bf16(x[j][0], x[j][1]); w.y = cvt_pk_bf16(x[j][2], x[j][3]); __builtin_nontemporal_store(w, (u32x2*)(xdst_b + (size_t)r * DM + 4 * lane + 256 * j));
                x[j] = (f32x4){__uint_as_float(w.x << 16), __uint_as_float(w.x & 0xffff0000u), __uint_as_float(w.y << 16), __uint_as_float(w.y & 0xffff0000u)}; }
        }
        if (wpre) {
            float ss = 0.f;
#pragma unroll
            for (int j = 0; j < 4; ++j) ss += (x[j][0] * x[j][0] + x[j][1] * x[j][1]) + (x[j][2] * x[j][2] + x[j][3] * x[j][3]);
            const float rstd = rsqrtf(wave_sum(ss, lane) * (1.f / DM) + EPS);
            f32x4 hm[4];
#pragma unroll
            for (int j = 0; j < 4; ++j) { const int cidx = 4 * lane + 256 * j;
                const f32x4 wv = *(const f32x4*)(wpre + cidx), s1 = *(const f32x4*)(sc + (size_t)bm * 6144 + cidx), s0 = *(const f32x4*)(sh + (size_t)bm * 6144 + cidx);
                hm[j] = (x[j] * rstd * wv) * (1.f + s1) + s0;
                u32x2 w; w.x = cvt_pk_bf16(hm[j][0], hm[j][1]); w.y = cvt_pk_bf16(hm[j][2], hm[j][3]);
                *(u32x2*)(HMb + (size_t)r * DM + cidx) = w; }
            if (WGl) {
                float mine = 0.f;
#pragma unroll
                for (int h = 0; h < 8; ++h) { float d = 0.f;
#pragma unroll
                    for (int j = 0; j < 4; ++j) { const f32x4 wv = wg[h][j]; d += (hm[j][0] * wv[0] + hm[j][1] * wv[1]) + (hm[j][2] * wv[2] + hm[j][3] * wv[3]); }
                    d = wave_sum(d, lane); if (lane == h) mine = d; }
                if (lane < 8) { const float lf = logsig(mine + bfor[lane]);
                    if (prompt) out[O_LP + ((size_t)((lnext * 4 + (r >> 12)) * 8 + lane)) * 4096 + (r & 4095)] = lf;
                    else { const int rr = r - NPR; out[O_LS + ((size_t)((lnext * 8 + (rr >> 6)) * 8 + lane)) * 64 + (rr & 63)] = lf; } }
            }
        }
    }
}

__device__ __forceinline__ void vt_finalize(const Args& a, int l, int lane, int gwi, int nw) {
    const float* PV = (const float*)(a.ws + WS_F1); bf16_t* VTP = (bf16_t*)(a.ws + WS_VTP); bf16_t* VTS = (bf16_t*)(a.ws + WS_VTS);
    for (int it = gwi; it < 16 * 128; it += nw) {
        const int tile = it >> 7, rem = it & 127, hb = rem >> 5, to = rem & 31, hdl = hb * 64 + lane, pm = tile >> 3, pn = 58 + (tile & 7);
        const int hd = pm * 256 + hdl, h = hd >> 6, d = hd & 63, tok = pn * 256 + to * 8;
        f32x4 v0 = {0.f, 0.f, 0.f, 0.f}, v1 = {0.f, 0.f, 0.f, 0.f};
#pragma unroll
        for (int ks = 0; ks < 4; ++ks) { const float* p = PV + ((size_t)(tile * 4 + ks) * 256 + hdl) * 256 + to * 8; v0 = v0 + *(const f32x4*)p; v1 = v1 + *(const f32x4*)(p + 4); }
        const u32x4 w = pack8(v0, v1);
        if (pn < 64) { const int b = tok >> 12, t = tok & 4095;
            *(u32x4*)(VTP + ((size_t)(b * 8 + h) * 64 + d) * 4096 + t) = w;
            float* o = a.out + O_VP + ((size_t)((l * 4 + b) * 8 + h) * 4096 + t) * 64 + d;
#pragma unroll
            for (int j = 0; j < 4; ++j) { __builtin_nontemporal_store(v0[j], o + (size_t)j * 64); __builtin_nontemporal_store(v1[j], o + (size_t)(j + 4) * 64); } }
        else { const int tt = tok - NPR, b = tt >> 6, t = tt & 63;
            *(u32x4*)(VTS + ((size_t)(b * 8 + h) * 64 + d) * KVS + PAST + t) = w;
            float* o = a.out + O_VS + ((size_t)((l * 8 + b) * 8 + h) * 64 + t) * 64 + d;
#pragma unroll
            for (int j = 0; j < 4; ++j) { __builtin_nontemporal_store(v0[j], o + (size_t)j * 64); __builtin_nontemporal_store(v1[j], o + (size_t)(j + 4) * 64); } }
    }
}
__device__ __forceinline__ void cumsum_items(const Args& a, int l, LAS unsigned char* lds, int tid, int wave, int lane, int c, int G) {
    LAS float* wt = (LAS float*)(lds);
    for (int it = c - 64; it >= 0 && it < 96; it += G) {
        const bool prompt = it < 32;
        float v[8]; float run = 0.f; int i0, cnt;
        if (prompt) { i0 = tid * 8; cnt = 8;
            const float* src = a.out + O_LP + (size_t)(l * 32 + it) * 4096 + i0;
            const f32x4 p0 = *(const f32x4*)src, p1 = *(const f32x4*)(src + 4);
            v[0] = p0[0]; v[1] = p0[1]; v[2] = p0[2]; v[3] = p0[3]; v[4] = p1[0]; v[5] = p1[1]; v[6] = p1[2]; v[7] = p1[3]; }
        else { const int sq = it - 32; i0 = tid * 4; cnt = tid < 272 ? 4 : 0;
            const float* src = tid < 256 ? INP(6) + (size_t)(l * 64 + sq) * PAST + i0 : a.out + O_LS + (size_t)(l * 64 + sq) * 64 + (tid < 272 ? i0 - PAST : 0);
            const f32x4 p0 = *(const f32x4*)src;
            v[0] = p0[0]; v[1] = p0[1]; v[2] = p0[2]; v[3] = p0[3]; v[4] = 0.f; v[5] = 0.f; v[6] = 0.f; v[7] = 0.f;
            if (tid >= 272) { v[0] = 0.f; v[1] = 0.f; v[2] = 0.f; v[3] = 0.f; } }
#pragma unroll
        for (int j = 0; j < 8; ++j) { run += v[j]; v[j] = run; }
        float incl = run;
#pragma unroll
        for (int o = 1; o < 64; o <<= 1) { const float t = bperm(incl, lane >= o ? lane - o : lane); if (lane >= o) incl += t; }
        if (lane == 63) wt[wave] = incl;
        __syncthreads();
        float off = incl - run;
        for (int w = 0; w < wave; ++w) off += wt[w];
        float* dst = (prompt ? (float*)(a.ws + WS_BIASP) + (size_t)it * 4096 : (float*)(a.ws + WS_BIASS) + (size_t)(it - 32) * KVS) + i0;
        if (cnt == 8) { *(f32x4*)dst = (f32x4){-(off + v[0]) * LOG2E, -(off + v[1]) * LOG2E, -(off + v[2]) * LOG2E, -(off + v[3]) * LOG2E};
                        *(f32x4*)(dst + 4) = (f32x4){-(off + v[4]) * LOG2E, -(off + v[5]) * LOG2E, -(off + v[6]) * LOG2E, -(off + v[7]) * LOG2E}; }
        else if (cnt == 4) *(f32x4*)dst = (f32x4){-(off + v[0]) * LOG2E, -(off + v[1]) * LOG2E, -(off + v[2]) * LOG2E, -(off + v[3]) * LOG2E};
        __syncthreads();
    }
}

__device__ __forceinline__ void ssm_scan(const Args& a, int l, LAS unsigned char* lds, int wave, int lane, int c, int G) {
    const float* E = (const float*)(a.ws + WS_E); bf16_t* UA = (bf16_t*)(a.ws + WS_UA); const float* A16 = (const float*)(a.ws + WS_A16);
    LAS float* endst = (LAS float*)(lds);
    for (int it = c; it < 128; it += G) {
        const int b = it >> 5, gq = it & 31, p = lane;
        const float ar = A16[(l * 32 + gq) * 128 + p], ai = A16[(l * 32 + gq) * 128 + 64 + p];
        float er[32], ei[32];
        const int ch0 = b * 256 + wave * 32;
#pragma unroll
        for (int i = 0; i < 32; ++i) { const float* e = E + ((size_t)gq * CHP + ch0 + i) * 128; er[i] = e[p]; ei[i] = e[64 + p]; }
        float hr = 0.f, hi = 0.f;
#pragma unroll
        for (int i = 0; i < 32; ++i) { const float nr = ar * hr - ai * hi + er[i], ni = ar * hi + ai * hr + ei[i]; hr = nr; hi = ni; }
        endst[(wave * 2) * 64 + p] = hr; endst[(wave * 2 + 1) * 64 + p] = hi;
        float pr = ar, pi = ai;
#pragma unroll
        for (int s = 0; s < 5; ++s) { const float nr = pr * pr - pi * pi, ni = 2.f * pr * pi; pr = nr; pi = ni; }
        __syncthreads();
        hr = 0.f; hi = 0.f;
        for (int w = 0; w < wave; ++w) { const float xr = endst[(w * 2) * 64 + p], xi = endst[(w * 2 + 1) * 64 + p];
            const float nr = pr * hr - pi * hi + xr, ni = pr * hi + pi * hr + xi; hr = nr; hi = ni; }
#pragma unroll
        for (int i = 0; i < 32; ++i) { bf16_t* u = UA + ((size_t)gq * CHP + ch0 + i) * UAK + 256; u[p] = f2bf(hr); u[64 + p] = f2bf(hi);
            const float nr = ar * hr - ai * hi + er[i], ni = ar * hi + ai * hr + ei[i]; hr = nr; hi = ni; }
        if (wave == 7) { a.out[O_RP + (size_t)((l * 4 + b) * 32 + gq) * 64 + p] = hr; a.out[O_IP + (size_t)((l * 4 + b) * 32 + gq) * 64 + p] = hi; }
        __syncthreads();
    }
    for (int it = (G - 1 - c) * 8 + wave; it < 256; it += G * 8) {
        const int b = it >> 5, gq = it & 31, p = lane;
        const float ar = A16[(l * 32 + gq) * 128 + p], ai = A16[(l * 32 + gq) * 128 + 64 + p];
        float hr = INP(7)[(size_t)((l * 8 + b) * 32 + gq) * 64 + p], hi = INP(8)[(size_t)((l * 8 + b) * 32 + gq) * 64 + p];
        const int ch0 = 1024 + b * 4;
#pragma unroll
        for (int i = 0; i < 4; ++i) { const float* e = E + ((size_t)gq * CHP + ch0 + i) * 128; const float xr = e[p], xi = e[64 + p];
            bf16_t* u = UA + ((size_t)gq * CHP + ch0 + i) * UAK + 256; u[p] = f2bf(hr); u[64 + p] = f2bf(hi);
            const float nr = ar * hr - ai * hi + xr, ni = ar * hi + ai * hr + xi; hr = nr; hi = ni; }
        a.out[O_RS + (size_t)((l * 8 + b) * 32 + gq) * 64 + p] = hr; a.out[O_IS + (size_t)((l * 8 + b) * 32 + gq) * 64 + p] = hi;
    }
}

#define DPPMAX(v, ctrl) v = fmaxf(v, __int_as_float(__builtin_amdgcn_update_dpp(0, __float_as_int(v), ctrl, 0xF, 0xF, true)))
__device__ __forceinline__ float wave_max_nonneg(float v) {
    DPPMAX(v, 0xB1); DPPMAX(v, 0x4E); DPPMAX(v, 0x141); DPPMAX(v, 0x140);
    const float r0 = __int_as_float(__builtin_amdgcn_readlane(__float_as_int(v), 0)), r1 = __int_as_float(__builtin_amdgcn_readlane(__float_as_int(v), 16));
    const float r2 = __int_as_float(__builtin_amdgcn_readlane(__float_as_int(v), 32)), r3 = __int_as_float(__builtin_amdgcn_readlane(__float_as_int(v), 48));
    return fmaxf(fmaxf(r0, r1), fmaxf(r2, r3));
}
__device__ __forceinline__ void kmax_items(const Args& a, int lane, int gw, int NGW) {
    float* KM = (float*)(a.ws + WS_KMAX);
    for (int it = NGW - 1 - gw; it < 2048 + 1088; it += NGW) {
        const bf16_t* kp; int oidx;
        if (it < 2048) { const int bh = it >> 6, t = it & 63; kp = (const bf16_t*)(a.ws + WS_KP) + ((size_t)bh * 4096 + t * 64) * 64; oidx = it; }
        else { const int r = it - 2048, sq = r / 17, t = r - sq * 17; kp = (const bf16_t*)(a.ws + WS_KS) + ((size_t)sq * KVS + t * 64) * 64; oidx = (32 + sq) * 64 + t; }
        float ss = 0.f;
#pragma unroll
        for (int i = 0; i < 8; ++i) { const u32x4 w = *(const u32x4*)(kp + (size_t)lane * 64 + i * 8);
#pragma unroll
            for (int j = 0; j < 4; ++j) { const float lo = __uint_as_float(w[j] << 16), hi = __uint_as_float(w[j] & 0xffff0000u); ss += lo * lo + hi * hi; } }
        const float m = wave_max_nonneg(ss);
        if (lane == 0) KM[oidx] = sqrtf(m) * 1.001f;
    }
}
constexpr int AT_ROW = 144, AT_TILE = 64 * AT_ROW  , AT_KB = 0, AT_VB = 4 * AT_TILE, AT_BB = 8 * AT_TILE;
__device__ __forceinline__ void attn_tile(const LAS unsigned char* Kb, const LAS unsigned char* Vb, const LAS float* Bb, const bf16x8 (&qf)[4], f32x16& o0, f32x16& o1, float& lsum,
                                          float bq, int myq, int key0, bool domask, int ka_off, int va_off, int hi) {
    f32x16 s0, s1;
#pragma unroll
    for (int a2 = 0; a2 < 2; ++a2) { const f32x4 b0 = *(const LAS f32x4*)(Bb + a2 * 16 + hi * 8), b1 = *(const LAS f32x4*)(Bb + a2 * 16 + hi * 8 + 4);
        const f32x4 c0 = *(const LAS f32x4*)(Bb + 32 + a2 * 16 + hi * 8), c1 = *(const LAS f32x4*)(Bb + 32 + a2 * 16 + hi * 8 + 4);
#pragma unroll
        for (int j = 0; j < 4; ++j) { s0[a2 * 8 + j] = b0[j]; s0[a2 * 8 + 4 + j] = b1[j]; s1[a2 * 8 + j] = c0[j]; s1[a2 * 8 + 4 + j] = c1[j]; } }
    __builtin_amdgcn_s_setprio(1);
#pragma unroll
    for (int ks = 0; ks < 4; ++ks) {
        const bf16x8 k0 = *(const LAS bf16x8*)(Kb + ka_off + ks * 32), k1 = *(const LAS bf16x8*)(Kb + 32 * AT_ROW + ka_off + ks * 32);
        s0 = __builtin_amdgcn_mfma_f32_32x32x16_bf16(k0, qf[ks], s0, 0, 0, 0);
        s1 = __builtin_amdgcn_mfma_f32_32x32x16_bf16(k1, qf[ks], s1, 0, 0, 0);
    }
    __builtin_amdgcn_s_setprio(0);
    if (domask) {
#pragma unroll
        for (int r = 0; r < 16; ++r) { const int kj = key0 + 16 * (r >> 3) + 8 * hi + (r & 7);
            if (kj > myq) s0[r] = -INFINITY; if (kj + 32 > myq) s1[r] = -INFINITY; }
    }
    s0 = s0 - bq; s1 = s1 - bq;
#pragma unroll
    for (int r = 0; r < 16; ++r) { s0[r] = __builtin_amdgcn_exp2f(s0[r]); s1[r] = __builtin_amdgcn_exp2f(s1[r]); }
    { const f32x16 e = s0 + s1;
      const f32x8 e8 = __builtin_shufflevector(e, e, 0, 1, 2, 3, 4, 5, 6, 7) + __builtin_shufflevector(e, e, 8, 9, 10, 11, 12, 13, 14, 15);
      const f32x4 e4 = __builtin_shufflevector(e8, e8, 0, 1, 2, 3) + __builtin_shufflevector(e8, e8, 4, 5, 6, 7);
      lsum += (e4[0] + e4[1]) + (e4[2] + e4[3]); }
    bf16x8 pa[4];
#pragma unroll
    for (int a2 = 0; a2 < 2; ++a2) {
        u32x4 w0, w1;
        w0.x = cvt_pk_bf16(s0[a2 * 8 + 0], s0[a2 * 8 + 1]); w0.y = cvt_pk_bf16(s0[a2 * 8 + 2], s0[a2 * 8 + 3]); w0.z = cvt_pk_bf16(s0[a2 * 8 + 4], s0[a2 * 8 + 5]); w0.w = cvt_pk_bf16(s0[a2 * 8 + 6], s0[a2 * 8 + 7]);
        w1.x = cvt_pk_bf16(s1[a2 * 8 + 0], s1[a2 * 8 + 1]); w1.y = cvt_pk_bf16(s1[a2 * 8 + 2], s1[a2 * 8 + 3]); w1.z = cvt_pk_bf16(s1[a2 * 8 + 4], s1[a2 * 8 + 5]); w1.w = cvt_pk_bf16(s1[a2 * 8 + 6], s1[a2 * 8 + 7]);
        pa[a2] = __builtin_bit_cast(bf16x8, w0); pa[2 + a2] = __builtin_bit_cast(bf16x8, w1);
    }
    __builtin_amdgcn_s_setprio(1);
#pragma unroll
    for (int kk = 0; kk < 4; ++kk) {
        const bf16x8 v0 = *(const LAS bf16x8*)(Vb + va_off + kk * 32), v1 = *(const LAS bf16x8*)(Vb + 32 * AT_ROW + va_off + kk * 32);
        o0 = __builtin_amdgcn_mfma_f32_32x32x16_bf16(v0, pa[kk], o0, 0, 0, 0);
        o1 = __builtin_amdgcn_mfma_f32_32x32x16_bf16(v1, pa[kk], o1, 0, 0, 0);
    }
    __builtin_amdgcn_s_setprio(0);
}
__device__ __forceinline__ void attn_unit(LAS unsigned char* lds, const bf16_t* Qrow0, int h, int nrows, int qpos0, int NT,
                                          const bf16_t* Kp, const bf16_t* VTp, int vpitch, const float* biasp, const float* kmaxp, bf16_t* Orow0, int tid, int wave, int lane) {
    const int q = lane & 31, hi = lane >> 5;
    const bool active = wave * 32 < nrows;
    bf16x8 qf[4];
#pragma unroll
    for (int ks = 0; ks < 4; ++ks) qf[ks] = active ? *(const bf16x8*)(Qrow0 + (size_t)(wave * 32 + q) * 512 + h * 64 + ks * 16 + hi * 8) : (bf16x8){0, 0, 0, 0, 0, 0, 0, 0};
    f32x16 o0 = {}, o1 = {};
    float lsum = 0.f;
    const int myq = qpos0 + wave * 32 + q;
    const int wq_lo = qpos0 + wave * 32, wq_hi = wq_lo + 31;
    const float bq = active ? biasp[myq] : 0.f;
    const int NS = (NT + 1) >> 1;
    int s_first;
    { float ssq = 0.f;
#pragma unroll
      for (int ks = 0; ks < 4; ++ks)
#pragma unroll
          for (int e = 0; e < 8; ++e) { const float v = __uint_as_float(((unsigned)(unsigned short)qf[ks][e]) << 16); ssq += v * v; }
      ssq += bperm(ssq, lane ^ 32);
      const float wm = wave_max_nonneg(ssq);
      volatile LAS float* qm = (volatile LAS float*)(lds + 131072 + 512);
      volatile LAS int* tst = (volatile LAS int*)(lds + 131072 + 576);
      if (lane == 0) qm[wave] = wm;
      __syncthreads();
      if (wave == 0) {
          float m2 = 0.f;
#pragma unroll
          for (int w = 0; w < 8; ++w) m2 = fmaxf(m2, qm[w]);
          const float QN = sqrtf(m2) * 1.001f;
          bool fail = true;
          if (lane < NT) fail = !(QN * kmaxp[lane] + biasp[64 * lane + 63] - biasp[qpos0] < -160.f);
          const unsigned long long mask = __builtin_amdgcn_ballot_w64(fail);
          const int tfirst = mask ? (int)__builtin_ctzll(mask) : 0;
          if (lane == 0) tst[0] = tfirst >> 1;
      }
      __syncthreads();
      s_first = tst[0]; }
    const int krow = tid >> 3, kch = tid & 7;
    const bf16_t* kg = Kp + (size_t)tid * 8;
    const bf16_t* vg = VTp + (size_t)krow * vpitch + kch * 8;
    const int st_off = krow * AT_ROW + kch * 16;
    const int kap = (q & 19) | ((q & 4) << 1) | ((q & 8) >> 1);
    const int ka_off = kap * AT_ROW + hi * 16, va_off = q * AT_ROW + hi * 16;
    u32x4 kr0, kr1, vr0, vr1; f32x4 br = {0.f, 0.f, 0.f, 0.f};
    { const int tb = 2 * s_first; kr0 = *(const u32x4*)(kg + (size_t)tb * 4096); kr1 = *(const u32x4*)(kg + (size_t)(tb + 1) * 4096); vr0 = *(const u32x4*)(vg + tb * 64); vr1 = *(const u32x4*)(vg + (tb + 1) * 64); if (tid < 32) br = *(const f32x4*)(biasp + tb * 64 + tid * 4); }
    *(LAS u32x4*)(lds + AT_KB + st_off) = kr0; *(LAS u32x4*)(lds + AT_KB + AT_TILE + st_off) = kr1;
    *(LAS u32x4*)(lds + AT_VB + st_off) = vr0; *(LAS u32x4*)(lds + AT_VB + AT_TILE + st_off) = vr1; if (tid < 32) *(LAS f32x4*)(lds + AT_BB + tid * 16) = br;
    __syncthreads();
    for (int sidx = s_first; sidx < NS; ++sidx) {
        const int buf = (sidx - s_first) & 1, t0 = 2 * sidx;
        const bool more = sidx + 1 < NS;
        if (more) { kr0 = *(const u32x4*)(kg + (size_t)(t0 + 2) * 4096); kr1 = *(const u32x4*)(kg + (size_t)(t0 + 3) * 4096); vr0 = *(const u32x4*)(vg + (t0 + 2) * 64); vr1 = *(const u32x4*)(vg + (t0 + 3) * 64);
            if (tid < 32) br = *(const f32x4*)(biasp + (t0 + 2) * 64 + tid * 4); }
        if (active) {
            const LAS unsigned char* Kb = lds + AT_KB + buf * 2 * AT_TILE;
            const LAS unsigned char* Vb = lds + AT_VB + buf * 2 * AT_TILE;
            const LAS float* Bb = (const LAS float*)(lds + AT_BB + buf * 512);
            if (t0 * 64 <= wq_hi) attn_tile(Kb, Vb, Bb, qf, o0, o1, lsum, bq, myq, t0 * 64, t0 * 64 + 63 > wq_lo, ka_off, va_off, hi);
            if ((t0 + 1) * 64 <= wq_hi) attn_tile(Kb + AT_TILE, Vb + AT_TILE, Bb + 64, qf, o0, o1, lsum, bq, myq, (t0 + 1) * 64, (t0 + 1) * 64 + 63 > wq_lo, ka_off, va_off, hi);
        }
        if (more) { const int nb = buf ^ 1;
            *(LAS u32x4*)(lds + AT_KB + nb * 2 * AT_TILE + st_off) = kr0; *(LAS u32x4*)(lds + AT_KB + nb * 2 * AT_TILE + AT_TILE + st_off) = kr1;
            *(LAS u32x4*)(lds + AT_VB + nb * 2 * AT_TILE + st_off) = vr0; *(LAS u32x4*)(lds + AT_VB + nb * 2 * AT_TILE + AT_TILE + st_off) = vr1;
            if (tid < 32) *(LAS f32x4*)(lds + AT_BB + nb * 512 + tid * 16) = br; }
        __syncthreads();
    }
    if (active) {
        lsum += bperm(lsum, lane ^ 32);
        const float inv = 1.f / lsum;
        bf16_t* orow = Orow0 + (size_t)(wave * 32 + q) * 1024 + h * 64;
#pragma unroll
        for (int i = 0; i < 4; ++i) { u32x2 w0, w1;
            w0.x = cvt_pk_bf16(o0[4 * i] * inv, o0[4 * i + 1] * inv); w0.y = cvt_pk_bf16(o0[4 * i + 2] * inv, o0[4 * i + 3] * inv);
            w1.x = cvt_pk_bf16(o1[4 * i] * inv, o1[4 * i + 1] * inv); w1.y = cvt_pk_bf16(o1[4 * i + 2] * inv, o1[4 * i + 3] * inv);
            *(u32x2*)(orow + 8 * i + 4 * hi) = w0; *(u32x2*)(orow + 32 + 8 * i + 4 * hi) = w1; }
    }
}
__device__ __forceinline__ void attn_phase(const Args& a, int l, LAS unsigned char* lds, int tid, int wave, int lane) {
    const bf16_t* Q = (const bf16_t*)(a.ws + WS_Q); bf16_t* MIX = (bf16_t*)(a.ws + WS_MIX);
    unsigned* ctr = (unsigned*)(a.ws + WS_CTL) + 3600 + 64 * l;
    volatile LAS unsigned* slot = (volatile LAS unsigned*)(lds + 131072 + 256);
    for (;;) {
        if (tid == 0) slot[0] = __hip_atomic_fetch_add(ctr, 1u, __ATOMIC_RELAXED, __HIP_MEMORY_SCOPE_AGENT);
        __syncthreads();
        const int idx = (int)slot[0];
        __syncthreads();
        if (idx >= 576) break;
        if (idx < 512) { const int qb = 15 - (idx >> 5), bh = idx & 31, b = bh >> 3, h = bh & 7; const size_t row0 = (size_t)b * 4096 + qb * 256;
            attn_unit(lds, Q + row0 * 512, h, 256, qb * 256, 4 * qb + 4, (const bf16_t*)(a.ws + WS_KP) + (size_t)bh * 4096 * 64, (const bf16_t*)(a.ws + WS_VTP) + (size_t)bh * 64 * 4096, 4096,
                      (const float*)(a.ws + WS_BIASP) + (size_t)bh * 4096, (const float*)(a.ws + WS_KMAX) + bh * 64, MIX + row0 * 1024, tid, wave, lane); }
        else { const int sidx = idx - 512, b = sidx >> 3, h = sidx & 7;
            attn_unit(lds, Q + (size_t)(NPR + b * 64) * 512, h, 64, PAST, 17, (const bf16_t*)(a.ws + WS_KS) + (size_t)sidx * KVS * 64, (const bf16_t*)(a.ws + WS_VTS) + (size_t)sidx * 64 * KVS, KVS,
                      (const float*)(a.ws + WS_BIASS) + (size_t)sidx * KVS, (const float*)(a.ws + WS_KMAX) + (32 + sidx) * 64, MIX + (size_t)(NPR + b * 64) * 1024, tid, wave, lane); }
    }
}

#define XB_TMO      128
#define XB_XCNT(j)  (256  + 64 * (j))
#define XB_XSUB(j)  (1280 + 64 * (j))
#define XB_XGEN(j)  (2304 + 64 * (j))
#define XB_TOP      3328
#define XB_TOPGEN   3392
#define XCD_BAR_WORDS 3456
#define XB_SPIN_CAP (1u << 18)
__device__ __forceinline__ unsigned xb_ld(unsigned* p)              { return __hip_atomic_load(p, __ATOMIC_RELAXED, __HIP_MEMORY_SCOPE_AGENT); }
__device__ __forceinline__ unsigned xb_add(unsigned* p, unsigned v) { return __hip_atomic_fetch_add(p, v, __ATOMIC_RELAXED, __HIP_MEMORY_SCOPE_AGENT); }
__device__ __forceinline__ unsigned xb_xcc_id() { return (unsigned)__builtin_amdgcn_s_getreg((3 << 11) | 20) & 0xFu; }
#define XB_SPIN(cond, bar) do { unsigned _sp = 0; while (cond) { __builtin_amdgcn_s_sleep(1); \
    if ((++_sp & 255u) == 0u) { if (xb_ld(&(bar)[XB_TMO])) break; if (_sp > XB_SPIN_CAP) { atomicAdd(&(bar)[XB_TMO], 1u); break; } } } } while (0)
__device__ __forceinline__ void xcd_barrier_complete(unsigned* bar, unsigned x, unsigned G, unsigned& nloc, unsigned& nx) {
    unsigned sum, cnt, mine, sp = 0u;
    for (;;) {
        sum = 0u; cnt = 0u; mine = 0u;
#pragma unroll
        for (unsigned j = 0; j < 16; ++j) { const unsigned c = xb_ld(&bar[XB_XCNT(j)]); sum += c; cnt += (c > 0u) ? 1u : 0u; mine = (j == x) ? c : mine; }
        if (sum == G) break;
        __builtin_amdgcn_s_sleep(1);
        if ((++sp & 255u) == 0u) { if (xb_ld(&bar[XB_TMO])) break; if (sp > XB_SPIN_CAP) { atomicAdd(&bar[XB_TMO], 1u); break; } }
    }
    nloc = mine > 0u ? mine : 1u; nx = cnt > 0u ? cnt : 1u;
}
__device__ __forceinline__ void xcd_barrier(unsigned* bar, volatile LAS unsigned* st, bool leader, unsigned G) {
    asm volatile("s_waitcnt vmcnt(0)" ::: "memory");
    __syncthreads();
    if (leader) {
        const unsigned x = xb_xcc_id();
        __builtin_amdgcn_s_waitcnt(0);
        unsigned nloc = st[0], nx = st[1];
        if (nloc == 0u) { xcd_barrier_complete(bar, x, G, nloc, nx); st[0] = nloc; st[1] = nx; }
        const unsigned old = xb_add(&bar[XB_XSUB(x)], 1u);
        const unsigned gen = old / nloc;
        if (old + 1u == (gen + 1u) * nloc) {
            __builtin_amdgcn_fence(__ATOMIC_RELEASE, "agent");
            asm volatile("s_waitcnt vmcnt(0)" ::: "memory");
            const unsigned og = xb_add(&bar[XB_TOP], 1u);
            const unsigned tg = og / nx;
            if (og + 1u == (tg + 1u) * nx) xb_add(&bar[XB_TOPGEN], 1u);
            else XB_SPIN(xb_ld(&bar[XB_TOPGEN]) == tg, bar);
            __builtin_amdgcn_fence(__ATOMIC_ACQUIRE, "agent");
            xb_add(&bar[XB_XGEN(x)], 1u);
            asm volatile("s_waitcnt vmcnt(0)" ::: "memory");
        } else {
            XB_SPIN(xb_ld(&bar[XB_XGEN(x)]) == gen, bar);
            __builtin_amdgcn_fence(__ATOMIC_ACQUIRE, "agent");
            asm volatile("s_waitcnt vmcnt(0)" ::: "memory");
        }
    }
    __syncthreads();
}

constexpr int NS5 = 160, CW_SUB = 3520;
__device__ __forceinline__ void sub_barrier(unsigned* ctr, unsigned target, bool leader) {
    asm volatile("s_waitcnt vmcnt(0)" ::: "memory");
    __syncthreads();
    if (leader) {
        __builtin_amdgcn_fence(__ATOMIC_RELEASE, "agent");
        asm volatile("s_waitcnt vmcnt(0)" ::: "memory");
        (void)xb_add(ctr, 1u);
        unsigned sp = 0u;
        while (xb_ld(ctr) < target) { __builtin_amdgcn_s_sleep(1); if (++sp > (1u << 22)) break; }
        __builtin_amdgcn_fence(__ATOMIC_ACQUIRE, "agent");
        asm volatile("s_waitcnt vmcnt(0)" ::: "memory");
    }
    __syncthreads();
}
#undef INP
#define INP(i) (al.in[i])
typedef const __attribute__((address_space(4))) unsigned char* kptr_t;
__device__ __forceinline__ kptr_t opq_k(kptr_t p) { asm volatile("" : "+s"(p)); return p; }
__device__ __forceinline__ Args load_args(kptr_t kp) {
    typedef const __attribute__((address_space(4))) unsigned long long* q_t; q_t q = (q_t)kp; Args r;
    typedef __attribute__((address_space(1))) const float* gcf_t; typedef __attribute__((address_space(1))) float* gf_t; typedef __attribute__((address_space(1))) unsigned char* gu8_t;
#pragma unroll
    for (int i = 0; i < 30; ++i) r.in[i] = (const float*)(gcf_t)q[i];
    r.out = (float*)(gf_t)q[30]; r.ws = (unsigned char*)(gu8_t)q[31]; return r;
}
#define FRESH() const Args al = load_args(opq_k((kptr_t)__builtin_amdgcn_kernarg_segment_ptr())); unsigned char* ws = al.ws; \
    const int G = __builtin_amdgcn_readfirstlane(opq((int)gridDim.x)); const int NGW = G * 8; (void)NGW; \
    const int wave = __builtin_amdgcn_readfirstlane(opq(wave0)); const int c = __builtin_amdgcn_readfirstlane(opq((int)blockIdx.x)); const int gw = c * 8 + wave; \
    float* MOD = (float*)(ws + WS_MOD); float* X = (float*)(ws + WS_X); bf16_t* HM = (bf16_t*)(ws + WS_HM); bf16_t* F1 = (bf16_t*)(ws + WS_F1); bf16_t* MIX = (bf16_t*)(ws + WS_MIX); \
    (void)MOD; (void)X; (void)HM; (void)F1; (void)MIX; (void)gw;
#define LAYER_BODY(l) { \
        { FRESH(); PH(5) cumsum_items(al, l, lds, tid, wave, lane, c, G); } \
        PH(6) { FRESH(); pg8::Gemm g{HM, (const bf16_t*)(ws + WS_WIN) + (size_t)l * 1536 * 1024, MT, 1536, 1024, 1024, 1024, 1 << 20, 0, 512u, (const bf16_t*)(ws + WS_WV) + (size_t)l * 512 * 1024, HM}; \
          pg8::PhaseAOrder S; S.init(G, c); \
          EpiA E{EpiIn{(bf16_t*)(ws + WS_Q), (bf16_t*)(ws + WS_KP), (bf16_t*)(ws + WS_KS), (bf16_t*)(ws + WS_UA), al.out, l}, EpiVT{(bf16_t*)(ws + WS_VTP), (bf16_t*)(ws + WS_VTS), al.out, l, lds}, EpiVtPart{(float*)(ws + WS_F1)}}; \
          pg8::gemm_phase(lds, g, S, E, wave); } \
        GSYNC(); \
        { FRESH(); kmax_items(al, lane, gw, NGW); vt_finalize(al, l, lane, gw, NGW); } \
        GSYNC(); \
        if (INS5) { \
        PH(8) { FRESH(); pg8::Gemm g{(const bf16_t*)(ws + WS_UA), (const bf16_t*)(ws + WS_BT1) + (size_t)l * 32 * 128 * 256, NG * CHP, 256, 256, UAK, 256, 5, (size_t)128 * 256, 0u}; \
          pg8::StaticOrder S; S.init(NG * CHP, 256, NS5, c); \
          EpiE E{(float*)(ws + WS_E)}; \
          pg8::gemm_phase(lds, g, S, E, wave); } \
        SUBBAR((l) * 3 + 1); \
        { FRESH(); PH(9) ssm_scan(al, l, lds, wave, lane, c, NS5); } \
        SUBBAR((l) * 3 + 2); \
        PH(10) { FRESH(); pg8::Gemm g{(const bf16_t*)(ws + WS_UA), (const bf16_t*)(ws + WS_BT3) + (size_t)l * 32 * 256 * UAK, NG * CHP, 256, UAK, UAK, UAK, 5, (size_t)256 * UAK, 0u}; \
          pg8::StaticOrder S; S.init(NG * CHP, 256, NS5, c); \
          EpiZ E{(bf16_t*)(ws + WS_Z)}; \
          pg8::gemm_phase(lds, g, S, E, wave); } \
        SUBBAR((l) * 3 + 3); \
        PH(11) { FRESH(); pg8::Gemm g{(const bf16_t*)(ws + WS_Z), (const bf16_t*)(ws + WS_WGLU) + (size_t)l * 512 * 512, MT, 512, 512, 512, 512, 1 << 20, 0, 0u}; \
          pg8::StaticOrder S; S.init(MT, 512, NS5, c); \
          EpiGlu E{(const bf16_t*)(ws + WS_Z), MIX}; \
          pg8::gemm_phase(lds, g, S, E, wave); } \
        __syncthreads(); \
        } \
        { FRESH(); PH(12) attn_phase(al, l, lds, tid, wave, lane); } \
        GSYNC(); \
        PH(13) { FRESH(); pg8::Gemm g{MIX, (const bf16_t*)(ws + WS_WOUT) + (size_t)l * 1024 * 1024, MT, 1024, 1024, 1024, 1024, 1 << 20, 0, 256u}; \
          pg8::MainSplitOrder S; S.init(G, c, 8, 2); \
          EpiMS E{EpiPlain{F1, 1024}, EpiAtomic{(float*)(ws + WS_Q)}}; \
          pg8::gemm_phase(lds, g, S, E, wave); } \
        GSYNC(); \
        { FRESH(); const float* modl = MOD + (size_t)l * 12 * 6144; \
          PH(14) rowpass<8>(INP(0), INP(1), l == 0 ? (const bf16_t*)nullptr : (const bf16_t*)X, F1, (const float*)(ws + WS_Q), 8, modl + 2 * 1024, INP(12) + l * 1024, nullptr, (bf16_t*)X, \
                INP(13) + l * 1024, modl + 4 * 1024, modl + 3 * 1024, HM, nullptr, nullptr, al.out, 0, lane, gw, NGW); } \
        GSYNC(); \
        PH(15) { FRESH(); pg8::Gemm g{HM, (const bf16_t*)(ws + WS_WGU) + (size_t)l * 5632 * 1024, MT, 5632, 1024, 1024, 1024, 1 << 20, 0, 0u}; \
          pg8::StaticOrder S; S.init(MT, 5632, G, c); \
          EpiSwi E{(bf16_t*)(ws + WS_H)}; \
          pg8::gemm_phase(lds, g, S, E, wave); } \
        { FRESH(); if ((l) + 1 < NL && c >= 172) { __syncthreads(); p0_weights(al, (l) + 1, false, lds, wave, lane, (c - 172) * 8 + wave, (G - 172) * 8); } } \
        GSYNC(); \
        PH(16) { FRESH(); pg8::Gemm g{(const bf16_t*)(ws + WS_H), (const bf16_t*)(ws + WS_WD) + (size_t)l * 1024 * DFF, MT, 1024, DFF, DFF, DFF, 1 << 20, 0, 512u}; \
          pg8::MainSplitOrder S; S.init(G, c, 11, 4); \
          EpiMS E{EpiPlain{F1, 1024}, EpiAtomic{(float*)(ws + WS_FS2)}}; \
          pg8::gemm_phase(lds, g, S, E, wave); } \
        GSYNC(); \
        if (l + 1 < NL) { \
            { FRESH(); const float* modl = MOD + (size_t)l * 12 * 6144; const float* modn = MOD + (size_t)(l + 1) * 12 * 6144; \
              PH(17) rowpass<11>(INP(0), INP(1), (const bf16_t*)X, F1, (const float*)(ws + WS_FS2), 11, modl + 5 * 1024, INP(14) + l * 1024, nullptr, (bf16_t*)X, INP(11) + (l + 1) * 1024, modn + 1024, modn, HM, \
                    (const float*)(ws + WS_WG) + (size_t)(l + 1) * 8 * 1024, INP(16) + (l + 1) * 8, al.out, l + 1, lane, gw, NGW); \
              PH(1) cache_convert(al, l + 1, lds, wave, lane, gw, NGW); } \
            GSYNC(); \
        } else { \
            FRESH(); const float* modl = MOD + (size_t)l * 12 * 6144; \
            PH(18) rowpass<11>(INP(0), INP(1), (const bf16_t*)X, F1, (const float*)(ws + WS_FS2), 11, modl + 5 * 1024, INP(14) + l * 1024, al.out, nullptr, nullptr, nullptr, nullptr, nullptr, nullptr, nullptr, al.out, 0, lane, gw, NGW); \
        } \
    }
__global__ void __launch_bounds__(512, 2) mega(Args a) {
    extern __shared__ __attribute__((aligned(16))) unsigned char lds_raw[];
    LAS unsigned char* lds = (LAS unsigned char*)lds_raw;
    cg::grid_group grid = cg::this_grid();
    const int wave0 = __builtin_amdgcn_readfirstlane((int)threadIdx.x >> 6);
#define GSYNC() do { const Args alb = load_args(opq_k((kptr_t)__builtin_amdgcn_kernarg_segment_ptr())); \
        const int ln_ = (int)__builtin_amdgcn_mbcnt_hi(~0u, __builtin_amdgcn_mbcnt_lo(~0u, (unsigned)opq(0))); \
        xcd_barrier((unsigned*)(alb.ws + WS_CTL), (volatile LAS unsigned*)(lds + LDS_MISC), wave0 == 0 && ln_ == 0, (unsigned)gridDim.x); } while (0)
#define SUBBAR(seq) do { const Args alb = load_args(opq_k((kptr_t)__builtin_amdgcn_kernarg_segment_ptr())); \
        const int ln_ = (int)__builtin_amdgcn_mbcnt_hi(~0u, __builtin_amdgcn_mbcnt_lo(~0u, (unsigned)opq(0))); \
        xcd_barrier((unsigned*)(alb.ws + WS_CTL) + 4096, (volatile LAS unsigned*)(lds + LDS_MISC + 16), wave0 == 0 && ln_ == 0, (unsigned)NS5); } while (0)
#define INS5 (__builtin_amdgcn_readfirstlane(opq((int)blockIdx.x)) < NS5)
    if (threadIdx.x < 8) ((volatile LAS unsigned*)(lds + LDS_MISC))[threadIdx.x] = 0u;
    if (threadIdx.x == 0) (void)xb_add((unsigned*)(a.ws + WS_CTL) + XB_XCNT(xb_xcc_id()), 1u);
    if (threadIdx.x == 0 && blockIdx.x < NS5) (void)xb_add((unsigned*)(a.ws + WS_CTL) + 4096 + XB_XCNT(xb_xcc_id()), 1u);
    __syncthreads();
#define lane ((int)__builtin_amdgcn_mbcnt_hi(~0u, __builtin_amdgcn_mbcnt_lo(~0u, (unsigned)opq(0))))
#define tid (wave * 64 + lane)

    { FRESH();
      PH(0) p0_weights(al, 0, true, lds, wave, lane, gw, NGW);
      PH(1) cache_convert(al, 0, lds, wave, lane, gw, NGW);
      __syncthreads();
      PH(2) p0_adaln(al, lds, tid, wave, lane, c, G);
      PH(3) p0_ssm(al, lds, tid, (c + 128) % G, G); }
    grid.sync();
    { FRESH();
      PH(4) rowpass<0>(INP(0), INP(1), nullptr, nullptr, nullptr, 0, nullptr, nullptr, nullptr, nullptr, INP(11), MOD + 1024, MOD, HM, (const float*)(ws + WS_WG), INP(16), al.out, 0, lane, gw, NGW); }
    GSYNC();

    LAYER_BODY(0)
    LAYER_BODY(1)
    LAYER_BODY(2)
    LAYER_BODY(3)
}
#undef tid
#undef lane

extern "C" void kernel_launch(void* const* d_in, const int* in_sizes, int n_in, void* d_out, int out_size, void* d_ws, size_t ws_size, hipStream_t stream) {
    static int grid = 0;
    if (grid == 0) {
        if (n_in != 30 || (size_t)out_size != O_END || ws_size < WS_END) { fprintf(stderr, "kernel_launch: unexpected sizes n_in %d out %d ws %zu\n", n_in, out_size, ws_size); grid = -1; return; }
        int dev = 0, cus = 0, per_cu = 0;
        hipGetDevice(&dev); hipDeviceGetAttribute(&cus, hipDeviceAttributeMultiprocessorCount, dev);
        hipFuncSetAttribute((const void*)mega, hipFuncAttributeMaxDynamicSharedMemorySize, LDS_BYTES);
        hipOccupancyMaxActiveBlocksPerMultiprocessor(&per_cu, (const void*)mega, 512, LDS_BYTES);
        if (per_cu < 1) { fprintf(stderr, "kernel_launch: occupancy query reports %d blocks per CU\n", per_cu); grid = -1; return; }
        if (cus != 256) { fprintf(stderr, "kernel_launch: this build's static unit orders need 256 CUs (found %d)\n", cus); grid = -1; return; }
        grid = cus;
    }
    if (grid < 0) return;
    if (hipMemsetAsync((char*)d_ws + WS_CTL, 0, CTL_BYTES, stream) != hipSuccess) { fprintf(stderr, "kernel_launch: memset failed\n"); return; }
    Args a{};
    for (int i = 0; i < 30; ++i) a.in[i] = (const float*)d_in[i];
    a.out = (float*)d_out; a.ws = (unsigned char*)d_ws;
    void* args[] = {&a};
    hipError_t e = hipLaunchCooperativeKernel((const void*)mega, dim3(grid), dim3(512), args, LDS_BYTES, stream);
    if (e != hipSuccess) fprintf(stderr, "cooperative launch failed: %s (grid %d)\n", hipGetErrorString(e), grid);
}
```

```cpp
#include <hip/hip_runtime.h>
#include <hip/hip_cooperative_groups.h>
#include <cstdio>
#include <cstdint>
namespace cg = cooperative_groups;

#define LAS __attribute__((address_space(3)))
typedef unsigned short bf16_t;
typedef short bf16x8 __attribute__((ext_vector_type(8)));
typedef float f32x4 __attribute__((ext_vector_type(4)));
typedef float f32x16 __attribute__((ext_vector_type(16)));
typedef float f32x8 __attribute__((ext_vector_type(8)));
typedef unsigned u32x4 __attribute__((ext_vector_type(4)));
typedef unsigned u32x2 __attribute__((ext_vector_type(2)));

constexpr int DM = 1024, NPR = 16384, NSM = 512, MT = 16896, NL = 4, NH = 8, HD = 64;
constexpr int SEQ = 4096, PAST = 1024, DSEQ = 64, KVS = 1088, DFF = 2816, DIN = 2056;
constexpr int NG = 32, NP = 64, MG = 16, LC = 16, NCH = MT / LC  , CHP = 1280  , UAK = 384;
constexpr float C2 = 0.125f * 1.4426950408889634f, LOG2E = 1.4426950408889634f, EPS = 1e-6f;
constexpr size_t O_YP = 0, O_KP = 17301504, O_VP = 50855936, O_LP = 84410368, O_RP = 84934656, O_IP = 84967424,
                 O_KS = 85000192, O_VS = 86048768, O_LS = 87097344, O_RS = 87113728, O_IS = 87179264, O_END = 87244800;
constexpr size_t MiB = 1u << 20;
constexpr size_t WS_CTL = 1536 * 1024, CTL_BYTES = 32768;
constexpr int LDS_MISC = 131072 + 64;
constexpr size_t WS_MOD = 0, WS_WG = 2 * MiB, WS_A16 = 2 * MiB + 256 * 1024, WS_BIASP = 3 * MiB, WS_BIASS = 3 * MiB + 512 * 1024, WS_KMAX = 2 * MiB + 384 * 1024;
constexpr size_t WS_WIN = 4 * MiB, WS_WV = 16 * MiB, WS_WGLU = 20 * MiB, WS_WOUT = 22 * MiB, WS_WGU = 30 * MiB, WS_WD = 74 * MiB;
constexpr size_t WS_BT3 = 96 * MiB, WS_BT1 = 120 * MiB, WS_HM = 130 * MiB, WS_X = 164 * MiB, WS_F1 = 230 * MiB, WS_MIX = 264 * MiB;
constexpr size_t WS_Q = 298 * MiB, WS_KP = 315 * MiB, WS_VTP = 331 * MiB, WS_KS = 347 * MiB, WS_VTS = 356 * MiB, WS_UA = 365 * MiB,
                 WS_E = 395 * MiB, WS_Z = 415 * MiB, WS_H = 298 * MiB, WS_FS1 = 435 * MiB, WS_FS2 = 443 * MiB, WS_END = 465 * MiB;
constexpr int LDS_BYTES = 151552;
#ifndef PH_MASK
#define PH_MASK 0xffffffffu
#endif
#define PH(k) if (PH_MASK & (1u << (k)))

__device__ __forceinline__ unsigned cvt_pk_bf16(float lo, float hi) { unsigned r; asm volatile("v_cvt_pk_bf16_f32 %0, %1, %2" : "=v"(r) : "v"(lo), "v"(hi)); return r; }
__device__ __forceinline__ bf16_t f2bf(float f) { return (bf16_t)(cvt_pk_bf16(f, 0.f) & 0xffffu); }
__device__ __forceinline__ float bf2f(unsigned short b) { return __uint_as_float(((unsigned)b) << 16); }
__device__ __forceinline__ int opq(int x) { asm volatile("" : "+v"(x)); return x; }
__device__ __forceinline__ float bperm(float v, int srclane) { return __int_as_float(__builtin_amdgcn_ds_bpermute(srclane << 2, __float_as_int(v))); }
__device__ __forceinline__ float dpp_f(float v, const int ctrl) { return v; }
#define DPPADD(v, ctrl) v += __int_as_float(__builtin_amdgcn_update_dpp(0, __float_as_int(v), ctrl, 0xF, 0xF, true))
__device__ __forceinline__ float wave_sum(float v, int ln) {
    (void)ln;
    DPPADD(v, 0xB1);
    DPPADD(v, 0x4E);
    DPPADD(v, 0x141);
    DPPADD(v, 0x140);
    const float r0 = __int_as_float(__builtin_amdgcn_readlane(__float_as_int(v), 0)), r1 = __int_as_float(__builtin_amdgcn_readlane(__float_as_int(v), 16));
    const float r2 = __int_as_float(__builtin_amdgcn_readlane(__float_as_int(v), 32)), r3 = __int_as_float(__builtin_amdgcn_readlane(__float_as_int(v), 48));
    return (r0 + r1) + (r2 + r3);
}
__device__ __forceinline__ float sigm(float x) { return __builtin_amdgcn_rcpf(1.f + __builtin_amdgcn_exp2f(-1.4426950408889634f * x)); }
__device__ __forceinline__ float silu_f(float x) { return x * sigm(x); }
__device__ __forceinline__ float gelu_f(float x) { const float u = 0.7978845608028654f * (x + 0.044715f * x * x * x); return x * sigm(2.f * u); }
__device__ __forceinline__ float logsig(float x) { return fminf(x, 0.f) - log1pf(__expf(-fabsf(x))); }

namespace pg8 {
constexpr int BM = 256, BK = 64, HALF = 128, HTB = HALF * BK * 2, STAGE_BYTES = 8 * HTB, NXCD = 8, WGM = 8;
__host__ __device__ __forceinline__ int lds_byte(int r, int c) { const int st = (r >> 4) * 2 + (c >> 5), rr = r & 15, cc = c & 31, ob = rr * 64 + cc * 2; return st * 1024 + (ob ^ (((ob >> 9) & 1) << 5)); }
__host__ __device__ __forceinline__ void stage_rc(int b, int& R, int& C) { const int st = b / 1024, sb = b % 1024, swz = sb ^ (((sb >> 9) & 1) << 5); R = (st >> 1) * 16 + swz / 64; C = (st & 1) * 32 + (swz % 64) / 2; }
__host__ __device__ __forceinline__ int perm32(int rho) { const int n = rho >> 4, i = rho & 15; return 8 * (i >> 2) + 4 * n + (i & 3); }
struct Unit { int pm, pn, ks, kind, nt; };
struct Gemm { const bf16_t* A; const bf16_t* Bt; int M, N, K, lda, ldb, gdiv; size_t gstrideB; unsigned kcb; const bf16_t* A1; const bf16_t* Bt1; };
struct StaticOrder {
    int nM, nN, nwg, G, c;
    __device__ __forceinline__ void init(int M, int N, int G_, int c_) { nM = M / BM; nN = N / BM; nwg = nM * nN; G = G_; c = c_; }
    __device__ __forceinline__ bool next(int i, Unit& u) const {
        const long L = (long)i * G + c; if (L >= nwg) return false;
        int wgid = (int)L; { const int q = nwg / NXCD, r = nwg % NXCD, xcd = wgid % NXCD, off = wgid / NXCD; wgid = (xcd < r ? xcd * (q + 1) : r * (q + 1) + (xcd - r) * q) + off; }
        const int nig = WGM * nN, gid = wgid / nig, fm = gid * WGM, gsz = (nM - fm) < WGM ? (nM - fm) : WGM;
        u.pm = fm + ((wgid % nig) % gsz); u.pn = (wgid % nig) / gsz; u.ks = 0; u.kind = 0; u.nt = 0; return true;
    }
};
struct SplitOrder {
    int nsub, G, c, S;
    __device__ __forceinline__ void init(int S_, int G_, int c_) { S = S_; nsub = 8 * S_; G = G_; c = c_; }
    __device__ __forceinline__ bool next(int i, Unit& u) const { const int idx = i * G + c; if (idx >= nsub) return false; u.ks = idx % S; const int t = idx / S; u.pn = t & 3; u.pm = 64 + (t >> 2); u.kind = 0; u.nt = 0; return true; }
};
struct VtOrder {
    int idx;
    __device__ __forceinline__ void init(int G_, int c_) { idx = c_ - (G_ - 116); }
    __device__ __forceinline__ bool next(int i, Unit& u) const { if (i != 0 || idx < 0 || idx >= 116) return false; u.pm = idx / 58; u.pn = idx - u.pm * 58; u.ks = 0; u.kind = 0; u.nt = 0; return true; }
};
struct VtSplitOrder {
    int c;
    __device__ __forceinline__ void init(int c_) { c = c_; }
    __device__ __forceinline__ bool next(int i, Unit& u) const { if (i != 0 || c >= 64) return false; const int tile = c >> 2; u.ks = c & 3; u.pm = tile >> 3; u.pn = 58 + (tile & 7); u.kind = 0; u.nt = 0; return true; }
};
struct PhaseAOrder {
    StaticOrder so; int c;
    __device__ __forceinline__ void init(int G_, int c_) { so.init(MT, 1536, G_, c_); c = c_; }
    __device__ __forceinline__ bool next(int i, Unit& u) const {
        Unit t = {0, 0, 0, 0, 0}; bool ok = false;
        if (i <= 1) ok = so.next(i, t);
        int pm = t.pm, pn = t.pn, ks = 0, kind = 0, nt = 0;
        if (i == 1 && !ok) { const int idx = c - 140; ok = idx >= 0 && idx < 116; pm = idx / 58; pn = idx - pm * 58; kind = 1; nt = 16; }
        if (i == 2) { ok = c < 64; const int tile = c >> 2; ks = c & 3; pm = tile >> 3; pn = 58 + (tile & 7); kind = 1; nt = 4; }
        u.pm = pm; u.pn = pn; u.ks = ks; u.kind = kind; u.nt = nt;
        return ok;
    }
};
struct MainSplitOrder {
    StaticOrder so; int c, S, nts;
    __device__ __forceinline__ void init(int G_, int c_, int S_, int nts_) { so.init(NPR, 1024, G_, c_); c = c_; S = S_; nts = nts_; }
    __device__ __forceinline__ bool next(int i, Unit& u) const {
        Unit t = {0, 0, 0, 0, 0}; bool ok = false;
        if (i == 0) ok = so.next(0, t);
        int pm = t.pm, pn = t.pn, ks = 0, nt = 0;
        if (i == 1) { ok = c < 8 * S; ks = c % S; const int tt = c / S; pn = tt & 3; pm = 64 + (tt >> 2); nt = nts; }
        u.pm = pm; u.pn = pn; u.ks = ks; u.kind = 0; u.nt = nt;
        return ok;
    }
};
template <class Epi, class Sched>
__device__ __forceinline__ void gemm_phase(LAS unsigned char* lds, const Gemm g, const Sched& S, const Epi& E, const int wave_id) {
    const int lane = (int)__builtin_amdgcn_mbcnt_hi(~0u, __builtin_amdgcn_mbcnt_lo(~0u, (unsigned)opq(0))), wid = wave_id, tid = wid * 64 + lane, wr = wid >> 2, wc = wid & 3, fr = lane & 15, fq = lane >> 4;
    unsigned voffA[2], voffB[2];
#pragma unroll
    for (int i = 0; i < 2; ++i) { int R, C; stage_rc(tid * 16 + i * 8192, R, C); const int Rb = (R & ~31) + perm32(R & 31);
        voffA[i] = (unsigned)(R * g.lda + C) * 2u; voffB[i] = (unsigned)(Rb * g.ldb + C) * 2u; }
    const unsigned kstep = (unsigned)(BK * 2);
    const unsigned hstepA = (unsigned)HALF * g.lda * 2, hstepB = (unsigned)HALF * g.ldb * 2, tstepA = 2 * hstepA, tstepB = 2 * hstepB;
    const unsigned ldsw = (unsigned)wid * 1024u;
    const int aoff = lds_byte(wr * 64 + fr, fq * 8), boff = lds_byte(wc * 32 + fr, fq * 8);
#define PG8_SA(b, h) (((b) * 2 + (h)) * HTB)
#define PG8_SB(b, h) ((4 + (b) * 2 + (h)) * HTB)
#define PG8_STAGE(bufoff, gbase, voff) do { _Pragma("unroll") for (int _i = 0; _i < 2; ++_i) \
        __builtin_amdgcn_global_load_lds((const unsigned*)((const char*)(gbase) + (voff)[_i]), (LAS unsigned*)(lds + (bufoff) + ldsw + _i * 8192), 16, 0, 0); } while (0)
#define PG8_LDA(dst, b, h) do { _Pragma("unroll") for (int m = 0; m < 4; ++m) _Pragma("unroll") for (int k = 0; k < 2; ++k) dst[m][k] = *(const LAS bf16x8*)(lds + PG8_SA(b, h) + aoff + m * 2048 + k * 1024); } while (0)
#define PG8_LDB(dst, b, h) do { _Pragma("unroll") for (int n = 0; n < 2; ++n) _Pragma("unroll") for (int k = 0; k < 2; ++k) dst[n][k] = *(const LAS bf16x8*)(lds + PG8_SB(b, h) + boff + n * 2048 + k * 1024); } while (0)
#define PG8_MMA(ai, bj, At, Bt) do { __builtin_amdgcn_s_setprio(1); _Pragma("unroll") for (int m = 0; m < 4; ++m) _Pragma("unroll") for (int n = 0; n < 2; ++n) _Pragma("unroll") for (int k = 0; k < 2; ++k) \
        acc[ai][bj][m][n] = __builtin_amdgcn_mfma_f32_16x16x32_bf16(Bt[n][k], At[m][k], acc[ai][bj][m][n], 0, 0, 0); __builtin_amdgcn_s_setprio(0); } while (0)
#define PG8_WAIT_V(n) asm volatile("s_waitcnt vmcnt(" #n ")" ::: "memory")
#define PG8_WAIT_L(n) asm volatile("s_waitcnt lgkmcnt(" #n ")" ::: "memory")
#define PG8_BAR __builtin_amdgcn_s_barrier()
#define PG8_SCHED __builtin_amdgcn_sched_barrier(0)
    Unit cur = {0, 0, 0, 0, 0}, nxt = {0, 0, 0, 0, 0}; int ui = 0;
    if (!S.next(0, cur)) return;
    f32x4 acc[2][2][4][2];
    const float zf = __int_as_float(opq(0)); const f32x4 zero4 = (f32x4){zf, zf, zf, zf};
#pragma unroll
    for (int a = 0; a < 2; ++a)
#pragma unroll
        for (int b = 0; b < 2; ++b)
#pragma unroll
            for (int m = 0; m < 4; ++m)
#pragma unroll
                for (int n = 0; n < 2; ++n) acc[a][b][m][n] = zero4;
    bf16x8 At[4][2], B0[2][2], B1[2][2];
    const char* cA = (const char*)(cur.kind ? g.A1 : g.A) + (size_t)cur.pm * tstepA + (size_t)cur.ks * g.kcb;
    const char* cB = (const char*)(cur.kind ? g.Bt1 : g.Bt) + (size_t)(cur.pm / g.gdiv) * g.gstrideB * 2 + (size_t)cur.pn * tstepB + (size_t)cur.ks * g.kcb;
    int nt = cur.nt ? cur.nt : g.K / BK;
    PG8_STAGE(PG8_SB(0, 0), cB, voffB); PG8_STAGE(PG8_SB(0, 1), cB + hstepB, voffB); PG8_STAGE(PG8_SA(0, 0), cA, voffA); PG8_STAGE(PG8_SA(0, 1), cA + hstepA, voffA);
    if (wr == 1) PG8_BAR;
    PG8_WAIT_V(2); PG8_BAR;
    PG8_STAGE(PG8_SB(1, 0), cB + kstep, voffB); PG8_STAGE(PG8_SA(1, 0), cA + kstep, voffA); PG8_STAGE(PG8_SB(1, 1), cB + hstepB + kstep, voffB);
    PG8_WAIT_V(6); PG8_BAR;
    for (;;) {
        nxt.pm = 0; nxt.pn = 0; nxt.ks = 0; nxt.kind = 0; nxt.nt = 0;
        const bool has_next = S.next(ui + 1, nxt);
        const char* nA = has_next ? (const char*)(nxt.kind ? g.A1 : g.A) + (size_t)nxt.pm * tstepA + (size_t)nxt.ks * g.kcb : cA;
        const char* nB = has_next ? (const char*)(nxt.kind ? g.Bt1 : g.Bt) + (size_t)(nxt.pm / g.gdiv) * g.gstrideB * 2 + (size_t)nxt.pn * tstepB + (size_t)nxt.ks * g.kcb : cB;
#pragma unroll 1
        for (int t = 0; t < nt; t += 2) {
            const bool last = (t == nt - 2);
            const char* a1 = cA + (unsigned)(t + 1) * kstep;
            const char* a2 = last ? nA : cA + (unsigned)(t + 2) * kstep; const char* b2 = last ? nB : cB + (unsigned)(t + 2) * kstep;
            const char* a3 = a2 + kstep; const char* b3 = b2 + kstep;
            PG8_LDB(B0, 0, 0); PG8_LDB(B1, 0, 1); PG8_SCHED; PG8_LDA(At, 0, 0); PG8_STAGE(PG8_SA(1, 1), a1 + hstepA, voffA);
            PG8_WAIT_V(8); PG8_WAIT_L(0); PG8_BAR; PG8_MMA(0, 0, At, B0); PG8_MMA(0, 1, At, B1); PG8_BAR; PG8_SCHED;
            PG8_LDA(At, 0, 1); PG8_STAGE(PG8_SB(0, 0), b2, voffB); PG8_STAGE(PG8_SB(0, 1), b2 + hstepB, voffB); PG8_STAGE(PG8_SA(0, 0), a2, voffA);
            PG8_WAIT_V(8); PG8_WAIT_L(0); PG8_BAR; PG8_MMA(1, 0, At, B0); PG8_MMA(1, 1, At, B1); PG8_BAR; PG8_SCHED;
            PG8_LDB(B0, 1, 0); PG8_LDB(B1, 1, 1); PG8_SCHED; PG8_LDA(At, 1, 0); PG8_STAGE(PG8_SA(0, 1), a2 + hstepA, voffA);
            PG8_WAIT_V(8); PG8_WAIT_L(0); PG8_BAR; PG8_MMA(0, 0, At, B0); PG8_MMA(0, 1, At, B1); PG8_BAR; PG8_SCHED;
            PG8_LDA(At, 1, 1); PG8_STAGE(PG8_SB(1, 0), b3, voffB); PG8_STAGE(PG8_SB(1, 1), b3 + hstepB, voffB); PG8_STAGE(PG8_SA(1, 0), a3, voffA);
            PG8_WAIT_V(8); PG8_WAIT_L(0); PG8_BAR; PG8_MMA(1, 0, At, B0); PG8_MMA(1, 1, At, B1); PG8_BAR; PG8_SCHED;
        }
        if (wr == 0) PG8_BAR;
        E(acc, cur, wr, wc, fr, fq);
        if (!has_next) break;
#pragma unroll
        for (int a = 0; a < 2; ++a)
#pragma unroll
            for (int b = 0; b < 2; ++b)
#pragma unroll
                for (int m = 0; m < 4; ++m)
#pragma unroll
                    for (int n = 0; n < 2; ++n) acc[a][b][m][n] = zero4;
        cur = nxt; cA = nA; cB = nB; ++ui; nt = cur.nt ? cur.nt : g.K / BK;
        if (wr == 1) PG8_BAR;
    }
    PG8_WAIT_V(0);
    PG8_BAR;
#undef PG8_SA
#undef PG8_SB
#undef PG8_STAGE
#undef PG8_LDA
#undef PG8_LDB
#undef PG8_MMA
#undef PG8_WAIT_V
#undef PG8_WAIT_L
#undef PG8_BAR
#undef PG8_SCHED
}
}
using pg8::Unit;
typedef const f32x4 (&AccRef)[2][2][4][2];
__device__ __forceinline__ u32x4 pack8(f32x4 v0, f32x4 v1) { u32x4 w; w.x = cvt_pk_bf16(v0[0], v0[1]); w.y = cvt_pk_bf16(v0[2], v0[3]); w.z = cvt_pk_bf16(v1[0], v1[1]); w.w = cvt_pk_bf16(v1[2], v1[3]); return w; }

struct EpiPlain {
    bf16_t* O; int ldc;
    __device__ __forceinline__ void operator()(AccRef acc, const Unit& u, int wr, int wc, int fr, int fq) const {
        fr = opq(fr); fq = opq(fq);
#pragma unroll
        for (int ai = 0; ai < 2; ++ai)
#pragma unroll
            for (int m = 0; m < 4; ++m) { const int r = u.pm * 256 + ai * 128 + wr * 64 + m * 16 + fr;
#pragma unroll
                for (int bj = 0; bj < 2; ++bj) { const int c = u.pn * 256 + bj * 128 + wc * 32 + 8 * fq;
                    *(u32x4*)(O + (size_t)r * ldc + c) = pack8(acc[ai][bj][m][0], acc[ai][bj][m][1]); } }
    }
};
struct EpiIn {
    bf16_t *Q, *KP, *KS, *UA; float* out; int l;
    __device__ __forceinline__ void operator()(AccRef acc, const Unit& u, int wr, int wc, int fr, int fq) const {
        fr = opq(fr); fq = opq(fq);
        const bool prompt = u.pm < 64;
#pragma unroll
        for (int ai = 0; ai < 2; ++ai)
#pragma unroll
            for (int m = 0; m < 4; ++m) { const int r = u.pm * 256 + ai * 128 + wr * 64 + m * 16 + fr;
#pragma unroll
                for (int bj = 0; bj < 2; ++bj) { const int c = u.pn * 256 + bj * 128 + wc * 32 + 8 * fq;
                    const f32x4 v0 = acc[ai][bj][m][0], v1 = acc[ai][bj][m][1];
                    if (u.pn < 2) { *(u32x4*)(Q + (size_t)r * 512 + c) = pack8(v0 * C2, v1 * C2); }
                    else if (u.pn < 4) { const int ck = c - 512, h = ck >> 6, d = ck & 63; const u32x4 w = pack8(v0, v1);
                        if (prompt) { const int b = r >> 12, t = r & 4095;
                            *(u32x4*)(KP + ((size_t)(b * 8 + h) * 4096 + t) * 64 + d) = w;
                            float* o = out + O_KP + ((size_t)((l * 4 + b) * 8 + h) * 4096 + t) * 64 + d; __builtin_nontemporal_store(v0, (f32x4*)o); __builtin_nontemporal_store(v1, (f32x4*)(o + 4)); }
                        else { const int rr = r - NPR, b = rr >> 6, t = rr & 63;
                            *(u32x4*)(KS + ((size_t)(b * 8 + h) * KVS + PAST + t) * 64 + d) = w;
                            float* o = out + O_KS + ((size_t)((l * 8 + b) * 8 + h) * 64 + t) * 64 + d; __builtin_nontemporal_store(v0, (f32x4*)o); __builtin_nontemporal_store(v1, (f32x4*)(o + 4)); } }
                    else { const int cu = c - 1024, gq = cu >> 4, m0 = cu & 15, chunk = r >> 4, s = r & 15;
                        *(u32x4*)(UA + ((size_t)gq * CHP + chunk) * UAK + s * 16 + m0) = pack8(v0, v1); }
                    asm volatile("" ::: "memory"); } }
    }
};
struct EpiVT {
    bf16_t *VTP, *VTS; float* out; int l; LAS unsigned char* lds;
    __device__ __forceinline__ void operator()(AccRef acc, const Unit& u, int wr, int wc, int fr, int fq) const {
        fr = opq(fr); fq = opq(fq);
        const bool prompt = u.pn < 64; const int ln = fq * 16 + fr;
        LAS float* stg = (LAS float*)(lds + 131072 + 1024 + (wr * 4 + wc) * 2080);
#pragma unroll
        for (int ai = 0; ai < 2; ++ai)
#pragma unroll
            for (int bj = 0; bj < 2; ++bj) {
                const int h = (u.pm * 256 + ai * 128 + wr * 64) >> 6, tok0 = u.pn * 256 + bj * 128 + wc * 32;
                float* obase; bf16_t* vbase; size_t vpitch;
                if (prompt) { const int b = tok0 >> 12, t0 = tok0 & 4095; obase = out + O_VP + ((size_t)((l * 4 + b) * 8 + h) * 4096 + t0) * 64; vbase = VTP + (size_t)(b * 8 + h) * 64 * 4096 + t0; vpitch = 4096; }
                else { const int tt = tok0 - NPR, b = tt >> 6, t0 = tt & 63; obase = out + O_VS + ((size_t)((l * 8 + b) * 8 + h) * 64 + t0) * 64; vbase = VTS + (size_t)(b * 8 + h) * 64 * KVS + PAST + t0; vpitch = KVS; }
#pragma unroll
                for (int m = 0; m < 4; ++m) *(u32x4*)(vbase + (size_t)(m * 16 + fr) * vpitch + 8 * fq) = pack8(acc[ai][bj][m][0], acc[ai][bj][m][1]);
#pragma unroll
                for (int n = 0; n < 2; ++n)
#pragma unroll
                    for (int j0 = 0; j0 < 4; j0 += 2) {
#pragma unroll
                        for (int m = 0; m < 4; ++m) { stg[(2 * fq) * 65 + 16 * m + fr] = acc[ai][bj][m][n][j0]; stg[(2 * fq + 1) * 65 + 16 * m + fr] = acc[ai][bj][m][n][j0 + 1]; }
                        asm volatile("s_waitcnt lgkmcnt(0)" ::: "memory");
#pragma unroll
                        for (int sl = 0; sl < 8; ++sl) { const float v = stg[sl * 65 + ln]; __builtin_nontemporal_store(v, obase + (size_t)(8 * (sl >> 1) + 4 * n + j0 + (sl & 1)) * 64 + ln); }
                        asm volatile("s_waitcnt lgkmcnt(0)" ::: "memory");
                    }
            }
    }
};
struct EpiVtPart {
    float* PV;
    __device__ __forceinline__ void operator()(AccRef acc, const Unit& u, int wr, int wc, int fr, int fq) const {
        fr = opq(fr); fq = opq(fq);
        float* base = PV + (size_t)((u.pm * 8 + (u.pn - 58)) * 4 + u.ks) * 65536;
#pragma unroll
        for (int ai = 0; ai < 2; ++ai)
#pragma unroll
            for (int m = 0; m < 4; ++m) { const int r = ai * 128 + wr * 64 + m * 16 + fr;
#pragma unroll
                for (int bj = 0; bj < 2; ++bj) { float* o = base + r * 256 + bj * 128 + wc * 32 + 8 * fq; *(f32x4*)o = acc[ai][bj][m][0]; *(f32x4*)(o + 4) = acc[ai][bj][m][1]; } }
    }
};
struct EpiE {
    float* E;
    __device__ __forceinline__ void operator()(AccRef acc, const Unit& u, int wr, int wc, int fr, int fq) const {
        fr = opq(fr); fq = opq(fq);
#pragma unroll
        for (int ai = 0; ai < 2; ++ai)
#pragma unroll
            for (int m = 0; m < 4; ++m) { const int gq = u.pm / 5, chunk = (u.pm - gq * 5) * 256 + ai * 128 + wr * 64 + m * 16 + fr;
                { float* o = E + ((size_t)gq * CHP + chunk) * 128 + wc * 32 + 8 * fq; *(f32x4*)o = acc[ai][0][m][0]; *(f32x4*)(o + 4) = acc[ai][0][m][1]; } }
    }
};
struct EpiZ {
    bf16_t* Z;
    __device__ __forceinline__ void operator()(AccRef acc, const Unit& u, int wr, int wc, int fr, int fq) const {
        fr = opq(fr); fq = opq(fq);
#pragma unroll
        for (int ai = 0; ai < 2; ++ai)
#pragma unroll
            for (int m = 0; m < 4; ++m) { const int gq = u.pm / 5, chunk = (u.pm - gq * 5) * 256 + ai * 128 + wr * 64 + m * 16 + fr;
                {
#pragma unroll
                    for (int bj = 0; bj < 2; ++bj) { const int n = bj * 128 + wc * 32 + 8 * fq, t = n >> 4, m0 = n & 15;
                        f32x4 v0 = acc[ai][bj][m][0], v1 = acc[ai][bj][m][1];
#pragma unroll
                        for (int j = 0; j < 4; ++j) { v0[j] = gelu_f(v0[j]); v1[j] = gelu_f(v1[j]); }
                        *(u32x4*)(Z + (size_t)(chunk * 16 + t) * 512 + gq * 16 + m0) = pack8(v0, v1); __builtin_amdgcn_sched_barrier(0); } } }
    }
};
struct EpiGlu {
    const bf16_t* Z; bf16_t* MIX;
    __device__ __forceinline__ void operator()(AccRef acc, const Unit& u, int wr, int wc, int fr, int fq) const {
        fr = opq(fr); fq = opq(fq);
#pragma unroll
        for (int ai = 0; ai < 2; ++ai)
#pragma unroll
            for (int m = 0; m < 4; ++m) { const int r = u.pm * 256 + ai * 128 + wr * 64 + m * 16 + fr;
#pragma unroll
                for (int bj = 0; bj < 2; ++bj) { const int c = u.pn * 256 + bj * 128 + wc * 32 + 8 * fq;
                    const u32x4 zz = *(const u32x4*)(Z + (size_t)r * 512 + c);
                    f32x4 v0 = acc[ai][bj][m][0], v1 = acc[ai][bj][m][1];
#pragma unroll
                    for (int j = 0; j < 4; ++j) { const unsigned w0 = zz[j >> 1], w1 = zz[2 + (j >> 1)];
                        const float z0 = (j & 1) ? __uint_as_float(w0 & 0xffff0000u) : __uint_as_float(w0 << 16);
                        const float z1 = (j & 1) ? __uint_as_float(w1 & 0xffff0000u) : __uint_as_float(w1 << 16);
                        v0[j] = z0 * sigm(v0[j]); v1[j] = z1 * sigm(v1[j]); }
                    *(u32x4*)(MIX + (size_t)r * 1024 + 512 + c) = pack8(v0, v1); } }
    }
};
struct EpiAtomic {
    float* FS;
    __device__ __forceinline__ void operator()(AccRef acc, const Unit& u, int wr, int wc, int fr, int fq) const {
        fr = opq(fr); fq = opq(fq);
#pragma unroll
        for (int ai = 0; ai < 2; ++ai)
#pragma unroll
            for (int m = 0; m < 4; ++m) { const int r = (u.pm - 64) * 256 + ai * 128 + wr * 64 + m * 16 + fr;
#pragma unroll
                for (int bj = 0; bj < 2; ++bj) { float* o = FS + ((size_t)u.ks * 512 + r) * 1024 + u.pn * 256 + bj * 128 + wc * 32 + 8 * fq;
                    *(f32x4*)o = acc[ai][bj][m][0]; *(f32x4*)(o + 4) = acc[ai][bj][m][1]; } }
    }
};
struct EpiSwi {
    bf16_t* H;
    __device__ __forceinline__ void operator()(AccRef acc, const Unit& u, int wr, int wc, int fr, int fq) const {
        fr = opq(fr); fq = opq(fq);
#pragma unroll
        for (int ai = 0; ai < 2; ++ai)
#pragma unroll
            for (int m = 0; m < 4; ++m) { const int r = u.pm * 256 + ai * 128 + wr * 64 + m * 16 + fr; const int c = u.pn * 128 + wc * 32 + 8 * fq;
                f32x4 v0 = acc[ai][0][m][0], v1 = acc[ai][0][m][1]; const f32x4 u0 = acc[ai][1][m][0], u1 = acc[ai][1][m][1];
#pragma unroll
                for (int j = 0; j < 4; ++j) { v0[j] = silu_f(v0[j]) * u0[j]; v1[j] = silu_f(v1[j]) * u1[j]; }
                *(u32x4*)(H + (size_t)r * DFF + c) = pack8(v0, v1); }
    }
};

struct EpiA {
    EpiIn in; EpiVT vt; EpiVtPart vp;
    __device__ __forceinline__ void operator()(AccRef acc, const Unit& u, int wr, int wc, int fr, int fq) const {
        if (u.kind == 0) in(acc, u, wr, wc, fr, fq); else if (u.nt == 16) vt(acc, u, wr, wc, fr, fq); else vp(acc, u, wr, wc, fr, fq);
    }
};
struct EpiMS {
    EpiPlain p; EpiAtomic q;
    __device__ __forceinline__ void operator()(AccRef acc, const Unit& u, int wr, int wc, int fr, int fq) const {
        if (u.pm < 64) p(acc, u, wr, wc, fr, fq); else q(acc, u, wr, wc, fr, fq);
    }
};
struct Args { const float* in[30]; float* out; unsigned char* ws; };
struct Ctx {
    LAS unsigned char* lds; int tid, lane, wave, G, c;
    const float* const* in; float* out; unsigned char* ws;
};
#define INP(i) (a.in[i])

__device__ __forceinline__ void tr_item(const float* W, size_t ldw, int k0, int sc0, bf16_t* WT, size_t ldo, int dr0, LAS float* scr, int lane) {
    f32x4 tv[8];
#pragma unroll
    for (int i = 0; i < 8; ++i) { const int kk = 8 * i + (lane >> 3); tv[i] = __builtin_nontemporal_load((const f32x4*)(W + (size_t)(k0 + kk) * ldw + sc0 + 4 * (lane & 7))); }
#pragma unroll
    for (int i = 0; i < 8; ++i) { const int kk = 8 * i + (lane >> 3); LAS float* d = scr + kk * 33 + 4 * (lane & 7); d[0] = tv[i][0]; d[1] = tv[i][1]; d[2] = tv[i][2]; d[3] = tv[i][3]; }
    asm volatile("s_waitcnt lgkmcnt(0)" ::: "memory");
    const int c = lane & 7;
#pragma unroll
    for (int j = 0; j < 4; ++j) { const int n = (lane >> 3) + 8 * j; const LAS float* s = scr + (8 * c) * 33 + n;
        u32x4 o; o.x = cvt_pk_bf16(s[0 * 33], s[1 * 33]); o.y = cvt_pk_bf16(s[2 * 33], s[3 * 33]); o.z = cvt_pk_bf16(s[4 * 33], s[5 * 33]); o.w = cvt_pk_bf16(s[6 * 33], s[7 * 33]);
        *(u32x4*)(WT + (size_t)(dr0 + n) * ldo + k0 + 8 * c) = o; }
    asm volatile("s_waitcnt lgkmcnt(0)" ::: "memory");
}

__device__ __forceinline__ void sincos_d(double x, double& s, double& c) {
    const double k = rint(x * 0.63661977236758134308);
    const double r = (x - k * 1.57079632679489655800) - k * 6.123233995736766036e-17;
    const double r2 = r * r;
    double sp = 1.0 / 6227020800.0; sp = sp * r2 - 1.0 / 39916800.0; sp = sp * r2 + 1.0 / 362880.0; sp = sp * r2 - 1.0 / 5040.0; sp = sp * r2 + 1.0 / 120.0; sp = sp * r2 - 1.0 / 6.0; sp = sp * r2 + 1.0;
    const double sr = r * sp;
    double cp = 1.0 / 87178291200.0; cp = cp * r2 - 1.0 / 479001600.0; cp = cp * r2 + 1.0 / 3628800.0; cp = cp * r2 - 1.0 / 40320.0; cp = cp * r2 + 1.0 / 720.0; cp = cp * r2 - 1.0 / 24.0; cp = cp * r2 + 0.5;
    const double cr = 1.0 - r2 * cp;
    const int q = ((int)k) & 3;
    s = (q == 0) ? sr : (q == 1) ? cr : (q == 2) ? -sr : -cr;
    c = (q == 0) ? cr : (q == 1) ? -sr : (q == 2) ? -cr : sr;
}

__device__ __forceinline__ void p0_weights(const Args& a, int lw, bool do_wg, LAS unsigned char* lds, int wave, int lane, int gw, int NGW) {
    LAS float* scr = (LAS float*)(lds + wave * 16384);
    constexpr int I_IN = 16 * 16, I_GLU = 8 * 16, I_OUT = 16 * 32, I_G = 16 * 88, I_D = 44 * 32;
    constexpr int PER_L = 4 * I_IN + I_GLU + I_OUT + 2 * I_G + I_D;
    for (int it = gw; it < PER_L; it += NGW) {
        const int l = lw; int r = it;
        const float* win = INP(15) + (size_t)l * DM * DIN;
        bf16_t* WIN = (bf16_t*)(a.ws + WS_WIN) + (size_t)l * 1536 * 1024;
        if (r < 4 * I_IN) { const int part = r / I_IN, rr = r % I_IN, kb = rr / 16, nb = rr % 16;
            if (part == 0) tr_item(win, DIN, 64 * kb, 32 * nb, WIN, 1024, 32 * nb, scr, lane);
            else if (part == 1) tr_item(win, DIN, 64 * kb, 512 + 32 * nb, WIN, 1024, 512 + 32 * nb, scr, lane);
            else if (part == 2) tr_item(win, DIN, 64 * kb, 1544 + 32 * nb, WIN, 1024, 1024 + 32 * nb, scr, lane);
            else tr_item(win, DIN, 64 * kb, 1024 + 32 * nb, (bf16_t*)(a.ws + WS_WV) + (size_t)l * 512 * 1024, 1024, 32 * nb, scr, lane);
            continue; }
        r -= 4 * I_IN;
        if (r < I_GLU) { tr_item(INP(25) + (size_t)l * 512 * 512, 512, 64 * (r / 16), 32 * (r % 16), (bf16_t*)(a.ws + WS_WGLU) + (size_t)l * 512 * 512, 512, 32 * (r % 16), scr, lane); continue; }
        r -= I_GLU;
        if (r < I_OUT) { tr_item(INP(26) + (size_t)l * 1024 * 1024, 1024, 64 * (r / 32), 32 * (r % 32), (bf16_t*)(a.ws + WS_WOUT) + (size_t)l * 1024 * 1024, 1024, 32 * (r % 32), scr, lane); continue; }
        r -= I_OUT;
        if (r < 2 * I_G) { const int up = r / I_G, rr = r % I_G, kb = rr / 88, nb = rr % 88, c0 = 32 * nb;
            tr_item(INP(27 + up) + (size_t)l * DM * DFF, DFF, 64 * kb, c0, (bf16_t*)(a.ws + WS_WGU) + (size_t)l * 5632 * 1024, 1024, (c0 >> 7) * 256 + up * 128 + (c0 & 127), scr, lane);
            continue; }
        r -= 2 * I_G;
        tr_item(INP(29) + (size_t)l * DFF * DM, DM, 64 * (r / 32), 32 * (r % 32), (bf16_t*)(a.ws + WS_WD) + (size_t)l * 1024 * DFF, DFF, 32 * (r % 32), scr, lane);
    }
    float* WG = (float*)(a.ws + WS_WG);
    if (do_wg) for (int i = gw * 64 + lane; i < NL * 8 * 1024; i += NGW * 64) { const int l = i >> 13, h = (i >> 10) & 7, k = i & 1023; WG[i] = INP(15)[((size_t)l * DM + k) * DIN + 1536 + h]; }
}
__device__ __forceinline__ void p0_adaln(const Args& a, LAS unsigned char* lds, int tid, int wave, int lane, int c, int G) {
    LAS float* sc = (LAS float*)(lds);
    LAS float* red = (LAS float*)(lds + 49152);
    for (int i = tid; i < 12 * 1024; i += 512) { const float v = (i < 4096) ? INP(2)[i] : INP(3)[i - 4096]; sc[i] = silu_f(v); }
    __syncthreads();
    float* MOD = (float*)(a.ws + WS_MOD);
    for (int it = c; it < NL * 96; it += G) {
        const int l = it / 96, n0 = (it % 96) * 64;
        const float* W = INP(9) + (size_t)l * DM * 6144 + n0 + lane;
        float acc[12];
#pragma unroll
        for (int b = 0; b < 12; ++b) acc[b] = 0.f;
        for (int k = wave * 128; k < wave * 128 + 128; k += 16) {
            float w[16];
#pragma unroll
            for (int j = 0; j < 16; ++j) w[j] = __builtin_nontemporal_load(W + (size_t)(k + j) * 6144);
#pragma unroll
            for (int j = 0; j < 16; ++j)
#pragma unroll
                for (int b = 0; b < 12; ++b) acc[b] += sc[b * 1024 + k + j] * w[j];
        }
#pragma unroll
        for (int b = 0; b < 12; ++b) red[(wave * 12 + b) * 64 + lane] = acc[b];
        __syncthreads();
        for (int i = tid; i < 768; i += 512) { const int b = i >> 6, cc = i & 63; float s = 0.f;
#pragma unroll
            for (int w = 0; w < 8; ++w) s += red[(w * 12 + b) * 64 + cc];
            MOD[((size_t)l * 12 + b) * 6144 + n0 + cc] = s + INP(10)[(size_t)l * 6144 + n0 + cc]; }
        __syncthreads();
    }
}
__device__ __forceinline__ void p0_ssm(const Args& a, LAS unsigned char* lds, int tid, int c, int G) {
    LAS float* ap_re = (LAS float*)(lds + 65536);
    LAS float* ap_im = ap_re + 17 * 64;
    LAS float* bb_re = ap_im + 17 * 64;
    LAS float* bb_im = bb_re + 1024;
    LAS float* cc_re = bb_im + 1024;
    LAS float* cc_im = cc_re + 1024;
    LAS float* ktab = cc_im + 1024;
    for (int it = c; it < NL * NG; it += G) {
        const int l = it >> 5, gq = it & 31;
        const double dt = exp((double)INP(19)[l * 32 + gq]);
        for (int idx = tid; idx < 17 * 64; idx += 512) { const int d = idx >> 6, p = idx & 63;
            const double ar = (double)INP(17)[(l * 32 + gq) * 64 + p], ai = (double)INP(18)[(l * 32 + gq) * 64 + p];
            double s, co; sincos_d((double)d * ai * dt, s, co); const double er = exp((double)d * ar * dt);
            ap_re[idx] = (float)(er * co); ap_im[idx] = (float)(er * s); }
        for (int idx = tid; idx < 1024; idx += 512) { const int p = idx >> 4, m = idx & 15;
            const double ar = (double)INP(17)[(l * 32 + gq) * 64 + p], ai = (double)INP(18)[(l * 32 + gq) * 64 + p];
            double s, co; sincos_d(ai * dt, s, co); const double er = exp(ar * dt);
            const double xr = er * co - 1.0, xi = er * s, den = 1.0 / (ar * ar + ai * ai);
            const double qr = (xr * ar + xi * ai) * den, qi = (xi * ar - xr * ai) * den;
            const double br = (double)INP(20)[((size_t)(l * 32 + gq) * 64 + p) * 16 + m], bi = (double)INP(21)[((size_t)(l * 32 + gq) * 64 + p) * 16 + m];
            bb_re[idx] = (float)(qr * br - qi * bi); bb_im[idx] = (float)(qr * bi + qi * br);
            cc_re[idx] = INP(22)[(size_t)(l * 32 + gq) * 1024 + idx]; cc_im[idx] = INP(23)[(size_t)(l * 32 + gq) * 1024 + idx]; }
        __syncthreads();
        { const int d = tid >> 5, m = (tid >> 1) & 15, half = tid & 1;
          float acc8[8];
#pragma unroll
          for (int j = 0; j < 8; ++j) acc8[j] = 0.f;
          for (int p = 0; p < 64; ++p) { const float cr = cc_re[m * 64 + p], ci = cc_im[m * 64 + p], pr = ap_re[d * 64 + p], pi = ap_im[d * 64 + p];
              const float re = cr * pr - ci * pi, im = cr * pi + ci * pr;
              const f32x4 br0 = *(const LAS f32x4*)(bb_re + p * 16 + 8 * half), br1 = *(const LAS f32x4*)(bb_re + p * 16 + 8 * half + 4);
              const f32x4 bi0 = *(const LAS f32x4*)(bb_im + p * 16 + 8 * half), bi1 = *(const LAS f32x4*)(bb_im + p * 16 + 8 * half + 4);
#pragma unroll
              for (int j = 0; j < 4; ++j) { acc8[j] += re * br0[j] - im * bi0[j]; acc8[4 + j] += re * br1[j] - im * bi1[j]; } }
#pragma unroll
          for (int j = 0; j < 8; ++j) { const int m2 = 8 * half + j; float v = acc8[j];
              if (d == 0 && m == m2) v += INP(24)[l * 512 + gq * 16 + m];
              ktab[(d * 16 + m) * 16 + m2] = v; } }
        __syncthreads();
        bf16_t* BT3 = (bf16_t*)(a.ws + WS_BT3) + (size_t)(l * 32 + gq) * 256 * UAK;
        for (int grp = tid; grp < 256 * 48; grp += 512) { const int n = grp / 48, k0 = (grp % 48) * 8, t = n >> 4, m = n & 15; float v[8];
            if (k0 < 256) { const int s = k0 >> 4, m20 = k0 & 15;
#pragma unroll
                for (int j = 0; j < 8; ++j) v[j] = (s <= t) ? ktab[((t - s) * 16 + m) * 16 + m20 + j] : 0.f; }
            else { const int kk = k0 - 256, ri = kk >> 6, p0 = kk & 63;
#pragma unroll
                for (int j = 0; j < 8; ++j) { const int p = p0 + j; const float cr = cc_re[m * 64 + p], ci = cc_im[m * 64 + p], pr = ap_re[(t + 1) * 64 + p], pi = ap_im[(t + 1) * 64 + p];
                    v[j] = ri ? -(cr * pi + ci * pr) : (cr * pr - ci * pi); } }
            u32x4 w; w.x = cvt_pk_bf16(v[0], v[1]); w.y = cvt_pk_bf16(v[2], v[3]); w.z = cvt_pk_bf16(v[4], v[5]); w.w = cvt_pk_bf16(v[6], v[7]);
            *(u32x4*)(BT3 + (size_t)n * UAK + k0) = w; }
        bf16_t* BT1 = (bf16_t*)(a.ws + WS_BT1) + (size_t)(l * 32 + gq) * 128 * 256;
        for (int grp = tid; grp < 128 * 32; grp += 512) { const int n = grp >> 5, k0 = (grp & 31) * 8, s = k0 >> 4, m0 = k0 & 15, ri = n >> 6, p = n & 63; float v[8];
            const float pr = ap_re[(15 - s) * 64 + p], pi = ap_im[(15 - s) * 64 + p];
#pragma unroll
            for (int j = 0; j < 8; ++j) { const float br = bb_re[p * 16 + m0 + j], bi = bb_im[p * 16 + m0 + j]; v[j] = ri ? (pr * bi + pi * br) : (pr * br - pi * bi); }
            u32x4 w; w.x = cvt_pk_bf16(v[0], v[1]); w.y = cvt_pk_bf16(v[2], v[3]); w.z = cvt_pk_bf16(v[4], v[5]); w.w = cvt_pk_bf16(v[6], v[7]);
            *(u32x4*)(BT1 + (size_t)n * 256 + k0) = w; }
        if (tid < 64) { float* A16 = (float*)(a.ws + WS_A16) + (size_t)(l * 32 + gq) * 128; A16[tid] = ap_re[16 * 64 + tid]; A16[64 + tid] = ap_im[16 * 64 + tid]; }
        __syncthreads();
    }
}

__device__ __forceinline__ void cache_convert(const Args& a, int l, LAS unsigned char* lds, int wave, int lane, int gw, int NGW) {
    bf16_t* KS = (bf16_t*)(a.ws + WS_KS); bf16_t* VTS = (bf16_t*)(a.ws + WS_VTS);
    const float* ck = INP(4) + (size_t)l * 64 * PAST * 64; const float* cv = INP(5) + (size_t)l * 64 * PAST * 64;
    for (int i = gw * 64 + lane; i < 64 * PAST * 8; i += NGW * 64) {
        const int bh = i >> 13, rem = i & 8191;
        const f32x4 v0 = __builtin_nontemporal_load((const f32x4*)(ck + (size_t)i * 8)), v1 = __builtin_nontemporal_load((const f32x4*)(ck + (size_t)i * 8 + 4));
        *(u32x4*)(KS + (size_t)bh * KVS * 64 + (size_t)rem * 8) = pack8(v0, v1); }
    LAS float* scr = (LAS float*)(lds + wave * 16384);
    for (int it = gw; it < 64 * 32; it += NGW) { const int bh = it >> 5, r = it & 31, kb = r >> 1, nb = r & 1;
        tr_item(cv + (size_t)bh * PAST * 64, 64, 64 * kb, 32 * nb, VTS + (size_t)bh * 64 * KVS, KVS, 32 * nb, scr, lane); }
}

template <int NSPLIT>
__device__ __forceinline__ void rowpass(const float* xsrc_p, const float* xsrc_s, const bf16_t* xsrc_b, const bf16_t* Fb, const float* FS, int nsplit, const float* gate, const float* wpost, float* xdst, bf16_t* xdst_b,
                                        const float* wpre, const float* sc, const float* sh, bf16_t* HMb, const float* WGl, const float* bfor, float* out, int lnext,
                                        int lane, int gw, int NGW) {
    f32x4 wg[8][4];
    if (WGl) {
#pragma unroll
        for (int h = 0; h < 8; ++h)
#pragma unroll
            for (int j = 0; j < 4; ++j) wg[h][j] = *(const f32x4*)(WGl + h * 1024 + 4 * lane + 256 * j);
    }
#define LOADX(dst, rr, xr, j) do { if (xsrc_b) { const u32x2 w_ = __builtin_nontemporal_load((const u32x2*)(xsrc_b + (size_t)(rr) * DM + 4 * lane + 256 * (j))); \
        dst = (f32x4){__uint_as_float(w_.x << 16), __uint_as_float(w_.x & 0xffff0000u), __uint_as_float(w_.y << 16), __uint_as_float(w_.y & 0xffff0000u)}; } \
        else dst = __builtin_nontemporal_load((const f32x4*)((xr) + 4 * lane + 256 * (j))); } while (0)
    for (int r = gw; r < MT; r += NGW) {
        const bool prompt = r < NPR; const int bm = prompt ? (r >> 12) : 4 + ((r - NPR) >> 6);
        f32x4 x[4]; u32x2 fw[4];
        { const float* xr = prompt ? xsrc_p + (size_t)r * DM : xsrc_s + (size_t)(r - NPR) * DM;
#pragma unroll
          for (int j = 0; j < 4; ++j) { LOADX(x[j], r, xr, j); fw[j] = (Fb && prompt) ? __builtin_nontemporal_load((const u32x2*)(Fb + (size_t)r * DM + 4 * lane + 256 * j)) : (u32x2){0u, 0u}; } }
        if (Fb) {
            f32x4 f[4]; float ss = 0.f;
#pragma unroll
            for (int j = 0; j < 4; ++j) {
                if (prompt) { const u32x2 w = fw[j];
                    f[j] = (f32x4){__uint_as_float(w.x << 16), __uint_as_float(w.x & 0xffff0000u), __uint_as_float(w.y << 16), __uint_as_float(w.y & 0xffff0000u)}; }
                else { const float* fp = FS + (size_t)(r - NPR) * DM + 4 * lane + 256 * j; f32x4 part[NSPLIT > 0 ? NSPLIT : 1];
#pragma unroll
                    for (int sp = 0; sp < NSPLIT; ++sp) part[sp] = *(const f32x4*)(fp + (size_t)sp * 512 * 1024);
                    f32x4 sacc = part[0];
#pragma unroll
                    for (int sp = 1; sp < NSPLIT; ++sp) sacc = sacc + part[sp];
                    f[j] = sacc; }
                ss += (f[j][0] * f[j][0] + f[j][1] * f[j][1]) + (f[j][2] * f[j][2] + f[j][3] * f[j][3]); }
            const float rstd = rsqrtf(wave_sum(ss, lane) * (1.f / DM) + EPS);
#pragma unroll
            for (int j = 0; j < 4; ++j) { const f32x4 gt = *(const f32x4*)(gate + (size_t)bm * 6144 + 4 * lane + 256 * j), wp = *(const f32x4*)(wpost + 4 * lane + 256 * j);
                x[j] = x[j] + gt * (f[j] * rstd * wp); }
        }
        if (xdst) {
#pragma unroll
            for (int j = 0; j < 4; ++j) __builtin_nontemporal_store(x[j], (f32x4*)(xdst + (size_t)r * DM + 4 * lane + 256 * j));
        }
        if (xdst_b) {
#pragma unroll
            for (int j = 0; j < 4; ++j) { u32x2 w; w.x = cvt_pk_bf16(x[j][0], x[j][1]); w.y = cvt_pk_bf16(x[j][2], x[j][3]); __builtin_nontemporal_store(w, (u32x2*)(xdst_b + (size_t)r * DM + 4 * lane + 256 * j));
                x[j] = (f32x4){__uint_as_float(w.x << 16), __uint_as_float(w.x & 0xffff0000u), __uint_as_float(w.y << 16), __uint_as_float(w.y & 0xffff0000u)}; }
        }
        if (wpre) {
            float ss = 0.f;
#pragma unroll
            for (int j = 0; j < 4; ++j) ss += (x[j][0] * x[j][0] + x[j][1] * x[j][1]) + (x[j][2] * x[j][2] + x[j][3] * x[j][3]);
            const float rstd = rsqrtf(wave_sum(ss, lane) * (1.f / DM) + EPS);
            f32x4 hm[4];
#pragma unroll
            for (int j = 0; j < 4; ++j) { const int cidx = 4 * lane + 256 * j;
                const f32x4 wv = *(const f32x4*)(wpre + cidx), s1 = *(const f32x4*)(sc + (size_t)bm * 6144 + cidx), s0 = *(const f32x4*)(sh + (size_t)bm * 6144 + cidx);
                hm[j] = (x[j] * rstd * wv) * (1.f + s1) + s0;
                u32x2 w; w.x = cvt_pk_bf16(hm[j][0], hm[j][1]); w.y = cvt_pk_bf16(hm[j][2], hm[j][3]);
                *(u32x2*)(HMb + (size_t)r * DM + cidx) = w; }
            if (WGl) {
                float mine = 0.f;
#pragma unroll
                for (int h = 0; h < 8; ++h) { float d = 0.f;
#pragma unroll
                    for (int j = 0; j < 4; ++j) { const f32x4 wv = wg[h][j]; d += (hm[j][0] * wv[0] + hm[j][1] * wv[1]) + (hm[j][2] * wv[2] + hm[j][3] * wv[3]); }
                    d = wave_sum(d, lane); if (lane == h) mine = d; }
                if (lane < 8) { const float lf = logsig(mine + bfor[lane]);
                    if (prompt) out[O_LP + ((size_t)((lnext * 4 + (r >> 12)) * 8 + lane)) * 4096 + (r & 4095)] = lf;
                    else { const int rr = r - NPR; out[O_LS + ((size_t)((lnext * 8 + (rr >> 6)) * 8 + lane)) * 64 + (rr & 63)] = lf; } }
            }
        }
    }
}

__device__ __forceinline__ void vt_finalize(const Args& a, int l, int lane, int gwi, int nw) {
    const float* PV = (const float*)(a.ws + WS_F1); bf16_t* VTP = (bf16_t*)(a.ws + WS_VTP); bf16_t* VTS = (bf16_t*)(a.ws + WS_VTS);
    for (int it = gwi; it < 16 * 128; it += nw) {
        const int tile = it >> 7, rem = it & 127, hb = rem >> 5, to = rem & 31, hdl = hb * 64 + lane, pm = tile >> 3, pn = 58 + (tile & 7);
        const int hd = pm * 256 + hdl, h = hd >> 6, d = hd & 63, tok = pn * 256 + to * 8;
        f32x4 v0 = {0.f, 0.f, 0.f, 0.f}, v1 = {0.f, 0.f, 0.f, 0.f};
#pragma unroll
        for (int ks = 0; ks < 4; ++ks) { const float* p = PV + ((size_t)(tile * 4 + ks) * 256 + hdl) * 256 + to * 8; v0 = v0 + *(const f32x4*)p; v1 = v1 + *(const f32x4*)(p + 4); }
        const u32x4 w = pack8(v0, v1);
        if (pn < 64) { const int b = tok >> 12, t = tok & 4095;
            *(u32x4*)(VTP + ((size_t)(b * 8 + h) * 64 + d) * 4096 + t) = w;
            float* o = a.out + O_VP + ((size_t)((l * 4 + b) * 8 + h) * 4096 + t) * 64 + d;
#pragma unroll
            for (int j = 0; j < 4; ++j) { __builtin_nontemporal_store(v0[j], o + (size_t)j * 64); __builtin_nontemporal_store(v1[j], o + (size_t)(j + 4) * 64); } }
        else { const int tt = tok - NPR, b = tt >> 6, t = tt & 63;
            *(u32x4*)(VTS + ((size_t)(b * 8 + h) * 64 + d) * KVS + PAST + t) = w;
            float* o = a.out + O_VS + ((size_t)((l * 8 + b) * 8 + h) * 64 + t) * 64 + d;
#pragma unroll
            for (int j = 0; j < 4; ++j) { __builtin_nontemporal_store(v0[j], o + (size_t)j * 64); __builtin_nontemporal_store(v1[j], o + (size_t)(j + 4) * 64); } }
    }
}
__device__ __forceinline__ void cumsum_items(const Args& a, int l, LAS unsigned char* lds, int tid, int wave, int lane, int c, int G) {
    LAS float* wt = (LAS float*)(lds);
    for (int it = c - 64; it >= 0 && it < 96; it += G) {
        const bool prompt = it < 32;
        float v[8]; float run = 0.f; int i0, cnt;
        if (prompt) { i0 = tid * 8; cnt = 8;
            const float* src = a.out + O_LP + (size_t)(l * 32 + it) * 4096 + i0;
            const f32x4 p0 = *(const f32x4*)src, p1 = *(const f32x4*)(src + 4);
            v[0] = p0[0]; v[1] = p0[1]; v[2] = p0[2]; v[3] = p0[3]; v[4] = p1[0]; v[5] = p1[1]; v[6] = p1[2]; v[7] = p1[3]; }
        else { const int sq = it - 32; i0 = tid * 4; cnt = tid < 272 ? 4 : 0;
            const float* src = tid < 256 ? INP(6) + (size_t)(l * 64 + sq) * PAST + i0 : a.out + O_LS + (size_t)(l * 64 + sq) * 64 + (tid < 272 ? i0 - PAST : 0);
            const f32x4 p0 = *(const f32x4*)src;
            v[0] = p0[0]; v[1] = p0[1]; v[2] = p0[2]; v[3] = p0[3]; v[4] = 0.f; v[5] = 0.f; v[6] = 0.f; v[7] = 0.f;
            if (tid >= 272) { v[0] = 0.f; v[1] = 0.f; v[2] = 0.f; v[3] = 0.f; } }
#pragma unroll
        for (int j = 0; j < 8; ++j) { run += v[j]; v[j] = run; }
        float incl = run;
#pragma unroll
        for (int o = 1; o < 64; o <<= 1) { const float t = bperm(incl, lane >= o ? lane - o : lane); if (lane >= o) incl += t; }
        if (lane == 63) wt[wave] = incl;
        __syncthreads();
        float off = incl - run;
        for (int w = 0; w < wave; ++w) off += wt[w];
        float* dst = (prompt ? (float*)(a.ws + WS_BIASP) + (size_t)it * 4096 : (float*)(a.ws + WS_BIASS) + (size_t)(it - 32) * KVS) + i0;
        if (cnt == 8) { *(f32x4*)dst = (f32x4){-(off + v[0]) * LOG2E, -(off + v[1]) * LOG2E, -(off + v[2]) * LOG2E, -(off + v[3]) * LOG2E};
                        *(f32x4*)(dst + 4) = (f32x4){-(off + v[4]) * LOG2E, -(off + v[5]) * LOG2E, -(off + v[6]) * LOG2E, -(off + v[7]) * LOG2E}; }
        else if (cnt == 4) *(f32x4*)dst = (f32x4){-(off + v[0]) * LOG2E, -(off + v[1]) * LOG2E, -(off + v[2]) * LOG2E, -(off + v[3]) * LOG2E};
        __syncthreads();
    }
}

__device__ __forceinline__ void ssm_scan(const Args& a, int l, LAS unsigned char* lds, int wave, int lane, int c, int G) {
    const float* E = (const float*)(a.ws + WS_E); bf16_t* UA = (bf16_t*)(a.ws + WS_UA); const float* A16 = (const float*)(a.ws + WS_A16);
    LAS float* endst = (LAS float*)(lds);
    for (int it = c; it < 128; it += G) {
        const int b = it >> 5, gq = it & 31, p = lane;
        const float ar = A16[(l * 32 + gq) * 128 + p], ai = A16[(l * 32 + gq) * 128 + 64 + p];
        float er[32], ei[32];
        const int ch0 = b * 256 + wave * 32;
#pragma unroll
        for (int i = 0; i < 32; ++i) { const float* e = E + ((size_t)gq * CHP + ch0 + i) * 128; er[i] = e[p]; ei[i] = e[64 + p]; }
        float hr = 0.f, hi = 0.f;
#pragma unroll
        for (int i = 0; i < 32; ++i) { const float nr = ar * hr - ai * hi + er[i], ni = ar * hi + ai * hr + ei[i]; hr = nr; hi = ni; }
        endst[(wave * 2) * 64 + p] = hr; endst[(wave * 2 + 1) * 64 + p] = hi;
        float pr = ar, pi = ai;
#pragma unroll
        for (int s = 0; s < 5; ++s) { const float nr = pr * pr - pi * pi, ni = 2.f * pr * pi; pr = nr; pi = ni; }
        __syncthreads();
        hr = 0.f; hi = 0.f;
        for (int w = 0; w < wave; ++w) { const float xr = endst[(w * 2) * 64 + p], xi = endst[(w * 2 + 1) * 64 + p];
            const float nr = pr * hr - pi * hi + xr, ni = pr * hi + pi * hr + xi; hr = nr; hi = ni; }
#pragma unroll
        for (int i = 0; i < 32; ++i) { bf16_t* u = UA + ((size_t)gq * CHP + ch0 + i) * UAK + 256; u[p] = f2bf(hr); u[64 + p] = f2bf(hi);
            const float nr = ar * hr - ai * hi + er[i], ni = ar * hi + ai * hr + ei[i]; hr = nr; hi = ni; }
        if (wave == 7) { a.out[O_RP + (size_t)((l * 4 + b) * 32 + gq) * 64 + p] = hr; a.out[O_IP + (size_t)((l * 4 + b) * 32 + gq) * 64 + p] = hi; }
        __syncthreads();
    }
    for (int it = (G - 1 - c) * 8 + wave; it < 256; it += G * 8) {
        const int b = it >> 5, gq = it & 31, p = lane;
        const float ar = A16[(l * 32 + gq) * 128 + p], ai = A16[(l * 32 + gq) * 128 + 64 + p];
        float hr = INP(7)[(size_t)((l * 8 + b) * 32 + gq) * 64 + p], hi = INP(8)[(size_t)((l * 8 + b) * 32 + gq) * 64 + p];
        const int ch0 = 1024 + b * 4;
#pragma unroll
        for (int i = 0; i < 4; ++i) { const float* e = E + ((size_t)gq * CHP + ch0 + i) * 128; const float xr = e[p], xi = e[64 + p];
            bf16_t* u = UA + ((size_t)gq * CHP + ch0 + i) * UAK + 256; u[p] = f2bf(hr); u[64 + p] = f2bf(hi);
            const float nr = ar * hr - ai * hi + xr, ni = ar * hi + ai * hr + xi; hr = nr; hi = ni; }
        a.out[O_RS + (size_t)((l * 8 + b) * 32 + gq) * 64 + p] = hr; a.out[O_IS + (size_t)((l * 8 + b) * 32 + gq) * 64 + p] = hi;
    }
}

#define DPPMAX(v, ctrl) v = fmaxf(v, __int_as_float(__builtin_amdgcn_update_dpp(0, __float_as_int(v), ctrl, 0xF, 0xF, true)))
__device__ __forceinline__ float wave_max_nonneg(float v) {
    DPPMAX(v, 0xB1); DPPMAX(v, 0x4E); DPPMAX(v, 0x141); DPPMAX(v, 0x140);
    const float r0 = __int_as_float(__builtin_amdgcn_readlane(__float_as_int(v), 0)), r1 = __int_as_float(__builtin_amdgcn_readlane(__float_as_int(v), 16));
    const float r2 = __int_as_float(__builtin_amdgcn_readlane(__float_as_int(v), 32)), r3 = __int_as_float(__builtin_amdgcn_readlane(__float_as_int(v), 48));
    return fmaxf(fmaxf(r0, r1), fmaxf(r2, r3));
}
__device__ __forceinline__ void kmax_items(const Args& a, int lane, int gw, int NGW) {
    float* KM = (float*)(a.ws + WS_KMAX);
    for (int it = NGW - 1 - gw; it < 2048 + 1088; it += NGW) {
        const bf16_t* kp; int oidx;
        if (it < 2048) { const int bh = it >> 6, t = it & 63; kp = (const bf16_t*)(a.ws + WS_KP) + ((size_t)bh * 4096 + t * 64) * 64; oidx = it; }
        else { const int r = it - 2048, sq = r / 17, t = r - sq * 17; kp = (const bf16_t*)(a.ws + WS_KS) + ((size_t)sq * KVS + t * 64) * 64; oidx = (32 + sq) * 64 + t; }
        float ss = 0.f;
#pragma unroll
        for (int i = 0; i < 8; ++i) { const u32x4 w = *(const u32x4*)(kp + (size_t)lane * 64 + i * 8);
#pragma unroll
            for (int j = 0; j < 4; ++j) { const float lo = __uint_as_float(w[j] << 16), hi = __uint_as_float(w[j] & 0xffff0000u); ss += lo * lo + hi * hi; } }
        const float m = wave_max_nonneg(ss);
        if (lane == 0) KM[oidx] = sqrtf(m) * 1.001f;
    }
}
constexpr int AT_ROW = 144, AT_TILE = 64 * AT_ROW  , AT_KB = 0, AT_VB = 4 * AT_TILE, AT_BB = 8 * AT_TILE;
__device__ __forceinline__ void attn_tile(const LAS unsigned char* Kb, const LAS unsigned char* Vb, const LAS float* Bb, const bf16x8 (&qf)[4], f32x16& o0, f32x16& o1, float& lsum,
                                          float bq, int myq, int key0, bool domask, int ka_off, int va_off, int hi) {
    f32x16 s0, s1;
#pragma unroll
    for (int a2 = 0; a2 < 2; ++a2) { const f32x4 b0 = *(const LAS f32x4*)(Bb + a2 * 16 + hi * 8), b1 = *(const LAS f32x4*)(Bb + a2 * 16 + hi * 8 + 4);
        const f32x4 c0 = *(const LAS f32x4*)(Bb + 32 + a2 * 16 + hi * 8), c1 = *(const LAS f32x4*)(Bb + 32 + a2 * 16 + hi * 8 + 4);
#pragma unroll
        for (int j = 0; j < 4; ++j) { s0[a2 * 8 + j] = b0[j]; s0[a2 * 8 + 4 + j] = b1[j]; s1[a2 * 8 + j] = c0[j]; s1[a2 * 8 + 4 + j] = c1[j]; } }
    __builtin_amdgcn_s_setprio(1);
#pragma unroll
    for (int ks = 0; ks < 4; ++ks) {
        const bf16x8 k0 = *(const LAS bf16x8*)(Kb + ka_off + ks * 32), k1 = *(const LAS bf16x8*)(Kb + 32 * AT_ROW + ka_off + ks * 32);
        s0 = __builtin_amdgcn_mfma_f32_32x32x16_bf16(k0, qf[ks], s0, 0, 0, 0);
        s1 = __builtin_amdgcn_mfma_f32_32x32x16_bf16(k1, qf[ks], s1, 0, 0, 0);
    }
    __builtin_amdgcn_s_setprio(0);
    if (domask) {
#pragma unroll
        for (int r = 0; r < 16; ++r) { const int kj = key0 + 16 * (r >> 3) + 8 * hi + (r & 7);
            if (kj > myq) s0[r] = -INFINITY; if (kj + 32 > myq) s1[r] = -INFINITY; }
    }
    s0 = s0 - bq; s1 = s1 - bq;
#pragma unroll
    for (int r = 0; r < 16; ++r) { s0[r] = __builtin_amdgcn_exp2f(s0[r]); s1[r] = __builtin_amdgcn_exp2f(s1[r]); }
    { const f32x16 e = s0 + s1;
      const f32x8 e8 = __builtin_shufflevector(e, e, 0, 1, 2, 3, 4, 5, 6, 7) + __builtin_shufflevector(e, e, 8, 9, 10, 11, 12, 13, 14, 15);
      const f32x4 e4 = __builtin_shufflevector(e8, e8, 0, 1, 2, 3) + __builtin_shufflevector(e8, e8, 4, 5, 6, 7);
      lsum += (e4[0] + e4[1]) + (e4[2] + e4[3]); }
    bf16x8 pa[4];
#pragma unroll
    for (int a2 = 0; a2 < 2; ++a2) {
        u32x4 w0, w1;
        w0.x = cvt_pk_bf16(s0[a2 * 8 + 0], s0[a2 * 8 + 1]); w0.y = cvt_pk_bf16(s0[a2 * 8 + 2], s0[a2 * 8 + 3]); w0.z = cvt_pk_bf16(s0[a2 * 8 + 4], s0[a2 * 8 + 5]); w0.w = cvt_pk_bf16(s0[a2 * 8 + 6], s0[a2 * 8 + 7]);
        w1.x = cvt_pk_bf16(s1[a2 * 8 + 0], s1[a2 * 8 + 1]); w1.y = cvt_pk_bf16(s1[a2 * 8 + 2], s1[a2 * 8 + 3]); w1.z = cvt_pk_bf16(s1[a2 * 8 + 4], s1[a2 * 8 + 5]); w1.w = cvt_pk_bf16(s1[a2 * 8 + 6], s1[a2 * 8 + 7]);
        pa[a2] = __builtin_bit_cast(bf16x8, w0); pa[2 + a2] = __builtin_bit_cast(bf16x8, w1);
    }
    __builtin_amdgcn_s_setprio(1);
#pragma unroll
    for (int kk = 0; kk < 4; ++kk) {
        const bf16x8 v0 = *(const LAS bf16x8*)(Vb + va_off + kk * 32), v1 = *(const LAS bf16x8*)(Vb + 32 * AT_ROW + va_off + kk * 32);
        o0 = __builtin_amdgcn_mfma_f32_32x32x16_bf16(v0, pa[kk], o0, 0, 0, 0);
        o1 = __builtin_amdgcn_mfma_f32_32x32x16_bf16(v1, pa[kk], o1, 0, 0, 0);
    }
    __builtin_amdgcn_s_setprio(0);
}
__device__ __forceinline__ void attn_unit(LAS unsigned char* lds, const bf16_t* Qrow0, int h, int nrows, int qpos0, int NT,
                                          const bf16_t* Kp, const bf16_t* VTp, int vpitch, const float* biasp, const float* kmaxp, bf16_t* Orow0, int tid, int wave, int lane) {
    const int q = lane & 31, hi = lane >> 5;
    const bool active = wave * 32 < nrows;
    bf16x8 qf[4];
#pragma unroll
    for (int ks = 0; ks < 4; ++ks) qf[ks] = active ? *(const bf16x8*)(Qrow0 + (size_t)(wave * 32 + q) * 512 + h * 64 + ks * 16 + hi * 8) : (bf16x8){0, 0, 0, 0, 0, 0, 0, 0};
    f32x16 o0 = {}, o1 = {};
    float lsum = 0.f;
    const int myq = qpos0 + wave * 32 + q;
    const int wq_lo = qpos0 + wave * 32, wq_hi = wq_lo + 31;
    const float bq = active ? biasp[myq] : 0.f;
    const int NS = (NT + 1) >> 1;
    int s_first;
    { float ssq = 0.f;
#pragma unroll
      for (int ks = 0; ks < 4; ++ks)
#pragma unroll
          for (int e = 0; e < 8; ++e) { const float v = __uint_as_float(((unsigned)(unsigned short)qf[ks][e]) << 16); ssq += v * v; }
      ssq += bperm(ssq, lane ^ 32);
      const float wm = wave_max_nonneg(ssq);
      volatile LAS float* qm = (volatile LAS float*)(lds + 131072 + 512);
      volatile LAS int* tst = (volatile LAS int*)(lds + 131072 + 576);
      if (lane == 0) qm[wave] = wm;
      __syncthreads();
      if (wave == 0) {
          float m2 = 0.f;
#pragma unroll
          for (int w = 0; w < 8; ++w) m2 = fmaxf(m2, qm[w]);
          const float QN = sqrtf(m2) * 1.001f;
          bool fail = true;
          if (lane < NT) fail = !(QN * kmaxp[lane] + biasp[64 * lane + 63] - biasp[qpos0] < -160.f);
          const unsigned long long mask = __builtin_amdgcn_ballot_w64(fail);
          const int tfirst = mask ? (int)__builtin_ctzll(mask) : 0;
          if (lane == 0) tst[0] = tfirst >> 1;
      }
      __syncthreads();
      s_first = tst[0]; }
    const int krow = tid >> 3, kch = tid & 7;
    const bf16_t* kg = Kp + (size_t)tid * 8;
    const bf16_t* vg = VTp + (size_t)krow * vpitch + kch * 8;
    const int st_off = krow * AT_ROW + kch * 16;
    const int kap = (q & 19) | ((q & 4) << 1) | ((q & 8) >> 1);
    const int ka_off = kap * AT_ROW + hi * 16, va_off = q * AT_ROW + hi * 16;
    u32x4 kr0, kr1, vr0, vr1; f32x4 br = {0.f, 0.f, 0.f, 0.f};
    { const int tb = 2 * s_first; kr0 = *(const u32x4*)(kg + (size_t)tb * 4096); kr1 = *(const u32x4*)(kg + (size_t)(tb + 1) * 4096); vr0 = *(const u32x4*)(vg + tb * 64); vr1 = *(const u32x4*)(vg + (tb + 1) * 64); if (tid < 32) br = *(const f32x4*)(biasp + tb * 64 + tid * 4); }
    *(LAS u32x4*)(lds + AT_KB + st_off) = kr0; *(LAS u32x4*)(lds + AT_KB + AT_TILE + st_off) = kr1;
    *(LAS u32x4*)(lds + AT_VB + st_off) = vr0; *(LAS u32x4*)(lds + AT_VB + AT_TILE + st_off) = vr1; if (tid < 32) *(LAS f32x4*)(lds + AT_BB + tid * 16) = br;
    __syncthreads();
    for (int sidx = s_first; sidx < NS; ++sidx) {
        const int buf = (sidx - s_first) & 1, t0 = 2 * sidx;
        const bool more = sidx + 1 < NS;
        if (more) { kr0 = *(const u32x4*)(kg + (size_t)(t0 + 2) * 4096); kr1 = *(const u32x4*)(kg + (size_t)(t0 + 3) * 4096); vr0 = *(const u32x4*)(vg + (t0 + 2) * 64); vr1 = *(const u32x4*)(vg + (t0 + 3) * 64);
            if (tid < 32) br = *(const f32x4*)(biasp + (t0 + 2) * 64 + tid * 4); }
        if (active) {
            const LAS unsigned char* Kb = lds + AT_KB + buf * 2 * AT_TILE;
            const LAS unsigned char* Vb = lds + AT_VB + buf * 2 * AT_TILE;
            const LAS float* Bb = (const LAS float*)(lds + AT_BB + buf * 512);
            if (t0 * 64 <= wq_hi) attn_tile(Kb, Vb, Bb, qf, o0, o1, lsum, bq, myq, t0 * 64, t0 * 64 + 63 > wq_lo, ka_off, va_off, hi);
            if ((t0 + 1) * 64 <= wq_hi) attn_tile(Kb + AT_TILE, Vb + AT_TILE, Bb + 64, qf, o0, o1, lsum, bq, myq, (t0 + 1) * 64, (t0 + 1) * 64 + 63 > wq_lo, ka_off, va_off, hi);
        }
        if (more) { const int nb = buf ^ 1;
            *(LAS u32x4*)(lds + AT_KB + nb * 2 * AT_TILE + st_off) = kr0; *(LAS u32x4*)(lds + AT_KB + nb * 2 * AT_TILE + AT_TILE + st_off) = kr1;
            *(LAS u32x4*)(lds + AT_VB + nb * 2 * AT_TILE + st_off) = vr0; *(LAS u32x4*)(lds + AT_VB + nb * 2 * AT_TILE + AT_TILE + st_off) = vr1;
            if (tid < 32) *(LAS f32x4*)(lds + AT_BB + nb * 512 + tid * 16) = br; }
        __syncthreads();
    }
    if (active) {
        lsum += bperm(lsum, lane ^ 32);
        const float inv = 1.f / lsum;
        bf16_t* orow = Orow0 + (size_t)(wave * 32 + q) * 1024 + h * 64;
#pragma unroll
        for (int i = 0; i < 4; ++i) { u32x2 w0, w1;
            w0.x = cvt_pk_bf16(o0[4 * i] * inv, o0[4 * i + 1] * inv); w0.y = cvt_pk_bf16(o0[4 * i + 2] * inv, o0[4 * i + 3] * inv);
            w1.x = cvt_pk_bf16(o1[4 * i] * inv, o1[4 * i + 1] * inv); w1.y = cvt_pk_bf16(o1[4 * i + 2] * inv, o1[4 * i + 3] * inv);
            *(u32x2*)(orow + 8 * i + 4 * hi) = w0; *(u32x2*)(orow + 32 + 8 * i + 4 * hi) = w1; }
    }
}
__device__ __forceinline__ void attn_phase(const Args& a, int l, LAS unsigned char* lds, int tid, int wave, int lane) {
    const bf16_t* Q = (const bf16_t*)(a.ws + WS_Q); bf16_t* MIX = (bf16_t*)(a.ws + WS_MIX);
    unsigned* ctr = (unsigned*)(a.ws + WS_CTL) + 3600 + 64 * l;
    volatile LAS unsigned* slot = (volatile LAS unsigned*)(lds + 131072 + 256);
    for (;;) {
        if (tid == 0) slot[0] = __hip_atomic_fetch_add(ctr, 1u, __ATOMIC_RELAXED, __HIP_MEMORY_SCOPE_AGENT);
        __syncthreads();
        const int idx = (int)slot[0];
        __syncthreads();
        if (idx >= 576) break;
        if (idx < 512) { const int qb = 15 - (idx >> 5), bh = idx & 31, b = bh >> 3, h = bh & 7; const size_t row0 = (size_t)b * 4096 + qb * 256;
            attn_unit(lds, Q + row0 * 512, h, 256, qb * 256, 4 * qb + 4, (const bf16_t*)(a.ws + WS_KP) + (size_t)bh * 4096 * 64, (const bf16_t*)(a.ws + WS_VTP) + (size_t)bh * 64 * 4096, 4096,
                      (const float*)(a.ws + WS_BIASP) + (size_t)bh * 4096, (const float*)(a.ws + WS_KMAX) + bh * 64, MIX + row0 * 1024, tid, wave, lane); }
        else { const int sidx = idx - 512, b = sidx >> 3, h = sidx & 7;
            attn_unit(lds, Q + (size_t)(NPR + b * 64) * 512, h, 64, PAST, 17, (const bf16_t*)(a.ws + WS_KS) + (size_t)sidx * KVS * 64, (const bf16_t*)(a.ws + WS_VTS) + (size_t)sidx * 64 * KVS, KVS,
                      (const float*)(a.ws + WS_BIASS) + (size_t)sidx * KVS, (const float*)(a.ws + WS_KMAX) + (32 + sidx) * 64, MIX + (size_t)(NPR + b * 64) * 1024, tid, wave, lane); }
    }
}

#define XB_TMO      128
#define XB_XCNT(j)  (256  + 64 * (j))
#define XB_XSUB(j)  (1280 + 64 * (j))
#define XB_XGEN(j)  (2304 + 64 * (j))
#define XB_TOP      3328
#define XB_TOPGEN   3392
#define XCD_BAR_WORDS 3456
#define XB_SPIN_CAP (1u << 18)
__device__ __forceinline__ unsigned xb_ld(unsigned* p)              { return __hip_atomic_load(p, __ATOMIC_RELAXED, __HIP_MEMORY_SCOPE_AGENT); }
__device__ __forceinline__ unsigned xb_add(unsigned* p, unsigned v) { return __hip_atomic_fetch_add(p, v, __ATOMIC_RELAXED, __HIP_MEMORY_SCOPE_AGENT); }
__device__ __forceinline__ unsigned xb_xcc_id() { return (unsigned)__builtin_amdgcn_s_getreg((3 << 11) | 20) & 0xFu; }
#define XB_SPIN(cond, bar) do { unsigned _sp = 0; while (cond) { __builtin_amdgcn_s_sleep(1); \
    if ((++_sp & 255u) == 0u) { if (xb_ld(&(bar)[XB_TMO])) break; if (_sp > XB_SPIN_CAP) { atomicAdd(&(bar)[XB_TMO], 1u); break; } } } } while (0)
__device__ __forceinline__ void xcd_barrier_complete(unsigned* bar, unsigned x, unsigned G, unsigned& nloc, unsigned& nx) {
    unsigned sum, cnt, mine, sp = 0u;
    for (;;) {
        sum = 0u; cnt = 0u; mine = 0u;
#pragma unroll
        for (unsigned j = 0; j < 16; ++j) { const unsigned c = xb_ld(&bar[XB_XCNT(j)]); sum += c; cnt += (c > 0u) ? 1u : 0u; mine = (j == x) ? c : mine; }
        if (sum == G) break;
        __builtin_amdgcn_s_sleep(1);
        if ((++sp & 255u) == 0u) { if (xb_ld(&bar[XB_TMO])) break; if (sp > XB_SPIN_CAP) { atomicAdd(&bar[XB_TMO], 1u); break; } }
    }
    nloc = mine > 0u ? mine : 1u; nx = cnt > 0u ? cnt : 1u;
}
__device__ __forceinline__ void xcd_barrier(unsigned* bar, volatile LAS unsigned* st, bool leader, unsigned G) {
    asm volatile("s_waitcnt vmcnt(0)" ::: "memory");
    __syncthreads();
    if (leader) {
        const unsigned x = xb_xcc_id();
        __builtin_amdgcn_s_waitcnt(0);
        unsigned nloc = st[0], nx = st[1];
        if (nloc == 0u) { xcd_barrier_complete(bar, x, G, nloc, nx); st[0] = nloc; st[1] = nx; }
        const unsigned old = xb_add(&bar[XB_XSUB(x)], 1u);
        const unsigned gen = old / nloc;
        if (old + 1u == (gen + 1u) * nloc) {
            __builtin_amdgcn_fence(__ATOMIC_RELEASE, "agent");
            asm volatile("s_waitcnt vmcnt(0)" ::: "memory");
            const unsigned og = xb_add(&bar[XB_TOP], 1u);
            const unsigned tg = og / nx;
            if (og + 1u == (tg + 1u) * nx) xb_add(&bar[XB_TOPGEN], 1u);
            else XB_SPIN(xb_ld(&bar[XB_TOPGEN]) == tg, bar);
            __builtin_amdgcn_fence(__ATOMIC_ACQUIRE, "agent");
            xb_add(&bar[XB_XGEN(x)], 1u);
            asm volatile("s_waitcnt vmcnt(0)" ::: "memory");
        } else {
            XB_SPIN(xb_ld(&bar[XB_XGEN(x)]) == gen, bar);
            __builtin_amdgcn_fence(__ATOMIC_ACQUIRE, "agent");
            asm volatile("s_waitcnt vmcnt(0)" ::: "memory");
        }
    }
    __syncthreads();
}

constexpr int NS5 = 160, CW_SUB = 3520;
__device__ __forceinline__ void sub_barrier(unsigned* ctr, unsigned target, bool leader) {
    asm volatile("s_waitcnt vmcnt(0)" ::: "memory");
    __syncthreads();
    if (leader) {
        __builtin_amdgcn_fence(__ATOMIC_RELEASE, "agent");
        asm volatile("s_waitcnt vmcnt(0)" ::: "memory");
        (void)xb_add(ctr, 1u);
        unsigned sp = 0u;
        while (xb_ld(ctr) < target) { __builtin_amdgcn_s_sleep(1); if (++sp > (1u << 22)) break; }
        __builtin_amdgcn_fence(__ATOMIC_ACQUIRE, "agent");
        asm volatile("s_waitcnt vmcnt(0)" ::: "memory");
    }
    __syncthreads();
}
#undef INP
#define INP(i) (al.in[i])
typedef const __attribute__((address_space(4))) unsigned char* kptr_t;
__device__ __forceinline__ kptr_t opq_k(kptr_t p) { asm volatile("" : "+s"(p)); return p; }
__device__ __forceinline__ Args load_args(kptr_t kp) {
    typedef const __attribute__((address_space(4))) unsigned long long* q_t; q_t q = (q_t)kp; Args r;
    typedef __attribute__((address_space(1))) const float* gcf_t; typedef __attribute__((address_space(1))) float* gf_t; typedef __attribute__((address_space(1))) unsigned char* gu8_t;
#pragma unroll
    for (int i = 0; i < 30; ++i) r.in[i] = (const float*)(gcf_t)q[i];
    r.out = (float*)(gf_t)q[30]; r.ws = (unsigned char*)(gu8_t)q[31]; return r;
}
#define FRESH() const Args al = load_args(opq_k((kptr_t)__builtin_amdgcn_kernarg_segment_ptr())); unsigned char* ws = al.ws; \
    const int G = __builtin_amdgcn_readfirstlane(opq((int)gridDim.x)); const int NGW = G * 8; (void)NGW; \
    const int wave = __builtin_amdgcn_readfirstlane(opq(wave0)); const int c = __builtin_amdgcn_readfirstlane(opq((int)blockIdx.x)); const int gw = c * 8 + wave; \
    float* MOD = (float*)(ws + WS_MOD); float* X = (float*)(ws + WS_X); bf16_t* HM = (bf16_t*)(ws + WS_HM); bf16_t* F1 = (bf16_t*)(ws + WS_F1); bf16_t* MIX = (bf16_t*)(ws + WS_MIX); \
    (void)MOD; (void)X; (void)HM; (void)F1; (void)MIX; (void)gw;
#define LAYER_BODY(l) { \
        { FRESH(); PH(5) cumsum_items(al, l, lds, tid, wave, lane, c, G); } \
        PH(6) { FRESH(); pg8::Gemm g{HM, (const bf16_t*)(ws + WS_WIN) + (size_t)l * 1536 * 1024, MT, 1536, 1024, 1024, 1024, 1 << 20, 0, 512u, (const bf16_t*)(ws + WS_WV) + (size_t)l * 512 * 1024, HM}; \
          pg8::PhaseAOrder S; S.init(G, c); \
          EpiA E{EpiIn{(bf16_t*)(ws + WS_Q), (bf16_t*)(ws + WS_KP), (bf16_t*)(ws + WS_KS), (bf16_t*)(ws + WS_UA), al.out, l}, EpiVT{(bf16_t*)(ws + WS_VTP), (bf16_t*)(ws + WS_VTS), al.out, l, lds}, EpiVtPart{(float*)(ws + WS_F1)}}; \
          pg8::gemm_phase(lds, g, S, E, wave); } \
        GSYNC(); \
        { FRESH(); kmax_items(al, lane, gw, NGW); vt_finalize(al, l, lane, gw, NGW); } \
        GSYNC(); \
        if (INS5) { \
        PH(8) { FRESH(); pg8::Gemm g{(const bf16_t*)(ws + WS_UA), (const bf16_t*)(ws + WS_BT1) + (size_t)l * 32 * 128 * 256, NG * CHP, 256, 256, UAK, 256, 5, (size_t)128 * 256, 0u}; \
          pg8::StaticOrder S; S.init(NG * CHP, 256, NS5, c); \
          EpiE E{(float*)(ws + WS_E)}; \
          pg8::gemm_phase(lds, g, S, E, wave); } \
        SUBBAR((l) * 3 + 1); \
        { FRESH(); PH(9) ssm_scan(al, l, lds, wave, lane, c, NS5); } \
        SUBBAR((l) * 3 + 2); \
        PH(10) { FRESH(); pg8::Gemm g{(const bf16_t*)(ws + WS_UA), (const bf16_t*)(ws + WS_BT3) + (size_t)l * 32 * 256 * UAK, NG * CHP, 256, UAK, UAK, UAK, 5, (size_t)256 * UAK, 0u}; \
          pg8::StaticOrder S; S.init(NG * CHP, 256, NS5, c); \
          EpiZ E{(bf16_t*)(ws + WS_Z)}; \
          pg8::gemm_phase(lds, g, S, E, wave); } \
        SUBBAR((l) * 3 + 3); \
        PH(11) { FRESH(); pg8::Gemm g{(const bf16_t*)(ws + WS_Z), (const bf16_t*)(ws + WS_WGLU) + (size_t)l * 512 * 512, MT, 512, 512, 512, 512, 1 << 20, 0, 0u}; \
          pg8::StaticOrder S; S.init(MT, 512, NS5, c); \
          EpiGlu E{(const bf16_t*)(ws + WS_Z), MIX}; \
          pg8::gemm_phase(lds, g, S, E, wave); } \
        __syncthreads(); \
        } \
        { FRESH(); PH(12) attn_phase(al, l, lds, tid, wave, lane); } \
        GSYNC(); \
        PH(13) { FRESH(); pg8::Gemm g{MIX, (const bf16_t*)(ws + WS_WOUT) + (size_t)l * 1024 * 1024, MT, 1024, 1024, 1024, 1024, 1 << 20, 0, 256u}; \
          pg8::MainSplitOrder S; S.init(G, c, 8, 2); \
          EpiMS E{EpiPlain{F1, 1024}, EpiAtomic{(float*)(ws + WS_Q)}}; \
          pg8::gemm_phase(lds, g, S, E, wave); } \
        GSYNC(); \
        { FRESH(); const float* modl = MOD + (size_t)l * 12 * 6144; \
          PH(14) rowpass<8>(INP(0), INP(1), l == 0 ? (const bf16_t*)nullptr : (const bf16_t*)X, F1, (const float*)(ws + WS_Q), 8, modl + 2 * 1024, INP(12) + l * 1024, nullptr, (bf16_t*)X, \
                INP(13) + l * 1024, modl + 4 * 1024, modl + 3 * 1024, HM, nullptr, nullptr, al.out, 0, lane, gw, NGW); } \
        GSYNC(); \
        PH(15) { FRESH(); pg8::Gemm g{HM, (const bf16_t*)(ws + WS_WGU) + (size_t)l * 5632 * 1024, MT, 5632, 1024, 1024, 1024, 1 << 20, 0, 0u}; \
          pg8::StaticOrder S; S.init(MT, 5632, G, c); \
          EpiSwi E{(bf16_t*)(ws + WS_H)}; \
          pg8::gemm_phase(lds, g, S, E, wave); } \
        { FRESH(); if ((l) + 1 < NL && c >= 172) { __syncthreads(); p0_weights(al, (l) + 1, false, lds, wave, lane, (c - 172) * 8 + wave, (G - 172) * 8); } } \
        GSYNC(); \
        PH(16) { FRESH(); pg8::Gemm g{(const bf16_t*)(ws + WS_H), (const bf16_t*)(ws + WS_WD) + (size_t)l * 1024 * DFF, MT, 1024, DFF, DFF, DFF, 1 << 20, 0, 512u}; \
          pg8::MainSplitOrder S; S.init(G, c, 11, 4); \
          EpiMS E{EpiPlain{F1, 1024}, EpiAtomic{(float*)(ws + WS_FS2)}}; \
          pg8::gemm_phase(lds, g, S, E, wave); } \
        GSYNC(); \
        if (l + 1 < NL) { \
            { FRESH(); const float* modl = MOD + (size_t)l * 12 * 6144; const float* modn = MOD + (size_t)(l + 1) * 12 * 6144; \
              PH(17) rowpass<11>(INP(0), INP(1), (const bf16_t*)X, F1, (const float*)(ws + WS_FS2), 11, modl + 5 * 1024, INP(14) + l * 1024, nullptr, (bf16_t*)X, INP(11) + (l + 1) * 1024, modn + 1024, modn, HM, \
                    (const float*)(ws + WS_WG) + (size_t)(l + 1) * 8 * 1024, INP(16) + (l + 1) * 8, al.out, l + 1, lane, gw, NGW); \
              PH(1) cache_convert(al, l + 1, lds, wave, lane, gw, NGW); } \
            GSYNC(); \
        } else { \
            FRESH(); const float* modl = MOD + (size_t)l * 12 * 6144; \
            PH(18) rowpass<11>(INP(0), INP(1), (const bf16_t*)X, F1, (const float*)(ws + WS_FS2), 11, modl + 5 * 1024, INP(14) + l * 1024, al.out, nullptr, nullptr, nullptr, nullptr, nullptr, nullptr, nullptr, al.out, 0, lane, gw, NGW); \
        } \
    }
__global__ void __launch_bounds__(512, 2) mega(Args a) {
    extern __shared__ __attribute__((aligned(16))) unsigned char lds_raw[];
    LAS unsigned char* lds = (LAS unsigned char*)lds_raw;
    cg::grid_group grid = cg::this_grid();
    const int wave0 = __builtin_amdgcn_readfirstlane((int)threadIdx.x >> 6);
#define GSYNC() do { const Args alb = load_args(opq_k((kptr_t)__builtin_amdgcn_kernarg_segment_ptr())); \
        const int ln_ = (int)__builtin_amdgcn_mbcnt_hi(~0u, __builtin_amdgcn_mbcnt_lo(~0u, (unsigned)opq(0))); \
        xcd_barrier((unsigned*)(alb.ws + WS_CTL), (volatile LAS unsigned*)(lds + LDS_MISC), wave0 == 0 && ln_ == 0, (unsigned)gridDim.x); } while (0)
#define SUBBAR(seq) do { const Args alb = load_args(opq_k((kptr_t)__builtin_amdgcn_kernarg_segment_ptr())); \
        const int ln_ = (int)__builtin_amdgcn_mbcnt_hi(~0u, __builtin_amdgcn_mbcnt_lo(~0u, (unsigned)opq(0))); \
        xcd_barrier((unsigned*)(alb.ws + WS_CTL) + 4096, (volatile LAS unsigned*)(lds + LDS_MISC + 16), wave0 == 0 && ln_ == 0, (unsigned)NS5); } while (0)
#define INS5 (__builtin_amdgcn_readfirstlane(opq((int)blockIdx.x)) < NS5)
    if (threadIdx.x < 8) ((volatile LAS unsigned*)(lds + LDS_MISC))[threadIdx.x] = 0u;
    if (threadIdx.x == 0) (void)xb_add((unsigned*)(a.ws + WS_CTL) + XB_XCNT(xb_xcc_id()), 1u);
    if (threadIdx.x == 0 && blockIdx.x < NS5) (void)xb_add((unsigned*)(a.ws + WS_CTL) + 4096 + XB_XCNT(xb_xcc_id()), 1u);
    __syncthreads();
#define lane ((int)__builtin_amdgcn_mbcnt_hi(~0u, __builtin_amdgcn_mbcnt_lo(~0u, (unsigned)opq(0))))
#define tid (wave * 64 + lane)

    { FRESH();
      PH(0) p0_weights(al, 0, true, lds, wave, lane, gw, NGW);
      PH(1) cache_convert(al, 0, lds, wave, lane, gw, NGW);
      __syncthreads();
      PH(2) p0_adaln(al, lds, tid, wave, lane, c, G);
      PH(3) p0_ssm(al, lds, tid, (c + 128) % G, G); }
    grid.sync();
    { FRESH();
      PH(4) rowpass<0>(INP(0), INP(1), nullptr, nullptr, nullptr, 0, nullptr, nullptr, nullptr, nullptr, INP(11), MOD + 1024, MOD, HM, (const float*)(ws + WS_WG), INP(16), al.out, 0, lane, gw, NGW); }
    GSYNC();

    LAYER_BODY(0)
    LAYER_BODY(1)
    LAYER_BODY(2)
    LAYER_BODY(3)
}
#undef tid
#undef lane

extern "C" void kernel_launch(void* const* d_in, const int* in_sizes, int n_in, void* d_out, int out_size, void* d_ws, size_t ws_size, hipStream_t stream) {
    static int grid = 0;
    if (grid == 0) {
        if (n_in != 30 || (size_t)out_size != O_END || ws_size < WS_END) { fprintf(stderr, "kernel_launch: unexpected sizes n_in %d out %d ws %zu\n", n_in, out_size, ws_size); grid = -1; return; }
        int dev = 0, cus = 0, per_cu = 0;
        hipGetDevice(&dev); hipDeviceGetAttribute(&cus, hipDeviceAttributeMultiprocessorCount, dev);
        hipFuncSetAttribute((const void*)mega, hipFuncAttributeMaxDynamicSharedMemorySize, LDS_BYTES);
        hipOccupancyMaxActiveBlocksPerMultiprocessor(&per_cu, (const void*)mega, 512, LDS_BYTES);
        if (per_cu < 1) { fprintf(stderr, "kernel_launch: occupancy query reports %d blocks per CU\n", per_cu); grid = -1; return; }
        if (cus != 256) { fprintf(stderr, "kernel_launch: this build's static unit orders need 256 CUs (found %d)\n", cus); grid = -1; return; }
        grid = cus;
    }
    if (grid < 0) return;
    if (hipMemsetAsync((char*)d_ws + WS_CTL, 0, CTL_BYTES, stream) != hipSuccess) { fprintf(stderr, "kernel_launch: memset failed\n"); return; }
    Args a{};
    for (int i = 0; i < 30; ++i) a.in[i] = (const float*)d_in[i];
    a.out = (float*)d_out; a.ws = (unsigned char*)d_ws;
    void* args[] = {&a};
    hipError_t e = hipLaunchCooperativeKernel((const void*)mega, dim3(grid), dim3(512), args, LDS_BYTES, stream);
    if (e != hipSuccess) fprintf(stderr, "cooperative launch failed: %s (grid %d)\n", hipGetErrorString(e), grid);
}
```
